# Optimizing an MI355X kernel written in HIP

```python
import math
import jax
import jax.numpy as jnp
from jax import lax
import numpy as np

D_MODEL = 1024
BATCH = 8
SEQ = 2048
DEPTH = 1
DEC_BATCH = 128
DEC_SEQ = 8
PAST_LEN = 16384
PAGE_SIZE = 128

RWKV_WIDTH = D_MODEL // 2
RWKV_HEAD = 64
RWKV_HEADS = RWKV_WIDTH // RWKV_HEAD
RWKV_DECAY_LORA = 64
RWKV_A_LORA = 64
RWKV_GATE_LORA = 128
RWKV_LN_EPS = 1e-5 * RWKV_HEAD
GLA_HEADS = 4
GLA_KEY_WIDTH = D_MODEL // 4
GLA_VALUE_WIDTH = D_MODEL // 2
GLA_DK = GLA_KEY_WIDTH // GLA_HEADS
GLA_DV = GLA_VALUE_WIDTH // GLA_HEADS
GLA_GATE_LORA = 16
GLA_GATE_TEMP = 16.0
GLA_CHUNK = 32
FFN_HIDDEN = ((8 * D_MODEL // 3 + 127) // 128) * 128
CONV_WIDTH = 3
NORM_EPS = 1e-6
SHIFT_COLS = 3 * RWKV_WIDTH + RWKV_DECAY_LORA + RWKV_A_LORA + RWKV_GATE_LORA
GLA_COLS = 2 * GLA_KEY_WIDTH + 2 * GLA_VALUE_WIDTH + GLA_GATE_LORA
GATE_COLS = 2 * D_MODEL
IN_COLS = SHIFT_COLS + GLA_COLS + GATE_COLS

kernel_name = "hybrid_rwkv7_gla_convffn_step"


def _split(t, sizes):
    return jnp.split(t, [int(s) for s in np.cumsum(sizes)[:-1]], axis=-1)


def _rmsnorm(x, g):
    xf = x.astype(jnp.float32)
    y = xf * lax.rsqrt(jnp.mean(xf * xf, axis=-1, keepdims=True) + NORM_EPS)
    return (y * g.astype(jnp.float32)).astype(x.dtype)


def _rwkv7_recurrence(r, decay, k, v, a, b, S0):
    def step(S, inp):
        r_t, w_t, k_t, v_t, a_t, b_t = inp
        sa = jnp.einsum("bhvk,bhk->bhv", S, a_t)
        S = S * w_t[:, :, None, :] + sa[..., None] * b_t[:, :, None, :] + v_t[..., None] * k_t[:, :, None, :]
        return S, jnp.einsum("bhvk,bhk->bhv", S, r_t)
    xs = tuple(jnp.moveaxis(t.astype(jnp.float32), 1, 0) for t in (r, decay, k, v, a, b))
    S, o = lax.scan(step, S0.astype(jnp.float32), xs)
    return jnp.moveaxis(o, 0, 1), S


def _gla_chunked(q, k, v, log_a, S0):
    B, T, H, _ = q.shape
    dv = v.shape[-1]
    C = math.gcd(T, GLA_CHUNK)
    N = T // C

    def chunks(t):
        return jnp.moveaxis(t.astype(jnp.float32).reshape(B, N, C, H, t.shape[-1]), 1, 0)

    causal = jnp.tril(jnp.ones((C, C), dtype=bool))

    def step(S, inp):
        qc, kc, vc, gc = inp
        cum = jnp.cumsum(gc, axis=1)
        last = cum[:, -1]
        q_dec = qc * jnp.exp(cum)
        k_inv = kc * jnp.exp(-cum)
        scores = jnp.where(causal, jnp.einsum("bchd,bshd->bhcs", q_dec, k_inv), 0.0)
        o = jnp.einsum("bhcs,bshv->bchv", scores, vc) + jnp.einsum("bchd,bhdv->bchv", q_dec, S)
        k_end = kc * jnp.exp(last[:, None] - cum)
        S = jnp.exp(last)[..., None] * S + jnp.einsum("bshd,bshv->bhdv", k_end, vc)
        return S, o

    S, o = lax.scan(step, S0.astype(jnp.float32), (chunks(q), chunks(k), chunks(v), chunks(log_a)))
    return jnp.moveaxis(o, 0, 1).reshape(B, T, H, dv), S


def _mixer(h, shift_prev, wkv0, gla0, p, l):
    B, T, _ = h.shape
    f32 = jnp.float32
    proj = h @ p["w_in"][l]
    p_rw, p_gla, p_gate = _split(proj, [SHIFT_COLS, GLA_COLS, GATE_COLS])

    prev = jnp.concatenate([shift_prev[:, None].astype(p_rw.dtype), p_rw[:, :-1]], axis=1)
    xs = p_rw + (prev - p_rw) * p["mu_shift"][l]
    new_shift = p_rw[:, -1]
    r, k, v, lw, la, lg = _split(xs, [RWKV_WIDTH] * 3 + [RWKV_DECAY_LORA, RWKV_A_LORA, RWKV_GATE_LORA])
    w = -jax.nn.softplus(-(p["rwkv_w0"][l] + jnp.tanh(lw) @ p["rwkv_w2"][l]).astype(f32)) - 0.5
    decay = jnp.exp(-jnp.exp(w))
    a = jax.nn.sigmoid((p["rwkv_a0"][l] + la @ p["rwkv_a2"][l]).astype(f32))
    g = jax.nn.sigmoid(lg) @ p["rwkv_g2"][l]

    def heads(t):
        return t.reshape(B, T, RWKV_HEADS, RWKV_HEAD)

    rh = heads(r.astype(f32))
    vh = heads(v.astype(f32))
    ah = heads(a)
    kk = heads((k * p["rwkv_k_k"][l]).astype(f32))
    kk = kk / jnp.maximum(jnp.sqrt(jnp.sum(kk * kk, axis=-1, keepdims=True)), 1e-12)
    kh = heads(k.astype(f32) * (1.0 + (a - 1.0) * p["rwkv_k_a"][l].astype(f32)))
    o, wkv = _rwkv7_recurrence(rh, heads(decay), kh, vh, -kk, kk * ah, wkv0)
    mu = jnp.mean(o, axis=-1, keepdims=True)
    var = jnp.mean(jnp.square(o - mu), axis=-1, keepdims=True)
    o = ((o - mu) * lax.rsqrt(var + RWKV_LN_EPS)).reshape(B, T, RWKV_WIDTH)
    o = o * p["rwkv_ln_w"][l] + p["rwkv_ln_b"][l]
    bonus = jnp.sum(rh * kh * p["rwkv_r_k"][l].astype(f32), axis=-1, keepdims=True) * vh
    o = o + bonus.reshape(B, T, RWKV_WIDTH)
    y_a = (o.astype(h.dtype) * g) @ p["w_out_a"][l]

    q, kg, vg, lga, og = _split(p_gla, [GLA_KEY_WIDTH, GLA_KEY_WIDTH, GLA_VALUE_WIDTH, GLA_GATE_LORA, GLA_VALUE_WIDTH])
    log_a = jax.nn.log_sigmoid((lga @ p["gla_wg2"][l] + p["gla_bg"][l]).astype(f32)) / GLA_GATE_TEMP
    ob, gla_state = _gla_chunked(
        (q * GLA_DK ** -0.5).reshape(B, T, GLA_HEADS, GLA_DK),
        kg.reshape(B, T, GLA_HEADS, GLA_DK),
        vg.reshape(B, T, GLA_HEADS, GLA_DV),
        log_a.reshape(B, T, GLA_HEADS, GLA_DK),
        gla0)
    ob = ob * lax.rsqrt(jnp.mean(ob * ob, axis=-1, keepdims=True) + NORM_EPS) * p["gla_norm_w"][l]
    ob = ob.reshape(B, T, GLA_VALUE_WIDTH) * jax.nn.silu(og.astype(f32))
    y_b = ob.astype(h.dtype) @ p["w_out_b"][l]

    gate_a, gate_b = _split(p_gate, [D_MODEL, D_MODEL])
    merged = jax.nn.sigmoid(gate_a) * y_a + jax.nn.sigmoid(gate_b) * y_b
    return merged @ p["w_o"][l], new_shift, wkv.astype(wkv0.dtype), gla_state.astype(gla0.dtype)


def _conv_ffn(h, conv_prev, p, l):
    T = h.shape[1]
    u = h @ p["ffn_w_up"][l]
    ext = jnp.concatenate([conv_prev.astype(u.dtype), u], axis=1)
    w = p["ffn_conv_w"][l]
    c = p["ffn_conv_b"][l] + w[0] * ext[:, 0:T]
    for j in range(1, CONV_WIDTH):
        c = c + w[j] * ext[:, j:j + T]
    val, gate = _split(c, [FFN_HIDDEN, FFN_HIDDEN])
    y = (jax.nn.gelu(gate) * val) @ p["ffn_w_down"][l]
    return y, ext[:, -(CONV_WIDTH - 1):]


def _trunk(x, shift0, wkv0, gla0, conv0, p):
    s_shift, s_wkv, s_gla, s_conv = [], [], [], []
    for l in range(DEPTH):
        y, n_shift, n_wkv, n_gla = _mixer(_rmsnorm(x, p["norm_mix"][l]), shift0[l], wkv0[l], gla0[l], p, l)
        x = x + y
        y, n_conv = _conv_ffn(_rmsnorm(x, p["norm_ffn"][l]), conv0[l], p, l)
        x = x + y
        s_shift.append(n_shift)
        s_wkv.append(n_wkv)
        s_gla.append(n_gla)
        s_conv.append(n_conv)
    return (_rmsnorm(x, p["norm_final"]), jnp.stack(s_shift), jnp.stack(s_wkv),
            jnp.stack(s_gla), jnp.stack(s_conv))


def setup_inputs(seed: int = 0) -> dict:
    key = jax.random.key(seed)
    ks = iter(jax.random.split(key, 40))

    def nrm(shape, scale):
        return scale * jax.random.normal(next(ks), shape, jnp.float32)

    def unif(shape, lo, hi):
        return jax.random.uniform(next(ks), shape, jnp.float32, lo, hi)

    L = DEPTH
    F2 = 2 * FFN_HIDDEN
    return {
        "x_prompt": nrm((BATCH, SEQ, D_MODEL), 1.0),
        "x_sample": nrm((DEC_BATCH, DEC_SEQ, D_MODEL), 1.0),
        "state_rwkv_shift": nrm((L, DEC_BATCH, SHIFT_COLS), 1.0),
        "state_rwkv_wkv": nrm((L, DEC_BATCH, RWKV_HEADS, RWKV_HEAD, RWKV_HEAD), 0.3),
        "state_gla": nrm((L, DEC_BATCH, GLA_HEADS, GLA_DK, GLA_DV), 0.3),
        "state_ffn_conv": nrm((L, DEC_BATCH, CONV_WIDTH - 1, F2), 1.0),
        "norm_mix": 1.0 + nrm((L, D_MODEL), 0.05),
        "w_in": nrm((L, D_MODEL, IN_COLS), D_MODEL ** -0.5),
        "mu_shift": unif((L, SHIFT_COLS), 0.0, 1.0),
        "rwkv_w0": unif((L, RWKV_WIDTH), -4.0, 0.0),
        "rwkv_w2": nrm((L, RWKV_DECAY_LORA, RWKV_WIDTH), 0.5 * RWKV_DECAY_LORA ** -0.5),
        "rwkv_a0": nrm((L, RWKV_WIDTH), 0.1),
        "rwkv_a2": nrm((L, RWKV_A_LORA, RWKV_WIDTH), RWKV_A_LORA ** -0.5),
        "rwkv_g2": nrm((L, RWKV_GATE_LORA, RWKV_WIDTH), RWKV_GATE_LORA ** -0.5),
        "rwkv_k_k": 0.85 + nrm((L, RWKV_WIDTH), 0.05),
        "rwkv_k_a": 1.0 + nrm((L, RWKV_WIDTH), 0.05),
        "rwkv_r_k": nrm((L, RWKV_HEADS, RWKV_HEAD), 0.1),
        "rwkv_ln_w": 1.0 + nrm((L, RWKV_WIDTH), 0.05),
        "rwkv_ln_b": nrm((L, RWKV_WIDTH), 0.02),
        "gla_wg2": nrm((L, GLA_GATE_LORA, GLA_KEY_WIDTH), GLA_GATE_LORA ** -0.5),
        "gla_bg": 1.0 + nrm((L, GLA_KEY_WIDTH), 0.5),
        "gla_norm_w": 1.0 + nrm((L, GLA_DV), 0.05),
        "w_out_a": nrm((L, RWKV_WIDTH, D_MODEL), RWKV_WIDTH ** -0.5),
        "w_out_b": nrm((L, GLA_VALUE_WIDTH, D_MODEL), GLA_VALUE_WIDTH ** -0.5),
        "w_o": nrm((L, D_MODEL, D_MODEL), D_MODEL ** -0.5),
        "norm_ffn": 1.0 + nrm((L, D_MODEL), 0.05),
        "ffn_w_up": nrm((L, D_MODEL, F2), D_MODEL ** -0.5),
        "ffn_conv_w": nrm((L, CONV_WIDTH, F2), CONV_WIDTH ** -0.5),
        "ffn_conv_b": nrm((L, F2), 0.02),
        "ffn_w_down": nrm((L, FFN_HIDDEN, D_MODEL), FFN_HIDDEN ** -0.5),
        "norm_final": 1.0 + nrm((D_MODEL,), 0.05),
    }


def reference(x_prompt, x_sample, state_rwkv_shift, state_rwkv_wkv, state_gla, state_ffn_conv,
              norm_mix, w_in, mu_shift, rwkv_w0, rwkv_w2, rwkv_a0, rwkv_a2, rwkv_g2,
              rwkv_k_k, rwkv_k_a, rwkv_r_k, rwkv_ln_w, rwkv_ln_b, gla_wg2, gla_bg, gla_norm_w,
              w_out_a, w_out_b, w_o, norm_ffn, ffn_w_up, ffn_conv_w, ffn_conv_b, ffn_w_down,
              norm_final):
    params = dict(norm_mix=norm_mix, w_in=w_in, mu_shift=mu_shift, rwkv_w0=rwkv_w0,
                  rwkv_w2=rwkv_w2, rwkv_a0=rwkv_a0, rwkv_a2=rwkv_a2, rwkv_g2=rwkv_g2,
                  rwkv_k_k=rwkv_k_k, rwkv_k_a=rwkv_k_a, rwkv_r_k=rwkv_r_k, rwkv_ln_w=rwkv_ln_w,
                  rwkv_ln_b=rwkv_ln_b, gla_wg2=gla_wg2, gla_bg=gla_bg, gla_norm_w=gla_norm_w,
                  w_out_a=w_out_a, w_out_b=w_out_b, w_o=w_o, norm_ffn=norm_ffn,
                  ffn_w_up=ffn_w_up, ffn_conv_w=ffn_conv_w, ffn_conv_b=ffn_conv_b,
                  ffn_w_down=ffn_w_down, norm_final=norm_final)
    bp = x_prompt.shape[0]
    dt = x_prompt.dtype
    zero_shift = jnp.zeros((DEPTH, bp, SHIFT_COLS), dt)
    zero_wkv = jnp.zeros((DEPTH, bp, RWKV_HEADS, RWKV_HEAD, RWKV_HEAD), dt)
    zero_gla = jnp.zeros((DEPTH, bp, GLA_HEADS, GLA_DK, GLA_DV), dt)
    zero_conv = jnp.zeros((DEPTH, bp, CONV_WIDTH - 1, 2 * FFN_HIDDEN), dt)
    y_p, shift_p, wkv_p, gla_p, conv_p = _trunk(x_prompt, zero_shift, zero_wkv, zero_gla, zero_conv, params)
    y_s, shift_s, wkv_s, gla_s, conv_s = _trunk(x_sample, state_rwkv_shift, state_rwkv_wkv, state_gla,
                                                state_ffn_conv, params)
    return (y_p, y_s, shift_p, wkv_p, gla_p, conv_p, shift_s, wkv_s, gla_s, conv_s)
```

```cpp
#include <hip/hip_runtime.h>
#include <hip/hip_cooperative_groups.h>
#include <cstdio>
#include <cstdint>
namespace cg = cooperative_groups;
#define PHREP 0
namespace pg8 {
#define PG8_LAS __attribute__((address_space(3)))
typedef unsigned short bf16_t;
typedef short bf16x8 __attribute__((ext_vector_type(8)));
typedef float f32x4 __attribute__((ext_vector_type(4)));
typedef unsigned u32x4 __attribute__((ext_vector_type(4)));
constexpr int BM = 256, BK = 64, HALF = 128, HTB = HALF * BK * 2  , STAGE_BYTES = 8 * HTB, NXCD = 8, WGM = 8;

__host__ __device__ __forceinline__ int lds_byte(int r, int c) { const int st = (r >> 4) * 2 + (c >> 5), rr = r & 15, cc = c & 31, ob = rr * 64 + cc * 2; return st * 1024 + (ob ^ (((ob >> 9) & 1) << 5)); }
__host__ __device__ __forceinline__ void stage_rc(int b, int& R, int& C) { const int st = b / 1024, sb = b % 1024, swz = sb ^ (((sb >> 9) & 1) << 5); R = (st >> 1) * 16 + swz / 64; C = (st & 1) * 32 + (swz % 64) / 2; }
__host__ __device__ __forceinline__ int perm32(int rho) { const int n = rho >> 4, i = rho & 15; return 8 * (i >> 2) + 4 * n + (i & 3); }

struct Unit { int pm, pn; };
struct Gemm { const bf16_t* A; const bf16_t* Bt; int M, N, K, lda; };

struct StaticOrder {
    int nM, nN, nwg, G, c;
    int limit;
    __host__ __device__ void init(int M, int N, int G_, int c_) { nM = M / BM; nN = N / BM; nwg = nM * nN; G = G_; c = c_; limit = nwg; }
    __host__ __device__ bool next(int i, Unit& u) const {
        const int L = i * G + c; if (L >= limit) return false;
        unit_of(L, u); return true;
    }
    __host__ __device__ void unit_of(int L, Unit& u) const {
        int wgid = L; { const int q = nwg / NXCD, r = nwg % NXCD, xcd = wgid % NXCD, off = wgid / NXCD; wgid = (xcd < r ? xcd * (q + 1) : r * (q + 1) + (xcd - r) * q) + off; }
        const int nig = WGM * nN, gid = wgid / nig, fm = gid * WGM, gsz = (nM - fm) < WGM ? (nM - fm) : WGM;
        u.pm = fm + ((wgid % nig) % gsz); u.pn = (wgid % nig) / gsz;
    }
    __device__ __forceinline__ void a_ready(const Unit&) const {}
    __device__ __forceinline__ void done(const Unit&) const {}
};
__device__ __forceinline__ unsigned cvt_pk_bf16(float lo, float hi) { unsigned r; asm volatile("v_cvt_pk_bf16_f32 %0, %1, %2" : "=v"(r) : "v"(lo), "v"(hi)); return r; }
typedef float f32x2 __attribute__((ext_vector_type(2)));
template <class Epi, class Sched, bool ALIGN_EPI = false, bool SP2 = false>
__device__ __forceinline__ void gemm_phase(PG8_LAS unsigned char* lds, const Gemm g, const Sched& S, const Epi& E) {
    int tid_ = threadIdx.x; asm volatile("" : "+v"(tid_));
    const int tid = tid_, wid = __builtin_amdgcn_readfirstlane(tid >> 6), lane = tid & 63, wr = wid >> 2, wc = wid & 3, fr = lane & 15, fq = lane >> 4;
    const int K = g.K, nt = K / BK;
    unsigned voffA[2], voffB[2];
#pragma unroll
    for (int i = 0; i < 2; ++i) { int R, C; stage_rc(tid * 16 + i * 8192, R, C); const int Rb = Epi::PERM ? ((R & ~31) + perm32(R & 31)) : R;
        voffA[i] = (unsigned)(R * g.lda + C) * 2u; voffB[i] = (unsigned)(Rb * K + C) * 2u; }
    const size_t kstep = (size_t)(BK * 2);
    const size_t hstep = (size_t)HALF * K * 2;
    const size_t tstep = 2 * hstep;
    const size_t hstepA = (size_t)HALF * g.lda * 2, tstepA = 2 * hstepA;
    const unsigned ldsw = (unsigned)wid * 1024u;
    const int aoff = lds_byte(wr * 64 + fr, fq * 8), boff = lds_byte(wc * 32 + fr, fq * 8);
#define PG8_SA(b, h) (((b) * 2 + (h)) * HTB)
#define PG8_SB(b, h) ((4 + (b) * 2 + (h)) * HTB)
#define PG8_STAGE(bufoff, gbase, voff) do { _Pragma("unroll") for (int _i = 0; _i < 2; ++_i) \
        __builtin_amdgcn_global_load_lds((const unsigned*)((const char*)(gbase) + (voff)[_i]), (PG8_LAS unsigned*)(lds + (bufoff) + ldsw + _i * 8192), 16, 0, 0); } while (0)
#define PG8_LDA(dst, b, h) do { _Pragma("unroll") for (int m = 0; m < 4; ++m) _Pragma("unroll") for (int k = 0; k < 2; ++k) dst[m][k] = *(const PG8_LAS bf16x8*)(lds + PG8_SA(b, h) + aoff + m * 2048 + k * 1024); } while (0)
#define PG8_LDB(dst, b, h) do { _Pragma("unroll") for (int n = 0; n < 2; ++n) _Pragma("unroll") for (int k = 0; k < 2; ++k) dst[n][k] = *(const PG8_LAS bf16x8*)(lds + PG8_SB(b, h) + boff + n * 2048 + k * 1024); } while (0)
#define PG8_MMA(ai, bj, At, Bt) do { __builtin_amdgcn_s_setprio(1); _Pragma("unroll") for (int m = 0; m < 4; ++m) _Pragma("unroll") for (int n = 0; n < 2; ++n) _Pragma("unroll") for (int k = 0; k < 2; ++k) \
        acc[ai][bj][m][n] = __builtin_amdgcn_mfma_f32_16x16x32_bf16(Bt[n][k], At[m][k], acc[ai][bj][m][n], 0, 0, 0); __builtin_amdgcn_s_setprio(0); } while (0)
#define PG8_WAIT_V(n) asm volatile("s_waitcnt vmcnt(" #n ")" ::: "memory")
#define PG8_WAIT_L(n) asm volatile("s_waitcnt lgkmcnt(" #n ")" ::: "memory")
#define PG8_BAR __builtin_amdgcn_s_barrier()
#define PG8_SCHED __builtin_amdgcn_sched_barrier(0)
    Unit cur, nxt; int ui = 0;
    if (!S.next(0, cur)) return;
    f32x4 acc[2][2][4][2];
#pragma unroll
    for (int a = 0; a < 2; ++a)
#pragma unroll
        for (int b = 0; b < 2; ++b)
#pragma unroll
            for (int m = 0; m < 4; ++m)
#pragma unroll
                for (int n = 0; n < 2; ++n) acc[a][b][m][n] = (f32x4){0.f, 0.f, 0.f, 0.f};
    bf16x8 At[4][2], B0[2][2], B1[2][2];
    const char* cA = (const char*)g.A + (size_t)cur.pm * tstepA; const char* cB = (const char*)g.Bt + (size_t)cur.pn * tstep;
    S.a_ready(cur);
    if constexpr (SP2) {
        PG8_STAGE(PG8_SB(0, 0), cB, voffB); PG8_STAGE(PG8_SB(0, 1), cB + hstep, voffB); PG8_STAGE(PG8_SA(0, 0), cA, voffA); PG8_STAGE(PG8_SA(0, 1), cA + hstepA, voffA);
        if (wr == 1) PG8_BAR;
        PG8_WAIT_V(2); PG8_BAR;
        PG8_STAGE(PG8_SB(1, 0), cB + kstep, voffB); PG8_STAGE(PG8_SA(1, 0), cA + kstep, voffA); PG8_STAGE(PG8_SB(1, 1), cB + hstep + kstep, voffB);
        PG8_WAIT_V(6); PG8_BAR;
    } else {
        PG8_STAGE(PG8_SB(0, 0), cB, voffB); PG8_STAGE(PG8_SA(0, 0), cA, voffA); PG8_STAGE(PG8_SB(0, 1), cB + hstep, voffB); PG8_STAGE(PG8_SA(0, 1), cA + hstepA, voffA);
        if (wr == 1) PG8_BAR;
        PG8_WAIT_V(4); PG8_BAR;
        PG8_STAGE(PG8_SB(1, 0), cB + kstep, voffB); PG8_STAGE(PG8_SA(1, 0), cA + kstep, voffA); PG8_STAGE(PG8_SB(1, 1), cB + hstep + kstep, voffB);
        PG8_WAIT_V(6); PG8_BAR;
    }
    for (;;) {
        const bool has_next = S.next(ui + 1, nxt);
        const char* nA = has_next ? (const char*)g.A + (size_t)nxt.pm * tstepA : cA; const char* nB = has_next ? (const char*)g.Bt + (size_t)nxt.pn * tstep : cB;
        for (int t = 0; t < nt; t += 2) {
            const bool last = (t == nt - 2);
            const char* a1 = cA + (size_t)(t + 1) * kstep;
            const char* a2 = last ? nA : cA + (size_t)(t + 2) * kstep; const char* b2 = last ? nB : cB + (size_t)(t + 2) * kstep;
            const char* a3 = a2 + kstep; const char* b3 = b2 + kstep;
            if (last && has_next) S.a_ready(nxt);
            if constexpr (SP2) {
            PG8_LDB(B0, 0, 0); PG8_LDB(B1, 0, 1); PG8_SCHED; PG8_LDA(At, 0, 0); PG8_STAGE(PG8_SA(1, 1), a1 + hstepA, voffA);
            PG8_WAIT_V(8); PG8_WAIT_L(0); PG8_BAR; PG8_MMA(0, 0, At, B0); PG8_MMA(0, 1, At, B1); PG8_BAR; PG8_SCHED;
            PG8_LDA(At, 0, 1); PG8_STAGE(PG8_SB(0, 0), b2, voffB); PG8_STAGE(PG8_SB(0, 1), b2 + hstep, voffB); PG8_STAGE(PG8_SA(0, 0), a2, voffA);
            PG8_WAIT_V(8); PG8_WAIT_L(0); PG8_BAR; PG8_MMA(1, 0, At, B0); PG8_MMA(1, 1, At, B1); PG8_BAR; PG8_SCHED;
            PG8_LDB(B0, 1, 0); PG8_LDB(B1, 1, 1); PG8_SCHED; PG8_LDA(At, 1, 0); PG8_STAGE(PG8_SA(0, 1), a2 + hstepA, voffA);
            PG8_WAIT_V(8); PG8_WAIT_L(0); PG8_BAR; PG8_MMA(0, 0, At, B0); PG8_MMA(0, 1, At, B1); PG8_BAR; PG8_SCHED;
            PG8_LDA(At, 1, 1); PG8_STAGE(PG8_SB(1, 0), b3, voffB); PG8_STAGE(PG8_SB(1, 1), b3 + hstep, voffB); PG8_STAGE(PG8_SA(1, 0), a3, voffA);
            PG8_WAIT_V(8); PG8_WAIT_L(0); PG8_BAR; PG8_MMA(1, 0, At, B0); PG8_MMA(1, 1, At, B1); PG8_BAR; PG8_SCHED;
            } else {
            PG8_LDB(B0, 0, 0); PG8_SCHED; PG8_LDA(At, 0, 0); PG8_STAGE(PG8_SA(1, 1), a1 + hstepA, voffA);
            PG8_WAIT_L(8); PG8_BAR; PG8_WAIT_L(0); PG8_MMA(0, 0, At, B0); PG8_BAR; PG8_SCHED;
            PG8_LDB(B1, 0, 1); PG8_STAGE(PG8_SB(0, 0), b2, voffB);
            PG8_BAR; PG8_WAIT_L(0); PG8_MMA(0, 1, At, B1); PG8_BAR;
            PG8_LDA(At, 0, 1); PG8_STAGE(PG8_SA(0, 0), a2, voffA);
            PG8_BAR; PG8_WAIT_L(0); PG8_MMA(1, 0, At, B0); PG8_BAR; PG8_SCHED;
            PG8_STAGE(PG8_SB(0, 1), b2 + hstep, voffB);
            PG8_WAIT_V(6); PG8_BAR; PG8_MMA(1, 1, At, B1); PG8_BAR;
            PG8_LDB(B0, 1, 0); PG8_SCHED; PG8_LDA(At, 1, 0); PG8_STAGE(PG8_SA(0, 1), a2 + hstepA, voffA);
            PG8_WAIT_L(8); PG8_BAR; PG8_WAIT_L(0); PG8_MMA(0, 0, At, B0); PG8_BAR; PG8_SCHED;
            PG8_LDB(B1, 1, 1); PG8_STAGE(PG8_SB(1, 0), b3, voffB);
            PG8_BAR; PG8_WAIT_L(0); PG8_MMA(0, 1, At, B1); PG8_BAR;
            PG8_LDA(At, 1, 1); PG8_STAGE(PG8_SA(1, 0), a3, voffA);
            PG8_BAR; PG8_WAIT_L(0); PG8_MMA(1, 0, At, B0); PG8_BAR; PG8_SCHED;
            PG8_STAGE(PG8_SB(1, 1), b3 + hstep, voffB);
            PG8_WAIT_V(6); PG8_BAR; PG8_MMA(1, 1, At, B1); PG8_BAR;
            }
        }
        if constexpr (ALIGN_EPI) { if (wr == 0) PG8_BAR; }
        if constexpr (!Epi::AFTER_DRAIN) { E(acc, cur, wr, wc, fr, fq); S.done(cur); }
        if (!has_next) break;
#pragma unroll
        for (int a = 0; a < 2; ++a)
#pragma unroll
            for (int b = 0; b < 2; ++b)
#pragma unroll
                for (int m = 0; m < 4; ++m)
#pragma unroll
                    for (int n = 0; n < 2; ++n) acc[a][b][m][n] = (f32x4){0.f, 0.f, 0.f, 0.f};
        cur = nxt; cA = nA; cB = nB; ++ui;
        if constexpr (ALIGN_EPI) { if (wr == 1) PG8_BAR; }
    }
    PG8_WAIT_V(0);
    if constexpr (!ALIGN_EPI) { if (wr == 0) PG8_BAR; }
    PG8_BAR;
    if constexpr (Epi::AFTER_DRAIN) { E.fused(acc, cur, wr, wc, fr, fq, lds, wid, lane); S.done(cur); }
#undef PG8_SA
#undef PG8_SB
#undef PG8_STAGE
#undef PG8_LDA
#undef PG8_LDB
#undef PG8_MMA
#undef PG8_WAIT_V
#undef PG8_WAIT_L
#undef PG8_BAR
#undef PG8_SCHED
}
}

#define LAS __attribute__((address_space(3)))
typedef unsigned short bf16_t;
typedef short bf16x8 __attribute__((ext_vector_type(8)));
typedef float f32x4 __attribute__((ext_vector_type(4)));
typedef unsigned u32x4 __attribute__((ext_vector_type(4)));
typedef unsigned u32x2 __attribute__((ext_vector_type(2)));
using pg8::Unit;

constexpr int M = 17408, MP = 16384, DM = 1024;
constexpr int NPRW = 1792, NPGLA = 1792, NGATE = 2048, NIN = 5632;
constexpr int FF = 2816, F2 = 5632;
constexpr float NORM_EPS = 1e-6f;
constexpr int NWAVES = 8, NTHREADS = 512;
constexpr int LDS_BYTES = 131072 + 32768;
constexpr size_t OFF_BAR = 512 * 1024;

constexpr size_t MiB = 1u << 20;
constexpr size_t OFF_ROWSS = 0;
constexpr size_t OFF_WIN = 1 * MiB, OFF_WUP = 12 * MiB, OFF_WDN = 23 * MiB, OFF_WO = 29 * MiB, OFF_WOA = 31 * MiB, OFF_WOB = 32 * MiB;
constexpr size_t OFF_W2T = 33 * MiB, OFF_A2T = OFF_W2T + 65536, OFF_G2T = OFF_A2T + 65536;
constexpr size_t OFF_PRW = 35 * MiB, OFF_PGLA = 95 * MiB, OFF_PGATE = 155 * MiB, OFF_G = 223 * MiB;
constexpr size_t OFF_MERGED = OFF_PRW, OFF_UH = OFF_WIN, OFF_X1B = 222 * MiB, OFF_U = OFF_PRW, OFF_ACT = OFF_PRW, OFF_US = 29 * MiB;
static_assert(OFF_PRW + (size_t)M * NPRW * 2 <= OFF_PGLA && OFF_PGLA + (size_t)M * NPGLA * 2 <= OFF_PGATE && OFF_PGATE + (size_t)M * NGATE * 2 <= OFF_G, "ws map");
static_assert(OFF_G + (size_t)M * 512 * 2 <= 256 * MiB && OFF_U + (size_t)M * F2 * 2 <= OFF_X1B && OFF_X1B + (size_t)M * DM * 2 <= 256 * MiB, "ws map");
static_assert(OFF_UH + (size_t)256 * 4 * F2 * 2 <= OFF_WUP && OFF_ACT + (size_t)M * FF * 2 <= OFF_X1B, "ws map");

constexpr size_t OUT_SHIFT_P = (size_t)M * DM, OUT_WKV_P = OUT_SHIFT_P + 8 * 1792, OUT_GLA_P = OUT_WKV_P + 8 * 8 * 64 * 64, OUT_CONV_P = OUT_GLA_P + 8 * 4 * 64 * 128;
constexpr size_t OUT_SHIFT_S = OUT_CONV_P + 8 * 2 * F2, OUT_WKV_S = OUT_SHIFT_S + 128 * 1792, OUT_GLA_S = OUT_WKV_S + (size_t)128 * 8 * 64 * 64, OUT_CONV_S = OUT_GLA_S + (size_t)128 * 4 * 64 * 128;
constexpr size_t OUTB_H = 0, OUTB_EW = 0, OUTB_AARR = (size_t)M * 512 * 2, OUTB_ORW = (size_t)M * 1024 * 2, OUTB_OGL = OUTB_ORW + (size_t)M * 512 * 2;

struct Args { const float* in[31]; float* out; unsigned char* ws; };
#define IN_XP 0
#define IN_XS 1
#define IN_ST_SHIFT 2
#define IN_ST_WKV 3
#define IN_ST_GLA 4
#define IN_ST_CONV 5
#define IN_NORM_MIX 6
#define IN_W_IN 7
#define IN_MU 8
#define IN_W0 9
#define IN_W2 10
#define IN_A0 11
#define IN_A2 12
#define IN_G2 13
#define IN_KK 14
#define IN_KA 15
#define IN_RK 16
#define IN_LNW 17
#define IN_LNB 18
#define IN_WG2 19
#define IN_BG 20
#define IN_GNW 21
#define IN_WOA 22
#define IN_WOB 23
#define IN_WO 24
#define IN_NORM_FFN 25
#define IN_WUP 26
#define IN_CONVW 27
#define IN_CONVB 28
#define IN_WDN 29
#define IN_NORM_FINAL 30

__device__ __forceinline__ float bf_lo(unsigned w) { return __builtin_bit_cast(float, w << 16); }
__device__ __forceinline__ float bf_hi(unsigned w) { return __builtin_bit_cast(float, w & 0xffff0000u); }
__device__ __forceinline__ float bf2f(bf16_t h) { return __builtin_bit_cast(float, (unsigned)h << 16); }
__device__ __forceinline__ unsigned f2bf(float f) { unsigned u = __builtin_bit_cast(unsigned, f); return (u + 0x7fffu + ((u >> 16) & 1u)) >> 16; }
typedef float f32x2_t __attribute__((ext_vector_type(2)));
typedef __bf16 bf16x2_t __attribute__((ext_vector_type(2)));
__device__ __forceinline__ unsigned pk2(float lo, float hi) { const f32x2_t v = {lo, hi}; const bf16x2_t b = __builtin_convertvector(v, bf16x2_t); return __builtin_bit_cast(unsigned, b); }
__device__ __forceinline__ void unpack8(u32x4 w, float (&o)[8]) { o[0] = bf_lo(w.x); o[1] = bf_hi(w.x); o[2] = bf_lo(w.y); o[3] = bf_hi(w.y); o[4] = bf_lo(w.z); o[5] = bf_hi(w.z); o[6] = bf_lo(w.w); o[7] = bf_hi(w.w); }
__device__ __forceinline__ u32x4 pack8(const float (&v)[8]) { u32x4 w; w.x = pk2(v[0], v[1]); w.y = pk2(v[2], v[3]); w.z = pk2(v[4], v[5]); w.w = pk2(v[6], v[7]); return w; }
__device__ __forceinline__ void ld8bf(const bf16_t* p, float (&o)[8]) { unpack8(*(const u32x4*)p, o); }
__device__ __forceinline__ void ld8f(const float* p, float (&o)[8]) { const f32x4 a = *(const f32x4*)p, b = *(const f32x4*)(p + 4); o[0] = a.x; o[1] = a.y; o[2] = a.z; o[3] = a.w; o[4] = b.x; o[5] = b.y; o[6] = b.z; o[7] = b.w; }
__device__ __forceinline__ float fsigmoid(float x) { return __builtin_amdgcn_rcpf(1.f + __expf(-x)); }
__device__ __forceinline__ float ftanh(float x) { return 1.f - 2.f * __builtin_amdgcn_rcpf(__expf(2.f * x) + 1.f); }
__device__ __forceinline__ float fsoftplus(float x) { return fmaxf(x, 0.f) + __logf(1.f + __expf(-fabsf(x))); }
template <int CTRL> __device__ __forceinline__ float dpp_mov(float x) { return __builtin_bit_cast(float, __builtin_amdgcn_mov_dpp(__builtin_bit_cast(int, x), CTRL, 0xf, 0xf, true)); }
__device__ __forceinline__ float row16_allsum(float x) { x += dpp_mov<0xB1>(x); x += dpp_mov<0x4E>(x); x += dpp_mov<0x124>(x); x += dpp_mov<0x128>(x); return x; }
__device__ __forceinline__ float row8_allsum(float x) { x += dpp_mov<0xB1>(x); x += dpp_mov<0x4E>(x); x += dpp_mov<0x141>(x); return x; }
__device__ __forceinline__ float rdlane(float x, int l) { return __builtin_bit_cast(float, __builtin_amdgcn_readlane(__builtin_bit_cast(int, x), l)); }
__device__ __forceinline__ float wave_allsum(float x) { x = row16_allsum(x); return (rdlane(x, 0) + rdlane(x, 16)) + (rdlane(x, 32) + rdlane(x, 48)); }
#define LDS_WAIT() asm volatile("s_waitcnt lgkmcnt(0)" ::: "memory")
__device__ __forceinline__ const float* xrow_ptr(const Args& A, int r) { return r < MP ? A.in[IN_XP] + (size_t)r * DM : A.in[IN_XS] + (size_t)(r - MP) * DM; }

#define XB_TMO      128
#define XB_XCNT(j)  (256  + 64 * (j))
#define XB_XSUB(j)  (1280 + 64 * (j))
#define XB_XGEN(j)  (2304 + 64 * (j))
#define XB_TOP      3328
#define XB_TOPGEN   3392
#define XCD_BAR_WORDS 3456
#define XB_SPIN_CAP (1u << 18)

__device__ __forceinline__ unsigned xb_ld(unsigned* p)              { return __hip_atomic_load(p, __ATOMIC_RELAXED, __HIP_MEMORY_SCOPE_AGENT); }
__device__ __forceinline__ unsigned xb_add(unsigned* p, unsigned v) { return __hip_atomic_fetch_add(p, v, __ATOMIC_RELAXED, __HIP_MEMORY_SCOPE_AGENT); }
__device__ __forceinline__ unsigned xb_xcc_id() { return (unsigned)__builtin_amdgcn_s_getreg((3 << 11) | 20) & 0xFu; }
#define XB_SPIN(cond, bar) do { unsigned _sp = 0; while (cond) { __builtin_amdgcn_s_sleep(1); \
    if ((++_sp & 255u) == 0u) { if (xb_ld(&(bar)[XB_TMO])) break; if (_sp > XB_SPIN_CAP) { atomicAdd(&(bar)[XB_TMO], 1u); break; } } } } while (0)

struct XcdBarrier {
    unsigned* bar; unsigned x;
    volatile LAS unsigned* st;
};

__device__ __forceinline__ XcdBarrier xcd_barrier_post(unsigned* bar, volatile LAS unsigned* st) {
    XcdBarrier b; b.bar = bar; b.x = xb_xcc_id(); b.st = st;
    if (threadIdx.x == 0) (void)xb_add(&bar[XB_XCNT(b.x)], 1u);
    return b;
}
__device__ __forceinline__ void xcd_barrier_complete(unsigned* bar, unsigned x, unsigned& nloc, unsigned& nx) {
    const unsigned G = gridDim.x * gridDim.y * gridDim.z;
    unsigned sum, cnt, mine, sp = 0u;
    for (;;) {
        sum = 0u; cnt = 0u; mine = 0u;
#pragma unroll
        for (unsigned j = 0; j < 16; ++j) { const unsigned c = xb_ld(&bar[XB_XCNT(j)]); sum += c; cnt += (c > 0u) ? 1u : 0u; mine = (j == x) ? c : mine; }
        if (sum == G) break;
        __builtin_amdgcn_s_sleep(1);
        if ((++sp & 255u) == 0u) { if (xb_ld(&bar[XB_TMO])) break; if (sp > XB_SPIN_CAP) { atomicAdd(&bar[XB_TMO], 1u); break; } }
    }
    nloc = mine > 0u ? mine : 1u; nx = cnt > 0u ? cnt : 1u;
}

__device__ __forceinline__ void xcd_barrier(const XcdBarrier& b) {
    asm volatile("s_waitcnt vmcnt(0)" ::: "memory");
    __syncthreads();
    if (threadIdx.x == 0) {
        unsigned* bar = b.bar;
        __builtin_amdgcn_s_waitcnt(0);
        unsigned nloc = b.st[0], nx = b.st[1];
        if (nloc == 0u) { xcd_barrier_complete(bar, b.x, nloc, nx); b.st[0] = nloc; b.st[1] = nx; }
        const unsigned old = xb_add(&bar[XB_XSUB(b.x)], 1u);
        const unsigned gen = old / nloc;
        if (old + 1u == (gen + 1u) * nloc) {
            __builtin_amdgcn_fence(__ATOMIC_RELEASE, "agent");
            asm volatile("s_waitcnt vmcnt(0)" ::: "memory");
            const unsigned og = xb_add(&bar[XB_TOP], 1u);
            const unsigned tg = og / nx;
            if (og + 1u == (tg + 1u) * nx) xb_add(&bar[XB_TOPGEN], 1u);
            else XB_SPIN(xb_ld(&bar[XB_TOPGEN]) == tg, bar);
            __builtin_amdgcn_fence(__ATOMIC_ACQUIRE, "agent");
            xb_add(&bar[XB_XGEN(b.x)], 1u);
            asm volatile("s_waitcnt vmcnt(0)" ::: "memory");
        } else {
            XB_SPIN(xb_ld(&bar[XB_XGEN(b.x)]) == gen, bar);
            __builtin_amdgcn_fence(__ATOMIC_ACQUIRE, "agent");
            asm volatile("s_waitcnt vmcnt(0)" ::: "memory");
        }
    }
    __syncthreads();
}


struct EpiProj {
    static constexpr bool PERM = true, AFTER_DRAIN = false;
    bf16_t *prw, *pgla, *pgate; float *shift_p, *shift_s;
    __device__ __forceinline__ void operator()(const f32x4 (&acc)[2][2][4][2], const Unit& u, int wr, int wc, int fr, int fq) const {
        asm volatile("" : "+v"(fr), "+v"(fq));
        bf16_t* base; int ld, colt;
        if (u.pn < 7) { base = prw; ld = NPRW; colt = u.pn * 256; } else if (u.pn < 14) { base = pgla; ld = NPGLA; colt = (u.pn - 7) * 256; } else { base = pgate; ld = NGATE; colt = (u.pn - 14) * 256; }
        const int row0 = u.pm * 256 + wr * 64 + fr, col0 = colt + wc * 32 + 8 * fq;
#pragma unroll
        for (int ai = 0; ai < 2; ++ai)
#pragma unroll
            for (int m = 0; m < 4; ++m) {
                const int r = row0 + ai * 128 + m * 16; bf16_t* rowp = base + (size_t)r * ld + col0;
#pragma unroll
                for (int bj = 0; bj < 2; ++bj) { const f32x4 v0 = acc[ai][bj][m][0], v1 = acc[ai][bj][m][1]; u32x4 w; w.x = pk2(v0[0], v0[1]); w.y = pk2(v0[2], v0[3]); w.z = pk2(v1[0], v1[1]); w.w = pk2(v1[2], v1[3]); *(u32x4*)(rowp + bj * 128) = w; }
            }
    }
};
template <bool FIRST> struct EpiGate {
    static constexpr bool PERM = true, AFTER_DRAIN = false;
    bf16_t* merged; const bf16_t* gate;
    __device__ __forceinline__ void operator()(const f32x4 (&acc)[2][2][4][2], const Unit& u, int wr, int wc, int fr, int fq) const {
        asm volatile("" : "+v"(fr), "+v"(fq));
        const int row0 = u.pm * 256 + wr * 64 + fr, col0 = u.pn * 256 + wc * 32 + 8 * fq;
#pragma unroll
        for (int ai = 0; ai < 2; ++ai)
#pragma unroll
            for (int m = 0; m < 4; ++m) { const int r = row0 + ai * 128 + m * 16;
#pragma unroll
                for (int bj = 0; bj < 2; ++bj) { const int c = col0 + bj * 128; float g[8], v[8]; ld8bf(gate + (size_t)r * NGATE + c, g);
                    const f32x4 v0 = acc[ai][bj][m][0], v1 = acc[ai][bj][m][1];
#pragma unroll
                    for (int i = 0; i < 4; ++i) { v[i] = v0[i] * fsigmoid(g[i]); v[4 + i] = v1[i] * fsigmoid(g[4 + i]); }
                    if (!FIRST) { float p[8]; ld8bf(merged + (size_t)r * DM + c, p);
#pragma unroll
                        for (int i = 0; i < 8; ++i) v[i] += p[i]; }
                    *(u32x4*)(merged + (size_t)r * DM + c) = pack8(v); } }
    }
};
struct EpiX1 {
    static constexpr bool PERM = true, AFTER_DRAIN = false;
    const float *xp, *xs; float* x1; bf16_t* x1b; float* rowss;
    __device__ __forceinline__ void operator()(const f32x4 (&acc)[2][2][4][2], const Unit& u, int wr, int wc, int fr, int fq) const {
        asm volatile("" : "+v"(fr), "+v"(fq));
        const int row0 = u.pm * 256 + wr * 64 + fr, col0 = u.pn * 256 + wc * 32 + 8 * fq;
#pragma unroll
        for (int ai = 0; ai < 2; ++ai)
#pragma unroll
            for (int m = 0; m < 4; ++m) { const int r = row0 + ai * 128 + m * 16; const float* xr = (r < MP ? xp + (size_t)r * DM : xs + (size_t)(r - MP) * DM); float ssq = 0.f;
#pragma unroll
                for (int bj = 0; bj < 2; ++bj) { const int c = col0 + bj * 128; float v[8]; ld8f(xr + c, v);
#pragma unroll
                    for (int i = 0; i < 4; ++i) { v[i] += acc[ai][bj][m][0][i]; v[4 + i] += acc[ai][bj][m][1][i]; }
#pragma unroll
                    for (int i = 0; i < 8; ++i) ssq += v[i] * v[i];
                    float* o = x1 + (size_t)r * DM + c; *(f32x4*)o = (f32x4){v[0], v[1], v[2], v[3]}; *(f32x4*)(o + 4) = (f32x4){v[4], v[5], v[6], v[7]};
                    *(u32x4*)(x1b + (size_t)r * DM + c) = pack8(v); }
                ssq += __shfl_xor(ssq, 16); ssq += __shfl_xor(ssq, 32);
                if (fq == 0) atomicAdd(rowss + r, ssq); }
    }
};
struct EpiX2 {
    static constexpr bool PERM = true, AFTER_DRAIN = false;
    float* x; float* xd;
    __device__ __forceinline__ void operator()(const f32x4 (&acc)[2][2][4][2], const Unit& u, int wr, int wc, int fr, int fq) const {
        asm volatile("" : "+v"(fr), "+v"(fq));
        const int row0 = u.pm * 256 + wr * 64 + fr, col0 = u.pn * 256 + wc * 32 + 8 * fq;
#pragma unroll
        for (int ai = 0; ai < 2; ++ai)
#pragma unroll
            for (int m = 0; m < 4; ++m) { const int r = row0 + ai * 128 + m * 16;
#pragma unroll
                for (int bj = 0; bj < 2; ++bj) { const size_t off = (size_t)r * DM + col0 + bj * 128; const float* o = x + off; float* od = xd + off; const f32x4 a = *(const f32x4*)o, b = *(const f32x4*)(o + 4); *(f32x4*)od = a + acc[ai][bj][m][0]; *(f32x4*)(od + 4) = b + acc[ai][bj][m][1]; } }
    }
};
__device__ __forceinline__ float gelu_gate(float g, float v) { const float t = g * (1.f + 0.044715f * g * g) * 1.5957691216057308f; return g * fsigmoid(t) * v; }
struct EpiU {
    static constexpr bool PERM = true, AFTER_DRAIN = false;
    const float* rowss; bf16_t *U, *uh; float *conv_p, *conv_s;
    __device__ __forceinline__ void operator()(const f32x4 (&acc)[2][2][4][2], const Unit& u, int wr, int wc, int fr, int fq) const {
        asm volatile("" : "+v"(fr), "+v"(fq));
        const int row0 = u.pm * 256 + wr * 64 + fr, col0 = u.pn * 256 + wc * 32 + 8 * fq;
#pragma unroll
        for (int ai = 0; ai < 2; ++ai)
#pragma unroll
            for (int m = 0; m < 4; ++m) { const int r = row0 + ai * 128 + m * 16; const float rs = rsqrtf(rowss[r] * (1.f / DM) + NORM_EPS);
#pragma unroll
                for (int bj = 0; bj < 2; ++bj) { const int c = col0 + bj * 128; const f32x4 v0 = acc[ai][bj][m][0] * rs, v1 = acc[ai][bj][m][1] * rs;
                    u32x4 w; w.x = pk2(v0[0], v0[1]); w.y = pk2(v0[2], v0[3]); w.z = pk2(v1[0], v1[1]); w.w = pk2(v1[2], v1[3]);
                    *(u32x4*)(U + (size_t)r * F2 + c) = w;
                    if (m == 3 && fr >= 14 && r < MP) { *(u32x4*)(uh + ((size_t)(r >> 6) * 2 + (fr - 14)) * F2 + c) = w;
                        if ((r & 2047) >= 2046) { float* cp = conv_p + ((size_t)(r >> 11) * 2 + (fr - 14)) * F2 + c; *(f32x4*)cp = v0; *(f32x4*)(cp + 4) = v1; } }
                    if (r >= MP && (fr & 7) >= 6) { float* cp = conv_s + ((size_t)((r - MP) >> 3) * 2 + ((fr & 7) - 6)) * F2 + c; *(f32x4*)cp = v0; *(f32x4*)(cp + 4) = v1; } } }
    }
};

struct EpiAct {
    static constexpr bool PERM = true, AFTER_DRAIN = false;
    const float *rowss, *convw, *convb; bf16_t *act, *uh, *us; float *conv_p, *conv_s; LAS float* ringbase;
    __device__ __forceinline__ void operator()(const f32x4 (&acc)[2][2][4][2], const Unit& u, int wr_, int wc_, int fr_, int fq_) const {
        int wr = wr_, wc = wc_, fr = fr_, fq = fq_;
        asm volatile("" : "+v"(fr), "+v"(fq)); asm volatile("" : "+s"(wr), "+s"(wc));
        const bool sample = u.pm >= 64;
        const int jc0 = u.pn * 128 + wc * 32 + 8 * fq;
        LAS float* ring = ringbase + (wr * 4 + wc) * 512;
#pragma unroll
        for (int ai = 0; ai < 2; ++ai) {
            const int rbase = u.pm * 256 + ai * 128 + wr * 64, grp = rbase >> 6;
#pragma unroll
            for (int m = 0; m < 4; ++m) {
                const int row = rbase + 16 * m + fr;
                const bool wuh = !sample && ((m == 0 && fr < 2) || (m == 3 && fr >= 14)), wus = sample && (fr & 7) < 2, wcs = sample && (fr & 7) >= 6;
                if (wuh || wus || wcs) {
                    const float rsm = rsqrtf(rowss[row] * (1.f / DM) + NORM_EPS);
#pragma unroll
                    for (int bj = 0; bj < 2; ++bj) { const f32x4 v0 = acc[ai][bj][m][0] * rsm, v1 = acc[ai][bj][m][1] * rsm;
                        if (wcs) { float* cp = conv_s + ((size_t)((row - MP) >> 3) * 2 + ((fr & 7) - 6)) * F2 + bj * FF + jc0; *(f32x4*)cp = v0; *(f32x4*)(cp + 4) = v1; }
                        else { u32x4 w; w.x = pk2(v0[0], v0[1]); w.y = pk2(v0[2], v0[3]); w.z = pk2(v1[0], v1[1]); w.w = pk2(v1[2], v1[3]);
                            bf16_t* dst = wuh ? uh + ((size_t)grp * 4 + (m == 0 ? fr : fr - 12)) * F2 : us + ((size_t)((row - MP) >> 3) * 2 + (fr & 7)) * F2;
                            *(u32x4*)(dst + bj * FF + jc0) = w;
                            if (wuh && m == 3 && (grp & 31) == 31) { float* cp = conv_p + ((size_t)(rbase >> 11) * 2 + (fr - 14)) * F2 + bj * FF + jc0; *(f32x4*)cp = v0; *(f32x4*)(cp + 4) = v1; } } }
                }
            }
        }
        asm volatile("" ::: "memory");
#define EPIACT_STEP(AI, N) do { const int col4 = jc0 + 4 * (N); const int rbase = u.pm * 256 + (AI) * 128 + wr * 64; \
            const f32x4 w0v = *(const f32x4*)(convw + col4), w1v = *(const f32x4*)(convw + F2 + col4), w2v = *(const f32x4*)(convw + 2 * F2 + col4), cbv = *(const f32x4*)(convb + col4); \
            const f32x4 w0g = *(const f32x4*)(convw + FF + col4), w1g = *(const f32x4*)(convw + F2 + FF + col4), w2g = *(const f32x4*)(convw + 2 * F2 + FF + col4), cbg = *(const f32x4*)(convb + FF + col4); \
            _Pragma("unroll") for (int m = 0; m < 4; ++m) { const float rsm = rsqrtf(rowss[rbase + 16 * m + fr] * (1.f / DM) + NORM_EPS); \
                const f32x4 xv = acc[AI][0][m][N] * rsm, xg = acc[AI][1][m][N] * rsm; const int idx = (m & 1) * 16 + fr; \
                *(LAS f32x4*)(ring + idx * 16 + fq * 4) = xv; *(LAS f32x4*)(ring + 4096 + idx * 16 + fq * 4) = xg; \
                const f32x4 p1v = *(const LAS f32x4*)(ring + ((idx + 31) & 31) * 16 + fq * 4), p2v = *(const LAS f32x4*)(ring + ((idx + 30) & 31) * 16 + fq * 4); \
                const f32x4 p1g = *(const LAS f32x4*)(ring + 4096 + ((idx + 31) & 31) * 16 + fq * 4), p2g = *(const LAS f32x4*)(ring + 4096 + ((idx + 30) & 31) * 16 + fq * 4); \
                const f32x4 cv = cbv + w0v * p2v + w1v * p1v + w2v * xv, cg = cbg + w0g * p2g + w1g * p1g + w2g * xg; \
                const bool fix = sample ? ((fr & 7) < 2) : (m == 0 && fr < 2); \
                if (!fix) { u32x2 w; w.x = pk2(gelu_gate(cg[0], cv[0]), gelu_gate(cg[1], cv[1])); w.y = pk2(gelu_gate(cg[2], cv[2]), gelu_gate(cg[3], cv[3])); \
                    *(u32x2*)(act + (size_t)(rbase + 16 * m + fr) * FF + col4) = w; } } \
            asm volatile("" ::: "memory"); } while (0)
        EPIACT_STEP(0, 0); EPIACT_STEP(1, 0); EPIACT_STEP(0, 1); EPIACT_STEP(1, 1);
#undef EPIACT_STEP
    }
};

template <class EF> __device__ __forceinline__ void tail_gemm(LAS unsigned char* lds, const bf16_t* Amat, int lda, const bf16_t* Bt, int K, const pg8::StaticOrder& S, int wave, int lane, const EF& ef) {
    const int l15 = lane & 15, q = lane >> 4, ntail = S.nwg - S.limit, nk = K / 256;
    LAS float* red = (LAS float*)lds;
    for (int item = blockIdx.x; item < ntail * 16; item += gridDim.x) {
        pg8::Unit u; S.unit_of(S.limit + (item >> 4), u);
        const int r0 = u.pm * 256 + (item & 15) * 16, c0 = u.pn * 256;
        const bf16_t* ap = Amat + (size_t)(r0 + l15) * lda + 8 * q + 32 * nk * wave; const bf16_t* bp = Bt + (size_t)(c0 + l15) * K + 8 * q + 32 * nk * wave;
        f32x4 acc[16];
#pragma unroll
        for (int n = 0; n < 16; ++n) acc[n] = (f32x4){0.f, 0.f, 0.f, 0.f};
        for (int ks = 0; ks < nk; ++ks) {
            const bf16x8 a = *(const bf16x8*)(ap + 32 * ks); bf16x8 b[16];
#pragma unroll
            for (int n = 0; n < 16; ++n) b[n] = *(const bf16x8*)(bp + (size_t)(16 * n) * K + 32 * ks);
#pragma unroll
            for (int n = 0; n < 16; ++n) acc[n] = __builtin_amdgcn_mfma_f32_16x16x32_bf16(a, b[n], acc[n], 0, 0, 0);
        }
        __syncthreads();
#pragma unroll
        for (int n = 0; n < 16; ++n) *(LAS f32x4*)(red + ((wave * 16 + n) * 64 + lane) * 4) = acc[n];
        __syncthreads();
        f32x4 s0 = {0.f, 0.f, 0.f, 0.f}, s1 = s0;
#pragma unroll
        for (int w2 = 0; w2 < 8; ++w2) { s0 += *(const LAS f32x4*)(red + ((w2 * 16 + 2 * wave) * 64 + lane) * 4); s1 += *(const LAS f32x4*)(red + ((w2 * 16 + 2 * wave + 1) * 64 + lane) * 4); }
        ef(r0 + 4 * q, c0 + 32 * wave + l15, s0, s1);
    }
    __syncthreads();
}
struct TfGate { bool first; bf16_t* merged; const bf16_t* gate;
    __device__ __forceinline__ void operator()(int row, int col, f32x4 a0, f32x4 a1) const {
#pragma unroll
        for (int i = 0; i < 4; ++i)
#pragma unroll
            for (int n = 0; n < 2; ++n) { const size_t r = (size_t)(row + i); const int c = col + 16 * n; float v = (n ? a1[i] : a0[i]) * fsigmoid(bf2f(gate[r * NGATE + c]));
                if (!first) v += bf2f(merged[r * DM + c]); merged[r * DM + c] = (bf16_t)f2bf(v); } } };
struct TfX1 { const float *xp, *xs; float* x1; bf16_t* x1b; float* rowss;
    __device__ __forceinline__ void operator()(int row, int col, f32x4 a0, f32x4 a1) const {
#pragma unroll
        for (int i = 0; i < 4; ++i) { const int r = row + i; const float* xr = (r < MP ? xp + (size_t)r * DM : xs + (size_t)(r - MP) * DM);
            const float v0 = xr[col] + a0[i], v1 = xr[col + 16] + a1[i];
            x1[(size_t)r * DM + col] = v0; x1[(size_t)r * DM + col + 16] = v1; x1b[(size_t)r * DM + col] = (bf16_t)f2bf(v0); x1b[(size_t)r * DM + col + 16] = (bf16_t)f2bf(v1);
            const float ss = row16_allsum(v0 * v0 + v1 * v1); if ((col & 15) == 0) atomicAdd(rowss + r, ss); } } };
struct TfX2 { float* x; float* xd;
    __device__ __forceinline__ void operator()(int row, int col, f32x4 a0, f32x4 a1) const {
#pragma unroll
        for (int i = 0; i < 4; ++i) { const size_t off = (size_t)(row + i) * DM + col; xd[off] = x[off] + a0[i]; xd[off + 16] = x[off + 16] + a1[i]; } } };

template <int MODE> __device__ __forceinline__ int map_col(int R) {
    if (MODE == 1) { if (R < 1792) return R; if (R < 3584) return (R - 1792 < 1552) ? R : -1; return R - 240; }
    if (MODE == 2) { return ((R >> 7) & 1) * FF + ((R >> 8) << 7) + (R & 127); }
    return R;
}
template <int MODE> __device__ __forceinline__ void tr_item(const float* __restrict__ W, int K, int Nsrc, int Ndst, bf16_t* WT, const float* kscale, LAS float* scr, int item, int lane) {
    const int nblk = Ndst >> 5, kb = item / nblk, nb = item - kb * nblk, k0 = kb << 6, n0 = nb << 5;
    const int col = map_col<MODE>(n0 + (lane & 31));
    float tv[32];
#pragma unroll
    for (int i = 0; i < 32; ++i) { const int kk = 2 * i + (lane >> 5); tv[i] = (col >= 0) ? W[(size_t)(k0 + kk) * Nsrc + col] : 0.f; }
#pragma unroll
    for (int i = 0; i < 32; ++i) { const int kk = 2 * i + (lane >> 5); float v = tv[i]; if (kscale) v *= kscale[k0 + kk]; scr[kk * 33 + (lane & 31)] = v; }
    LDS_WAIT();
    const int c = lane & 7;
#pragma unroll
    for (int j = 0; j < 4; ++j) { const int n = (lane >> 3) + 8 * j; const LAS float* s = scr + (8 * c) * 33 + n;
        u32x4 o; o.x = pk2(s[0 * 33], s[1 * 33]); o.y = pk2(s[2 * 33], s[3 * 33]); o.z = pk2(s[4 * 33], s[5 * 33]); o.w = pk2(s[6 * 33], s[7 * 33]);
        *(u32x4*)(WT + (size_t)(n0 + n) * K + k0 + 8 * c) = o; }
    LDS_WAIT();
}
__device__ __forceinline__ void p0_prologue(const Args& A, LAS unsigned char* lds, int gw, int NGW, int wave, int lane) {
    LAS float* scr = (LAS float*)(lds + wave * 16384);
    unsigned char* ws = A.ws;
    constexpr int I_IN = 16 * (NIN / 32), I_UP = 16 * (F2 / 32), I_DN = 44 * 32, I_O = 16 * 32, I_OA = 8 * 32, I_W2 = 16, I_G2 = 2 * 16;
    constexpr int NITEMS = I_IN + I_UP + I_DN + I_O + 2 * I_OA + 2 * I_W2 + I_G2;
    for (int it = gw; it < NITEMS; it += NGW) {
        int r = it;
        if (r < I_IN) { tr_item<1>(A.in[IN_W_IN], 1024, 5392, NIN, (bf16_t*)(ws + OFF_WIN), nullptr, scr, r, lane); continue; } r -= I_IN;
        if (r < I_UP) { tr_item<2>(A.in[IN_WUP], 1024, F2, F2, (bf16_t*)(ws + OFF_WUP), A.in[IN_NORM_FFN], scr, r, lane); continue; } r -= I_UP;
        if (r < I_DN) { tr_item<0>(A.in[IN_WDN], FF, 1024, 1024, (bf16_t*)(ws + OFF_WDN), nullptr, scr, r, lane); continue; } r -= I_DN;
        if (r < I_O) { tr_item<0>(A.in[IN_WO], 1024, 1024, 1024, (bf16_t*)(ws + OFF_WO), nullptr, scr, r, lane); continue; } r -= I_O;
        if (r < I_OA) { tr_item<0>(A.in[IN_WOA], 512, 1024, 1024, (bf16_t*)(ws + OFF_WOA), nullptr, scr, r, lane); continue; } r -= I_OA;
        if (r < I_OA) { tr_item<0>(A.in[IN_WOB], 512, 1024, 1024, (bf16_t*)(ws + OFF_WOB), nullptr, scr, r, lane); continue; } r -= I_OA;
        if (r < I_W2) { tr_item<0>(A.in[IN_W2], 64, 512, 512, (bf16_t*)(ws + OFF_W2T), nullptr, scr, r, lane); continue; } r -= I_W2;
        if (r < I_W2) { tr_item<0>(A.in[IN_A2], 64, 512, 512, (bf16_t*)(ws + OFF_A2T), nullptr, scr, r, lane); continue; } r -= I_W2;
        tr_item<0>(A.in[IN_G2], 128, 512, 512, (bf16_t*)(ws + OFF_G2T), nullptr, scr, r, lane);
    }
    bf16_t* H = (bf16_t*)((unsigned char*)A.out + OUTB_H);
    const float* gm = A.in[IN_NORM_MIX];
    for (int m = gw; m < M; m += 2 * NGW) {
        const int m2 = m + NGW; const bool has2 = m2 < M;
        const f32x4* xr = (const f32x4*)xrow_ptr(A, m) + lane; const f32x4* xr2 = (const f32x4*)xrow_ptr(A, has2 ? m2 : m) + lane; f32x4 v[4], w[4]; float s = 0.f, s2 = 0.f;
#pragma unroll
        for (int j = 0; j < 4; ++j) { v[j] = xr[64 * j]; w[j] = xr2[64 * j]; }
#pragma unroll
        for (int j = 0; j < 4; ++j) { s += (v[j].x * v[j].x + v[j].y * v[j].y) + (v[j].z * v[j].z + v[j].w * v[j].w); s2 += (w[j].x * w[j].x + w[j].y * w[j].y) + (w[j].z * w[j].z + w[j].w * w[j].w); }
        const float rstd = rsqrtf(wave_allsum(s) * (1.f / DM) + NORM_EPS), rstd2 = rsqrtf(wave_allsum(s2) * (1.f / DM) + NORM_EPS);
        u32x2* o8 = (u32x2*)(H + (size_t)m * DM) + lane; u32x2* o82 = (u32x2*)(H + (size_t)m2 * DM) + lane;
#pragma unroll
        for (int j = 0; j < 4; ++j) { const f32x4 g = *((const f32x4*)gm + lane + 64 * j); u32x2 p; p.x = pk2(v[j].x * rstd * g.x, v[j].y * rstd * g.y); p.y = pk2(v[j].z * rstd * g.z, v[j].w * rstd * g.w); o8[64 * j] = p;
            if (has2) { u32x2 p2; p2.x = pk2(w[j].x * rstd2 * g.x, w[j].y * rstd2 * g.y); p2.y = pk2(w[j].z * rstd2 * g.z, w[j].w * rstd2 * g.w); o82[64 * j] = p2; } }
    }
    float* rowss = (float*)(ws + OFF_ROWSS);
    for (int i = gw * 64 + lane; i < M; i += NGW * 64) rowss[i] = 0.f;
}

__device__ __forceinline__ void prw_mixed8(const Args& A, const bf16_t* PRW, int r, int col0, float (&xs)[8]) {
    float cur[8], prev[8];
    ld8bf(PRW + (size_t)r * NPRW + col0, cur);
    const bool first = (r < MP) ? ((r & 2047) == 0) : (((r - MP) & 7) == 0);
    if (!first) ld8bf(PRW + (size_t)(r - 1) * NPRW + col0, prev);
    else if (r < MP) {
#pragma unroll
        for (int i = 0; i < 8; ++i) prev[i] = 0.f;
    } else ld8f(A.in[IN_ST_SHIFT] + (size_t)((r - MP) >> 3) * 1792 + col0, prev);
    float mu[8]; ld8f(A.in[IN_MU] + col0, mu);
#pragma unroll
    for (int i = 0; i < 8; ++i) xs[i] = cur[i] + (prev[i] - cur[i]) * mu[i];
}
template <int ACT> __device__ __forceinline__ bf16x8 afrag(const Args& A, const bf16_t* PRW, int r, int col0) {
    float xs[8]; prw_mixed8(A, PRW, r, col0, xs);
#pragma unroll
    for (int i = 0; i < 8; ++i) xs[i] = ACT == 1 ? ftanh(xs[i]) : (ACT == 2 ? fsigmoid(xs[i]) : xs[i]);
    return __builtin_bit_cast(bf16x8, pack8(xs));
}
__device__ __forceinline__ void p2a_lora(const Args& A, int gw, int NGW, int lane) {
    const bf16_t* PRW = (const bf16_t*)(A.ws + OFF_PRW);
    const bf16_t *W2T = (const bf16_t*)(A.ws + OFF_W2T), *A2T = (const bf16_t*)(A.ws + OFF_A2T), *G2T = (const bf16_t*)(A.ws + OFF_G2T);
    bf16_t *EW = (bf16_t*)((unsigned char*)A.out + OUTB_EW), *AARR = (bf16_t*)((unsigned char*)A.out + OUTB_AARR), *G = (bf16_t*)(A.ws + OFF_G);
    for (int i = gw * 64 + lane; i < 136 * 224; i += NGW * 64) { const int sq = i / 224, c8 = (i - sq * 224) * 8; const int r = sq < 8 ? sq * 2048 + 2047 : MP + (sq - 8) * 8 + 7;
        float v[8]; ld8bf(PRW + (size_t)r * NPRW + c8, v); float* dst = (sq < 8 ? A.out + OUT_SHIFT_P + (size_t)sq * 1792 : A.out + OUT_SHIFT_S + (size_t)(sq - 8) * 1792) + c8;
        *(f32x4*)dst = (f32x4){v[0], v[1], v[2], v[3]}; *(f32x4*)(dst + 4) = (f32x4){v[4], v[5], v[6], v[7]}; }
    const int l15 = lane & 15, kq = lane >> 4;
    for (int task = gw; task < (M / 16) * 8; task += NGW) {
        const int tile = task >> 3, h = task & 7, t0 = tile * 16, r = t0 + l15;
        bf16x8 aw[2], aa[2], ag[4];
#pragma unroll
        for (int ks = 0; ks < 2; ++ks) { aw[ks] = afrag<1>(A, PRW, r, 1536 + ks * 32 + kq * 8); aa[ks] = afrag<0>(A, PRW, r, 1600 + ks * 32 + kq * 8); }
#pragma unroll
        for (int ks = 0; ks < 4; ++ks) ag[ks] = afrag<2>(A, PRW, r, 1664 + ks * 32 + kq * 8);
#pragma unroll
        for (int nt = 0; nt < 4; ++nt) {
            const int c = 64 * h + 16 * nt + l15;
            f32x4 cw = {0.f, 0.f, 0.f, 0.f}, ca = cw, cgv = cw;
#pragma unroll
            for (int ks = 0; ks < 2; ++ks) {
                const bf16x8 bw = *(const bf16x8*)(W2T + (size_t)c * 64 + ks * 32 + kq * 8), ba = *(const bf16x8*)(A2T + (size_t)c * 64 + ks * 32 + kq * 8);
                cw = __builtin_amdgcn_mfma_f32_16x16x32_bf16(bw, aw[ks], cw, 0, 0, 0); ca = __builtin_amdgcn_mfma_f32_16x16x32_bf16(ba, aa[ks], ca, 0, 0, 0); }
#pragma unroll
            for (int ks = 0; ks < 4; ++ks) { const bf16x8 bg = *(const bf16x8*)(G2T + (size_t)c * 128 + ks * 32 + kq * 8); cgv = __builtin_amdgcn_mfma_f32_16x16x32_bf16(bg, ag[ks], cgv, 0, 0, 0); }
            const int c4 = 64 * h + 16 * nt + 4 * kq; const size_t o = (size_t)(t0 + l15) * 512 + c4;
            const f32x4 w0v = *(const f32x4*)(A.in[IN_W0] + c4), a0v = *(const f32x4*)(A.in[IN_A0] + c4);
            float ew[4], av[4];
#pragma unroll
            for (int i = 0; i < 4; ++i) { ew[i] = __expf(-fsoftplus(-(w0v[i] + cw[i])) - 0.5f); av[i] = fsigmoid(a0v[i] + ca[i]); }
            u32x2 w; w.x = pk2(ew[0], ew[1]); w.y = pk2(ew[2], ew[3]); *(u32x2*)(EW + o) = w;
            w.x = pk2(av[0], av[1]); w.y = pk2(av[2], av[3]); *(u32x2*)(AARR + o) = w;
            w.x = pk2(cgv[0], cgv[1]); w.y = pk2(cgv[2], cgv[3]); *(u32x2*)(G + o) = w;
        }
    }
}

typedef short bf16x4 __attribute__((ext_vector_type(4)));
#define MFMA32(a, b, c) __builtin_amdgcn_mfma_f32_16x16x32_bf16(a, b, c, 0, 0, 0)
#define MFMA16(a, b, c) __builtin_amdgcn_mfma_f32_16x16x16bf16_1k(a, b, c, 0, 0, 0)
constexpr int SP = 72;
constexpr size_t OFF_RLT = 240 * MiB;
constexpr size_t OFF_GL = 1 * MiB, OFF_GG = 8 * MiB;
static_assert(OFF_RLT + (size_t)448 * 32768 <= 256 * MiB && OFF_GL + (size_t)224 * 32768 <= OFF_GG && OFF_GG + 224 * 256 <= OFF_WUP, "ws map (scan)");
__device__ __forceinline__ bf16x4 bf4(f32x4 v) { u32x2 w; w.x = pk2(v[0], v[1]); w.y = pk2(v[2], v[3]); return __builtin_bit_cast(bf16x4, w); }
__device__ __forceinline__ bf16x8 afr(const LAS bf16_t* X, int l15, int q, int ks) { const LAS bf16_t* p = X + l15 * SP + 32 * ks + 4 * q; const u32x2 lo = *(const LAS u32x2*)p, hi = *(const LAS u32x2*)(p + 16); u32x4 w; w.x = lo.x; w.y = lo.y; w.z = hi.x; w.w = hi.y; return __builtin_bit_cast(bf16x8, w); }
__device__ __forceinline__ bf16x8 hfrag(const f32x4& lo, const f32x4& hi) { u32x4 w; w.x = pk2(lo[0], lo[1]); w.y = pk2(lo[2], lo[3]); w.z = pk2(hi[0], hi[1]); w.w = pk2(hi[2], hi[3]); return __builtin_bit_cast(bf16x8, w); }
__device__ __forceinline__ f32x4 maskc(f32x4 v, int q, int l15, bool rows_lt_col, bool incl) {
#pragma unroll
    for (int i = 0; i < 4; ++i) { const int R = 4 * q + i; const bool keep = rows_lt_col ? (incl ? R <= l15 : R < l15) : (incl ? l15 <= R : l15 < R); v[i] = keep ? v[i] : 0.f; }
    return v;
}
template <bool GLA, int VP> __device__ __forceinline__ void scan_matrix_part(const LAS bf16_t* AT, const LAS bf16_t* RT, const LAS bf16_t* BT, const LAS bf16_t* KT, const LAS bf16_t* VS, const LAS float* GC, bf16_t* OUTP, int l15, int q, int sl, bool use_v, bool write_o, int rowb, int nv, f32x4 (&H)[4]) {
    const bf16x8 hb0 = hfrag(H[0], H[1]), hb1 = hfrag(H[2], H[3]);
    const bf16x8 rt0 = afr(RT, l15, q, 0), rt1 = afr(RT, l15, q, 1), kt0 = afr(KT, l15, q, 0), kt1 = afr(KT, l15, q, 1);
    const f32x4 z4 = {0.f, 0.f, 0.f, 0.f};
    bf16x4 vb = {0, 0, 0, 0};
    if (use_v) { const LAS bf16_t* vp = VS + (4 * q) * VP + 16 * sl + l15; u32x2 w; w.x = (unsigned)vp[0] | ((unsigned)vp[VP] << 16); w.y = (unsigned)vp[2 * VP] | ((unsigned)vp[3 * VP] << 16); vb = __builtin_bit_cast(bf16x4, w); }
    f32x4 O = MFMA32(rt0, hb0, z4); O = MFMA32(rt1, hb1, O);
    f32x4 U = z4;
    if (!GLA) {
        const bf16x8 at0 = afr(AT, l15, q, 0), at1 = afr(AT, l15, q, 1), bt0 = afr(BT, l15, q, 0), bt1 = afr(BT, l15, q, 1);
        f32x4 P = MFMA32(at0, bt0, z4); P = MFMA32(at1, bt1, P); P = maskc(P, q, l15, false, false);
        f32x4 PT = MFMA32(bt0, at0, z4); PT = MFMA32(bt1, at1, PT); PT = maskc(PT, q, l15, true, false);
        f32x4 nrbT = MFMA32(bt0, rt0, z4); nrbT = MFMA32(bt1, rt1, nrbT); nrbT = maskc(nrbT, q, l15, true, true);
        U = MFMA32(at0, hb0, z4); U = MFMA32(at1, hb1, U);
        if (use_v) { f32x4 makT = MFMA32(kt0, at0, z4); makT = MFMA32(kt1, at1, makT); makT = maskc(makT, q, l15, true, false); U = MFMA16(bf4(makT), vb, U); }
#pragma unroll
        for (int it = 0; it < 4; ++it) {
            U = MFMA16(bf4(PT), bf4(U), U);
            if (it < 3) { const f32x4 Pn = MFMA16(bf4(PT), bf4(P), z4), PTn = MFMA16(bf4(P), bf4(PT), z4); P = Pn; PT = PTn; }
        }
        O = MFMA16(bf4(nrbT), bf4(U), O);
    }
    if (use_v) { f32x4 nrkT = MFMA32(kt0, rt0, z4); nrkT = MFMA32(kt1, rt1, nrkT); nrkT = maskc(nrkT, q, l15, true, true); O = MFMA16(bf4(nrkT), vb, O); }
    if (write_o) {
#pragma unroll
        for (int i = 0; i < 4; ++i) if (4 * q + i < nv) OUTP[(size_t)(rowb + 4 * q + i) * 512] = (bf16_t)f2bf(O[i]);
    }
    const bf16x4 ub = bf4(U);
#pragma unroll
    for (int kt = 0; kt < 4; ++kt) {
        const f32x4 g4 = *(const LAS f32x4*)(GC + 16 * kt + 4 * q); const float gk = GC[16 * kt + l15];
        f32x4 acc = H[kt] * g4;
        if (!GLA) { const LAS bf16_t* p = BT + (4 * q) * SP + 16 * kt + l15; u32x2 w; w.x = pk2(bf2f(p[0]) * gk, bf2f(p[SP]) * gk); w.y = pk2(bf2f(p[2 * SP]) * gk, bf2f(p[3 * SP]) * gk); acc = MFMA16(__builtin_bit_cast(bf16x4, w), ub, acc); }
        if (use_v) { const LAS bf16_t* p = KT + (4 * q) * SP + 16 * kt + l15; u32x2 w; w.x = pk2(bf2f(p[0]) * gk, bf2f(p[SP]) * gk); w.y = pk2(bf2f(p[2 * SP]) * gk, bf2f(p[3 * SP]) * gk); acc = MFMA16(__builtin_bit_cast(bf16x4, w), vb, acc); }
        H[kt] = acc;
    }
}
constexpr int GL_RT = 2304, GL_BT = 4608, GL_KT = 6912, GL_VS = 9216, GL_GC = 13568, GL_EG = 13824, GL_BYTES = 26624;
template <bool GLA, int W> __device__ __forceinline__ void scan_block(const Args& A, LAS unsigned char* gl, int lane, int wg, int row0, int nsub, int nvalid, int first_kind, int bsamp, int hh, int sl, bool use_v, bool write_o, f32x4 (&H)[4], float& cumtot) {
    constexpr int TPW = 16 / W, VP = GLA ? 136 : 72;
    const int c = lane, l15 = lane & 15, q = lane >> 4, t0 = wg * TPW;
    const bf16_t* PRW = (const bf16_t*)(A.ws + OFF_PRW); const bf16_t* PGLA = (const bf16_t*)(A.ws + OFF_PGLA);
    const bf16_t *EW = (const bf16_t*)((unsigned char*)A.out + OUTB_EW), *AARR = (const bf16_t*)((unsigned char*)A.out + OUTB_AARR);
    bf16_t* OUTP = GLA ? (bf16_t*)((unsigned char*)A.out + OUTB_OGL) + 128 * hh + 16 * sl + l15 : (bf16_t*)((unsigned char*)A.out + OUTB_ORW) + 64 * hh + 16 * sl + l15;
    LAS bf16_t *AT = (LAS bf16_t*)gl, *RT = (LAS bf16_t*)(gl + GL_RT), *BT = (LAS bf16_t*)(gl + GL_BT), *KT = (LAS bf16_t*)(gl + GL_KT), *VS = (LAS bf16_t*)(gl + GL_VS);
    LAS float *GC = (LAS float*)(gl + GL_GC), *EG = (LAS float*)(gl + GL_EG);
    float mu_r = 0.f, mu_k = 0.f, mu_v = 0.f, kkc = 0.f, kac = 0.f, bgc = 0.f; float wgt[16];
#pragma unroll
    for (int j = 0; j < 16; ++j) wgt[j] = 0.f;
    if (!GLA) { const float* mu = A.in[IN_MU]; mu_r = mu[64 * hh + c]; mu_k = mu[512 + 64 * hh + c]; mu_v = mu[1024 + 64 * hh + c]; kkc = A.in[IN_KK][64 * hh + c]; kac = A.in[IN_KA][64 * hh + c]; }
    else { bgc = A.in[IN_BG][64 * hh + c];
#pragma unroll
        for (int j = 0; j < 16; ++j) wgt[j] = A.in[IN_WG2][j * 256 + 64 * hh + c]; }
    float pr[2] = {0.f, 0.f}, pk[2] = {0.f, 0.f}, pvv[2] = {0.f, 0.f}; bf16_t r0[2][TPW], r1[2][TPW], r2[2][TPW], r3[2][TPW], r4[2][TPW]; unsigned rvv[2][TPW]; u32x4 lg0[2][TPW], lg1[2][TPW];
#pragma unroll
    for (int p = 0; p < 2; ++p)
#pragma unroll
        for (int i = 0; i < TPW; ++i) { r0[p][i] = r1[p][i] = r2[p][i] = r3[p][i] = r4[p][i] = 0; rvv[p][i] = 0u; lg0[p][i] = (u32x4){0u, 0u, 0u, 0u}; lg1[p][i] = lg0[p][i]; }
#define SB_LOAD(SC, P) do { const int nv_ = ((SC) == nsub - 1) ? nvalid : 16; \
        if (!GLA) { if ((SC) == 0 && t0 == 0) { pr[P] = pk[P] = pvv[P] = 0.f; if (first_kind == 0) { const bf16_t* p = PRW + (size_t)(row0 - 1) * NPRW + 64 * hh + c; pr[P] = bf2f(p[0]); pk[P] = bf2f(p[512]); pvv[P] = bf2f(p[1024]); } \
                        else if (first_kind == 2) { const float* st = A.in[IN_ST_SHIFT] + (size_t)bsamp * 1792 + 64 * hh + c; pr[P] = st[0]; pk[P] = st[512]; pvv[P] = st[1024]; } } \
                    else if (t0 < nv_) { const bf16_t* p = PRW + (size_t)(row0 + 16 * (SC) + t0 - 1) * NPRW + 64 * hh + c; pr[P] = bf2f(p[0]); pk[P] = bf2f(p[512]); pvv[P] = bf2f(p[1024]); } } \
        _Pragma("unroll") for (int i = 0; i < TPW; ++i) if (t0 + i < nv_) { const size_t ro = (size_t)(row0 + 16 * (SC) + t0 + i); \
            if (!GLA) { const bf16_t* p = PRW + ro * NPRW + 64 * hh + c; r0[P][i] = p[0]; r1[P][i] = p[512]; r2[P][i] = p[1024]; r3[P][i] = EW[ro * 512 + 64 * hh + c]; r4[P][i] = AARR[ro * 512 + 64 * hh + c]; } \
            else { const bf16_t* p = PGLA + ro * NPGLA; r0[P][i] = p[64 * hh + c]; r1[P][i] = p[256 + 64 * hh + c]; rvv[P][i] = *(const unsigned*)(p + 512 + 128 * hh + 2 * lane); lg0[P][i] = *(const u32x4*)(p + 1024); lg1[P][i] = *(const u32x4*)(p + 1032); } } } while (0)
#define SB_EG(SC, P) do { const int nv_ = ((SC) == nsub - 1) ? nvalid : 16; LAS float* eg_ = EG + (P) * 1024; float tot_ = 0.f; \
        _Pragma("unroll") for (int i = 0; i < TPW; ++i) { float ev = 0.f; if (t0 + i < nv_) { if (!GLA) ev = bf2f(r3[P][i]); else { float lga[16], t8[8]; unpack8(lg0[P][i], t8); _Pragma("unroll") for (int j = 0; j < 8; ++j) lga[j] = t8[j]; \
                unpack8(lg1[P][i], t8); _Pragma("unroll") for (int j = 0; j < 8; ++j) lga[8 + j] = t8[j]; float z = bgc; _Pragma("unroll") for (int j = 0; j < 16; ++j) z += lga[j] * wgt[j]; ev = fsoftplus(-z) * 0.0625f; } } \
            eg_[(t0 + i) * 64 + c] = ev; tot_ += ev; } \
        WT[((P) * 8 + wg) * 64 + c] = tot_; } while (0)
#define SB_ITER(SC, P) do { const int sc = (SC); const int nv = (sc == nsub - 1) ? nvalid : 16; \
        __syncthreads();                                                         \
        { const LAS float* eg = EG + (P) * 1024; float cum = 0.f; \
          _Pragma("unroll") for (int w2 = 0; w2 < W - 1; ++w2) { const float tw = WT[((P) * 8 + w2) * 64 + c]; cum += (w2 < wg) ? tw : 0.f; } \
          _Pragma("unroll") for (int i = 0; i < TPW; ++i) { const int t = t0 + i; \
            if (t < nv) { \
                const float gp = __expf(-cum); cum += eg[t * 64 + c]; const float g = __expf(-cum), e = __expf(cum); \
                if (!GLA) { \
                    const float cr = bf2f(r0[P][i]), ck = bf2f(r1[P][i]), cv = bf2f(r2[P][i]), a = bf2f(r4[P][i]); \
                    const float xr = cr + (pr[P] - cr) * mu_r, xk = ck + (pk[P] - ck) * mu_k, xv = cv + (pvv[P] - cv) * mu_v; pr[P] = cr; pk[P] = ck; pvv[P] = cv; \
                    const float kkv = xk * kkc, ss = wave_allsum(kkv * kkv), kk = kkv * __builtin_amdgcn_rcpf(fmaxf(sqrtf(ss), 1e-12f)); \
                    const unsigned w01 = pk2(-kk * gp, xr * g), w23 = pk2(kk * a * e, xk * (1.f + (a - 1.f) * kac) * e); \
                    AT[t * SP + c] = (bf16_t)(w01 & 0xffffu); RT[t * SP + c] = (bf16_t)(w01 >> 16); BT[t * SP + c] = (bf16_t)(w23 & 0xffffu); KT[t * SP + c] = (bf16_t)(w23 >> 16); \
                    VS[t * VP + c] = (bf16_t)f2bf(xv); \
                } else { \
                    const unsigned w01 = pk2(bf2f(r0[P][i]) * 0.125f * g, bf2f(r1[P][i]) * e); \
                    RT[t * SP + c] = (bf16_t)(w01 & 0xffffu); KT[t * SP + c] = (bf16_t)(w01 >> 16); \
                    *(LAS unsigned*)(VS + t * VP + 2 * lane) = rvv[P][i]; \
                } \
            } else { \
                if (!GLA) { AT[t * SP + c] = 0; BT[t * SP + c] = 0; VS[t * VP + c] = 0; } else *(LAS unsigned*)(VS + t * VP + 2 * lane) = 0u; \
                RT[t * SP + c] = 0; KT[t * SP + c] = 0; \
            } \
          } \
          if (wg == W - 1) { GC[c] = __expf(-cum); cumtot += cum; } \
        } \
        if (sc + 2 < nsub) SB_LOAD(sc + 2, P); \
        __syncthreads();                                                         \
        scan_matrix_part<GLA, VP>(AT, RT, BT, KT, VS, GC, OUTP, l15, q, sl, use_v, write_o, row0 + 16 * sc, nv, H); \
        if (sc + 1 < nsub) SB_EG(sc + 1, 1 - (P)); } while (0)
    LAS float* WT = EG + 2048;
    SB_LOAD(0, 0); if (nsub > 1) SB_LOAD(1, 1); SB_EG(0, 0);
    for (int sc2 = 0; sc2 < nsub; sc2 += 2) { SB_ITER(sc2, 0); if (sc2 + 1 < nsub) SB_ITER(sc2 + 1, 1); }
#undef SB_LOAD
#undef SB_EG
#undef SB_ITER
}
constexpr int GP = 264;
__device__ __forceinline__ void gla_pass1_item(const Args& A, LAS unsigned char* lds, int wave, int lane, int b, int hh, int cc, int ig) {
    const bf16_t* PGLA = (const bf16_t*)(A.ws + OFF_PGLA);
    LAS bf16_t* KHT = (LAS bf16_t*)lds; LAS bf16_t* VT = KHT + 64 * GP; LAS float* WT = (LAS float*)(lds + (64 + 128) * GP * 2);
    const int c = lane, l15 = lane & 15, q = lane >> 4, row0 = b * 2048 + cc * 256 + 32 * wave;
    float wgt[16]; const float bgc = A.in[IN_BG][64 * hh + c];
#pragma unroll
    for (int j = 0; j < 16; ++j) wgt[j] = A.in[IN_WG2][j * 256 + 64 * hh + c];
    float cum[32]; float run = 0.f;
#pragma unroll
    for (int tb = 0; tb < 32; tb += 8) {
        u32x4 g0[8], g1[8];
#pragma unroll
        for (int j = 0; j < 8; ++j) { const bf16_t* p = PGLA + (size_t)(row0 + tb + j) * NPGLA; g0[j] = *(const u32x4*)(p + 1024); g1[j] = *(const u32x4*)(p + 1032); }
#pragma unroll
        for (int j = 0; j < 8; ++j) { float lga[16], t8[8];
            unpack8(g0[j], t8);
#pragma unroll
            for (int i = 0; i < 8; ++i) lga[i] = t8[i];
            unpack8(g1[j], t8);
#pragma unroll
            for (int i = 0; i < 8; ++i) lga[8 + i] = t8[i];
            float z = bgc;
#pragma unroll
            for (int i = 0; i < 16; ++i) z += lga[i] * wgt[i];
            run += fsoftplus(-z) * 0.0625f; cum[tb + j] = run; }
    }
    __syncthreads();
    WT[wave * 64 + c] = run;
    __syncthreads();
    float after = 0.f, tot = 0.f;
#pragma unroll
    for (int w2 = 0; w2 < 8; ++w2) { const float tw = WT[w2 * 64 + c]; tot += tw; after += (w2 > wave) ? tw : 0.f; }
#pragma unroll
    for (int tb = 0; tb < 32; tb += 16) {
        bf16_t rk[16]; unsigned rv[16];
#pragma unroll
        for (int j = 0; j < 16; ++j) { const bf16_t* p = PGLA + (size_t)(row0 + tb + j) * NPGLA; rk[j] = p[256 + 64 * hh + c]; rv[j] = *(const unsigned*)(p + 512 + 128 * hh + 2 * lane); }
#pragma unroll
        for (int j = 0; j < 16; ++j) { const int t = tb + j;
            KHT[c * GP + 32 * wave + t] = (bf16_t)f2bf(bf2f(rk[j]) * __expf(-(after + (run - cum[t]))));
            VT[(2 * lane) * GP + 32 * wave + t] = (bf16_t)(rv[j] & 0xffffu); VT[(2 * lane + 1) * GP + 32 * wave + t] = (bf16_t)(rv[j] >> 16); }
    }
    __syncthreads();
    f32x4 acc[4];
#pragma unroll
    for (int kt = 0; kt < 4; ++kt) acc[kt] = (f32x4){0.f, 0.f, 0.f, 0.f};
#pragma unroll
    for (int ks = 0; ks < 8; ++ks) { const bf16x8 bv = *(const LAS bf16x8*)(VT + (16 * wave + l15) * GP + 32 * ks + 8 * q);
#pragma unroll
        for (int kt = 0; kt < 4; ++kt) { const bf16x8 av = *(const LAS bf16x8*)(KHT + (16 * kt + l15) * GP + 32 * ks + 8 * q); acc[kt] = MFMA32(av, bv, acc[kt]); } }
    float* dst = (float*)(A.ws + OFF_GL) + (size_t)ig * 8192 + 16 * wave + l15;
#pragma unroll
    for (int kt = 0; kt < 4; ++kt)
#pragma unroll
        for (int i = 0; i < 4; ++i) dst[(16 * kt + 4 * q + i) * 128] = acc[kt][i];
    if (wave == 7) ((float*)(A.ws + OFF_GG))[ig * 64 + lane] = __expf(-tot);
}
constexpr int G2_QT = 0, G2_KT = 36864, G2_V = 73728, G2_HT = 139264, G2_WT = 157696;
__device__ __forceinline__ void gla_pass2_item(const Args& A, LAS unsigned char* lds, int wave, int lane_in, int b, int hh, int cc, int seq) {
    int lane = lane_in; asm volatile("" : "+v"(lane));
    const bf16_t* PGLA = (const bf16_t*)(A.ws + OFF_PGLA);
    LAS bf16_t *QT = (LAS bf16_t*)(lds + G2_QT), *KT = (LAS bf16_t*)(lds + G2_KT), *VV = (LAS bf16_t*)(lds + G2_V), *HT = (LAS bf16_t*)(lds + G2_HT); LAS float* WT = (LAS float*)(lds + G2_WT);
    const int c = lane, l15 = lane & 15, q = lane >> 4, rowc = b * 2048 + cc * 256, row0 = rowc + 32 * wave;
    f32x4 H[4];
#pragma unroll
    for (int kt = 0; kt < 4; ++kt) H[kt] = (f32x4){0.f, 0.f, 0.f, 0.f};
    for (int j = 0; j < cc; ++j) { const float* Lj = (const float*)(A.ws + OFF_GL) + (size_t)(seq * 7 + j) * 8192; const float* Gj = (const float*)(A.ws + OFF_GG) + (seq * 7 + j) * 64;
#pragma unroll
        for (int kt = 0; kt < 4; ++kt)
#pragma unroll
            for (int i = 0; i < 4; ++i) H[kt][i] = Gj[16 * kt + 4 * q + i] * H[kt][i] + Lj[(16 * kt + 4 * q + i) * 128 + 16 * wave + l15]; }
    float wgt[16]; const float bgc = A.in[IN_BG][64 * hh + c];
#pragma unroll
    for (int j = 0; j < 16; ++j) wgt[j] = A.in[IN_WG2][j * 256 + 64 * hh + c];
    float cum[32]; float run = 0.f;
#pragma unroll
    for (int tb = 0; tb < 32; tb += 8) {
        u32x4 g0[8], g1[8];
#pragma unroll
        for (int j = 0; j < 8; ++j) { const bf16_t* p = PGLA + (size_t)(row0 + tb + j) * NPGLA; g0[j] = *(const u32x4*)(p + 1024); g1[j] = *(const u32x4*)(p + 1032); }
#pragma unroll
        for (int j = 0; j < 8; ++j) { float lga[16], t8[8];
            unpack8(g0[j], t8);
#pragma unroll
            for (int i = 0; i < 8; ++i) lga[i] = t8[i];
            unpack8(g1[j], t8);
#pragma unroll
            for (int i = 0; i < 8; ++i) lga[8 + i] = t8[i];
            float z = bgc;
#pragma unroll
            for (int i = 0; i < 16; ++i) z += lga[i] * wgt[i];
            run += fsoftplus(-z) * 0.0625f; cum[tb + j] = run; }
    }
    __syncthreads();
    WT[wave * 64 + c] = run;
#pragma unroll
    for (int kt = 0; kt < 4; ++kt) { u32x2 w; w.x = pk2(H[kt][0], H[kt][1]); w.y = pk2(H[kt][2], H[kt][3]); *(LAS u32x2*)(HT + (16 * wave + l15) * 72 + 16 * kt + 4 * q) = w; }
    __syncthreads();
    float before = 0.f;
#pragma unroll
    for (int w2 = 0; w2 < 8; ++w2) { const float tw = WT[w2 * 64 + c]; before += (w2 < wave) ? tw : 0.f; }
#pragma unroll
    for (int tb = 0; tb < 32; tb += 16) {
        bf16_t rq[16], rk[16]; unsigned rv[16];
#pragma unroll
        for (int j = 0; j < 16; ++j) { const bf16_t* p = PGLA + (size_t)(row0 + tb + j) * NPGLA; rq[j] = p[64 * hh + c]; rk[j] = p[256 + 64 * hh + c]; rv[j] = *(const unsigned*)(p + 512 + 128 * hh + 2 * lane); }
#pragma unroll
        for (int j = 0; j < 16; ++j) { const int t = tb + j; const float cg = fminf(before + cum[t], 80.f);
            const unsigned w01 = pk2(bf2f(rq[j]) * 0.125f * __expf(-cg), bf2f(rk[j]) * __expf(cg));
            QT[(32 * wave + t) * 72 + c] = (bf16_t)(w01 & 0xffffu); KT[(32 * wave + t) * 72 + c] = (bf16_t)(w01 >> 16);
            *(LAS unsigned*)(VV + (32 * wave + t) * 128 + 2 * lane) = rv[j]; }
    }
    __syncthreads();
    bf16_t* OUTP = (bf16_t*)((unsigned char*)A.out + OUTB_OGL) + 128 * hh + l15;
#pragma unroll 1
    for (int half = 0; half < 2; ++half) {
        const int tt = half ? 15 - wave : wave;
        const bf16x8 aq0 = *(const LAS bf16x8*)(QT + (16 * tt + l15) * 72 + 8 * q), aq1 = *(const LAS bf16x8*)(QT + (16 * tt + l15) * 72 + 32 + 8 * q);
        f32x4 O[8];
#pragma unroll
        for (int vt = 0; vt < 8; ++vt) { const LAS bf16_t* hp = HT + (16 * vt + l15) * 72 + 8 * q; O[vt] = MFMA32(aq0, *(const LAS bf16x8*)hp, ((f32x4){0.f, 0.f, 0.f, 0.f})); O[vt] = MFMA32(aq1, *(const LAS bf16x8*)(hp + 32), O[vt]); }
        for (int st = 0; st <= tt; ++st) {
            const LAS bf16_t* kp = KT + (16 * st + l15) * 72 + 8 * q;
            f32x4 ST = MFMA32(*(const LAS bf16x8*)kp, aq0, ((f32x4){0.f, 0.f, 0.f, 0.f})); ST = MFMA32(*(const LAS bf16x8*)(kp + 32), aq1, ST);
            if (st == tt) ST = maskc(ST, q, l15, true, true);
            const bf16x4 pa = bf4(ST);
#pragma unroll
            for (int vt = 0; vt < 8; ++vt) { const LAS bf16_t* vp = VV + (16 * st + 4 * q) * 128 + 16 * vt + l15; u32x2 w; w.x = (unsigned)vp[0] | ((unsigned)vp[128] << 16); w.y = (unsigned)vp[256] | ((unsigned)vp[384] << 16);
                O[vt] = MFMA16(pa, __builtin_bit_cast(bf16x4, w), O[vt]); }
        }
#pragma unroll
        for (int vt = 0; vt < 8; ++vt)
#pragma unroll
            for (int i = 0; i < 4; ++i) OUTP[(size_t)(rowc + 16 * tt + 4 * q + i) * 512 + 16 * vt] = (bf16_t)f2bf(O[vt][i]);
    }
    if (cc == 7) {
#pragma unroll 1
        for (int st = 0; st < 16; ++st) { const LAS bf16_t* vp = VV + (16 * st + 4 * q) * 128 + 16 * wave + l15; u32x2 wv; wv.x = (unsigned)vp[0] | ((unsigned)vp[128] << 16); wv.y = (unsigned)vp[256] | ((unsigned)vp[384] << 16);
#pragma unroll
            for (int kt = 0; kt < 4; ++kt) { const LAS bf16_t* kp = KT + (16 * st + 4 * q) * 72 + 16 * kt + l15; u32x2 wk; wk.x = (unsigned)kp[0] | ((unsigned)kp[72] << 16); wk.y = (unsigned)kp[144] | ((unsigned)kp[216] << 16);
                H[kt] = MFMA16(__builtin_bit_cast(bf16x4, wk), __builtin_bit_cast(bf16x4, wv), H[kt]); } }
        float* o = A.out + OUT_GLA_P + (((size_t)b * 4 + hh) * 64) * 128 + 16 * wave + l15;
#pragma unroll
        for (int kt = 0; kt < 4; ++kt)
#pragma unroll
            for (int i = 0; i < 4; ++i) { const int k = 16 * kt + 4 * q + i; float tk = 0.f;
#pragma unroll
                for (int w2 = 0; w2 < 8; ++w2) tk += WT[w2 * 64 + k];
                o[(size_t)k * 128] = __expf(-tk) * H[kt][i]; }
    }
}
__device__ __forceinline__ void p2x_scan1(const Args& A, LAS unsigned char* lds, int wave, int lane) {
    const int l15 = lane & 15, q = lane >> 4;
    for (int it = blockIdx.x; it < 448 + 224; it += gridDim.x) {
        f32x4 H[4]; float cumtot = 0.f;
        if (it < 448) {
            const int seq = it / 7, cc = it - seq * 7, b = seq >> 3, hh = seq & 7; const bool isT = wave >= 4; const int sl = wave & 3;
#pragma unroll
            for (int kt = 0; kt < 4; ++kt)
#pragma unroll
                for (int i = 0; i < 4; ++i) H[kt][i] = (isT && (16 * kt + 4 * q + i == 16 * sl + l15)) ? 1.f : 0.f;
            scan_block<false, 8>(A, lds, lane, wave, b * 2048 + cc * 256, 16, 16, cc == 0 ? 1 : 0, 0, hh, sl, !isT, false, H, cumtot);
            float* dst = (float*)(A.ws + OFF_RLT) + (size_t)it * 8192 + (isT ? 4096 : 0) + 16 * sl + l15;
#pragma unroll
            for (int kt = 0; kt < 4; ++kt)
#pragma unroll
                for (int i = 0; i < 4; ++i) dst[(16 * kt + 4 * q + i) * 64] = H[kt][i];
        } else {
            const int ig = it - 448, seq = ig / 7, cc = ig - seq * 7, b = seq >> 2, hh = seq & 3;
            gla_pass1_item(A, lds, wave, lane, b, hh, cc, ig);
        }
    }
    __syncthreads();
}
__device__ __forceinline__ void p2y_scan2(const Args& A, LAS unsigned char* lds, int wave, int lane) {
    const int l15 = lane & 15, q = lane >> 4;
    for (int bi = blockIdx.x; bi < 256 + 256 + 512 + 512; bi += gridDim.x) {
        f32x4 H[4]; float cumtot = 0.f;
#pragma unroll
        for (int kt = 0; kt < 4; ++kt) H[kt] = (f32x4){0.f, 0.f, 0.f, 0.f};
        if (bi < 256) {
            const int item = 2 * bi + (wave >> 2), sl = wave & 3, cc = item & 7, seq = item >> 3, b = seq >> 3, hh = seq & 7;
            for (int j = 0; j < cc; ++j) {
                const float* Lj = (const float*)(A.ws + OFF_RLT) + (size_t)(seq * 7 + j) * 8192; const float* Tj = Lj + 4096;
                const bf16x8 hb0 = hfrag(H[0], H[1]), hb1 = hfrag(H[2], H[3]);
#pragma unroll
                for (int kt = 0; kt < 4; ++kt) {
                    f32x4 acc;
#pragma unroll
                    for (int i = 0; i < 4; ++i) acc[i] = Lj[(16 * kt + 4 * q + i) * 64 + 16 * sl + l15];
                    const float* tr = Tj + (16 * kt + l15) * 64 + 4 * q;
                    const f32x4 t0 = *(const f32x4*)tr, t1 = *(const f32x4*)(tr + 16), t2 = *(const f32x4*)(tr + 32), t3 = *(const f32x4*)(tr + 48);
                    acc = MFMA32(hfrag(t0, t1), hb0, acc); acc = MFMA32(hfrag(t2, t3), hb1, acc);
                    H[kt] = acc;
                }
            }
            scan_block<false, 4>(A, lds + (wave >> 2) * GL_BYTES, lane, wave & 3, b * 2048 + cc * 256, 16, 16, cc == 0 ? 1 : 0, 0, hh, sl, true, true, H, cumtot);
            if (cc == 7) { float* o = A.out + OUT_WKV_P + (((size_t)b * 8 + hh) * 64 + 16 * sl + l15) * 64 + 4 * q;
#pragma unroll
                for (int kt = 0; kt < 4; ++kt) *(f32x4*)(o + 16 * kt) = H[kt]; }
        } else if (bi < 512) {
            const int item = bi - 256, cc = item & 7, seq = item >> 3, b = seq >> 2, hh = seq & 3;
            gla_pass2_item(A, lds, wave, lane, b, hh, cc, seq);
            __syncthreads();
        } else if (bi < 1024) {
            const int item = 2 * (bi - 512) + (wave >> 2), sl = wave & 3, hh = item & 7, b = item >> 3;
            const float* st = A.in[IN_ST_WKV] + (((size_t)b * 8 + hh) * 64 + 16 * sl + l15) * 64 + 4 * q;
#pragma unroll
            for (int kt = 0; kt < 4; ++kt) H[kt] = *(const f32x4*)(st + 16 * kt);
            scan_block<false, 4>(A, lds + (wave >> 2) * GL_BYTES, lane, wave & 3, MP + b * 8, 1, 8, 2, b, hh, sl, true, true, H, cumtot);
            float* o = A.out + OUT_WKV_S + (((size_t)b * 8 + hh) * 64 + 16 * sl + l15) * 64 + 4 * q;
#pragma unroll
            for (int kt = 0; kt < 4; ++kt) *(f32x4*)(o + 16 * kt) = H[kt];
        } else {
            const int item = bi - 1024, sl = wave, hh = item & 3, b = item >> 2;
            const float* st = A.in[IN_ST_GLA] + (((size_t)b * 4 + hh) * 64) * 128 + 16 * sl + l15;
#pragma unroll
            for (int kt = 0; kt < 4; ++kt)
#pragma unroll
                for (int i = 0; i < 4; ++i) H[kt][i] = st[(size_t)(16 * kt + 4 * q + i) * 128];
            scan_block<true, 8>(A, lds, lane, wave, MP + b * 8, 1, 8, 0, b, hh, sl, true, true, H, cumtot);
            float* o = A.out + OUT_GLA_S + (((size_t)b * 4 + hh) * 64) * 128 + 16 * sl + l15;
#pragma unroll
            for (int kt = 0; kt < 4; ++kt)
#pragma unroll
                for (int i = 0; i < 4; ++i) o[(size_t)(16 * kt + 4 * q + i) * 128] = H[kt][i];
        }
    }
}
__device__ __forceinline__ void p2c_mix(const Args& A, int r, int col0, u32x4 rcur, u32x4 rprev, float (&xs)[8]) {
    float cur[8], prev[8]; unpack8(rcur, cur);
    const bool first = (r < MP) ? ((r & 2047) == 0) : (((r - MP) & 7) == 0);
    if (!first) unpack8(rprev, prev);
    else if (r < MP) {
#pragma unroll
        for (int i = 0; i < 8; ++i) prev[i] = 0.f;
    } else ld8f(A.in[IN_ST_SHIFT] + (size_t)((r - MP) >> 3) * 1792 + col0, prev);
    float mu[8]; ld8f(A.in[IN_MU] + col0, mu);
#pragma unroll
    for (int i = 0; i < 8; ++i) xs[i] = cur[i] + (prev[i] - cur[i]) * mu[i];
}
__device__ __forceinline__ void p2c_post(const Args& A, int gw, int NGW, int lane, bool shadow) {
    const bf16_t* PRW = (const bf16_t*)(A.ws + OFF_PRW); const bf16_t* PGLA = (const bf16_t*)(A.ws + OFF_PGLA);
    const bf16_t *AARR = (const bf16_t*)((unsigned char*)A.out + OUTB_AARR), *G = (const bf16_t*)(A.ws + OFF_G);
    bf16_t *ORW = (bf16_t*)((unsigned char*)A.out + OUTB_ORW), *OGL = (bf16_t*)((unsigned char*)A.out + OUTB_OGL);
    const int c0 = 8 * lane;
    for (int rb = gw; rb < M; rb += 2 * NGW) {
        u32x4 raw[2][11];
#pragma unroll
        for (int k = 0; k < 2; ++k) { const int r = (rb + k * NGW < M) ? rb + k * NGW : rb; const int rp = r > 0 ? r - 1 : 0;
            raw[k][0] = *(const u32x4*)(ORW + (size_t)r * 512 + c0); raw[k][1] = *(const u32x4*)(OGL + (size_t)r * 512 + c0);
            raw[k][2] = *(const u32x4*)(PRW + (size_t)r * NPRW + c0); raw[k][3] = *(const u32x4*)(PRW + (size_t)r * NPRW + 512 + c0); raw[k][4] = *(const u32x4*)(PRW + (size_t)r * NPRW + 1024 + c0);
            raw[k][5] = *(const u32x4*)(PRW + (size_t)rp * NPRW + c0); raw[k][6] = *(const u32x4*)(PRW + (size_t)rp * NPRW + 512 + c0); raw[k][7] = *(const u32x4*)(PRW + (size_t)rp * NPRW + 1024 + c0);
            raw[k][8] = *(const u32x4*)(AARR + (size_t)r * 512 + c0); raw[k][9] = *(const u32x4*)(G + (size_t)r * 512 + c0); raw[k][10] = *(const u32x4*)(PGLA + (size_t)r * NPGLA + 1040 + c0); }
#pragma unroll
        for (int k = 0; k < 2; ++k) { const int r = rb + k * NGW; if (r < M) {
            float o[8], d[8], xr[8], xk[8], xv[8], a[8], g[8], p[8], res[8];
            unpack8(raw[k][0], o);
            float s1 = 0.f;
#pragma unroll
            for (int i = 0; i < 8; ++i) s1 += o[i];
            const float mu = row8_allsum(s1) * (1.f / 64.f); float s2 = 0.f;
#pragma unroll
            for (int i = 0; i < 8; ++i) { d[i] = o[i] - mu; s2 += d[i] * d[i]; }
            const float rstd = rsqrtf(row8_allsum(s2) * (1.f / 64.f) + 64e-5f);
            p2c_mix(A, r, c0, raw[k][2], raw[k][5], xr); p2c_mix(A, r, 512 + c0, raw[k][3], raw[k][6], xk); p2c_mix(A, r, 1024 + c0, raw[k][4], raw[k][7], xv);
            unpack8(raw[k][8], a); unpack8(raw[k][9], g);
            float bs = 0.f; ld8f(A.in[IN_KA] + c0, p);
#pragma unroll
            for (int i = 0; i < 8; ++i) d[i] *= rstd, xk[i] = xk[i] * (1.f + (a[i] - 1.f) * p[i]);
            ld8f(A.in[IN_RK] + c0, p);
#pragma unroll
            for (int i = 0; i < 8; ++i) bs += xr[i] * xk[i] * p[i];
            bs = row8_allsum(bs);
            ld8f(A.in[IN_LNW] + c0, p); ld8f(A.in[IN_LNB] + c0, a);
#pragma unroll
            for (int i = 0; i < 8; ++i) res[i] = ((d[i] * p[i] + a[i]) + bs * xv[i]) * g[i];
            if (!shadow) *(u32x4*)(ORW + (size_t)r * 512 + c0) = pack8(res); else *(u32x4*)((bf16_t*)(A.ws + 240 * MiB) + (size_t)(r & 8191) * 512 + c0) = pack8(res);
            unpack8(raw[k][1], o);
            float ms = 0.f;
#pragma unroll
            for (int i = 0; i < 8; ++i) ms += o[i] * o[i];
            const float rs = rsqrtf(row16_allsum(ms) * (1.f / 128.f) + NORM_EPS);
            unpack8(raw[k][10], g); ld8f(A.in[IN_GNW] + (c0 & 127), p);
#pragma unroll
            for (int i = 0; i < 8; ++i) res[i] = o[i] * rs * p[i] * (g[i] * fsigmoid(g[i]));
            if (!shadow) *(u32x4*)(OGL + (size_t)r * 512 + c0) = pack8(res); else *(u32x4*)((bf16_t*)(A.ws + 248 * MiB) + (size_t)(r & 8191) * 512 + c0) = pack8(res);
        } }
    }
}
__device__ __forceinline__ void p6_act(const Args& A, int gtid, int NGT) {
    bf16_t* U = (bf16_t*)(A.ws + OFF_U); const bf16_t* UH = (const bf16_t*)(A.ws + OFF_UH);
    const float *convw = A.in[IN_CONVW], *convb = A.in[IN_CONVB], *cstate = A.in[IN_ST_CONV];
    for (int item = gtid; item < (M / 64) * 352; item += NGT) {
        const int rb = item / 352, jc = (item - rb * 352) * 8, r0 = rb * 64; const bool sample = r0 >= MP;
        float p1v[8], p2v[8], p1g[8], p2g[8], w0v[8], w1v[8], w2v[8], cbv[8], w0g[8], w1g[8], w2g[8], cbg[8];
        ld8f(convw + jc, w0v); ld8f(convw + F2 + jc, w1v); ld8f(convw + 2 * F2 + jc, w2v); ld8f(convb + jc, cbv);
        ld8f(convw + FF + jc, w0g); ld8f(convw + F2 + FF + jc, w1g); ld8f(convw + 2 * F2 + FF + jc, w2g); ld8f(convb + FF + jc, cbg);
#pragma unroll
        for (int i = 0; i < 8; ++i) p1v[i] = p2v[i] = p1g[i] = p2g[i] = 0.f;
        if (!sample && (rb & 31) != 0) { const bf16_t* q = UH + (size_t)(rb - 1) * 2 * F2; ld8bf(q + jc, p2v); ld8bf(q + FF + jc, p2g); ld8bf(q + F2 + jc, p1v); ld8bf(q + F2 + FF + jc, p1g); }
        for (int r8 = 0; r8 < 64; r8 += 8) {
            u32x4 rawv[8], rawg[8];
#pragma unroll
            for (int k = 0; k < 8; ++k) { const bf16_t* row = U + (size_t)(r0 + r8 + k) * F2; rawv[k] = *(const u32x4*)(row + jc); rawg[k] = *(const u32x4*)(row + FF + jc); }
            if (sample) { const float* st = cstate + (size_t)((r0 + r8 - MP) >> 3) * 2 * F2; ld8f(st + jc, p2v); ld8f(st + FF + jc, p2g); ld8f(st + F2 + jc, p1v); ld8f(st + F2 + FF + jc, p1g); }
#pragma unroll
            for (int k = 0; k < 8; ++k) {
                float cv[8], cg[8], res[8]; unpack8(rawv[k], cv); unpack8(rawg[k], cg);
#pragma unroll
                for (int i = 0; i < 8; ++i) { const float v = cbv[i] + w0v[i] * p2v[i] + w1v[i] * p1v[i] + w2v[i] * cv[i], gg = cbg[i] + w0g[i] * p2g[i] + w1g[i] * p1g[i] + w2g[i] * cg[i];
                    res[i] = gelu_gate(gg, v); p2v[i] = p1v[i]; p1v[i] = cv[i]; p2g[i] = p1g[i]; p1g[i] = cg[i]; }
                *(u32x4*)(U + (size_t)(r0 + r8 + k) * F2 + jc) = pack8(res);
            }
        }
    }
}
__device__ __forceinline__ void pfix_act(const Args& A, int gtid, int NGT) {
    const bf16_t* UH = (const bf16_t*)(A.ws + OFF_UH); const bf16_t* US = (const bf16_t*)(A.ws + OFF_US); bf16_t* ACT = (bf16_t*)(A.ws + OFF_ACT);
    const float *convw = A.in[IN_CONVW], *convb = A.in[IN_CONVB], *cstate = A.in[IN_ST_CONV];
    for (int idx = gtid; idx < (256 + 128) * 2 * 352; idx += NGT) {
        const int g = idx / 704, rem = idx - g * 704, rsel = rem / 352, jc = (rem - rsel * 352) * 8;
        float cv[8], cg[8], p1v[8], p1g[8], p2v[8], p2g[8], res[8]; int orow;
#pragma unroll
        for (int i = 0; i < 8; ++i) p1v[i] = p1g[i] = p2v[i] = p2g[i] = 0.f;
        if (g < 256) {
            const bool seq0 = (g & 31) == 0; orow = 64 * g + rsel;
            ld8bf(UH + ((size_t)g * 4 + rsel) * F2 + jc, cv); ld8bf(UH + ((size_t)g * 4 + rsel) * F2 + FF + jc, cg);
            if (rsel == 0) { if (!seq0) { const bf16_t* q = UH + ((size_t)(g - 1) * 4 + 3) * F2; ld8bf(q + jc, p1v); ld8bf(q + FF + jc, p1g); q -= F2; ld8bf(q + jc, p2v); ld8bf(q + FF + jc, p2g); } }
            else { const bf16_t* q = UH + ((size_t)g * 4) * F2; ld8bf(q + jc, p1v); ld8bf(q + FF + jc, p1g);
                if (!seq0) { q = UH + ((size_t)(g - 1) * 4 + 3) * F2; ld8bf(q + jc, p2v); ld8bf(q + FF + jc, p2g); } }
        } else {
            const int sb = g - 256; orow = MP + 8 * sb + rsel; const float* st = cstate + (size_t)sb * 2 * F2;
            ld8bf(US + ((size_t)sb * 2 + rsel) * F2 + jc, cv); ld8bf(US + ((size_t)sb * 2 + rsel) * F2 + FF + jc, cg);
            if (rsel == 0) { ld8f(st + jc, p2v); ld8f(st + FF + jc, p2g); ld8f(st + F2 + jc, p1v); ld8f(st + F2 + FF + jc, p1g); }
            else { ld8f(st + F2 + jc, p2v); ld8f(st + F2 + FF + jc, p2g); ld8bf(US + ((size_t)sb * 2) * F2 + jc, p1v); ld8bf(US + ((size_t)sb * 2) * F2 + FF + jc, p1g); }
        }
#pragma unroll
        for (int i = 0; i < 8; ++i) { const int col = jc + i;
            const float v = convb[col] + convw[col] * p2v[i] + convw[F2 + col] * p1v[i] + convw[2 * F2 + col] * cv[i];
            const float gg = convb[FF + col] + convw[FF + col] * p2g[i] + convw[F2 + FF + col] * p1g[i] + convw[2 * F2 + FF + col] * cg[i];
            res[i] = gelu_gate(gg, v); }
        *(u32x4*)(ACT + (size_t)orow * FF + jc) = pack8(res);
    }
}
__device__ __forceinline__ void p8_final(const Args& A, int gw, int NGW, int lane, float* dst) {
    const float* gf = A.in[IN_NORM_FINAL];
    for (int m = gw; m < M; m += 2 * NGW) {
        const int m2 = m + NGW; const bool has2 = m2 < M;
        const f32x4* xr = (const f32x4*)(A.out + (size_t)m * DM) + lane; const f32x4* xr2 = (const f32x4*)(A.out + (size_t)(has2 ? m2 : m) * DM) + lane; f32x4 v[4], w[4]; float s = 0.f, s2 = 0.f;
#pragma unroll
        for (int j = 0; j < 4; ++j) { v[j] = xr[64 * j]; w[j] = xr2[64 * j]; }
#pragma unroll
        for (int j = 0; j < 4; ++j) { s += (v[j].x * v[j].x + v[j].y * v[j].y) + (v[j].z * v[j].z + v[j].w * v[j].w); s2 += (w[j].x * w[j].x + w[j].y * w[j].y) + (w[j].z * w[j].z + w[j].w * w[j].w); }
        const float rstd = rsqrtf(wave_allsum(s) * (1.f / DM) + NORM_EPS), rstd2 = rsqrtf(wave_allsum(s2) * (1.f / DM) + NORM_EPS);
#pragma unroll
        for (int j = 0; j < 4; ++j) { const f32x4 g = *((const f32x4*)gf + lane + 64 * j); ((f32x4*)(dst + (size_t)m * DM) + lane)[64 * j] = v[j] * rstd * g; if (has2) ((f32x4*)(dst + (size_t)m2 * DM) + lane)[64 * j] = w[j] * rstd2 * g; }
    }
}

#ifndef PHMASK
#define PHMASK 0xFFFF
#endif
#ifndef PHREP
#define PHREP 0
#endif
#define PH(k) for (int rep_ = 0; rep_ < ((((PHMASK) >> (k)) & 1) ? ((((PHREP) >> (k)) & 1) ? 2 : 1) : 0); ++rep_)
__global__ void __launch_bounds__(NTHREADS, 2) fwd_megakernel(Args A) {
    extern __shared__ __attribute__((aligned(16))) unsigned char lds_raw[];
    LAS unsigned char* lds = (LAS unsigned char*)lds_raw;
    cg::grid_group grid = cg::this_grid();
    const int tid = threadIdx.x, lane = tid & 63, wave = __builtin_amdgcn_readfirstlane(tid >> 6);
    const int G = gridDim.x, gw = blockIdx.x * NWAVES + wave, NGW = G * NWAVES;
    unsigned char* ws = A.ws;
    if (tid < 4) ((LAS unsigned*)(lds + LDS_BYTES - 16))[tid] = 0u;
    __syncthreads();
    const XcdBarrier xbar = xcd_barrier_post((unsigned*)(ws + OFF_BAR), (volatile LAS unsigned*)(lds + LDS_BYTES - 16));
#define GSYNC() xcd_barrier(xbar)
    PH(0) p0_prologue(A, lds, gw, NGW, wave, lane);
    if (A.ws == nullptr) grid.sync();
    GSYNC();
    PH(1) { pg8::Gemm g{(const bf16_t*)((unsigned char*)A.out + OUTB_H), (const bf16_t*)(ws + OFF_WIN), M, NIN, 1024, 1024}; pg8::StaticOrder S; S.init(M, NIN, G, (int)blockIdx.x);
      EpiProj E{(bf16_t*)(ws + OFF_PRW), (bf16_t*)(ws + OFF_PGLA), (bf16_t*)(ws + OFF_PGATE), A.out + OUT_SHIFT_P, A.out + OUT_SHIFT_S};
      pg8::gemm_phase<EpiProj, pg8::StaticOrder, true, true>(lds, g, S, E); }
    GSYNC();
    PH(2) p2a_lora(A, gw, NGW, lane);
    GSYNC();
    PH(3) p2x_scan1(A, lds, wave, lane);
    GSYNC();
    PH(11) p2y_scan2(A, lds, wave, lane);
    GSYNC();
#ifdef SHADOW_P2C
    p2c_post(A, gw, NGW, lane, true);
#endif
    PH(4) p2c_post(A, gw, NGW, lane, false);
    GSYNC();
    PH(5) { pg8::StaticOrder S; S.init(M, 1024, G, (int)blockIdx.x); S.limit = __builtin_amdgcn_readfirstlane((S.nwg / G) * G);
      { pg8::Gemm g{(const bf16_t*)((unsigned char*)A.out + OUTB_ORW), (const bf16_t*)(ws + OFF_WOA), M, 1024, 512, 512};
        EpiGate<true> E{(bf16_t*)(ws + OFF_MERGED), (const bf16_t*)(ws + OFF_PGATE)};
        pg8::gemm_phase<EpiGate<true>, pg8::StaticOrder, true, true>(lds, g, S, E);
        tail_gemm(lds, (const bf16_t*)((unsigned char*)A.out + OUTB_ORW), 512, (const bf16_t*)(ws + OFF_WOA), 512, S, wave, lane, TfGate{true, (bf16_t*)(ws + OFF_MERGED), (const bf16_t*)(ws + OFF_PGATE)}); }
      { pg8::Gemm g{(const bf16_t*)((unsigned char*)A.out + OUTB_OGL), (const bf16_t*)(ws + OFF_WOB), M, 1024, 512, 512};
        EpiGate<false> E{(bf16_t*)(ws + OFF_MERGED), (const bf16_t*)(ws + OFF_PGATE) + 1024};
        pg8::gemm_phase<EpiGate<false>, pg8::StaticOrder, true, true>(lds, g, S, E);
        tail_gemm(lds, (const bf16_t*)((unsigned char*)A.out + OUTB_OGL), 512, (const bf16_t*)(ws + OFF_WOB), 512, S, wave, lane, TfGate{false, (bf16_t*)(ws + OFF_MERGED), (const bf16_t*)(ws + OFF_PGATE) + 1024}); } }
    GSYNC();
    PH(6) { pg8::Gemm g{(const bf16_t*)(ws + OFF_MERGED), (const bf16_t*)(ws + OFF_WO), M, 1024, 1024, 1024}; pg8::StaticOrder S; S.init(M, 1024, G, (int)blockIdx.x); S.limit = __builtin_amdgcn_readfirstlane((S.nwg / G) * G);
#ifdef SHADOW_G3
      float* rss = (rep_ == 0) ? (float*)(ws + OFF_ROWSS + 256 * 1024) : (float*)(ws + OFF_ROWSS);
#else
      float* rss = (float*)(ws + OFF_ROWSS);
#endif
      EpiX1 E{A.in[IN_XP], A.in[IN_XS], A.out, (bf16_t*)(ws + OFF_X1B), rss};
      pg8::gemm_phase<EpiX1, pg8::StaticOrder, true, true>(lds, g, S, E);
      tail_gemm(lds, (const bf16_t*)(ws + OFF_MERGED), 1024, (const bf16_t*)(ws + OFF_WO), 1024, S, wave, lane, TfX1{A.in[IN_XP], A.in[IN_XS], A.out, (bf16_t*)(ws + OFF_X1B), rss}); }
    GSYNC();
    PH(7) { pg8::Gemm g{(const bf16_t*)(ws + OFF_X1B), (const bf16_t*)(ws + OFF_WUP), M, F2, 1024, 1024}; pg8::StaticOrder S; S.init(M, F2, G, (int)blockIdx.x);
      EpiAct E{(const float*)(ws + OFF_ROWSS), A.in[IN_CONVW], A.in[IN_CONVB], (bf16_t*)(ws + OFF_ACT), (bf16_t*)(ws + OFF_UH), (bf16_t*)(ws + OFF_US), A.out + OUT_CONV_P, A.out + OUT_CONV_S, (LAS float*)(lds + 131072)};
      pg8::gemm_phase<EpiAct, pg8::StaticOrder, true, true>(lds, g, S, E); }
    __syncthreads(); if (tid < 4) ((LAS unsigned*)(lds + LDS_BYTES - 16))[tid] = 0u; __syncthreads();
    GSYNC();
    PH(8) pfix_act(A, blockIdx.x * NTHREADS + tid, G * NTHREADS);
    GSYNC();
    PH(9) { pg8::Gemm g{(const bf16_t*)(ws + OFF_ACT), (const bf16_t*)(ws + OFF_WDN), M, 1024, FF, FF}; pg8::StaticOrder S; S.init(M, 1024, G, (int)blockIdx.x); S.limit = __builtin_amdgcn_readfirstlane((S.nwg / G) * G);
#ifdef SHADOW_G5
      float* xd = (rep_ == 0) ? (float*)(ws + 129 * MiB) : A.out;
#else
      float* xd = A.out;
#endif
      EpiX2 E{A.out, xd};
      pg8::gemm_phase<EpiX2, pg8::StaticOrder, true, true>(lds, g, S, E);
      tail_gemm(lds, (const bf16_t*)(ws + OFF_ACT), FF, (const bf16_t*)(ws + OFF_WDN), FF, S, wave, lane, TfX2{A.out, xd}); }
    GSYNC();
#ifdef P8_SHADOW
    p8_final(A, gw, NGW, lane, (float*)(ws + OFF_U));
#endif
    PH(10) p8_final(A, gw, NGW, lane, A.out);
#ifdef EXTRA_SYNCS
    for (int i_ = 0; i_ < EXTRA_SYNCS; ++i_) GSYNC();
#endif
}

extern "C" void kernel_launch(void* const* d_in, const int* in_sizes, int n_in, void* d_out, int out_size, void* d_ws, size_t ws_size, hipStream_t stream) {
    static int grid = 0;
    if (grid == 0) {
        int dev = 0, cus = 0, per_cu = 0;
        if (n_in != 31 || ws_size < 256 * MiB) { fprintf(stderr, "kernel_launch: unexpected n_in %d / ws_size %zu\n", n_in, ws_size); grid = -1; return; }
        (void)hipGetDevice(&dev); (void)hipDeviceGetAttribute(&cus, hipDeviceAttributeMultiprocessorCount, dev);
        if (hipFuncSetAttribute((const void*)fwd_megakernel, hipFuncAttributeMaxDynamicSharedMemorySize, LDS_BYTES) != hipSuccess) { fprintf(stderr, "kernel_launch: hipFuncSetAttribute failed\n"); grid = -1; return; }
        if (hipOccupancyMaxActiveBlocksPerMultiprocessor(&per_cu, (const void*)fwd_megakernel, NTHREADS, LDS_BYTES) != hipSuccess || per_cu < 1) { fprintf(stderr, "kernel_launch: occupancy query failed (%d)\n", per_cu); (void)hipGetLastError(); grid = -1; return; }
        grid = cus * 1;
    }
    if (grid < 0) return;
    Args a{};
    for (int i = 0; i < 31; ++i) a.in[i] = (const float*)d_in[i];
    a.out = (float*)d_out; a.ws = (unsigned char*)d_ws;
    if (hipMemsetAsync((char*)d_ws + OFF_BAR, 0, XCD_BAR_WORDS * 4, stream) != hipSuccess) { fprintf(stderr, "kernel_launch: memset of the barrier words failed\n"); return; }
    void* params[] = {&a};
    hipError_t e = hipLaunchCooperativeKernel((const void*)fwd_megakernel, dim3(grid), dim3(NTHREADS), params, LDS_BYTES, stream);
    if (e != hipSuccess) fprintf(stderr, "kernel_launch: cooperative launch failed: %s (grid %d)\n", hipGetErrorString(e), grid);
}
```

```cpp
#include <hip/hip_runtime.h>
#include <hip/hip_cooperative_groups.h>
#include <cstdio>
#include <cstdint>
namespace cg = cooperative_groups;
#define PHREP 0
namespace pg8 {
#define PG8_LAS __attribute__((address_space(3)))
typedef unsigned short bf16_t;
typedef short bf16x8 __attribute__((ext_vector_type(8)));
typedef float f32x4 __attribute__((ext_vector_type(4)));
typedef unsigned u32x4 __attribute__((ext_vector_type(4)));
constexpr int BM = 256, BK = 64, HALF = 128, HTB = HALF * BK * 2  , STAGE_BYTES = 8 * HTB, NXCD = 8, WGM = 8;

__host__ __device__ __forceinline__ int lds_byte(int r, int c) { const int st = (r >> 4) * 2 + (c >> 5), rr = r & 15, cc = c & 31, ob = rr * 64 + cc * 2; return st * 1024 + (ob ^ (((ob >> 9) & 1) << 5)); }
__host__ __device__ __forceinline__ void stage_rc(int b, int& R, int& C) { const int st = b / 1024, sb = b % 1024, swz = sb ^ (((sb >> 9) & 1) << 5); R = (st >> 1) * 16 + swz / 64; C = (st & 1) * 32 + (swz % 64) / 2; }
__host__ __device__ __forceinline__ int perm32(int rho) { const int n = rho >> 4, i = rho & 15; return 8 * (i >> 2) + 4 * n + (i & 3); }

struct Unit { int pm, pn; };
struct Gemm { const bf16_t* A; const bf16_t* Bt; int M, N, K, lda; };

struct StaticOrder {
    int nM, nN, nwg, G, c;
    int limit;
    __host__ __device__ void init(int M, int N, int G_, int c_) { nM = M / BM; nN = N / BM; nwg = nM * nN; G = G_; c = c_; limit = nwg; }
    __host__ __device__ bool next(int i, Unit& u) const {
        const int L = i * G + c; if (L >= limit) return false;
        unit_of(L, u); return true;
    }
    __host__ __device__ void unit_of(int L, Unit& u) const {
        int wgid = L; { const int q = nwg / NXCD, r = nwg % NXCD, xcd = wgid % NXCD, off = wgid / NXCD; wgid = (xcd < r ? xcd * (q + 1) : r * (q + 1) + (xcd - r) * q) + off; }
        const int nig = WGM * nN, gid = wgid / nig, fm = gid * WGM, gsz = (nM - fm) < WGM ? (nM - fm) : WGM;
        u.pm = fm + ((wgid % nig) % gsz); u.pn = (wgid % nig) / gsz;
    }
    __device__ __forceinline__ void a_ready(const Unit&) const {}
    __device__ __forceinline__ void done(const Unit&) const {}
};
__device__ __forceinline__ unsigned cvt_pk_bf16(float lo, float hi) { unsigned r; asm volatile("v_cvt_pk_bf16_f32 %0, %1, %2" : "=v"(r) : "v"(lo), "v"(hi)); return r; }
typedef float f32x2 __attribute__((ext_vector_type(2)));
template <class Epi, class Sched, bool ALIGN_EPI = false, bool SP2 = false>
__device__ __forceinline__ void gemm_phase(PG8_LAS unsigned char* lds, const Gemm g, const Sched& S, const Epi& E) {
    int tid_ = threadIdx.x; asm volatile("" : "+v"(tid_));
    const int tid = tid_, wid = __builtin_amdgcn_readfirstlane(tid >> 6), lane = tid & 63, wr = wid >> 2, wc = wid & 3, fr = lane & 15, fq = lane >> 4;
    const int K = g.K, nt = K / BK;
    unsigned voffA[2], voffB[2];
#pragma unroll
    for (int i = 0; i < 2; ++i) { int R, C; stage_rc(tid * 16 + i * 8192, R, C); const int Rb = Epi::PERM ? ((R & ~31) + perm32(R & 31)) : R;
        voffA[i] = (unsigned)(R * g.lda + C) * 2u; voffB[i] = (unsigned)(Rb * K + C) * 2u; }
    const size_t kstep = (size_t)(BK * 2);
    const size_t hstep = (size_t)HALF * K * 2;
    const size_t tstep = 2 * hstep;
    const size_t hstepA = (size_t)HALF * g.lda * 2, tstepA = 2 * hstepA;
    const unsigned ldsw = (unsigned)wid * 1024u;
    const int aoff = lds_byte(wr * 64 + fr, fq * 8), boff = lds_byte(wc * 32 + fr, fq * 8);
#define PG8_SA(b, h) (((b) * 2 + (h)) * HTB)
#define PG8_SB(b, h) ((4 + (b) * 2 + (h)) * HTB)
#define PG8_STAGE(bufoff, gbase, voff) do { _Pragma("unroll") for (int _i = 0; _i < 2; ++_i) \
        __builtin_amdgcn_global_load_lds((const unsigned*)((const char*)(gbase) + (voff)[_i]), (PG8_LAS unsigned*)(lds + (bufoff) + ldsw + _i * 8192), 16, 0, 0); } while (0)
#define PG8_LDA(dst, b, h) do { _Pragma("unroll") for (int m = 0; m < 4; ++m) _Pragma("unroll") for (int k = 0; k < 2; ++k) dst[m][k] = *(const PG8_LAS bf16x8*)(lds + PG8_SA(b, h) + aoff + m * 2048 + k * 1024); } while (0)
#define PG8_LDB(dst, b, h) do { _Pragma("unroll") for (int n = 0; n < 2; ++n) _Pragma("unroll") for (int k = 0; k < 2; ++k) dst[n][k] = *(const PG8_LAS bf16x8*)(lds + PG8_SB(b, h) + boff + n * 2048 + k * 1024); } while (0)
#define PG8_MMA(ai, bj, At, Bt) do { __builtin_amdgcn_s_setprio(1); _Pragma("unroll") for (int m = 0; m < 4; ++m) _Pragma("unroll") for (int n = 0; n < 2; ++n) _Pragma("unroll") for (int k = 0; k < 2; ++k) \
        acc[ai][bj][m][n] = __builtin_amdgcn_mfma_f32_16x16x32_bf16(Bt[n][k], At[m][k], acc[ai][bj][m][n], 0, 0, 0); __builtin_amdgcn_s_setprio(0); } while (0)
#define PG8_WAIT_V(n) asm volatile("s_waitcnt vmcnt(" #n ")" ::: "memory")
#define PG8_WAIT_L(n) asm volatile("s_waitcnt lgkmcnt(" #n ")" ::: "memory")
#define PG8_BAR __builtin_amdgcn_s_barrier()
#define PG8_SCHED __builtin_amdgcn_sched_barrier(0)
    Unit cur, nxt; int ui = 0;
    if (!S.next(0, cur)) return;
    f32x4 acc[2][2][4][2];
#pragma unroll
    for (int a = 0; a < 2; ++a)
#pragma unroll
        for (int b = 0; b < 2; ++b)
#pragma unroll
            for (int m = 0; m < 4; ++m)
#pragma unroll
                for (int n = 0; n < 2; ++n) acc[a][b][m][n] = (f32x4){0.f, 0.f, 0.f, 0.f};
    bf16x8 At[4][2], B0[2][2], B1[2][2];
    const char* cA = (const char*)g.A + (size_t)cur.pm * tstepA; const char* cB = (const char*)g.Bt + (size_t)cur.pn * tstep;
    S.a_ready(cur);
    if constexpr (SP2) {
        PG8_STAGE(PG8_SB(0, 0), cB, voffB); PG8_STAGE(PG8_SB(0, 1), cB + hstep, voffB); PG8_STAGE(PG8_SA(0, 0), cA, voffA); PG8_STAGE(PG8_SA(0, 1), cA + hstepA, voffA);
        if (wr == 1) PG8_BAR;
        PG8_WAIT_V(2); PG8_BAR;
        PG8_STAGE(PG8_SB(1, 0), cB + kstep, voffB); PG8_STAGE(PG8_SA(1, 0), cA + kstep, voffA); PG8_STAGE(PG8_SB(1, 1), cB + hstep + kstep, voffB);
        PG8_WAIT_V(6); PG8_BAR;
    } else {
        PG8_STAGE(PG8_SB(0, 0), cB, voffB); PG8_STAGE(PG8_SA(0, 0), cA, voffA); PG8_STAGE(PG8_SB(0, 1), cB + hstep, voffB); PG8_STAGE(PG8_SA(0, 1), cA + hstepA, voffA);
        if (wr == 1) PG8_BAR;
        PG8_WAIT_V(4); PG8_BAR;
        PG8_STAGE(PG8_SB(1, 0), cB + kstep, voffB); PG8_STAGE(PG8_SA(1, 0), cA + kstep, voffA); PG8_STAGE(PG8_SB(1, 1), cB + hstep + kstep, voffB);
        PG8_WAIT_V(6); PG8_BAR;
    }
    for (;;) {
        const bool has_next = S.next(ui + 1, nxt);
        const char* nA = has_next ? (const char*)g.A + (size_t)nxt.pm * tstepA : cA; const char* nB = has_next ? (const char*)g.Bt + (size_t)nxt.pn * tstep : cB;
        for (int t = 0; t < nt; t += 2) {
            const bool last = (t == nt - 2);
            const char* a1 = cA + (size_t)(t + 1) * kstep;
            const char* a2 = last ? nA : cA + (size_t)(t + 2) * kstep; const char* b2 = last ? nB : cB + (size_t)(t + 2) * kstep;
            const char* a3 = a2 + kstep; const char* b3 = b2 + kstep;
            if (last && has_next) S.a_ready(nxt);
            if constexpr (SP2) {
            PG8_LDB(B0, 0, 0); PG8_LDB(B1, 0, 1); PG8_SCHED; PG8_LDA(At, 0, 0); PG8_STAGE(PG8_SA(1, 1), a1 + hstepA, voffA);
            PG8_WAIT_V(8); PG8_WAIT_L(0); PG8_BAR; PG8_MMA(0, 0, At, B0); PG8_MMA(0, 1, At, B1); PG8_BAR; PG8_SCHED;
            PG8_LDA(At, 0, 1); PG8_STAGE(PG8_SB(0, 0), b2, voffB); PG8_STAGE(PG8_SB(0, 1), b2 + hstep, voffB); PG8_STAGE(PG8_SA(0, 0), a2, voffA);
            PG8_WAIT_V(8); PG8_WAIT_L(0); PG8_BAR; PG8_MMA(1, 0, At, B0); PG8_MMA(1, 1, At, B1); PG8_BAR; PG8_SCHED;
            PG8_LDB(B0, 1, 0); PG8_LDB(B1, 1, 1); PG8_SCHED; PG8_LDA(At, 1, 0); PG8_STAGE(PG8_SA(0, 1), a2 + hstepA, voffA);
            PG8_WAIT_V(8); PG8_WAIT_L(0); PG8_BAR; PG8_MMA(0, 0, At, B0); PG8_MMA(0, 1, At, B1); PG8_BAR; PG8_SCHED;
            PG8_LDA(At, 1, 1); PG8_STAGE(PG8_SB(1, 0), b3, voffB); PG8_STAGE(PG8_SB(1, 1), b3 + hstep, voffB); PG8_STAGE(PG8_SA(1, 0), a3, voffA);
            PG8_WAIT_V(8); PG8_WAIT_L(0); PG8_BAR; PG8_MMA(1, 0, At, B0); PG8_MMA(1, 1, At, B1); PG8_BAR; PG8_SCHED;
            } else {
            PG8_LDB(B0, 0, 0); PG8_SCHED; PG8_LDA(At, 0, 0); PG8_STAGE(PG8_SA(1, 1), a1 + hstepA, voffA);
            PG8_WAIT_L(8); PG8_BAR; PG8_WAIT_L(0); PG8_MMA(0, 0, At, B0); PG8_BAR; PG8_SCHED;
            PG8_LDB(B1, 0, 1); PG8_STAGE(PG8_SB(0, 0), b2, voffB);
            PG8_BAR; PG8_WAIT_L(0); PG8_MMA(0, 1, At, B1); PG8_BAR;
            PG8_LDA(At, 0, 1); PG8_STAGE(PG8_SA(0, 0), a2, voffA);
            PG8_BAR; PG8_WAIT_L(0); PG8_MMA(1, 0, At, B0); PG8_BAR; PG8_SCHED;
            PG8_STAGE(PG8_SB(0, 1), b2 + hstep, voffB);
            PG8_WAIT_V(6); PG8_BAR; PG8_MMA(1, 1, At, B1); PG8_BAR;
            PG8_LDB(B0, 1, 0); PG8_SCHED; PG8_LDA(At, 1, 0); PG8_STAGE(PG8_SA(0, 1), a2 + hstepA, voffA);
            PG8_WAIT_L(8); PG8_BAR; PG8_WAIT_L(0); PG8_MMA(0, 0, At, B0); PG8_BAR; PG8_SCHED;
            PG8_LDB(B1, 1, 1); PG8_STAGE(PG8_SB(1, 0), b3, voffB);
            PG8_BAR; PG8_WAIT_L(0); PG8_MMA(0, 1, At, B1); PG8_BAR;
            PG8_LDA(At, 1, 1); PG8_STAGE(PG8_SA(1, 0), a3, voffA);
            PG8_BAR; PG8_WAIT_L(0); PG8_MMA(1, 0, At, B0); PG8_BAR; PG8_SCHED;
            PG8_STAGE(PG8_SB(1, 1), b3 + hstep, voffB);
            PG8_WAIT_V(6); PG8_BAR; PG8_MMA(1, 1, At, B1); PG8_BAR;
            }
        }
        if constexpr (ALIGN_EPI) { if (wr == 0) PG8_BAR; }
        if constexpr (!Epi::AFTER_DRAIN) { E(acc, cur, wr, wc, fr, fq); S.done(cur); }
        if (!has_next) break;
#pragma unroll
        for (int a = 0; a < 2; ++a)
#pragma unroll
            for (int b = 0; b < 2; ++b)
#pragma unroll
                for (int m = 0; m < 4; ++m)
#pragma unroll
                    for (int n = 0; n < 2; ++n) acc[a][b][m][n] = (f32x4){0.f, 0.f, 0.f, 0.f};
        cur = nxt; cA = nA; cB = nB; ++ui;
        if constexpr (ALIGN_EPI) { if (wr == 1) PG8_BAR; }
    }
    PG8_WAIT_V(0);
    if constexpr (!ALIGN_EPI) { if (wr == 0) PG8_BAR; }
    PG8_BAR;
    if constexpr (Epi::AFTER_DRAIN) { E.fused(acc, cur, wr, wc, fr, fq, lds, wid, lane); S.done(cur); }
#undef PG8_SA
#undef PG8_SB
#undef PG8_STAGE
#undef PG8_LDA
#undef PG8_LDB
#undef PG8_MMA
#undef PG8_WAIT_V
#undef PG8_WAIT_L
#undef PG8_BAR
#undef PG8_SCHED
}
}

#define LAS __attribute__((address_space(3)))
typedef unsigned short bf16_t;
typedef short bf16x8 __attribute__((ext_vector_type(8)));
typedef float f32x4 __attribute__((ext_vector_type(4)));
typedef unsigned u32x4 __attribute__((ext_vector_type(4)));
typedef unsigned u32x2 __attribute__((ext_vector_type(2)));
using pg8::Unit;

constexpr int M = 17408, MP = 16384, DM = 1024;
constexpr int NPRW = 1792, NPGLA = 1792, NGATE = 2048, NIN = 5632;
constexpr int FF = 2816, F2 = 5632;
constexpr float NORM_EPS = 1e-6f;
constexpr int NWAVES = 8, NTHREADS = 512;
constexpr int LDS_BYTES = 131072 + 32768;
constexpr size_t OFF_BAR = 512 * 1024;

constexpr size_t MiB = 1u << 20;
constexpr size_t OFF_ROWSS = 0;
constexpr size_t OFF_WIN = 1 * MiB, OFF_WUP = 12 * MiB, OFF_WDN = 23 * MiB, OFF_WO = 29 * MiB, OFF_WOA = 31 * MiB, OFF_WOB = 32 * MiB;
constexpr size_t OFF_W2T = 33 * MiB, OFF_A2T = OFF_W2T + 65536, OFF_G2T = OFF_A2T + 65536;
constexpr size_t OFF_PRW = 35 * MiB, OFF_PGLA = 95 * MiB, OFF_PGATE = 155 * MiB, OFF_G = 223 * MiB;
constexpr size_t OFF_MERGED = OFF_PRW, OFF_UH = OFF_WIN, OFF_X1B = 222 * MiB, OFF_U = OFF_PRW, OFF_ACT = OFF_PRW, OFF_US = 29 * MiB;
static_assert(OFF_PRW + (size_t)M * NPRW * 2 <= OFF_PGLA && OFF_PGLA + (size_t)M * NPGLA * 2 <= OFF_PGATE && OFF_PGATE + (size_t)M * NGATE * 2 <= OFF_G, "ws map");
static_assert(OFF_G + (size_t)M * 512 * 2 <= 256 * MiB && OFF_U + (size_t)M * F2 * 2 <= OFF_X1B && OFF_X1B + (size_t)M * DM * 2 <= 256 * MiB, "ws map");
static_assert(OFF_UH + (size_t)256 * 4 * F2 * 2 <= OFF_WUP && OFF_ACT + (size_t)M * FF * 2 <= OFF_X1B, "ws map");

constexpr size_t OUT_SHIFT_P = (size_t)M * DM, OUT_WKV_P = OUT_SHIFT_P + 8 * 1792, OUT_GLA_P = OUT_WKV_P + 8 * 8 * 64 * 64, OUT_CONV_P = OUT_GLA_P + 8 * 4 * 64 * 128;
constexpr size_t OUT_SHIFT_S = OUT_CONV_P + 8 * 2 * F2, OUT_WKV_S = OUT_SHIFT_S + 128 * 1792, OUT_GLA_S = OUT_WKV_S + (size_t)128 * 8 * 64 * 64, OUT_CONV_S = OUT_GLA_S + (size_t)128 * 4 * 64 * 128;
constexpr size_t OUTB_H = 0, OUTB_EW = 0, OUTB_AARR = (size_t)M * 512 * 2, OUTB_ORW = (size_t)M * 1024 * 2, OUTB_OGL = OUTB_ORW + (size_t)M * 512 * 2;

struct Args { const float* in[31]; float* out; unsigned char* ws; };
#define IN_XP 0
#define IN_XS 1
#define IN_ST_SHIFT 2
#define IN_ST_WKV 3
#define IN_ST_GLA 4
#define IN_ST_CONV 5
#define IN_NORM_MIX 6
#define IN_W_IN 7
#define IN_MU 8
#define IN_W0 9
#define IN_W2 10
#define IN_A0 11
#define IN_A2 12
#define IN_G2 13
#define IN_KK 14
#define IN_KA 15
#define IN_RK 16
#define IN_LNW 17
#define IN_LNB 18
#define IN_WG2 19
#define IN_BG 20
#define IN_GNW 21
#define IN_WOA 22
#define IN_WOB 23
#define IN_WO 24
#define IN_NORM_FFN 25
#define IN_WUP 26
#define IN_CONVW 27
#define IN_CONVB 28
#define IN_WDN 29
#define IN_NORM_FINAL 30

__device__ __forceinline__ float bf_lo(unsigned w) { return __builtin_bit_cast(float, w << 16); }
__device__ __forceinline__ float bf_hi(unsigned w) { return __builtin_bit_cast(float, w & 0xffff0000u); }
__device__ __forceinline__ float bf2f(bf16_t h) { return __builtin_bit_cast(float, (unsigned)h << 16); }
__device__ __forceinline__ unsigned f2bf(float f) { unsigned u = __builtin_bit_cast(unsigned, f); return (u + 0x7fffu + ((u >> 16) & 1u)) >> 16; }
typedef float f32x2_t __attribute__((ext_vector_type(2)));
typedef __bf16 bf16x2_t __attribute__((ext_vector_type(2)));
__device__ __forceinline__ unsigned pk2(float lo, float hi) { const f32x2_t v = {lo, hi}; const bf16x2_t b = __builtin_convertvector(v, bf16x2_t); return __builtin_bit_cast(unsigned, b); }
__device__ __forceinline__ void unpack8(u32x4 w, float (&o)[8]) { o[0] = bf_lo(w.x); o[1] = bf_hi(w.x); o[2] = bf_lo(w.y); o[3] = bf_hi(w.y); o[4] = bf_lo(w.z); o[5] = bf_hi(w.z); o[6] = bf_lo(w.w); o[7] = bf_hi(w.w); }
__device__ __forceinline__ u32x4 pack8(const float (&v)[8]) { u32x4 w; w.x = pk2(v[0], v[1]); w.y = pk2(v[2], v[3]); w.z = pk2(v[4], v[5]); w.w = pk2(v[6], v[7]); return w; }
__device__ __forceinline__ void ld8bf(const bf16_t* p, float (&o)[8]) { unpack8(*(const u32x4*)p, o); }
__device__ __forceinline__ void ld8f(const float* p, float (&o)[8]) { const f32x4 a = *(const f32x4*)p, b = *(const f32x4*)(p + 4); o[0] = a.x; o[1] = a.y; o[2] = a.z; o[3] = a.w; o[4] = b.x; o[5] = b.y; o[6] = b.z; o[7] = b.w; }
__device__ __forceinline__ float fsigmoid(float x) { return __builtin_amdgcn_rcpf(1.f + __expf(-x)); }
__device__ __forceinline__ float ftanh(float x) { return 1.f - 2.f * __builtin_amdgcn_rcpf(__expf(2.f * x) + 1.f); }
__device__ __forceinline__ float fsoftplus(float x) { return fmaxf(x, 0.f) + __logf(1.f + __expf(-fabsf(x))); }
template <int CTRL> __device__ __forceinline__ float dpp_mov(float x) { return __builtin_bit_cast(float, __builtin_amdgcn_mov_dpp(__builtin_bit_cast(int, x), CTRL, 0xf, 0xf, true)); }
__device__ __forceinline__ float row16_allsum(float x) { x += dpp_mov<0xB1>(x); x += dpp_mov<0x4E>(x); x += dpp_mov<0x124>(x); x += dpp_mov<0x128>(x); return x; }
__device__ __forceinline__ float row8_allsum(float x) { x += dpp_mov<0xB1>(x); x += dpp_mov<0x4E>(x); x += dpp_mov<0x141>(x); return x; }
__device__ __forceinline__ float rdlane(float x, int l) { return __builtin_bit_cast(float, __builtin_amdgcn_readlane(__builtin_bit_cast(int, x), l)); }
__device__ __forceinline__ float wave_allsum(float x) { x = row16_allsum(x); return (rdlane(x, 0) + rdlane(x, 16)) + (rdlane(x, 32) + rdlane(x, 48)); }
#define LDS_WAIT() asm volatile("s_waitcnt lgkmcnt(0)" ::: "memory")
__device__ __forceinline__ const float* xrow_ptr(const Args& A, int r) { return r < MP ? A.in[IN_XP] + (size_t)r * DM : A.in[IN_XS] + (size_t)(r - MP) * DM; }

#define XB_TMO      128
#define XB_XCNT(j)  (256  + 64 * (j))
#define XB_XSUB(j)  (1280 + 64 * (j))
#define XB_XGEN(j)  (2304 + 64 * (j))
#define XB_TOP      3328
#define XB_TOPGEN   3392
#define XCD_BAR_WORDS 3456
#define XB_SPIN_CAP (1u << 18)

__device__ __forceinline__ unsigned xb_ld(unsigned* p)              { return __hip_atomic_load(p, __ATOMIC_RELAXED, __HIP_MEMORY_SCOPE_AGENT); }
__device__ __forceinline__ unsigned xb_add(unsigned* p, unsigned v) { return __hip_atomic_fetch_add(p, v, __ATOMIC_RELAXED, __HIP_MEMORY_SCOPE_AGENT); }
__device__ __forceinline__ unsigned xb_xcc_id() { return (unsigned)__builtin_amdgcn_s_getreg((3 << 11) | 20) & 0xFu; }
#define XB_SPIN(cond, bar) do { unsigned _sp = 0; while (cond) { __builtin_amdgcn_s_sleep(1); \
    if ((++_sp & 255u) == 0u) { if (xb_ld(&(bar)[XB_TMO])) break; if (_sp > XB_SPIN_CAP) { atomicAdd(&(bar)[XB_TMO], 1u); break; } } } } while (0)

struct XcdBarrier {
    unsigned* bar; unsigned x;
    volatile LAS unsigned* st;
};

__device__ __forceinline__ XcdBarrier xcd_barrier_post(unsigned* bar, volatile LAS unsigned* st) {
    XcdBarrier b; b.bar = bar; b.x = xb_xcc_id(); b.st = st;
    if (threadIdx.x == 0) (void)xb_add(&bar[XB_XCNT(b.x)], 1u);
    return b;
}
__device__ __forceinline__ void xcd_barrier_complete(unsigned* bar, unsigned x, unsigned& nloc, unsigned& nx) {
    const unsigned G = gridDim.x * gridDim.y * gridDim.z;
    unsigned sum, cnt, mine, sp = 0u;
    for (;;) {
        sum = 0u; cnt = 0u; mine = 0u;
#pragma unroll
        for (unsigned j = 0; j < 16; ++j) { const unsigned c = xb_ld(&bar[XB_XCNT(j)]); sum += c; cnt += (c > 0u) ? 1u : 0u; mine = (j == x) ? c : mine; }
        if (sum == G) break;
        __builtin_amdgcn_s_sleep(1);
        if ((++sp & 255u) == 0u) { if (xb_ld(&bar[XB_TMO])) break; if (sp > XB_SPIN_CAP) { atomicAdd(&bar[XB_TMO], 1u); break; } }
    }
    nloc = mine > 0u ? mine : 1u; nx = cnt > 0u ? cnt : 1u;
}

__device__ __forceinline__ void xcd_barrier(const XcdBarrier& b) {
    asm volatile("s_waitcnt vmcnt(0)" ::: "memory");
    __syncthreads();
    if (threadIdx.x == 0) {
        unsigned* bar = b.bar;
        __builtin_amdgcn_s_waitcnt(0);
        unsigned nloc = b.st[0], nx = b.st[1];
        if (nloc == 0u) { xcd_barrier_complete(bar, b.x, nloc, nx); b.st[0] = nloc; b.st[1] = nx; }
        const unsigned old = xb_add(&bar[XB_XSUB(b.x)], 1u);
        const unsigned gen = old / nloc;
        if (old + 1u == (gen + 1u) * nloc) {
            __builtin_amdgcn_fence(__ATOMIC_RELEASE, "agent");
            asm volatile("s_waitcnt vmcnt(0)" ::: "memory");
            const unsigned og = xb_add(&bar[XB_TOP], 1u);
            const unsigned tg = og / nx;
            if (og + 1u == (tg + 1u) * nx) xb_add(&bar[XB_TOPGEN], 1u);
            else XB_SPIN(xb_ld(&bar[XB_TOPGEN]) == tg, bar);
            __builtin_amdgcn_fence(__ATOMIC_ACQUIRE, "agent");
            xb_add(&bar[XB_XGEN(b.x)], 1u);
            asm volatile("s_waitcnt vmcnt(0)" ::: "memory");
        } else {
            XB_SPIN(xb_ld(&bar[XB_XGEN(b.x)]) == gen, bar);
            __builtin_amdgcn_fence(__ATOMIC_ACQUIRE, "agent");
            asm volatile("s_waitcnt vmcnt(0)" ::: "memory");
        }
    }
    __syncthreads();
}


struct EpiProj {
    static constexpr bool PERM = true, AFTER_DRAIN = false;
    bf16_t *prw, *pgla, *pgate; float *shift_p, *shift_s;
    __device__ __forceinline__ void operator()(const f32x4 (&acc)[2][2][4][2], const Unit& u, int wr, int wc, int fr, int fq) const {
        asm volatile("" : "+v"(fr), "+v"(fq));
        bf16_t* base; int ld, colt;
        if (u.pn < 7) { base = prw; ld = NPRW; colt = u.pn * 256; } else if (u.pn < 14) { base = pgla; ld = NPGLA; colt = (u.pn - 7) * 256; } else { base = pgate; ld = NGATE; colt = (u.pn - 14) * 256; }
        const int row0 = u.pm * 256 + wr * 64 + fr, col0 = colt + wc * 32 + 8 * fq;
#pragma unroll
        for (int ai = 0; ai < 2; ++ai)
#pragma unroll
            for (int m = 0; m < 4; ++m) {
                const int r = row0 + ai * 128 + m * 16; bf16_t* rowp = base + (size_t)r * ld + col0;
#pragma unroll
                for (int bj = 0; bj < 2; ++bj) { const f32x4 v0 = acc[ai][bj][m][0], v1 = acc[ai][bj][m][1]; u32x4 w; w.x = pk2(v0[0], v0[1]); w.y = pk2(v0[2], v0[3]); w.z = pk2(v1[0], v1[1]); w.w = pk2(v1[2], v1[3]); *(u32x4*)(rowp + bj * 128) = w; }
            }
    }
};
template <bool FIRST> struct EpiGate {
    static constexpr bool PERM = true, AFTER_DRAIN = false;
    bf16_t* merged; const bf16_t* gate;
    __device__ __forceinline__ void operator()(const f32x4 (&acc)[2][2][4][2], const Unit& u, int wr, int wc, int fr, int fq) const {
        asm volatile("" : "+v"(fr), "+v"(fq));
        const int row0 = u.pm * 256 + wr * 64 + fr, col0 = u.pn * 256 + wc * 32 + 8 * fq;
#pragma unroll
        for (int ai = 0; ai < 2; ++ai) {
            u32x4 gr[4][2], pr[4][2];
#pragma unroll
            for (int m = 0; m < 4; ++m)
#pragma unroll
                for (int bj = 0; bj < 2; ++bj) { const size_t r = (size_t)(row0 + ai * 128 + m * 16); const int c = col0 + bj * 128; gr[m][bj] = *(const u32x4*)(gate + r * NGATE + c); if (!FIRST) pr[m][bj] = *(const u32x4*)(merged + r * DM + c); }
#pragma unroll
            for (int m = 0; m < 4; ++m)
#pragma unroll
                for (int bj = 0; bj < 2; ++bj) { const size_t r = (size_t)(row0 + ai * 128 + m * 16); const int c = col0 + bj * 128; float g[8], v[8]; unpack8(gr[m][bj], g);
                    const f32x4 v0 = acc[ai][bj][m][0], v1 = acc[ai][bj][m][1];
#pragma unroll
                    for (int i = 0; i < 4; ++i) { v[i] = v0[i] * fsigmoid(g[i]); v[4 + i] = v1[i] * fsigmoid(g[4 + i]); }
                    if (!FIRST) { float p[8]; unpack8(pr[m][bj], p);
#pragma unroll
                        for (int i = 0; i < 8; ++i) v[i] += p[i]; }
                    *(u32x4*)(merged + r * DM + c) = pack8(v); }
        }
    }
};
struct EpiX1 {
    static constexpr bool PERM = true, AFTER_DRAIN = false;
    const float *xp, *xs; float* x1; bf16_t* x1b; float* rowss;
    __device__ __forceinline__ void operator()(const f32x4 (&acc)[2][2][4][2], const Unit& u, int wr, int wc, int fr, int fq) const {
        asm volatile("" : "+v"(fr), "+v"(fq));
        const int row0 = u.pm * 256 + wr * 64 + fr, col0 = u.pn * 256 + wc * 32 + 8 * fq;
#pragma unroll
        for (int ai = 0; ai < 2; ++ai) {
            f32x4 xa[4][2][2];
#pragma unroll
            for (int m = 0; m < 4; ++m) { const int r = row0 + ai * 128 + m * 16; const float* xr = (r < MP ? xp + (size_t)r * DM : xs + (size_t)(r - MP) * DM);
#pragma unroll
                for (int bj = 0; bj < 2; ++bj) { xa[m][bj][0] = *(const f32x4*)(xr + col0 + bj * 128); xa[m][bj][1] = *(const f32x4*)(xr + col0 + bj * 128 + 4); } }
#pragma unroll
            for (int m = 0; m < 4; ++m) { const int r = row0 + ai * 128 + m * 16; float ssq = 0.f;
#pragma unroll
                for (int bj = 0; bj < 2; ++bj) { const int c = col0 + bj * 128; const f32x4 a = xa[m][bj][0] + acc[ai][bj][m][0], b = xa[m][bj][1] + acc[ai][bj][m][1];
                    ssq += (a[0] * a[0] + a[1] * a[1]) + (a[2] * a[2] + a[3] * a[3]) + (b[0] * b[0] + b[1] * b[1]) + (b[2] * b[2] + b[3] * b[3]);
                    float* o = x1 + (size_t)r * DM + c; *(f32x4*)o = a; *(f32x4*)(o + 4) = b;
                    u32x4 w; w.x = pk2(a[0], a[1]); w.y = pk2(a[2], a[3]); w.z = pk2(b[0], b[1]); w.w = pk2(b[2], b[3]); *(u32x4*)(x1b + (size_t)r * DM + c) = w; }
                ssq += __shfl_xor(ssq, 16); ssq += __shfl_xor(ssq, 32);
                if (fq == 0) atomicAdd(rowss + r, ssq); }
        }
    }
};
struct EpiX2 {
    static constexpr bool PERM = true, AFTER_DRAIN = false;
    float* x; float* xd;
    __device__ __forceinline__ void operator()(const f32x4 (&acc)[2][2][4][2], const Unit& u, int wr, int wc, int fr, int fq) const {
        asm volatile("" : "+v"(fr), "+v"(fq));
        const int row0 = u.pm * 256 + wr * 64 + fr, col0 = u.pn * 256 + wc * 32 + 8 * fq;
#pragma unroll
        for (int ai = 0; ai < 2; ++ai) {
            f32x4 xa[4][2][2];
#pragma unroll
            for (int m = 0; m < 4; ++m)
#pragma unroll
                for (int bj = 0; bj < 2; ++bj) { const float* o = x + (size_t)(row0 + ai * 128 + m * 16) * DM + col0 + bj * 128; xa[m][bj][0] = *(const f32x4*)o; xa[m][bj][1] = *(const f32x4*)(o + 4); }
#pragma unroll
            for (int m = 0; m < 4; ++m)
#pragma unroll
                for (int bj = 0; bj < 2; ++bj) { float* o = xd + (size_t)(row0 + ai * 128 + m * 16) * DM + col0 + bj * 128; *(f32x4*)o = xa[m][bj][0] + acc[ai][bj][m][0]; *(f32x4*)(o + 4) = xa[m][bj][1] + acc[ai][bj][m][1]; }
        }
    }
};
__device__ __forceinline__ float gelu_gate(float g, float v) { const float t = g * (1.f + 0.044715f * g * g) * 1.5957691216057308f; return g * fsigmoid(t) * v; }
struct EpiU {
    static constexpr bool PERM = true, AFTER_DRAIN = false;
    const float* rowss; bf16_t *U, *uh; float *conv_p, *conv_s;
    __device__ __forceinline__ void operator()(const f32x4 (&acc)[2][2][4][2], const Unit& u, int wr, int wc, int fr, int fq) const {
        asm volatile("" : "+v"(fr), "+v"(fq));
        const int row0 = u.pm * 256 + wr * 64 + fr, col0 = u.pn * 256 + wc * 32 + 8 * fq;
#pragma unroll
        for (int ai = 0; ai < 2; ++ai)
#pragma unroll
            for (int m = 0; m < 4; ++m) { const int r = row0 + ai * 128 + m * 16; const float rs = rsqrtf(rowss[r] * (1.f / DM) + NORM_EPS);
#pragma unroll
                for (int bj = 0; bj < 2; ++bj) { const int c = col0 + bj * 128; const f32x4 v0 = acc[ai][bj][m][0] * rs, v1 = acc[ai][bj][m][1] * rs;
                    u32x4 w; w.x = pk2(v0[0], v0[1]); w.y = pk2(v0[2], v0[3]); w.z = pk2(v1[0], v1[1]); w.w = pk2(v1[2], v1[3]);
                    *(u32x4*)(U + (size_t)r * F2 + c) = w;
                    if (m == 3 && fr >= 14 && r < MP) { *(u32x4*)(uh + ((size_t)(r >> 6) * 2 + (fr - 14)) * F2 + c) = w;
                        if ((r & 2047) >= 2046) { float* cp = conv_p + ((size_t)(r >> 11) * 2 + (fr - 14)) * F2 + c; *(f32x4*)cp = v0; *(f32x4*)(cp + 4) = v1; } }
                    if (r >= MP && (fr & 7) >= 6) { float* cp = conv_s + ((size_t)((r - MP) >> 3) * 2 + ((fr & 7) - 6)) * F2 + c; *(f32x4*)cp = v0; *(f32x4*)(cp + 4) = v1; } } }
    }
};

struct EpiAct {
    static constexpr bool PERM = true, AFTER_DRAIN = false;
    const float *rowss, *convw, *convb; bf16_t *act, *uh, *us; float *conv_p, *conv_s; LAS float* ringbase;
    __device__ __forceinline__ void operator()(const f32x4 (&acc)[2][2][4][2], const Unit& u, int wr_, int wc_, int fr_, int fq_) const {
        int wr = wr_, wc = wc_, fr = fr_, fq = fq_;
        asm volatile("" : "+v"(fr), "+v"(fq)); asm volatile("" : "+s"(wr), "+s"(wc));
        const bool sample = u.pm >= 64;
        const int jc0 = u.pn * 128 + wc * 32 + 8 * fq;
        LAS float* ring = ringbase + (wr * 4 + wc) * 512;
#pragma unroll
        for (int ai = 0; ai < 2; ++ai) {
            const int rbase = u.pm * 256 + ai * 128 + wr * 64, grp = rbase >> 6;
#pragma unroll
            for (int m = 0; m < 4; ++m) {
                const int row = rbase + 16 * m + fr;
                const bool wuh = !sample && ((m == 0 && fr < 2) || (m == 3 && fr >= 14)), wus = sample && (fr & 7) < 2, wcs = sample && (fr & 7) >= 6;
                if (wuh || wus || wcs) {
                    const float rsm = rsqrtf(rowss[row] * (1.f / DM) + NORM_EPS);
#pragma unroll
                    for (int bj = 0; bj < 2; ++bj) { const f32x4 v0 = acc[ai][bj][m][0] * rsm, v1 = acc[ai][bj][m][1] * rsm;
                        if (wcs) { float* cp = conv_s + ((size_t)((row - MP) >> 3) * 2 + ((fr & 7) - 6)) * F2 + bj * FF + jc0; *(f32x4*)cp = v0; *(f32x4*)(cp + 4) = v1; }
                        else { u32x4 w; w.x = pk2(v0[0], v0[1]); w.y = pk2(v0[2], v0[3]); w.z = pk2(v1[0], v1[1]); w.w = pk2(v1[2], v1[3]);
                            bf16_t* dst = wuh ? uh + ((size_t)grp * 4 + (m == 0 ? fr : fr - 12)) * F2 : us + ((size_t)((row - MP) >> 3) * 2 + (fr & 7)) * F2;
                            *(u32x4*)(dst + bj * FF + jc0) = w;
                            if (wuh && m == 3 && (grp & 31) == 31) { float* cp = conv_p + ((size_t)(rbase >> 11) * 2 + (fr - 14)) * F2 + bj * FF + jc0; *(f32x4*)cp = v0; *(f32x4*)(cp + 4) = v1; } } }
                }
            }
        }
        asm volatile("" ::: "memory");
#define EPIACT_STEP(AI, N) do { const int col4 = jc0 + 4 * (N); const int rbase = u.pm * 256 + (AI) * 128 + wr * 64; \
            const f32x4 w0v = *(const f32x4*)(convw + col4), w1v = *(const f32x4*)(convw + F2 + col4), w2v = *(const f32x4*)(convw + 2 * F2 + col4), cbv = *(const f32x4*)(convb + col4); \
            const f32x4 w0g = *(const f32x4*)(convw + FF + col4), w1g = *(const f32x4*)(convw + F2 + FF + col4), w2g = *(const f32x4*)(convw + 2 * F2 + FF + col4), cbg = *(const f32x4*)(convb + FF + col4); \
            _Pragma("unroll") for (int m = 0; m < 4; ++m) { const float rsm = rsqrtf(rowss[rbase + 16 * m + fr] * (1.f / DM) + NORM_EPS); \
                const f32x4 xv = acc[AI][0][m][N] * rsm, xg = acc[AI][1][m][N] * rsm; const int idx = (m & 1) * 16 + fr; \
                *(LAS f32x4*)(ring + idx * 16 + fq * 4) = xv; *(LAS f32x4*)(ring + 4096 + idx * 16 + fq * 4) = xg; \
                const f32x4 p1v = *(const LAS f32x4*)(ring + ((idx + 31) & 31) * 16 + fq * 4), p2v = *(const LAS f32x4*)(ring + ((idx + 30) & 31) * 16 + fq * 4); \
                const f32x4 p1g = *(const LAS f32x4*)(ring + 4096 + ((idx + 31) & 31) * 16 + fq * 4), p2g = *(const LAS f32x4*)(ring + 4096 + ((idx + 30) & 31) * 16 + fq * 4); \
                const f32x4 cv = cbv + w0v * p2v + w1v * p1v + w2v * xv, cg = cbg + w0g * p2g + w1g * p1g + w2g * xg; \
                const bool fix = sample ? ((fr & 7) < 2) : (m == 0 && fr < 2); \
                if (!fix) { u32x2 w; w.x = pk2(gelu_gate(cg[0], cv[0]), gelu_gate(cg[1], cv[1])); w.y = pk2(gelu_gate(cg[2], cv[2]), gelu_gate(cg[3], cv[3])); \
                    *(u32x2*)(act + (size_t)(rbase + 16 * m + fr) * FF + col4) = w; } } \
            asm volatile("" ::: "memory"); } while (0)
        EPIACT_STEP(0, 0); EPIACT_STEP(1, 0); EPIACT_STEP(0, 1); EPIACT_STEP(1, 1);
#undef EPIACT_STEP
    }
};

template <class EF> __device__ __forceinline__ void tail_gemm(LAS unsigned char* lds, const bf16_t* Amat, int lda, const bf16_t* Bt, int K, const pg8::StaticOrder& S, int wave, int lane, const EF& ef) {
    const int l15 = lane & 15, q = lane >> 4, ntail = S.nwg - S.limit, nk = K / 256;
    LAS float* red = (LAS float*)lds;
    for (int item = blockIdx.x; item < ntail * 16; item += gridDim.x) {
        pg8::Unit u; S.unit_of(S.limit + (item >> 4), u);
        const int r0 = u.pm * 256 + (item & 15) * 16, c0 = u.pn * 256;
        const bf16_t* ap = Amat + (size_t)(r0 + l15) * lda + 8 * q + 32 * nk * wave; const bf16_t* bp = Bt + (size_t)(c0 + l15) * K + 8 * q + 32 * nk * wave;
        f32x4 acc[16];
#pragma unroll
        for (int n = 0; n < 16; ++n) acc[n] = (f32x4){0.f, 0.f, 0.f, 0.f};
        for (int ks = 0; ks < nk; ++ks) {
            const bf16x8 a = *(const bf16x8*)(ap + 32 * ks); bf16x8 b[16];
#pragma unroll
            for (int n = 0; n < 16; ++n) b[n] = *(const bf16x8*)(bp + (size_t)(16 * n) * K + 32 * ks);
#pragma unroll
            for (int n = 0; n < 16; ++n) acc[n] = __builtin_amdgcn_mfma_f32_16x16x32_bf16(a, b[n], acc[n], 0, 0, 0);
        }
        __syncthreads();
#pragma unroll
        for (int n = 0; n < 16; ++n) *(LAS f32x4*)(red + ((wave * 16 + n) * 64 + lane) * 4) = acc[n];
        __syncthreads();
        f32x4 s0 = {0.f, 0.f, 0.f, 0.f}, s1 = s0;
#pragma unroll
        for (int w2 = 0; w2 < 8; ++w2) { s0 += *(const LAS f32x4*)(red + ((w2 * 16 + 2 * wave) * 64 + lane) * 4); s1 += *(const LAS f32x4*)(red + ((w2 * 16 + 2 * wave + 1) * 64 + lane) * 4); }
        ef(r0 + 4 * q, c0 + 32 * wave + l15, s0, s1);
    }
    __syncthreads();
}
struct TfGate { bool first; bf16_t* merged; const bf16_t* gate;
    __device__ __forceinline__ void operator()(int row, int col, f32x4 a0, f32x4 a1) const {
#pragma unroll
        for (int i = 0; i < 4; ++i)
#pragma unroll
            for (int n = 0; n < 2; ++n) { const size_t r = (size_t)(row + i); const int c = col + 16 * n; float v = (n ? a1[i] : a0[i]) * fsigmoid(bf2f(gate[r * NGATE + c]));
                if (!first) v += bf2f(merged[r * DM + c]); merged[r * DM + c] = (bf16_t)f2bf(v); } } };
struct TfX1 { const float *xp, *xs; float* x1; bf16_t* x1b; float* rowss;
    __device__ __forceinline__ void operator()(int row, int col, f32x4 a0, f32x4 a1) const {
#pragma unroll
        for (int i = 0; i < 4; ++i) { const int r = row + i; const float* xr = (r < MP ? xp + (size_t)r * DM : xs + (size_t)(r - MP) * DM);
            const float v0 = xr[col] + a0[i], v1 = xr[col + 16] + a1[i];
            x1[(size_t)r * DM + col] = v0; x1[(size_t)r * DM + col + 16] = v1; x1b[(size_t)r * DM + col] = (bf16_t)f2bf(v0); x1b[(size_t)r * DM + col + 16] = (bf16_t)f2bf(v1);
            const float ss = row16_allsum(v0 * v0 + v1 * v1); if ((col & 15) == 0) atomicAdd(rowss + r, ss); } } };
struct TfX2 { float* x; float* xd;
    __device__ __forceinline__ void operator()(int row, int col, f32x4 a0, f32x4 a1) const {
#pragma unroll
        for (int i = 0; i < 4; ++i) { const size_t off = (size_t)(row + i) * DM + col; xd[off] = x[off] + a0[i]; xd[off + 16] = x[off + 16] + a1[i]; } } };

template <int MODE> __device__ __forceinline__ int map_col(int R) {
    if (MODE == 1) { if (R < 1792) return R; if (R < 3584) return (R - 1792 < 1552) ? R : -1; return R - 240; }
    if (MODE == 2) { return ((R >> 7) & 1) * FF + ((R >> 8) << 7) + (R & 127); }
    return R;
}
template <int MODE> __device__ __forceinline__ void tr_item(const float* __restrict__ W, int K, int Nsrc, int Ndst, bf16_t* WT, const float* kscale, LAS float* scr, int item, int lane) {
    const int nblk = Ndst >> 5, kb = item / nblk, nb = item - kb * nblk, k0 = kb << 6, n0 = nb << 5;
    const int col = map_col<MODE>(n0 + (lane & 31));
    float tv[32];
#pragma unroll
    for (int i = 0; i < 32; ++i) { const int kk = 2 * i + (lane >> 5); tv[i] = (col >= 0) ? W[(size_t)(k0 + kk) * Nsrc + col] : 0.f; }
#pragma unroll
    for (int i = 0; i < 32; ++i) { const int kk = 2 * i + (lane >> 5); float v = tv[i]; if (kscale) v *= kscale[k0 + kk]; scr[kk * 33 + (lane & 31)] = v; }
    LDS_WAIT();
    const int c = lane & 7;
#pragma unroll
    for (int j = 0; j < 4; ++j) { const int n = (lane >> 3) + 8 * j; const LAS float* s = scr + (8 * c) * 33 + n;
        u32x4 o; o.x = pk2(s[0 * 33], s[1 * 33]); o.y = pk2(s[2 * 33], s[3 * 33]); o.z = pk2(s[4 * 33], s[5 * 33]); o.w = pk2(s[6 * 33], s[7 * 33]);
        *(u32x4*)(WT + (size_t)(n0 + n) * K + k0 + 8 * c) = o; }
    LDS_WAIT();
}
__device__ __forceinline__ void p0_prologue(const Args& A, LAS unsigned char* lds, int gw, int NGW, int wave, int lane) {
    LAS float* scr = (LAS float*)(lds + wave * 16384);
    unsigned char* ws = A.ws;
    constexpr int I_IN = 16 * (NIN / 32), I_UP = 16 * (F2 / 32), I_DN = 44 * 32, I_O = 16 * 32, I_OA = 8 * 32, I_W2 = 16, I_G2 = 2 * 16;
    constexpr int NITEMS = I_IN + I_UP + I_DN + I_O + 2 * I_OA + 2 * I_W2 + I_G2;
    for (int it = gw; it < NITEMS; it += NGW) {
        int r = it;
        if (r < I_IN) { tr_item<1>(A.in[IN_W_IN], 1024, 5392, NIN, (bf16_t*)(ws + OFF_WIN), nullptr, scr, r, lane); continue; } r -= I_IN;
        if (r < I_UP) { tr_item<2>(A.in[IN_WUP], 1024, F2, F2, (bf16_t*)(ws + OFF_WUP), A.in[IN_NORM_FFN], scr, r, lane); continue; } r -= I_UP;
        if (r < I_DN) { tr_item<0>(A.in[IN_WDN], FF, 1024, 1024, (bf16_t*)(ws + OFF_WDN), nullptr, scr, r, lane); continue; } r -= I_DN;
        if (r < I_O) { tr_item<0>(A.in[IN_WO], 1024, 1024, 1024, (bf16_t*)(ws + OFF_WO), nullptr, scr, r, lane); continue; } r -= I_O;
        if (r < I_OA) { tr_item<0>(A.in[IN_WOA], 512, 1024, 1024, (bf16_t*)(ws + OFF_WOA), nullptr, scr, r, lane); continue; } r -= I_OA;
        if (r < I_OA) { tr_item<0>(A.in[IN_WOB], 512, 1024, 1024, (bf16_t*)(ws + OFF_WOB), nullptr, scr, r, lane); continue; } r -= I_OA;
        if (r < I_W2) { tr_item<0>(A.in[IN_W2], 64, 512, 512, (bf16_t*)(ws + OFF_W2T), nullptr, scr, r, lane); continue; } r -= I_W2;
        if (r < I_W2) { tr_item<0>(A.in[IN_A2], 64, 512, 512, (bf16_t*)(ws + OFF_A2T), nullptr, scr, r, lane); continue; } r -= I_W2;
        tr_item<0>(A.in[IN_G2], 128, 512, 512, (bf16_t*)(ws + OFF_G2T), nullptr, scr, r, lane);
    }
    bf16_t* H = (bf16_t*)((unsigned char*)A.out + OUTB_H);
    const float* gm = A.in[IN_NORM_MIX];
    for (int m = gw; m < M; m += 2 * NGW) {
        const int m2 = m + NGW; const bool has2 = m2 < M;
        const f32x4* xr = (const f32x4*)xrow_ptr(A, m) + lane; const f32x4* xr2 = (const f32x4*)xrow_ptr(A, has2 ? m2 : m) + lane; f32x4 v[4], w[4]; float s = 0.f, s2 = 0.f;
#pragma unroll
        for (int j = 0; j < 4; ++j) { v[j] = xr[64 * j]; w[j] = xr2[64 * j]; }
#pragma unroll
        for (int j = 0; j < 4; ++j) { s += (v[j].x * v[j].x + v[j].y * v[j].y) + (v[j].z * v[j].z + v[j].w * v[j].w); s2 += (w[j].x * w[j].x + w[j].y * w[j].y) + (w[j].z * w[j].z + w[j].w * w[j].w); }
        const float rstd = rsqrtf(wave_allsum(s) * (1.f / DM) + NORM_EPS), rstd2 = rsqrtf(wave_allsum(s2) * (1.f / DM) + NORM_EPS);
        u32x2* o8 = (u32x2*)(H + (size_t)m * DM) + lane; u32x2* o82 = (u32x2*)(H + (size_t)m2 * DM) + lane;
#pragma unroll
        for (int j = 0; j < 4; ++j) { const f32x4 g = *((const f32x4*)gm + lane + 64 * j); u32x2 p; p.x = pk2(v[j].x * rstd * g.x, v[j].y * rstd * g.y); p.y = pk2(v[j].z * rstd * g.z, v[j].w * rstd * g.w); o8[64 * j] = p;
            if (has2) { u32x2 p2; p2.x = pk2(w[j].x * rstd2 * g.x, w[j].y * rstd2 * g.y); p2.y = pk2(w[j].z * rstd2 * g.z, w[j].w * rstd2 * g.w); o82[64 * j] = p2; } }
    }
    float* rowss = (float*)(ws + OFF_ROWSS);
    for (int i = gw * 64 + lane; i < M; i += NGW * 64) rowss[i] = 0.f;
}

__device__ __forceinline__ void prw_mixed8(const Args& A, const bf16_t* PRW, int r, int col0, float (&xs)[8]) {
    float cur[8], prev[8];
    ld8bf(PRW + (size_t)r * NPRW + col0, cur);
    const bool first = (r < MP) ? ((r & 2047) == 0) : (((r - MP) & 7) == 0);
    if (!first) ld8bf(PRW + (size_t)(r - 1) * NPRW + col0, prev);
    else if (r < MP) {
#pragma unroll
        for (int i = 0; i < 8; ++i) prev[i] = 0.f;
    } else ld8f(A.in[IN_ST_SHIFT] + (size_t)((r - MP) >> 3) * 1792 + col0, prev);
    float mu[8]; ld8f(A.in[IN_MU] + col0, mu);
#pragma unroll
    for (int i = 0; i < 8; ++i) xs[i] = cur[i] + (prev[i] - cur[i]) * mu[i];
}
template <int ACT> __device__ __forceinline__ bf16x8 afrag(const Args& A, const bf16_t* PRW, int r, int col0) {
    float xs[8]; prw_mixed8(A, PRW, r, col0, xs);
#pragma unroll
    for (int i = 0; i < 8; ++i) xs[i] = ACT == 1 ? ftanh(xs[i]) : (ACT == 2 ? fsigmoid(xs[i]) : xs[i]);
    return __builtin_bit_cast(bf16x8, pack8(xs));
}
__device__ __forceinline__ void p2a_lora(const Args& A, int gw, int NGW, int lane) {
    const bf16_t* PRW = (const bf16_t*)(A.ws + OFF_PRW);
    const bf16_t *W2T = (const bf16_t*)(A.ws + OFF_W2T), *A2T = (const bf16_t*)(A.ws + OFF_A2T), *G2T = (const bf16_t*)(A.ws + OFF_G2T);
    bf16_t *EW = (bf16_t*)((unsigned char*)A.out + OUTB_EW), *AARR = (bf16_t*)((unsigned char*)A.out + OUTB_AARR), *G = (bf16_t*)(A.ws + OFF_G);
    for (int i = gw * 64 + lane; i < 136 * 224; i += NGW * 64) { const int sq = i / 224, c8 = (i - sq * 224) * 8; const int r = sq < 8 ? sq * 2048 + 2047 : MP + (sq - 8) * 8 + 7;
        float v[8]; ld8bf(PRW + (size_t)r * NPRW + c8, v); float* dst = (sq < 8 ? A.out + OUT_SHIFT_P + (size_t)sq * 1792 : A.out + OUT_SHIFT_S + (size_t)(sq - 8) * 1792) + c8;
        *(f32x4*)dst = (f32x4){v[0], v[1], v[2], v[3]}; *(f32x4*)(dst + 4) = (f32x4){v[4], v[5], v[6], v[7]}; }
    const int l15 = lane & 15, kq = lane >> 4;
    for (int task = gw; task < (M / 16) * 8; task += NGW) {
        const int tile = task >> 3, h = task & 7, t0 = tile * 16, r = t0 + l15;
        bf16x8 aw[2], aa[2], ag[4];
#pragma unroll
        for (int ks = 0; ks < 2; ++ks) { aw[ks] = afrag<1>(A, PRW, r, 1536 + ks * 32 + kq * 8); aa[ks] = afrag<0>(A, PRW, r, 1600 + ks * 32 + kq * 8); }
#pragma unroll
        for (int ks = 0; ks < 4; ++ks) ag[ks] = afrag<2>(A, PRW, r, 1664 + ks * 32 + kq * 8);
#pragma unroll
        for (int nt = 0; nt < 4; ++nt) {
            const int c = 64 * h + 16 * nt + l15;
            f32x4 cw = {0.f, 0.f, 0.f, 0.f}, ca = cw, cgv = cw;
#pragma unroll
            for (int ks = 0; ks < 2; ++ks) {
                const bf16x8 bw = *(const bf16x8*)(W2T + (size_t)c * 64 + ks * 32 + kq * 8), ba = *(const bf16x8*)(A2T + (size_t)c * 64 + ks * 32 + kq * 8);
                cw = __builtin_amdgcn_mfma_f32_16x16x32_bf16(bw, aw[ks], cw, 0, 0, 0); ca = __builtin_amdgcn_mfma_f32_16x16x32_bf16(ba, aa[ks], ca, 0, 0, 0); }
#pragma unroll
            for (int ks = 0; ks < 4; ++ks) { const bf16x8 bg = *(const bf16x8*)(G2T + (size_t)c * 128 + ks * 32 + kq * 8); cgv = __builtin_amdgcn_mfma_f32_16x16x32_bf16(bg, ag[ks], cgv, 0, 0, 0); }
            const int c4 = 64 * h + 16 * nt + 4 * kq; const size_t o = (size_t)(t0 + l15) * 512 + c4;
            const f32x4 w0v = *(const f32x4*)(A.in[IN_W0] + c4), a0v = *(const f32x4*)(A.in[IN_A0] + c4);
            float ew[4], av[4];
#pragma unroll
            for (int i = 0; i < 4; ++i) { ew[i] = __expf(-fsoftplus(-(w0v[i] + cw[i])) - 0.5f); av[i] = fsigmoid(a0v[i] + ca[i]); }
            u32x2 w; w.x = pk2(ew[0], ew[1]); w.y = pk2(ew[2], ew[3]); *(u32x2*)(EW + o) = w;
            w.x = pk2(av[0], av[1]); w.y = pk2(av[2], av[3]); *(u32x2*)(AARR + o) = w;
            w.x = pk2(cgv[0], cgv[1]); w.y = pk2(cgv[2], cgv[3]); *(u32x2*)(G + o) = w;
        }
    }
}

typedef short bf16x4 __attribute__((ext_vector_type(4)));
#define MFMA32(a, b, c) __builtin_amdgcn_mfma_f32_16x16x32_bf16(a, b, c, 0, 0, 0)
#define MFMA16(a, b, c) __builtin_amdgcn_mfma_f32_16x16x16bf16_1k(a, b, c, 0, 0, 0)
constexpr int SP = 72;
constexpr size_t OFF_RLT = 240 * MiB;
constexpr size_t OFF_GL = 1 * MiB, OFF_GG = 8 * MiB;
static_assert(OFF_RLT + (size_t)448 * 32768 <= 256 * MiB && OFF_GL + (size_t)224 * 32768 <= OFF_GG && OFF_GG + 224 * 256 <= OFF_WUP, "ws map (scan)");
__device__ __forceinline__ bf16x4 bf4(f32x4 v) { u32x2 w; w.x = pk2(v[0], v[1]); w.y = pk2(v[2], v[3]); return __builtin_bit_cast(bf16x4, w); }
__device__ __forceinline__ bf16x8 afr(const LAS bf16_t* X, int l15, int q, int ks) { const LAS bf16_t* p = X + l15 * SP + 32 * ks + 4 * q; const u32x2 lo = *(const LAS u32x2*)p, hi = *(const LAS u32x2*)(p + 16); u32x4 w; w.x = lo.x; w.y = lo.y; w.z = hi.x; w.w = hi.y; return __builtin_bit_cast(bf16x8, w); }
__device__ __forceinline__ bf16x8 hfrag(const f32x4& lo, const f32x4& hi) { u32x4 w; w.x = pk2(lo[0], lo[1]); w.y = pk2(lo[2], lo[3]); w.z = pk2(hi[0], hi[1]); w.w = pk2(hi[2], hi[3]); return __builtin_bit_cast(bf16x8, w); }
__device__ __forceinline__ f32x4 maskc(f32x4 v, int q, int l15, bool rows_lt_col, bool incl) {
#pragma unroll
    for (int i = 0; i < 4; ++i) { const int R = 4 * q + i; const bool keep = rows_lt_col ? (incl ? R <= l15 : R < l15) : (incl ? l15 <= R : l15 < R); v[i] = keep ? v[i] : 0.f; }
    return v;
}
template <bool GLA, int VP> __device__ __forceinline__ void scan_matrix_part(const LAS bf16_t* AT, const LAS bf16_t* RT, const LAS bf16_t* BT, const LAS bf16_t* KT, const LAS bf16_t* VS, const LAS float* GC, bf16_t* OUTP, int l15, int q, int sl, bool use_v, bool write_o, int rowb, int nv, f32x4 (&H)[4]) {
    const bf16x8 hb0 = hfrag(H[0], H[1]), hb1 = hfrag(H[2], H[3]);
    const bf16x8 rt0 = afr(RT, l15, q, 0), rt1 = afr(RT, l15, q, 1), kt0 = afr(KT, l15, q, 0), kt1 = afr(KT, l15, q, 1);
    const f32x4 z4 = {0.f, 0.f, 0.f, 0.f};
    bf16x4 vb = {0, 0, 0, 0};
    if (use_v) { const LAS bf16_t* vp = VS + (4 * q) * VP + 16 * sl + l15; u32x2 w; w.x = (unsigned)vp[0] | ((unsigned)vp[VP] << 16); w.y = (unsigned)vp[2 * VP] | ((unsigned)vp[3 * VP] << 16); vb = __builtin_bit_cast(bf16x4, w); }
    f32x4 O = MFMA32(rt0, hb0, z4); O = MFMA32(rt1, hb1, O);
    f32x4 U = z4;
    if (!GLA) {
        const bf16x8 at0 = afr(AT, l15, q, 0), at1 = afr(AT, l15, q, 1), bt0 = afr(BT, l15, q, 0), bt1 = afr(BT, l15, q, 1);
        f32x4 P = MFMA32(at0, bt0, z4); P = MFMA32(at1, bt1, P); P = maskc(P, q, l15, false, false);
        f32x4 PT = MFMA32(bt0, at0, z4); PT = MFMA32(bt1, at1, PT); PT = maskc(PT, q, l15, true, false);
        f32x4 nrbT = MFMA32(bt0, rt0, z4); nrbT = MFMA32(bt1, rt1, nrbT); nrbT = maskc(nrbT, q, l15, true, true);
        U = MFMA32(at0, hb0, z4); U = MFMA32(at1, hb1, U);
        if (use_v) { f32x4 makT = MFMA32(kt0, at0, z4); makT = MFMA32(kt1, at1, makT); makT = maskc(makT, q, l15, true, false); U = MFMA16(bf4(makT), vb, U); }
#pragma unroll
        for (int it = 0; it < 4; ++it) {
            U = MFMA16(bf4(PT), bf4(U), U);
            if (it < 3) { const f32x4 Pn = MFMA16(bf4(PT), bf4(P), z4), PTn = MFMA16(bf4(P), bf4(PT), z4); P = Pn; PT = PTn; }
        }
        O = MFMA16(bf4(nrbT), bf4(U), O);
    }
    if (use_v) { f32x4 nrkT = MFMA32(kt0, rt0, z4); nrkT = MFMA32(kt1, rt1, nrkT); nrkT = maskc(nrkT, q, l15, true, true); O = MFMA16(bf4(nrkT), vb, O); }
    if (write_o) {
#pragma unroll
        for (int i = 0; i < 4; ++i) if (4 * q + i < nv) OUTP[(size_t)(rowb + 4 * q + i) * 512] = (bf16_t)f2bf(O[i]);
    }
    const bf16x4 ub = bf4(U);
#pragma unroll
    for (int kt = 0; kt < 4; ++kt) {
        const f32x4 g4 = *(const LAS f32x4*)(GC + 16 * kt + 4 * q); const float gk = GC[16 * kt + l15];
        f32x4 acc = H[kt] * g4;
        if (!GLA) { const LAS bf16_t* p = BT + (4 * q) * SP + 16 * kt + l15; u32x2 w; w.x = pk2(bf2f(p[0]) * gk, bf2f(p[SP]) * gk); w.y = pk2(bf2f(p[2 * SP]) * gk, bf2f(p[3 * SP]) * gk); acc = MFMA16(__builtin_bit_cast(bf16x4, w), ub, acc); }
        if (use_v) { const LAS bf16_t* p = KT + (4 * q) * SP + 16 * kt + l15; u32x2 w; w.x = pk2(bf2f(p[0]) * gk, bf2f(p[SP]) * gk); w.y = pk2(bf2f(p[2 * SP]) * gk, bf2f(p[3 * SP]) * gk); acc = MFMA16(__builtin_bit_cast(bf16x4, w), vb, acc); }
        H[kt] = acc;
    }
}
constexpr int GL_RT = 2304, GL_BT = 4608, GL_KT = 6912, GL_VS = 9216, GL_GC = 13568, GL_EG = 13824, GL_BYTES = 26624;
template <bool GLA, int W> __device__ __forceinline__ void scan_block(const Args& A, LAS unsigned char* gl, int lane, int wg, int row0, int nsub, int nvalid, int first_kind, int bsamp, int hh, int sl, bool use_v, bool write_o, f32x4 (&H)[4], float& cumtot) {
    constexpr int TPW = 16 / W, VP = GLA ? 136 : 72;
    const int c = lane, l15 = lane & 15, q = lane >> 4, t0 = wg * TPW;
    const bf16_t* PRW = (const bf16_t*)(A.ws + OFF_PRW); const bf16_t* PGLA = (const bf16_t*)(A.ws + OFF_PGLA);
    const bf16_t *EW = (const bf16_t*)((unsigned char*)A.out + OUTB_EW), *AARR = (const bf16_t*)((unsigned char*)A.out + OUTB_AARR);
    bf16_t* OUTP = GLA ? (bf16_t*)((unsigned char*)A.out + OUTB_OGL) + 128 * hh + 16 * sl + l15 : (bf16_t*)((unsigned char*)A.out + OUTB_ORW) + 64 * hh + 16 * sl + l15;
    LAS bf16_t *AT = (LAS bf16_t*)gl, *RT = (LAS bf16_t*)(gl + GL_RT), *BT = (LAS bf16_t*)(gl + GL_BT), *KT = (LAS bf16_t*)(gl + GL_KT), *VS = (LAS bf16_t*)(gl + GL_VS);
    LAS float *GC = (LAS float*)(gl + GL_GC), *EG = (LAS float*)(gl + GL_EG);
    float mu_r = 0.f, mu_k = 0.f, mu_v = 0.f, kkc = 0.f, kac = 0.f, bgc = 0.f; float wgt[16];
#pragma unroll
    for (int j = 0; j < 16; ++j) wgt[j] = 0.f;
    if (!GLA) { const float* mu = A.in[IN_MU]; mu_r = mu[64 * hh + c]; mu_k = mu[512 + 64 * hh + c]; mu_v = mu[1024 + 64 * hh + c]; kkc = A.in[IN_KK][64 * hh + c]; kac = A.in[IN_KA][64 * hh + c]; }
    else { bgc = A.in[IN_BG][64 * hh + c];
#pragma unroll
        for (int j = 0; j < 16; ++j) wgt[j] = A.in[IN_WG2][j * 256 + 64 * hh + c]; }
    float pr[2] = {0.f, 0.f}, pk[2] = {0.f, 0.f}, pvv[2] = {0.f, 0.f}; bf16_t r0[2][TPW], r1[2][TPW], r2[2][TPW], r3[2][TPW], r4[2][TPW]; unsigned rvv[2][TPW]; u32x4 lg0[2][TPW], lg1[2][TPW];
#pragma unroll
    for (int p = 0; p < 2; ++p)
#pragma unroll
        for (int i = 0; i < TPW; ++i) { r0[p][i] = r1[p][i] = r2[p][i] = r3[p][i] = r4[p][i] = 0; rvv[p][i] = 0u; lg0[p][i] = (u32x4){0u, 0u, 0u, 0u}; lg1[p][i] = lg0[p][i]; }
#define SB_LOAD(SC, P) do { const int nv_ = ((SC) == nsub - 1) ? nvalid : 16; \
        if (!GLA) { if ((SC) == 0 && t0 == 0) { pr[P] = pk[P] = pvv[P] = 0.f; if (first_kind == 0) { const bf16_t* p = PRW + (size_t)(row0 - 1) * NPRW + 64 * hh + c; pr[P] = bf2f(p[0]); pk[P] = bf2f(p[512]); pvv[P] = bf2f(p[1024]); } \
                        else if (first_kind == 2) { const float* st = A.in[IN_ST_SHIFT] + (size_t)bsamp * 1792 + 64 * hh + c; pr[P] = st[0]; pk[P] = st[512]; pvv[P] = st[1024]; } } \
                    else if (t0 < nv_) { const bf16_t* p = PRW + (size_t)(row0 + 16 * (SC) + t0 - 1) * NPRW + 64 * hh + c; pr[P] = bf2f(p[0]); pk[P] = bf2f(p[512]); pvv[P] = bf2f(p[1024]); } } \
        _Pragma("unroll") for (int i = 0; i < TPW; ++i) if (t0 + i < nv_) { const size_t ro = (size_t)(row0 + 16 * (SC) + t0 + i); \
            if (!GLA) { const bf16_t* p = PRW + ro * NPRW + 64 * hh + c; r0[P][i] = p[0]; r1[P][i] = p[512]; r2[P][i] = p[1024]; r3[P][i] = EW[ro * 512 + 64 * hh + c]; r4[P][i] = AARR[ro * 512 + 64 * hh + c]; } \
            else { const bf16_t* p = PGLA + ro * NPGLA; r0[P][i] = p[64 * hh + c]; r1[P][i] = p[256 + 64 * hh + c]; rvv[P][i] = *(const unsigned*)(p + 512 + 128 * hh + 2 * lane); lg0[P][i] = *(const u32x4*)(p + 1024); lg1[P][i] = *(const u32x4*)(p + 1032); } } } while (0)
#define SB_EG(SC, P) do { const int nv_ = ((SC) == nsub - 1) ? nvalid : 16; LAS float* eg_ = EG + (P) * 1024; float tot_ = 0.f; \
        _Pragma("unroll") for (int i = 0; i < TPW; ++i) { float ev = 0.f; if (t0 + i < nv_) { if (!GLA) ev = bf2f(r3[P][i]); else { float lga[16], t8[8]; unpack8(lg0[P][i], t8); _Pragma("unroll") for (int j = 0; j < 8; ++j) lga[j] = t8[j]; \
                unpack8(lg1[P][i], t8); _Pragma("unroll") for (int j = 0; j < 8; ++j) lga[8 + j] = t8[j]; float z = bgc; _Pragma("unroll") for (int j = 0; j < 16; ++j) z += lga[j] * wgt[j]; ev = fsoftplus(-z) * 0.0625f; } } \
            eg_[(t0 + i) * 64 + c] = ev; tot_ += ev; } \
        WT[((P) * 8 + wg) * 64 + c] = tot_; } while (0)
#define SB_ITER(SC, P) do { const int sc = (SC); const int nv = (sc == nsub - 1) ? nvalid : 16; \
        __syncthreads();                                                         \
        { const LAS float* eg = EG + (P) * 1024; float cum = 0.f; \
          _Pragma("unroll") for (int w2 = 0; w2 < W - 1; ++w2) { const float tw = WT[((P) * 8 + w2) * 64 + c]; cum += (w2 < wg) ? tw : 0.f; } \
          _Pragma("unroll") for (int i = 0; i < TPW; ++i) { const int t = t0 + i; \
            if (t < nv) { \
                const float gp = __expf(-cum); cum += eg[t * 64 + c]; const float g = __expf(-cum), e = __expf(cum); \
                if (!GLA) { \
                    const float cr = bf2f(r0[P][i]), ck = bf2f(r1[P][i]), cv = bf2f(r2[P][i]), a = bf2f(r4[P][i]); \
                    const float xr = cr + (pr[P] - cr) * mu_r, xk = ck + (pk[P] - ck) * mu_k, xv = cv + (pvv[P] - cv) * mu_v; pr[P] = cr; pk[P] = ck; pvv[P] = cv; \
                    const float kkv = xk * kkc, ss = wave_allsum(kkv * kkv), kk = kkv * __builtin_amdgcn_rcpf(fmaxf(sqrtf(ss), 1e-12f)); \
                    const unsigned w01 = pk2(-kk * gp, xr * g), w23 = pk2(kk * a * e, xk * (1.f + (a - 1.f) * kac) * e); \
                    AT[t * SP + c] = (bf16_t)(w01 & 0xffffu); RT[t * SP + c] = (bf16_t)(w01 >> 16); BT[t * SP + c] = (bf16_t)(w23 & 0xffffu); KT[t * SP + c] = (bf16_t)(w23 >> 16); \
                    VS[t * VP + c] = (bf16_t)f2bf(xv); \
                } else { \
                    const unsigned w01 = pk2(bf2f(r0[P][i]) * 0.125f * g, bf2f(r1[P][i]) * e); \
                    RT[t * SP + c] = (bf16_t)(w01 & 0xffffu); KT[t * SP + c] = (bf16_t)(w01 >> 16); \
                    *(LAS unsigned*)(VS + t * VP + 2 * lane) = rvv[P][i]; \
                } \
            } else { \
                if (!GLA) { AT[t * SP + c] = 0; BT[t * SP + c] = 0; VS[t * VP + c] = 0; } else *(LAS unsigned*)(VS + t * VP + 2 * lane) = 0u; \
                RT[t * SP + c] = 0; KT[t * SP + c] = 0; \
            } \
          } \
          if (wg == W - 1) { GC[c] = __expf(-cum); cumtot += cum; } \
        } \
        if (sc + 2 < nsub) SB_LOAD(sc + 2, P); \
        __syncthreads();                                                         \
        scan_matrix_part<GLA, VP>(AT, RT, BT, KT, VS, GC, OUTP, l15, q, sl, use_v, write_o, row0 + 16 * sc, nv, H); \
        if (sc + 1 < nsub) SB_EG(sc + 1, 1 - (P)); } while (0)
    LAS float* WT = EG + 2048;
    SB_LOAD(0, 0); if (nsub > 1) SB_LOAD(1, 1); SB_EG(0, 0);
    for (int sc2 = 0; sc2 < nsub; sc2 += 2) { SB_ITER(sc2, 0); if (sc2 + 1 < nsub) SB_ITER(sc2 + 1, 1); }
#undef SB_LOAD
#undef SB_EG
#undef SB_ITER
}
constexpr int GP = 264;
__device__ __forceinline__ void gla_pass1_item(const Args& A, LAS unsigned char* lds, int wave, int lane, int b, int hh, int cc, int ig) {
    const bf16_t* PGLA = (const bf16_t*)(A.ws + OFF_PGLA);
    LAS bf16_t* KHT = (LAS bf16_t*)lds; LAS bf16_t* VT = KHT + 64 * GP; LAS float* WT = (LAS float*)(lds + (64 + 128) * GP * 2);
    const int c = lane, l15 = lane & 15, q = lane >> 4, row0 = b * 2048 + cc * 256 + 32 * wave;
    float wgt[16]; const float bgc = A.in[IN_BG][64 * hh + c];
#pragma unroll
    for (int j = 0; j < 16; ++j) wgt[j] = A.in[IN_WG2][j * 256 + 64 * hh + c];
    float cum[32]; float run = 0.f;
#pragma unroll
    for (int tb = 0; tb < 32; tb += 8) {
        u32x4 g0[8], g1[8];
#pragma unroll
        for (int j = 0; j < 8; ++j) { const bf16_t* p = PGLA + (size_t)(row0 + tb + j) * NPGLA; g0[j] = *(const u32x4*)(p + 1024); g1[j] = *(const u32x4*)(p + 1032); }
#pragma unroll
        for (int j = 0; j < 8; ++j) { float lga[16], t8[8];
            unpack8(g0[j], t8);
#pragma unroll
            for (int i = 0; i < 8; ++i) lga[i] = t8[i];
            unpack8(g1[j], t8);
#pragma unroll
            for (int i = 0; i < 8; ++i) lga[8 + i] = t8[i];
            float z = bgc;
#pragma unroll
            for (int i = 0; i < 16; ++i) z += lga[i] * wgt[i];
            run += fsoftplus(-z) * 0.0625f; cum[tb + j] = run; }
    }
    __syncthreads();
    WT[wave * 64 + c] = run;
    __syncthreads();
    float after = 0.f, tot = 0.f;
#pragma unroll
    for (int w2 = 0; w2 < 8; ++w2) { const float tw = WT[w2 * 64 + c]; tot += tw; after += (w2 > wave) ? tw : 0.f; }
#pragma unroll
    for (int tb = 0; tb < 32; tb += 16) {
        bf16_t rk[16]; unsigned rv[16];
#pragma unroll
        for (int j = 0; j < 16; ++j) { const bf16_t* p = PGLA + (size_t)(row0 + tb + j) * NPGLA; rk[j] = p[256 + 64 * hh + c]; rv[j] = *(const unsigned*)(p + 512 + 128 * hh + 2 * lane); }
#pragma unroll
        for (int j = 0; j < 16; ++j) { const int t = tb + j;
            KHT[c * GP + 32 * wave + t] = (bf16_t)f2bf(bf2f(rk[j]) * __expf(-(after + (run - cum[t]))));
            VT[(2 * lane) * GP + 32 * wave + t] = (bf16_t)(rv[j] & 0xffffu); VT[(2 * lane + 1) * GP + 32 * wave + t] = (bf16_t)(rv[j] >> 16); }
    }
    __syncthreads();
    f32x4 acc[4];
#pragma unroll
    for (int kt = 0; kt < 4; ++kt) acc[kt] = (f32x4){0.f, 0.f, 0.f, 0.f};
#pragma unroll
    for (int ks = 0; ks < 8; ++ks) { const bf16x8 bv = *(const LAS bf16x8*)(VT + (16 * wave + l15) * GP + 32 * ks + 8 * q);
#pragma unroll
        for (int kt = 0; kt < 4; ++kt) { const bf16x8 av = *(const LAS bf16x8*)(KHT + (16 * kt + l15) * GP + 32 * ks + 8 * q); acc[kt] = MFMA32(av, bv, acc[kt]); } }
    float* dst = (float*)(A.ws + OFF_GL) + (size_t)ig * 8192 + 16 * wave + l15;
#pragma unroll
    for (int kt = 0; kt < 4; ++kt)
#pragma unroll
        for (int i = 0; i < 4; ++i) dst[(16 * kt + 4 * q + i) * 128] = acc[kt][i];
    if (wave == 7) ((float*)(A.ws + OFF_GG))[ig * 64 + lane] = __expf(-tot);
}
__device__ __forceinline__ void p2x_scan1(const Args& A, LAS unsigned char* lds, int wave, int lane) {
    const int l15 = lane & 15, q = lane >> 4;
    for (int it = blockIdx.x; it < 448 + 224; it += gridDim.x) {
        f32x4 H[4]; float cumtot = 0.f;
        if (it < 448) {
            const int seq = it / 7, cc = it - seq * 7, b = seq >> 3, hh = seq & 7; const bool isT = wave >= 4; const int sl = wave & 3;
#pragma unroll
            for (int kt = 0; kt < 4; ++kt)
#pragma unroll
                for (int i = 0; i < 4; ++i) H[kt][i] = (isT && (16 * kt + 4 * q + i == 16 * sl + l15)) ? 1.f : 0.f;
            scan_block<false, 8>(A, lds, lane, wave, b * 2048 + cc * 256, 16, 16, cc == 0 ? 1 : 0, 0, hh, sl, !isT, false, H, cumtot);
            float* dst = (float*)(A.ws + OFF_RLT) + (size_t)it * 8192 + (isT ? 4096 : 0) + 16 * sl + l15;
#pragma unroll
            for (int kt = 0; kt < 4; ++kt)
#pragma unroll
                for (int i = 0; i < 4; ++i) dst[(16 * kt + 4 * q + i) * 64] = H[kt][i];
        } else {
            const int ig = it - 448, seq = ig / 7, cc = ig - seq * 7, b = seq >> 2, hh = seq & 3;
            gla_pass1_item(A, lds, wave, lane, b, hh, cc, ig);
        }
    }
    __syncthreads();
}
__device__ __forceinline__ void p2y_scan2(const Args& A, LAS unsigned char* lds, int wave, int lane) {
    const int l15 = lane & 15, q = lane >> 4;
    for (int bi = blockIdx.x; bi < 256 + 256 + 512 + 512; bi += gridDim.x) {
        f32x4 H[4]; float cumtot = 0.f;
#pragma unroll
        for (int kt = 0; kt < 4; ++kt) H[kt] = (f32x4){0.f, 0.f, 0.f, 0.f};
        if (bi < 256) {
            const int item = 2 * bi + (wave >> 2), sl = wave & 3, cc = item & 7, seq = item >> 3, b = seq >> 3, hh = seq & 7;
            for (int j = 0; j < cc; ++j) {
                const float* Lj = (const float*)(A.ws + OFF_RLT) + (size_t)(seq * 7 + j) * 8192; const float* Tj = Lj + 4096;
                const bf16x8 hb0 = hfrag(H[0], H[1]), hb1 = hfrag(H[2], H[3]);
#pragma unroll
                for (int kt = 0; kt < 4; ++kt) {
                    f32x4 acc;
#pragma unroll
                    for (int i = 0; i < 4; ++i) acc[i] = Lj[(16 * kt + 4 * q + i) * 64 + 16 * sl + l15];
                    const float* tr = Tj + (16 * kt + l15) * 64 + 4 * q;
                    const f32x4 t0 = *(const f32x4*)tr, t1 = *(const f32x4*)(tr + 16), t2 = *(const f32x4*)(tr + 32), t3 = *(const f32x4*)(tr + 48);
                    acc = MFMA32(hfrag(t0, t1), hb0, acc); acc = MFMA32(hfrag(t2, t3), hb1, acc);
                    H[kt] = acc;
                }
            }
            scan_block<false, 4>(A, lds + (wave >> 2) * GL_BYTES, lane, wave & 3, b * 2048 + cc * 256, 16, 16, cc == 0 ? 1 : 0, 0, hh, sl, true, true, H, cumtot);
            if (cc == 7) { float* o = A.out + OUT_WKV_P + (((size_t)b * 8 + hh) * 64 + 16 * sl + l15) * 64 + 4 * q;
#pragma unroll
                for (int kt = 0; kt < 4; ++kt) *(f32x4*)(o + 16 * kt) = H[kt]; }
        } else if (bi < 512) {
            const int item = bi - 256, sl = wave, cc = item & 7, seq = item >> 3, b = seq >> 2, hh = seq & 3;
            for (int j = 0; j < cc; ++j) {
                const float* Lj = (const float*)(A.ws + OFF_GL) + (size_t)(seq * 7 + j) * 8192; const float* Gj = (const float*)(A.ws + OFF_GG) + (seq * 7 + j) * 64;
#pragma unroll
                for (int kt = 0; kt < 4; ++kt)
#pragma unroll
                    for (int i = 0; i < 4; ++i) H[kt][i] = Gj[16 * kt + 4 * q + i] * H[kt][i] + Lj[(16 * kt + 4 * q + i) * 128 + 16 * sl + l15];
            }
            scan_block<true, 8>(A, lds, lane, wave, b * 2048 + cc * 256, 16, 16, 0, 0, hh, sl, true, true, H, cumtot);
            if (cc == 7) { float* o = A.out + OUT_GLA_P + (((size_t)b * 4 + hh) * 64) * 128 + 16 * sl + l15;
#pragma unroll
                for (int kt = 0; kt < 4; ++kt)
#pragma unroll
                    for (int i = 0; i < 4; ++i) o[(size_t)(16 * kt + 4 * q + i) * 128] = H[kt][i]; }
        } else if (bi < 1024) {
            const int item = 2 * (bi - 512) + (wave >> 2), sl = wave & 3, hh = item & 7, b = item >> 3;
            const float* st = A.in[IN_ST_WKV] + (((size_t)b * 8 + hh) * 64 + 16 * sl + l15) * 64 + 4 * q;
#pragma unroll
            for (int kt = 0; kt < 4; ++kt) H[kt] = *(const f32x4*)(st + 16 * kt);
            scan_block<false, 4>(A, lds + (wave >> 2) * GL_BYTES, lane, wave & 3, MP + b * 8, 1, 8, 2, b, hh, sl, true, true, H, cumtot);
            float* o = A.out + OUT_WKV_S + (((size_t)b * 8 + hh) * 64 + 16 * sl + l15) * 64 + 4 * q;
#pragma unroll
            for (int kt = 0; kt < 4; ++kt) *(f32x4*)(o + 16 * kt) = H[kt];
        } else {
            const int item = bi - 1024, sl = wave, hh = item & 3, b = item >> 2;
            const float* st = A.in[IN_ST_GLA] + (((size_t)b * 4 + hh) * 64) * 128 + 16 * sl + l15;
#pragma unroll
            for (int kt = 0; kt < 4; ++kt)
#pragma unroll
                for (int i = 0; i < 4; ++i) H[kt][i] = st[(size_t)(16 * kt + 4 * q + i) * 128];
            scan_block<true, 8>(A, lds, lane, wave, MP + b * 8, 1, 8, 0, b, hh, sl, true, true, H, cumtot);
            float* o = A.out + OUT_GLA_S + (((size_t)b * 4 + hh) * 64) * 128 + 16 * sl + l15;
#pragma unroll
            for (int kt = 0; kt < 4; ++kt)
#pragma unroll
                for (int i = 0; i < 4; ++i) o[(size_t)(16 * kt + 4 * q + i) * 128] = H[kt][i];
        }
    }
}
__device__ __forceinline__ void p2c_mix(const Args& A, int r, int col0, u32x4 rcur, u32x4 rprev, float (&xs)[8]) {
    float cur[8], prev[8]; unpack8(rcur, cur);
    const bool first = (r < MP) ? ((r & 2047) == 0) : (((r - MP) & 7) == 0);
    if (!first) unpack8(rprev, prev);
    else if (r < MP) {
#pragma unroll
        for (int i = 0; i < 8; ++i) prev[i] = 0.f;
    } else ld8f(A.in[IN_ST_SHIFT] + (size_t)((r - MP) >> 3) * 1792 + col0, prev);
    float mu[8]; ld8f(A.in[IN_MU] + col0, mu);
#pragma unroll
    for (int i = 0; i < 8; ++i) xs[i] = cur[i] + (prev[i] - cur[i]) * mu[i];
}
__device__ __forceinline__ void p2c_post(const Args& A, int gw, int NGW, int lane, bool shadow) {
    const bf16_t* PRW = (const bf16_t*)(A.ws + OFF_PRW); const bf16_t* PGLA = (const bf16_t*)(A.ws + OFF_PGLA);
    const bf16_t *AARR = (const bf16_t*)((unsigned char*)A.out + OUTB_AARR), *G = (const bf16_t*)(A.ws + OFF_G);
    bf16_t *ORW = (bf16_t*)((unsigned char*)A.out + OUTB_ORW), *OGL = (bf16_t*)((unsigned char*)A.out + OUTB_OGL);
    const int c0 = 8 * lane;
    for (int rb = gw; rb < M; rb += 2 * NGW) {
        u32x4 raw[2][11];
#pragma unroll
        for (int k = 0; k < 2; ++k) { const int r = (rb + k * NGW < M) ? rb + k * NGW : rb; const int rp = r > 0 ? r - 1 : 0;
            raw[k][0] = *(const u32x4*)(ORW + (size_t)r * 512 + c0); raw[k][1] = *(const u32x4*)(OGL + (size_t)r * 512 + c0);
            raw[k][2] = *(const u32x4*)(PRW + (size_t)r * NPRW + c0); raw[k][3] = *(const u32x4*)(PRW + (size_t)r * NPRW + 512 + c0); raw[k][4] = *(const u32x4*)(PRW + (size_t)r * NPRW + 1024 + c0);
            raw[k][5] = *(const u32x4*)(PRW + (size_t)rp * NPRW + c0); raw[k][6] = *(const u32x4*)(PRW + (size_t)rp * NPRW + 512 + c0); raw[k][7] = *(const u32x4*)(PRW + (size_t)rp * NPRW + 1024 + c0);
            raw[k][8] = *(const u32x4*)(AARR + (size_t)r * 512 + c0); raw[k][9] = *(const u32x4*)(G + (size_t)r * 512 + c0); raw[k][10] = *(const u32x4*)(PGLA + (size_t)r * NPGLA + 1040 + c0); }
#pragma unroll
        for (int k = 0; k < 2; ++k) { const int r = rb + k * NGW; if (r < M) {
            float o[8], d[8], xr[8], xk[8], xv[8], a[8], g[8], p[8], res[8];
            unpack8(raw[k][0], o);
            float s1 = 0.f;
#pragma unroll
            for (int i = 0; i < 8; ++i) s1 += o[i];
            const float mu = row8_allsum(s1) * (1.f / 64.f); float s2 = 0.f;
#pragma unroll
            for (int i = 0; i < 8; ++i) { d[i] = o[i] - mu; s2 += d[i] * d[i]; }
            const float rstd = rsqrtf(row8_allsum(s2) * (1.f / 64.f) + 64e-5f);
            p2c_mix(A, r, c0, raw[k][2], raw[k][5], xr); p2c_mix(A, r, 512 + c0, raw[k][3], raw[k][6], xk); p2c_mix(A, r, 1024 + c0, raw[k][4], raw[k][7], xv);
            unpack8(raw[k][8], a); unpack8(raw[k][9], g);
            float bs = 0.f; ld8f(A.in[IN_KA] + c0, p);
#pragma unroll
            for (int i = 0; i < 8; ++i) d[i] *= rstd, xk[i] = xk[i] * (1.f + (a[i] - 1.f) * p[i]);
            ld8f(A.in[IN_RK] + c0, p);
#pragma unroll
            for (int i = 0; i < 8; ++i) bs += xr[i] * xk[i] * p[i];
            bs = row8_allsum(bs);
            ld8f(A.in[IN_LNW] + c0, p); ld8f(A.in[IN_LNB] + c0, a);
#pragma unroll
            for (int i = 0; i < 8; ++i) res[i] = ((d[i] * p[i] + a[i]) + bs * xv[i]) * g[i];
            if (!shadow) *(u32x4*)(ORW + (size_t)r * 512 + c0) = pack8(res); else *(u32x4*)((bf16_t*)(A.ws + 240 * MiB) + (size_t)(r & 8191) * 512 + c0) = pack8(res);
            unpack8(raw[k][1], o);
            float ms = 0.f;
#pragma unroll
            for (int i = 0; i < 8; ++i) ms += o[i] * o[i];
            const float rs = rsqrtf(row16_allsum(ms) * (1.f / 128.f) + NORM_EPS);
            unpack8(raw[k][10], g); ld8f(A.in[IN_GNW] + (c0 & 127), p);
#pragma unroll
            for (int i = 0; i < 8; ++i) res[i] = o[i] * rs * p[i] * (g[i] * fsigmoid(g[i]));
            if (!shadow) *(u32x4*)(OGL + (size_t)r * 512 + c0) = pack8(res); else *(u32x4*)((bf16_t*)(A.ws + 248 * MiB) + (size_t)(r & 8191) * 512 + c0) = pack8(res);
        } }
    }
}
__device__ __forceinline__ void p6_act(const Args& A, int gtid, int NGT) {
    bf16_t* U = (bf16_t*)(A.ws + OFF_U); const bf16_t* UH = (const bf16_t*)(A.ws + OFF_UH);
    const float *convw = A.in[IN_CONVW], *convb = A.in[IN_CONVB], *cstate = A.in[IN_ST_CONV];
    for (int item = gtid; item < (M / 64) * 352; item += NGT) {
        const int rb = item / 352, jc = (item - rb * 352) * 8, r0 = rb * 64; const bool sample = r0 >= MP;
        float p1v[8], p2v[8], p1g[8], p2g[8], w0v[8], w1v[8], w2v[8], cbv[8], w0g[8], w1g[8], w2g[8], cbg[8];
        ld8f(convw + jc, w0v); ld8f(convw + F2 + jc, w1v); ld8f(convw + 2 * F2 + jc, w2v); ld8f(convb + jc, cbv);
        ld8f(convw + FF + jc, w0g); ld8f(convw + F2 + FF + jc, w1g); ld8f(convw + 2 * F2 + FF + jc, w2g); ld8f(convb + FF + jc, cbg);
#pragma unroll
        for (int i = 0; i < 8; ++i) p1v[i] = p2v[i] = p1g[i] = p2g[i] = 0.f;
        if (!sample && (rb & 31) != 0) { const bf16_t* q = UH + (size_t)(rb - 1) * 2 * F2; ld8bf(q + jc, p2v); ld8bf(q + FF + jc, p2g); ld8bf(q + F2 + jc, p1v); ld8bf(q + F2 + FF + jc, p1g); }
        for (int r8 = 0; r8 < 64; r8 += 8) {
            u32x4 rawv[8], rawg[8];
#pragma unroll
            for (int k = 0; k < 8; ++k) { const bf16_t* row = U + (size_t)(r0 + r8 + k) * F2; rawv[k] = *(const u32x4*)(row + jc); rawg[k] = *(const u32x4*)(row + FF + jc); }
            if (sample) { const float* st = cstate + (size_t)((r0 + r8 - MP) >> 3) * 2 * F2; ld8f(st + jc, p2v); ld8f(st + FF + jc, p2g); ld8f(st + F2 + jc, p1v); ld8f(st + F2 + FF + jc, p1g); }
#pragma unroll
            for (int k = 0; k < 8; ++k) {
                float cv[8], cg[8], res[8]; unpack8(rawv[k], cv); unpack8(rawg[k], cg);
#pragma unroll
                for (int i = 0; i < 8; ++i) { const float v = cbv[i] + w0v[i] * p2v[i] + w1v[i] * p1v[i] + w2v[i] * cv[i], gg = cbg[i] + w0g[i] * p2g[i] + w1g[i] * p1g[i] + w2g[i] * cg[i];
                    res[i] = gelu_gate(gg, v); p2v[i] = p1v[i]; p1v[i] = cv[i]; p2g[i] = p1g[i]; p1g[i] = cg[i]; }
                *(u32x4*)(U + (size_t)(r0 + r8 + k) * F2 + jc) = pack8(res);
            }
        }
    }
}
__device__ __forceinline__ void pfix_act(const Args& A, int gtid, int NGT) {
    const bf16_t* UH = (const bf16_t*)(A.ws + OFF_UH); const bf16_t* US = (const bf16_t*)(A.ws + OFF_US); bf16_t* ACT = (bf16_t*)(A.ws + OFF_ACT);
    const float *convw = A.in[IN_CONVW], *convb = A.in[IN_CONVB], *cstate = A.in[IN_ST_CONV];
    for (int idx = gtid; idx < (256 + 128) * 2 * 352; idx += NGT) {
        const int g = idx / 704, rem = idx - g * 704, rsel = rem / 352, jc = (rem - rsel * 352) * 8;
        float cv[8], cg[8], p1v[8], p1g[8], p2v[8], p2g[8], res[8]; int orow;
#pragma unroll
        for (int i = 0; i < 8; ++i) p1v[i] = p1g[i] = p2v[i] = p2g[i] = 0.f;
        if (g < 256) {
            const bool seq0 = (g & 31) == 0; orow = 64 * g + rsel;
            ld8bf(UH + ((size_t)g * 4 + rsel) * F2 + jc, cv); ld8bf(UH + ((size_t)g * 4 + rsel) * F2 + FF + jc, cg);
            if (rsel == 0) { if (!seq0) { const bf16_t* q = UH + ((size_t)(g - 1) * 4 + 3) * F2; ld8bf(q + jc, p1v); ld8bf(q + FF + jc, p1g); q -= F2; ld8bf(q + jc, p2v); ld8bf(q + FF + jc, p2g); } }
            else { const bf16_t* q = UH + ((size_t)g * 4) * F2; ld8bf(q + jc, p1v); ld8bf(q + FF + jc, p1g);
                if (!seq0) { q = UH + ((size_t)(g - 1) * 4 + 3) * F2; ld8bf(q + jc, p2v); ld8bf(q + FF + jc, p2g); } }
        } else {
            const int sb = g - 256; orow = MP + 8 * sb + rsel; const float* st = cstate + (size_t)sb * 2 * F2;
            ld8bf(US + ((size_t)sb * 2 + rsel) * F2 + jc, cv); ld8bf(US + ((size_t)sb * 2 + rsel) * F2 + FF + jc, cg);
            if (rsel == 0) { ld8f(st + jc, p2v); ld8f(st + FF + jc, p2g); ld8f(st + F2 + jc, p1v); ld8f(st + F2 + FF + jc, p1g); }
            else { ld8f(st + F2 + jc, p2v); ld8f(st + F2 + FF + jc, p2g); ld8bf(US + ((size_t)sb * 2) * F2 + jc, p1v); ld8bf(US + ((size_t)sb * 2) * F2 + FF + jc, p1g); }
        }
#pragma unroll
        for (int i = 0; i < 8; ++i) { const int col = jc + i;
            const float v = convb[col] + convw[col] * p2v[i] + convw[F2 + col] * p1v[i] + convw[2 * F2 + col] * cv[i];
            const float gg = convb[FF + col] + convw[FF + col] * p2g[i] + convw[F2 + FF + col] * p1g[i] + convw[2 * F2 + FF + col] * cg[i];
            res[i] = gelu_gate(gg, v); }
        *(u32x4*)(ACT + (size_t)orow * FF + jc) = pack8(res);
    }
}
__device__ __forceinline__ void p8_final(const Args& A, int gw, int NGW, int lane, float* dst) {
    const float* gf = A.in[IN_NORM_FINAL];
    for (int m = gw; m < M; m += 2 * NGW) {
        const int m2 = m + NGW; const bool has2 = m2 < M;
        const f32x4* xr = (const f32x4*)(A.out + (size_t)m * DM) + lane; const f32x4* xr2 = (const f32x4*)(A.out + (size_t)(has2 ? m2 : m) * DM) + lane; f32x4 v[4], w[4]; float s = 0.f, s2 = 0.f;
#pragma unroll
        for (int j = 0; j < 4; ++j) { v[j] = xr[64 * j]; w[j] = xr2[64 * j]; }
#pragma unroll
        for (int j = 0; j < 4; ++j) { s += (v[j].x * v[j].x + v[j].y * v[j].y) + (v[j].z * v[j].z + v[j].w * v[j].w); s2 += (w[j].x * w[j].x + w[j].y * w[j].y) + (w[j].z * w[j].z + w[j].w * w[j].w); }
        const float rstd = rsqrtf(wave_allsum(s) * (1.f / DM) + NORM_EPS), rstd2 = rsqrtf(wave_allsum(s2) * (1.f / DM) + NORM_EPS);
#pragma unroll
        for (int j = 0; j < 4; ++j) { const f32x4 g = *((const f32x4*)gf + lane + 64 * j); ((f32x4*)(dst + (size_t)m * DM) + lane)[64 * j] = v[j] * rstd * g; if (has2) ((f32x4*)(dst + (size_t)m2 * DM) + lane)[64 * j] = w[j] * rstd2 * g; }
    }
}

#ifndef PHMASK
#define PHMASK 0xFFFF
#endif
#ifndef PHREP
#define PHREP 0
#endif
#define PH(k) for (int rep_ = 0; rep_ < ((((PHMASK) >> (k)) & 1) ? ((((PHREP) >> (k)) & 1) ? 2 : 1) : 0); ++rep_)
__global__ void __launch_bounds__(NTHREADS, 2) fwd_megakernel(Args A) {
    extern __shared__ __attribute__((aligned(16))) unsigned char lds_raw[];
    LAS unsigned char* lds = (LAS unsigned char*)lds_raw;
    cg::grid_group grid = cg::this_grid();
    const int tid = threadIdx.x, lane = tid & 63, wave = __builtin_amdgcn_readfirstlane(tid >> 6);
    const int G = gridDim.x, gw = blockIdx.x * NWAVES + wave, NGW = G * NWAVES;
    unsigned char* ws = A.ws;
    if (tid < 4) ((LAS unsigned*)(lds + 131072))[tid] = 0u;
    __syncthreads();
    const XcdBarrier xbar = xcd_barrier_post((unsigned*)(ws + OFF_BAR), (volatile LAS unsigned*)(lds + 131072));
#define GSYNC() xcd_barrier(xbar)
    PH(0) p0_prologue(A, lds, gw, NGW, wave, lane);
    if (A.ws == nullptr) grid.sync();
    GSYNC();
    PH(1) { pg8::Gemm g{(const bf16_t*)((unsigned char*)A.out + OUTB_H), (const bf16_t*)(ws + OFF_WIN), M, NIN, 1024, 1024}; pg8::StaticOrder S; S.init(M, NIN, G, (int)blockIdx.x);
      EpiProj E{(bf16_t*)(ws + OFF_PRW), (bf16_t*)(ws + OFF_PGLA), (bf16_t*)(ws + OFF_PGATE), A.out + OUT_SHIFT_P, A.out + OUT_SHIFT_S};
      pg8::gemm_phase<EpiProj, pg8::StaticOrder, true, true>(lds, g, S, E); }
    GSYNC();
    PH(2) p2a_lora(A, gw, NGW, lane);
    GSYNC();
    PH(3) p2x_scan1(A, lds, wave, lane);
    GSYNC();
    PH(11) p2y_scan2(A, lds, wave, lane);
    GSYNC();
#ifdef SHADOW_P2C
    p2c_post(A, gw, NGW, lane, true);
#endif
    PH(4) p2c_post(A, gw, NGW, lane, false);
    GSYNC();
    PH(5) { pg8::StaticOrder S; S.init(M, 1024, G, (int)blockIdx.x); S.limit = __builtin_amdgcn_readfirstlane((S.nwg / G) * G);
      { pg8::Gemm g{(const bf16_t*)((unsigned char*)A.out + OUTB_ORW), (const bf16_t*)(ws + OFF_WOA), M, 1024, 512, 512};
        EpiGate<true> E{(bf16_t*)(ws + OFF_MERGED), (const bf16_t*)(ws + OFF_PGATE)};
        pg8::gemm_phase<EpiGate<true>, pg8::StaticOrder, true, true>(lds, g, S, E);
        tail_gemm(lds, (const bf16_t*)((unsigned char*)A.out + OUTB_ORW), 512, (const bf16_t*)(ws + OFF_WOA), 512, S, wave, lane, TfGate{true, (bf16_t*)(ws + OFF_MERGED), (const bf16_t*)(ws + OFF_PGATE)}); }
      { pg8::Gemm g{(const bf16_t*)((unsigned char*)A.out + OUTB_OGL), (const bf16_t*)(ws + OFF_WOB), M, 1024, 512, 512};
        EpiGate<false> E{(bf16_t*)(ws + OFF_MERGED), (const bf16_t*)(ws + OFF_PGATE) + 1024};
        pg8::gemm_phase<EpiGate<false>, pg8::StaticOrder, true, true>(lds, g, S, E);
        tail_gemm(lds, (const bf16_t*)((unsigned char*)A.out + OUTB_OGL), 512, (const bf16_t*)(ws + OFF_WOB), 512, S, wave, lane, TfGate{false, (bf16_t*)(ws + OFF_MERGED), (const bf16_t*)(ws + OFF_PGATE) + 1024}); } }
    GSYNC();
    PH(6) { pg8::Gemm g{(const bf16_t*)(ws + OFF_MERGED), (const bf16_t*)(ws + OFF_WO), M, 1024, 1024, 1024}; pg8::StaticOrder S; S.init(M, 1024, G, (int)blockIdx.x); S.limit = __builtin_amdgcn_readfirstlane((S.nwg / G) * G);
#ifdef SHADOW_G3
      float* rss = (rep_ == 0) ? (float*)(ws + OFF_ROWSS + 256 * 1024) : (float*)(ws + OFF_ROWSS);
#else
      float* rss = (float*)(ws + OFF_ROWSS);
#endif
      EpiX1 E{A.in[IN_XP], A.in[IN_XS], A.out, (bf16_t*)(ws + OFF_X1B), rss};
      pg8::gemm_phase<EpiX1, pg8::StaticOrder, true, true>(lds, g, S, E);
      tail_gemm(lds, (const bf16_t*)(ws + OFF_MERGED), 1024, (const bf16_t*)(ws + OFF_WO), 1024, S, wave, lane, TfX1{A.in[IN_XP], A.in[IN_XS], A.out, (bf16_t*)(ws + OFF_X1B), rss}); }
    GSYNC();
    PH(7) { pg8::Gemm g{(const bf16_t*)(ws + OFF_X1B), (const bf16_t*)(ws + OFF_WUP), M, F2, 1024, 1024}; pg8::StaticOrder S; S.init(M, F2, G, (int)blockIdx.x);
      EpiAct E{(const float*)(ws + OFF_ROWSS), A.in[IN_CONVW], A.in[IN_CONVB], (bf16_t*)(ws + OFF_ACT), (bf16_t*)(ws + OFF_UH), (bf16_t*)(ws + OFF_US), A.out + OUT_CONV_P, A.out + OUT_CONV_S, (LAS float*)(lds + 131072)};
      pg8::gemm_phase<EpiAct, pg8::StaticOrder, true, true>(lds, g, S, E); }
    __syncthreads(); if (tid < 4) ((LAS unsigned*)(lds + 131072))[tid] = 0u; __syncthreads();
    GSYNC();
    PH(8) pfix_act(A, blockIdx.x * NTHREADS + tid, G * NTHREADS);
    GSYNC();
    PH(9) { pg8::Gemm g{(const bf16_t*)(ws + OFF_ACT), (const bf16_t*)(ws + OFF_WDN), M, 1024, FF, FF}; pg8::StaticOrder S; S.init(M, 1024, G, (int)blockIdx.x); S.limit = __builtin_amdgcn_readfirstlane((S.nwg / G) * G);
#ifdef SHADOW_G5
      float* xd = (rep_ == 0) ? (float*)(ws + 129 * MiB) : A.out;
#else
      float* xd = A.out;
#endif
      EpiX2 E{A.out, xd};
      pg8::gemm_phase<EpiX2, pg8::StaticOrder, true, true>(lds, g, S, E);
      tail_gemm(lds, (const bf16_t*)(ws + OFF_ACT), FF, (const bf16_t*)(ws + OFF_WDN), FF, S, wave, lane, TfX2{A.out, xd}); }
    GSYNC();
#ifdef P8_SHADOW
    p8_final(A, gw, NGW, lane, (float*)(ws + OFF_U));
#endif
    PH(10) p8_final(A, gw, NGW, lane, A.out);
#ifdef EXTRA_SYNCS
    for (int i_ = 0; i_ < EXTRA_SYNCS; ++i_) GSYNC();
#endif
}

extern "C" void kernel_launch(void* const* d_in, const int* in_sizes, int n_in, void* d_out, int out_size, void* d_ws, size_t ws_size, hipStream_t stream) {
    static int grid = 0;
    if (grid == 0) {
        int dev = 0, cus = 0, per_cu = 0;
        if (n_in != 31 || ws_size < 256 * MiB) { fprintf(stderr, "kernel_launch: unexpected n_in %d / ws_size %zu\n", n_in, ws_size); grid = -1; return; }
        (void)hipGetDevice(&dev); (void)hipDeviceGetAttribute(&cus, hipDeviceAttributeMultiprocessorCount, dev);
        if (hipFuncSetAttribute((const void*)fwd_megakernel, hipFuncAttributeMaxDynamicSharedMemorySize, LDS_BYTES) != hipSuccess) { fprintf(stderr, "kernel_launch: hipFuncSetAttribute failed\n"); grid = -1; return; }
        if (hipOccupancyMaxActiveBlocksPerMultiprocessor(&per_cu, (const void*)fwd_megakernel, NTHREADS, LDS_BYTES) != hipSuccess || per_cu < 1) { fprintf(stderr, "kernel_launch: occupancy query failed (%d)\n", per_cu); (void)hipGetLastError(); grid = -1; return; }
        grid = cus * 1;
    }
    if (grid < 0) return;
    Args a{};
    for (int i = 0; i < 31; ++i) a.in[i] = (const float*)d_in[i];
    a.out = (float*)d_out; a.ws = (unsigned char*)d_ws;
    if (hipMemsetAsync((char*)d_ws + OFF_BAR, 0, XCD_BAR_WORDS * 4, stream) != hipSuccess) { fprintf(stderr, "kernel_launch: memset of the barrier words failed\n"); return; }
    void* params[] = {&a};
    hipError_t e = hipLaunchCooperativeKernel((const void*)fwd_megakernel, dim3(grid), dim3(NTHREADS), params, LDS_BYTES, stream);
    if (e != hipSuccess) fprintf(stderr, "kernel_launch: cooperative launch failed: %s (grid %d)\n", hipGetErrorString(e), grid);
}
```

```cpp
#include <hip/hip_runtime.h>
#include <hip/hip_cooperative_groups.h>
#include <cstdio>
#include <cstdint>
namespace cg = cooperative_groups;
#define PHREP 0
namespace pg8 {
#define PG8_LAS __attribute__((address_space(3)))
typedef unsigned short bf16_t;
typedef short bf16x8 __attribute__((ext_vector_type(8)));
typedef float f32x4 __attribute__((ext_vector_type(4)));
typedef unsigned u32x4 __attribute__((ext_vector_type(4)));
constexpr int BM = 256, BK = 64, HALF = 128, HTB = HALF * BK * 2  , STAGE_BYTES = 8 * HTB, NXCD = 8, WGM = 8;

__host__ __device__ __forceinline__ int lds_byte(int r, int c) { const int st = (r >> 4) * 2 + (c >> 5), rr = r & 15, cc = c & 31, ob = rr * 64 + cc * 2; return st * 1024 + (ob ^ (((ob >> 9) & 1) << 5)); }
__host__ __device__ __forceinline__ void stage_rc(int b, int& R, int& C) { const int st = b / 1024, sb = b % 1024, swz = sb ^ (((sb >> 9) & 1) << 5); R = (st >> 1) * 16 + swz / 64; C = (st & 1) * 32 + (swz % 64) / 2; }
__host__ __device__ __forceinline__ int perm32(int rho) { const int n = rho >> 4, i = rho & 15; return 8 * (i >> 2) + 4 * n + (i & 3); }

struct Unit { int pm, pn; };
struct Gemm { const bf16_t* A; const bf16_t* Bt; int M, N, K, lda; };

struct StaticOrder {
    int nM, nN, nwg, G, c;
    int limit;
    __host__ __device__ void init(int M, int N, int G_, int c_) { nM = M / BM; nN = N / BM; nwg = nM * nN; G = G_; c = c_; limit = nwg; }
    __host__ __device__ __forceinline__ bool next(int i, Unit& u) const {
        const int L = i * G + c; if (L >= limit) return false;
        unit_of(L, u); return true;
    }
    __host__ __device__ __forceinline__ void unit_of(int L, Unit& u) const {
        int wgid = L; { const int q = nwg / NXCD, r = nwg % NXCD, xcd = wgid % NXCD, off = wgid / NXCD; wgid = (xcd < r ? xcd * (q + 1) : r * (q + 1) + (xcd - r) * q) + off; }
        const int nig = WGM * nN, gid = wgid / nig, fm = gid * WGM, gsz = (nM - fm) < WGM ? (nM - fm) : WGM;
        u.pm = fm + ((wgid % nig) % gsz); u.pn = (wgid % nig) / gsz;
    }
    __device__ __forceinline__ void a_ready(const Unit&) const {}
    __device__ __forceinline__ void done(const Unit&) const {}
};
__device__ __forceinline__ unsigned cvt_pk_bf16(float lo, float hi) { unsigned r; asm volatile("v_cvt_pk_bf16_f32 %0, %1, %2" : "=v"(r) : "v"(lo), "v"(hi)); return r; }
typedef float f32x2 __attribute__((ext_vector_type(2)));
template <class Epi, class Sched, bool ALIGN_EPI = false, bool SP2 = false>
__device__ __forceinline__ void gemm_phase(PG8_LAS unsigned char* lds, const Gemm g, const Sched& S, const Epi& E) {
    int tid_ = threadIdx.x; asm volatile("" : "+v"(tid_));
    const int tid = tid_, wid = __builtin_amdgcn_readfirstlane(tid >> 6), lane = tid & 63, wr = wid >> 2, wc = wid & 3, fr = lane & 15, fq = lane >> 4;
    const int K = g.K, nt = K / BK;
    unsigned voffA[2], voffB[2];
#pragma unroll
    for (int i = 0; i < 2; ++i) { int R, C; stage_rc(tid * 16 + i * 8192, R, C); const int Rb = Epi::PERM ? ((R & ~31) + perm32(R & 31)) : R;
        voffA[i] = (unsigned)(R * g.lda + C) * 2u; voffB[i] = (unsigned)(Rb * K + C) * 2u; }
    const size_t kstep = (size_t)(BK * 2);
    const size_t hstep = (size_t)HALF * K * 2;
    const size_t tstep = 2 * hstep;
    const size_t hstepA = (size_t)HALF * g.lda * 2, tstepA = 2 * hstepA;
    const unsigned ldsw = (unsigned)wid * 1024u;
    const int aoff = lds_byte(wr * 64 + fr, fq * 8), boff = lds_byte(wc * 32 + fr, fq * 8);
#define PG8_SA(b, h) (((b) * 2 + (h)) * HTB)
#define PG8_SB(b, h) ((4 + (b) * 2 + (h)) * HTB)
#define PG8_STAGE(bufoff, gbase, voff) do { _Pragma("unroll") for (int _i = 0; _i < 2; ++_i) \
        __builtin_amdgcn_global_load_lds((const unsigned*)((const char*)(gbase) + (voff)[_i]), (PG8_LAS unsigned*)(lds + (bufoff) + ldsw + _i * 8192), 16, 0, 0); } while (0)
#define PG8_LDA(dst, b, h) do { _Pragma("unroll") for (int m = 0; m < 4; ++m) _Pragma("unroll") for (int k = 0; k < 2; ++k) dst[m][k] = *(const PG8_LAS bf16x8*)(lds + PG8_SA(b, h) + aoff + m * 2048 + k * 1024); } while (0)
#define PG8_LDB(dst, b, h) do { _Pragma("unroll") for (int n = 0; n < 2; ++n) _Pragma("unroll") for (int k = 0; k < 2; ++k) dst[n][k] = *(const PG8_LAS bf16x8*)(lds + PG8_SB(b, h) + boff + n * 2048 + k * 1024); } while (0)
#define PG8_MMA(ai, bj, At, Bt) do { __builtin_amdgcn_s_setprio(1); _Pragma("unroll") for (int m = 0; m < 4; ++m) _Pragma("unroll") for (int n = 0; n < 2; ++n) _Pragma("unroll") for (int k = 0; k < 2; ++k) \
        acc[ai][bj][m][n] = __builtin_amdgcn_mfma_f32_16x16x32_bf16(Bt[n][k], At[m][k], acc[ai][bj][m][n], 0, 0, 0); __builtin_amdgcn_s_setprio(0); } while (0)
#define PG8_WAIT_V(n) asm volatile("s_waitcnt vmcnt(" #n ")" ::: "memory")
#define PG8_WAIT_L(n) asm volatile("s_waitcnt lgkmcnt(" #n ")" ::: "memory")
#define PG8_BAR __builtin_amdgcn_s_barrier()
#define PG8_SCHED __builtin_amdgcn_sched_barrier(0)
    Unit cur, nxt; int ui = 0;
    if (!S.next(0, cur)) return;
    f32x4 acc[2][2][4][2];
#pragma unroll
    for (int a = 0; a < 2; ++a)
#pragma unroll
        for (int b = 0; b < 2; ++b)
#pragma unroll
            for (int m = 0; m < 4; ++m)
#pragma unroll
                for (int n = 0; n < 2; ++n) acc[a][b][m][n] = (f32x4){0.f, 0.f, 0.f, 0.f};
    bf16x8 At[4][2], B0[2][2], B1[2][2];
    const char* cA = (const char*)g.A + (size_t)cur.pm * tstepA; const char* cB = (const char*)g.Bt + (size_t)cur.pn * tstep;
    S.a_ready(cur);
    if constexpr (SP2) {
        PG8_STAGE(PG8_SB(0, 0), cB, voffB); PG8_STAGE(PG8_SB(0, 1), cB + hstep, voffB); PG8_STAGE(PG8_SA(0, 0), cA, voffA); PG8_STAGE(PG8_SA(0, 1), cA + hstepA, voffA);
        if (wr == 1) PG8_BAR;
        PG8_WAIT_V(2); PG8_BAR;
        PG8_STAGE(PG8_SB(1, 0), cB + kstep, voffB); PG8_STAGE(PG8_SA(1, 0), cA + kstep, voffA); PG8_STAGE(PG8_SB(1, 1), cB + hstep + kstep, voffB);
        PG8_WAIT_V(6); PG8_BAR;
    } else {
        PG8_STAGE(PG8_SB(0, 0), cB, voffB); PG8_STAGE(PG8_SA(0, 0), cA, voffA); PG8_STAGE(PG8_SB(0, 1), cB + hstep, voffB); PG8_STAGE(PG8_SA(0, 1), cA + hstepA, voffA);
        if (wr == 1) PG8_BAR;
        PG8_WAIT_V(4); PG8_BAR;
        PG8_STAGE(PG8_SB(1, 0), cB + kstep, voffB); PG8_STAGE(PG8_SA(1, 0), cA + kstep, voffA); PG8_STAGE(PG8_SB(1, 1), cB + hstep + kstep, voffB);
        PG8_WAIT_V(6); PG8_BAR;
    }
    for (;;) {
        const bool has_next = S.next(ui + 1, nxt);
        const char* nA = has_next ? (const char*)g.A + (size_t)nxt.pm * tstepA : cA; const char* nB = has_next ? (const char*)g.Bt + (size_t)nxt.pn * tstep : cB;
        for (int t = 0; t < nt; t += 2) {
            const bool last = (t == nt - 2);
            const char* a1 = cA + (size_t)(t + 1) * kstep;
            const char* a2 = last ? nA : cA + (size_t)(t + 2) * kstep; const char* b2 = last ? nB : cB + (size_t)(t + 2) * kstep;
            const char* a3 = a2 + kstep; const char* b3 = b2 + kstep;
            if (last && has_next) S.a_ready(nxt);
            if constexpr (SP2) {
            PG8_LDB(B0, 0, 0); PG8_LDB(B1, 0, 1); PG8_SCHED; PG8_LDA(At, 0, 0); PG8_STAGE(PG8_SA(1, 1), a1 + hstepA, voffA);
            PG8_WAIT_V(8); PG8_WAIT_L(0); PG8_BAR; PG8_MMA(0, 0, At, B0); PG8_MMA(0, 1, At, B1); PG8_BAR; PG8_SCHED;
            PG8_LDA(At, 0, 1); PG8_STAGE(PG8_SB(0, 0), b2, voffB); PG8_STAGE(PG8_SB(0, 1), b2 + hstep, voffB); PG8_STAGE(PG8_SA(0, 0), a2, voffA);
            PG8_WAIT_V(8); PG8_WAIT_L(0); PG8_BAR; PG8_MMA(1, 0, At, B0); PG8_MMA(1, 1, At, B1); PG8_BAR; PG8_SCHED;
            PG8_LDB(B0, 1, 0); PG8_LDB(B1, 1, 1); PG8_SCHED; PG8_LDA(At, 1, 0); PG8_STAGE(PG8_SA(0, 1), a2 + hstepA, voffA);
            PG8_WAIT_V(8); PG8_WAIT_L(0); PG8_BAR; PG8_MMA(0, 0, At, B0); PG8_MMA(0, 1, At, B1); PG8_BAR; PG8_SCHED;
            PG8_LDA(At, 1, 1); PG8_STAGE(PG8_SB(1, 0), b3, voffB); PG8_STAGE(PG8_SB(1, 1), b3 + hstep, voffB); PG8_STAGE(PG8_SA(1, 0), a3, voffA);
            PG8_WAIT_V(8); PG8_WAIT_L(0); PG8_BAR; PG8_MMA(1, 0, At, B0); PG8_MMA(1, 1, At, B1); PG8_BAR; PG8_SCHED;
            } else {
            PG8_LDB(B0, 0, 0); PG8_SCHED; PG8_LDA(At, 0, 0); PG8_STAGE(PG8_SA(1, 1), a1 + hstepA, voffA);
            PG8_WAIT_L(8); PG8_BAR; PG8_WAIT_L(0); PG8_MMA(0, 0, At, B0); PG8_BAR; PG8_SCHED;
            PG8_LDB(B1, 0, 1); PG8_STAGE(PG8_SB(0, 0), b2, voffB);
            PG8_BAR; PG8_WAIT_L(0); PG8_MMA(0, 1, At, B1); PG8_BAR;
            PG8_LDA(At, 0, 1); PG8_STAGE(PG8_SA(0, 0), a2, voffA);
            PG8_BAR; PG8_WAIT_L(0); PG8_MMA(1, 0, At, B0); PG8_BAR; PG8_SCHED;
            PG8_STAGE(PG8_SB(0, 1), b2 + hstep, voffB);
            PG8_WAIT_V(6); PG8_BAR; PG8_MMA(1, 1, At, B1); PG8_BAR;
            PG8_LDB(B0, 1, 0); PG8_SCHED; PG8_LDA(At, 1, 0); PG8_STAGE(PG8_SA(0, 1), a2 + hstepA, voffA);
            PG8_WAIT_L(8); PG8_BAR; PG8_WAIT_L(0); PG8_MMA(0, 0, At, B0); PG8_BAR; PG8_SCHED;
            PG8_LDB(B1, 1, 1); PG8_STAGE(PG8_SB(1, 0), b3, voffB);
            PG8_BAR; PG8_WAIT_L(0); PG8_MMA(0, 1, At, B1); PG8_BAR;
            PG8_LDA(At, 1, 1); PG8_STAGE(PG8_SA(1, 0), a3, voffA);
            PG8_BAR; PG8_WAIT_L(0); PG8_MMA(1, 0, At, B0); PG8_BAR; PG8_SCHED;
            PG8_STAGE(PG8_SB(1, 1), b3 + hstep, voffB);
            PG8_WAIT_V(6); PG8_BAR; PG8_MMA(1, 1, At, B1); PG8_BAR;
            }
        }
        if constexpr (ALIGN_EPI) { if (wr == 0) PG8_BAR; }
        if constexpr (!Epi::AFTER_DRAIN) { E(acc, cur, wr, wc, fr, fq); S.done(cur); }
        if (!has_next) break;
#pragma unroll
        for (int a = 0; a < 2; ++a)
#pragma unroll
            for (int b = 0; b < 2; ++b)
#pragma unroll
                for (int m = 0; m < 4; ++m)
#pragma unroll
                    for (int n = 0; n < 2; ++n) acc[a][b][m][n] = (f32x4){0.f, 0.f, 0.f, 0.f};
        cur = nxt; cA = nA; cB = nB; ++ui;
        if constexpr (ALIGN_EPI) { if (wr == 1) PG8_BAR; }
    }
    PG8_WAIT_V(0);
    if constexpr (!ALIGN_EPI) { if (wr == 0) PG8_BAR; }
    PG8_BAR;
    if constexpr (Epi::AFTER_DRAIN) { E.fused(acc, cur, wr, wc, fr, fq, lds, wid, lane); S.done(cur); }
#undef PG8_SA
#undef PG8_SB
#undef PG8_STAGE
#undef PG8_LDA
#undef PG8_LDB
#undef PG8_MMA
#undef PG8_WAIT_V
#undef PG8_WAIT_L
#undef PG8_BAR
#undef PG8_SCHED
}
}

#define LAS __attribute__((address_space(3)))
typedef unsigned short bf16_t;
typedef short bf16x8 __attribute__((ext_vector_type(8)));
typedef float f32x4 __attribute__((ext_vector_type(4)));
typedef unsigned u32x4 __attribute__((ext_vector_type(4)));
typedef unsigned u32x2 __attribute__((ext_vector_type(2)));
using pg8::Unit;

constexpr int M = 17408, MP = 16384, DM = 1024;
constexpr int NPRW = 1792, NPGLA = 1792, NGATE = 2048, NIN = 5632;
constexpr int FF = 2816, F2 = 5632;
constexpr float NORM_EPS = 1e-6f;
constexpr int NWAVES = 8, NTHREADS = 512;
constexpr int LDS_BYTES = 131072 + 32768;
constexpr size_t OFF_BAR = 512 * 1024;

constexpr size_t MiB = 1u << 20;
constexpr size_t OFF_ROWSS = 0;
constexpr size_t OFF_WIN = 1 * MiB, OFF_WUP = 12 * MiB, OFF_WDN = 23 * MiB, OFF_WO = 29 * MiB, OFF_WOA = 31 * MiB, OFF_WOB = 32 * MiB;
constexpr size_t OFF_W2T = 33 * MiB, OFF_A2T = OFF_W2T + 65536, OFF_G2T = OFF_A2T + 65536;
constexpr size_t OFF_PRW = 35 * MiB, OFF_PGLA = 95 * MiB, OFF_PGATE = 155 * MiB, OFF_G = 223 * MiB;
constexpr size_t OFF_MERGED = OFF_PRW, OFF_UH = OFF_WIN, OFF_X1B = 222 * MiB, OFF_U = OFF_PRW, OFF_ACT = OFF_PRW, OFF_US = 29 * MiB;
static_assert(OFF_PRW + (size_t)M * NPRW * 2 <= OFF_PGLA && OFF_PGLA + (size_t)M * NPGLA * 2 <= OFF_PGATE && OFF_PGATE + (size_t)M * NGATE * 2 <= OFF_G, "ws map");
static_assert(OFF_G + (size_t)M * 512 * 2 <= 256 * MiB && OFF_U + (size_t)M * F2 * 2 <= OFF_X1B && OFF_X1B + (size_t)M * DM * 2 <= 256 * MiB, "ws map");
static_assert(OFF_UH + (size_t)256 * 4 * F2 * 2 <= OFF_WUP && OFF_ACT + (size_t)M * FF * 2 <= OFF_X1B, "ws map");

constexpr size_t OUT_SHIFT_P = (size_t)M * DM, OUT_WKV_P = OUT_SHIFT_P + 8 * 1792, OUT_GLA_P = OUT_WKV_P + 8 * 8 * 64 * 64, OUT_CONV_P = OUT_GLA_P + 8 * 4 * 64 * 128;
constexpr size_t OUT_SHIFT_S = OUT_CONV_P + 8 * 2 * F2, OUT_WKV_S = OUT_SHIFT_S + 128 * 1792, OUT_GLA_S = OUT_WKV_S + (size_t)128 * 8 * 64 * 64, OUT_CONV_S = OUT_GLA_S + (size_t)128 * 4 * 64 * 128;
constexpr size_t OUTB_H = 0, OUTB_EW = 0, OUTB_AARR = (size_t)M * 512 * 2, OUTB_ORW = (size_t)M * 1024 * 2, OUTB_OGL = OUTB_ORW + (size_t)M * 512 * 2;

struct Args { const float* in[31]; float* out; unsigned char* ws; };
#define IN_XP 0
#define IN_XS 1
#define IN_ST_SHIFT 2
#define IN_ST_WKV 3
#define IN_ST_GLA 4
#define IN_ST_CONV 5
#define IN_NORM_MIX 6
#define IN_W_IN 7
#define IN_MU 8
#define IN_W0 9
#define IN_W2 10
#define IN_A0 11
#define IN_A2 12
#define IN_G2 13
#define IN_KK 14
#define IN_KA 15
#define IN_RK 16
#define IN_LNW 17
#define IN_LNB 18
#define IN_WG2 19
#define IN_BG 20
#define IN_GNW 21
#define IN_WOA 22
#define IN_WOB 23
#define IN_WO 24
#define IN_NORM_FFN 25
#define IN_WUP 26
#define IN_CONVW 27
#define IN_CONVB 28
#define IN_WDN 29
#define IN_NORM_FINAL 30

__device__ __forceinline__ float bf_lo(unsigned w) { return __builtin_bit_cast(float, w << 16); }
__device__ __forceinline__ float bf_hi(unsigned w) { return __builtin_bit_cast(float, w & 0xffff0000u); }
__device__ __forceinline__ float bf2f(bf16_t h) { return __builtin_bit_cast(float, (unsigned)h << 16); }
__device__ __forceinline__ unsigned f2bf(float f) { unsigned u = __builtin_bit_cast(unsigned, f); return (u + 0x7fffu + ((u >> 16) & 1u)) >> 16; }
typedef float f32x2_t __attribute__((ext_vector_type(2)));
typedef __bf16 bf16x2_t __attribute__((ext_vector_type(2)));
__device__ __forceinline__ unsigned pk2(float lo, float hi) { const f32x2_t v = {lo, hi}; const bf16x2_t b = __builtin_convertvector(v, bf16x2_t); return __builtin_bit_cast(unsigned, b); }
__device__ __forceinline__ void unpack8(u32x4 w, float (&o)[8]) { o[0] = bf_lo(w.x); o[1] = bf_hi(w.x); o[2] = bf_lo(w.y); o[3] = bf_hi(w.y); o[4] = bf_lo(w.z); o[5] = bf_hi(w.z); o[6] = bf_lo(w.w); o[7] = bf_hi(w.w); }
__device__ __forceinline__ u32x4 pack8(const float (&v)[8]) { u32x4 w; w.x = pk2(v[0], v[1]); w.y = pk2(v[2], v[3]); w.z = pk2(v[4], v[5]); w.w = pk2(v[6], v[7]); return w; }
__device__ __forceinline__ void ld8bf(const bf16_t* p, float (&o)[8]) { unpack8(*(const u32x4*)p, o); }
__device__ __forceinline__ void ld8f(const float* p, float (&o)[8]) { const f32x4 a = *(const f32x4*)p, b = *(const f32x4*)(p + 4); o[0] = a.x; o[1] = a.y; o[2] = a.z; o[3] = a.w; o[4] = b.x; o[5] = b.y; o[6] = b.z; o[7] = b.w; }
__device__ __forceinline__ float fsigmoid(float x) { return __builtin_amdgcn_rcpf(1.f + __expf(-x)); }
__device__ __forceinline__ float ftanh(float x) { return 1.f - 2.f * __builtin_amdgcn_rcpf(__expf(2.f * x) + 1.f); }
__device__ __forceinline__ float fsoftplus(float x) { return fmaxf(x, 0.f) + __logf(1.f + __expf(-fabsf(x))); }
template <int CTRL> __device__ __forceinline__ float dpp_mov(float x) { return __builtin_bit_cast(float, __builtin_amdgcn_mov_dpp(__builtin_bit_cast(int, x), CTRL, 0xf, 0xf, true)); }
__device__ __forceinline__ float row16_allsum(float x) { x += dpp_mov<0xB1>(x); x += dpp_mov<0x4E>(x); x += dpp_mov<0x124>(x); x += dpp_mov<0x128>(x); return x; }
__device__ __forceinline__ float row8_allsum(float x) { x += dpp_mov<0xB1>(x); x += dpp_mov<0x4E>(x); x += dpp_mov<0x141>(x); return x; }
__device__ __forceinline__ float rdlane(float x, int l) { return __builtin_bit_cast(float, __builtin_amdgcn_readlane(__builtin_bit_cast(int, x), l)); }
__device__ __forceinline__ float wave_allsum(float x) { x = row16_allsum(x); return (rdlane(x, 0) + rdlane(x, 16)) + (rdlane(x, 32) + rdlane(x, 48)); }
#define LDS_WAIT() asm volatile("s_waitcnt lgkmcnt(0)" ::: "memory")
__device__ __forceinline__ const float* xrow_ptr(const Args& A, int r) { return r < MP ? A.in[IN_XP] + (size_t)r * DM : A.in[IN_XS] + (size_t)(r - MP) * DM; }

#define XB_TMO      128
#define XB_XCNT(j)  (256  + 64 * (j))
#define XB_XSUB(j)  (1280 + 64 * (j))
#define XB_XGEN(j)  (2304 + 64 * (j))
#define XB_TOP      3328
#define XB_TOPGEN   3392
#define XCD_BAR_WORDS 3456
#define XB_SPIN_CAP (1u << 18)

__device__ __forceinline__ unsigned xb_ld(unsigned* p)              { return __hip_atomic_load(p, __ATOMIC_RELAXED, __HIP_MEMORY_SCOPE_AGENT); }
__device__ __forceinline__ unsigned xb_add(unsigned* p, unsigned v) { return __hip_atomic_fetch_add(p, v, __ATOMIC_RELAXED, __HIP_MEMORY_SCOPE_AGENT); }
__device__ __forceinline__ unsigned xb_xcc_id() { return (unsigned)__builtin_amdgcn_s_getreg((3 << 11) | 20) & 0xFu; }
#define XB_SPIN(cond, bar) do { unsigned _sp = 0; while (cond) { __builtin_amdgcn_s_sleep(1); \
    if ((++_sp & 255u) == 0u) { if (xb_ld(&(bar)[XB_TMO])) break; if (_sp > XB_SPIN_CAP) { atomicAdd(&(bar)[XB_TMO], 1u); break; } } } } while (0)

struct XcdBarrier {
    unsigned* bar; unsigned x;
    volatile LAS unsigned* st;
};

__device__ __forceinline__ XcdBarrier xcd_barrier_post(unsigned* bar, volatile LAS unsigned* st) {
    XcdBarrier b; b.bar = bar; b.x = xb_xcc_id(); b.st = st;
    if (threadIdx.x == 0) (void)xb_add(&bar[XB_XCNT(b.x)], 1u);
    return b;
}
__device__ __forceinline__ void xcd_barrier_complete(unsigned* bar, unsigned x, unsigned& nloc, unsigned& nx) {
    const unsigned G = gridDim.x * gridDim.y * gridDim.z;
    unsigned sum, cnt, mine, sp = 0u;
    for (;;) {
        sum = 0u; cnt = 0u; mine = 0u;
#pragma unroll
        for (unsigned j = 0; j < 16; ++j) { const unsigned c = xb_ld(&bar[XB_XCNT(j)]); sum += c; cnt += (c > 0u) ? 1u : 0u; mine = (j == x) ? c : mine; }
        if (sum == G) break;
        __builtin_amdgcn_s_sleep(1);
        if ((++sp & 255u) == 0u) { if (xb_ld(&bar[XB_TMO])) break; if (sp > XB_SPIN_CAP) { atomicAdd(&bar[XB_TMO], 1u); break; } }
    }
    nloc = mine > 0u ? mine : 1u; nx = cnt > 0u ? cnt : 1u;
}

__device__ __forceinline__ void xcd_barrier(const XcdBarrier& b) {
    asm volatile("s_waitcnt vmcnt(0)" ::: "memory");
    __syncthreads();
    if (threadIdx.x == 0) {
        unsigned* bar = b.bar;
        __builtin_amdgcn_s_waitcnt(0);
        unsigned nloc = b.st[0], nx = b.st[1];
        if (nloc == 0u) { xcd_barrier_complete(bar, b.x, nloc, nx); b.st[0] = nloc; b.st[1] = nx; }
        const unsigned old = xb_add(&bar[XB_XSUB(b.x)], 1u);
        const unsigned gen = old / nloc;
        if (old + 1u == (gen + 1u) * nloc) {
            __builtin_amdgcn_fence(__ATOMIC_RELEASE, "agent");
            asm volatile("s_waitcnt vmcnt(0)" ::: "memory");
            const unsigned og = xb_add(&bar[XB_TOP], 1u);
            const unsigned tg = og / nx;
            if (og + 1u == (tg + 1u) * nx) xb_add(&bar[XB_TOPGEN], 1u);
            else XB_SPIN(xb_ld(&bar[XB_TOPGEN]) == tg, bar);
            __builtin_amdgcn_fence(__ATOMIC_ACQUIRE, "agent");
            xb_add(&bar[XB_XGEN(b.x)], 1u);
            asm volatile("s_waitcnt vmcnt(0)" ::: "memory");
        } else {
            XB_SPIN(xb_ld(&bar[XB_XGEN(b.x)]) == gen, bar);
            __builtin_amdgcn_fence(__ATOMIC_ACQUIRE, "agent");
            asm volatile("s_waitcnt vmcnt(0)" ::: "memory");
        }
    }
    __syncthreads();
}


struct EpiProj {
    static constexpr bool PERM = true, AFTER_DRAIN = false;
    bf16_t *prw, *pgla, *pgate; float *shift_p, *shift_s;
    __device__ __forceinline__ void operator()(const f32x4 (&acc)[2][2][4][2], const Unit& u, int wr, int wc, int fr, int fq) const {
        asm volatile("" : "+v"(fr), "+v"(fq));
        bf16_t* base; int ld, colt;
        if (u.pn < 7) { base = prw; ld = NPRW; colt = u.pn * 256; } else if (u.pn < 14) { base = pgla; ld = NPGLA; colt = (u.pn - 7) * 256; } else { base = pgate; ld = NGATE; colt = (u.pn - 14) * 256; }
        const int row0 = u.pm * 256 + wr * 64 + fr, col0 = colt + wc * 32 + 8 * fq;
#pragma unroll
        for (int ai = 0; ai < 2; ++ai)
#pragma unroll
            for (int m = 0; m < 4; ++m) {
                const int r = row0 + ai * 128 + m * 16; bf16_t* rowp = base + (size_t)r * ld + col0;
#pragma unroll
                for (int bj = 0; bj < 2; ++bj) { const f32x4 v0 = acc[ai][bj][m][0], v1 = acc[ai][bj][m][1]; u32x4 w; w.x = pk2(v0[0], v0[1]); w.y = pk2(v0[2], v0[3]); w.z = pk2(v1[0], v1[1]); w.w = pk2(v1[2], v1[3]); *(u32x4*)(rowp + bj * 128) = w; }
            }
    }
};
template <bool FIRST> struct EpiGate {
    static constexpr bool PERM = true, AFTER_DRAIN = false;
    bf16_t* merged; const bf16_t* gate;
    __device__ __forceinline__ void operator()(const f32x4 (&acc)[2][2][4][2], const Unit& u, int wr, int wc, int fr, int fq) const {
        asm volatile("" : "+v"(fr), "+v"(fq));
        const int row0 = u.pm * 256 + wr * 64 + fr, col0 = u.pn * 256 + wc * 32 + 8 * fq;
#pragma unroll
        for (int ai = 0; ai < 2; ++ai) {
            u32x4 gr[4][2], pr[4][2];
#pragma unroll
            for (int m = 0; m < 4; ++m)
#pragma unroll
                for (int bj = 0; bj < 2; ++bj) { const size_t r = (size_t)(row0 + ai * 128 + m * 16); const int c = col0 + bj * 128; gr[m][bj] = *(const u32x4*)(gate + r * NGATE + c); if (!FIRST) pr[m][bj] = *(const u32x4*)(merged + r * DM + c); }
#pragma unroll
            for (int m = 0; m < 4; ++m)
#pragma unroll
                for (int bj = 0; bj < 2; ++bj) { const size_t r = (size_t)(row0 + ai * 128 + m * 16); const int c = col0 + bj * 128; float g[8], v[8]; unpack8(gr[m][bj], g);
                    const f32x4 v0 = acc[ai][bj][m][0], v1 = acc[ai][bj][m][1];
#pragma unroll
                    for (int i = 0; i < 4; ++i) { v[i] = v0[i] * fsigmoid(g[i]); v[4 + i] = v1[i] * fsigmoid(g[4 + i]); }
                    if (!FIRST) { float p[8]; unpack8(pr[m][bj], p);
#pragma unroll
                        for (int i = 0; i < 8; ++i) v[i] += p[i]; }
                    *(u32x4*)(merged + r * DM + c) = pack8(v); }
        }
    }
};
struct EpiX1 {
    static constexpr bool PERM = true, AFTER_DRAIN = false;
    const float *xp, *xs; float* x1; bf16_t* x1b; float* rowss;
    __device__ __forceinline__ void operator()(const f32x4 (&acc)[2][2][4][2], const Unit& u, int wr, int wc, int fr, int fq) const {
        asm volatile("" : "+v"(fr), "+v"(fq));
        const int row0 = u.pm * 256 + wr * 64 + fr, col0 = u.pn * 256 + wc * 32 + 8 * fq;
#pragma unroll
        for (int ai = 0; ai < 2; ++ai) {
            f32x4 xa[4][2][2];
#pragma unroll
            for (int m = 0; m < 4; ++m) { const int r = row0 + ai * 128 + m * 16; const float* xr = (r < MP ? xp + (size_t)r * DM : xs + (size_t)(r - MP) * DM);
#pragma unroll
                for (int bj = 0; bj < 2; ++bj) { xa[m][bj][0] = *(const f32x4*)(xr + col0 + bj * 128); xa[m][bj][1] = *(const f32x4*)(xr + col0 + bj * 128 + 4); } }
#pragma unroll
            for (int m = 0; m < 4; ++m) { const int r = row0 + ai * 128 + m * 16; float ssq = 0.f;
#pragma unroll
                for (int bj = 0; bj < 2; ++bj) { const int c = col0 + bj * 128; const f32x4 a = xa[m][bj][0] + acc[ai][bj][m][0], b = xa[m][bj][1] + acc[ai][bj][m][1];
                    ssq += (a[0] * a[0] + a[1] * a[1]) + (a[2] * a[2] + a[3] * a[3]) + (b[0] * b[0] + b[1] * b[1]) + (b[2] * b[2] + b[3] * b[3]);
                    float* o = x1 + (size_t)r * DM + c; *(f32x4*)o = a; *(f32x4*)(o + 4) = b;
                    u32x4 w; w.x = pk2(a[0], a[1]); w.y = pk2(a[2], a[3]); w.z = pk2(b[0], b[1]); w.w = pk2(b[2], b[3]); *(u32x4*)(x1b + (size_t)r * DM + c) = w; }
                ssq += __shfl_xor(ssq, 16); ssq += __shfl_xor(ssq, 32);
                if (fq == 0) atomicAdd(rowss + r, ssq); }
        }
    }
};
struct EpiX2 {
    static constexpr bool PERM = true, AFTER_DRAIN = false;
    float* x; float* xd;
    __device__ __forceinline__ void operator()(const f32x4 (&acc)[2][2][4][2], const Unit& u, int wr, int wc, int fr, int fq) const {
        asm volatile("" : "+v"(fr), "+v"(fq));
        const int row0 = u.pm * 256 + wr * 64 + fr, col0 = u.pn * 256 + wc * 32 + 8 * fq;
#pragma unroll
        for (int ai = 0; ai < 2; ++ai) {
            f32x4 xa[4][2][2];
#pragma unroll
            for (int m = 0; m < 4; ++m)
#pragma unroll
                for (int bj = 0; bj < 2; ++bj) { const float* o = x + (size_t)(row0 + ai * 128 + m * 16) * DM + col0 + bj * 128; xa[m][bj][0] = *(const f32x4*)o; xa[m][bj][1] = *(const f32x4*)(o + 4); }
#pragma unroll
            for (int m = 0; m < 4; ++m)
#pragma unroll
                for (int bj = 0; bj < 2; ++bj) { float* o = xd + (size_t)(row0 + ai * 128 + m * 16) * DM + col0 + bj * 128; *(f32x4*)o = xa[m][bj][0] + acc[ai][bj][m][0]; *(f32x4*)(o + 4) = xa[m][bj][1] + acc[ai][bj][m][1]; }
        }
    }
};
__device__ __forceinline__ float gelu_gate(float g, float v) { const float t = g * (1.f + 0.044715f * g * g) * 1.5957691216057308f; return g * fsigmoid(t) * v; }
struct EpiU {
    static constexpr bool PERM = true, AFTER_DRAIN = false;
    const float* rowss; bf16_t *U, *uh; float *conv_p, *conv_s;
    __device__ __forceinline__ void operator()(const f32x4 (&acc)[2][2][4][2], const Unit& u, int wr, int wc, int fr, int fq) const {
        asm volatile("" : "+v"(fr), "+v"(fq));
        const int row0 = u.pm * 256 + wr * 64 + fr, col0 = u.pn * 256 + wc * 32 + 8 * fq;
#pragma unroll
        for (int ai = 0; ai < 2; ++ai)
#pragma unroll
            for (int m = 0; m < 4; ++m) { const int r = row0 + ai * 128 + m * 16; const float rs = rsqrtf(rowss[r] * (1.f / DM) + NORM_EPS);
#pragma unroll
                for (int bj = 0; bj < 2; ++bj) { const int c = col0 + bj * 128; const f32x4 v0 = acc[ai][bj][m][0] * rs, v1 = acc[ai][bj][m][1] * rs;
                    u32x4 w; w.x = pk2(v0[0], v0[1]); w.y = pk2(v0[2], v0[3]); w.z = pk2(v1[0], v1[1]); w.w = pk2(v1[2], v1[3]);
                    *(u32x4*)(U + (size_t)r * F2 + c) = w;
                    if (m == 3 && fr >= 14 && r < MP) { *(u32x4*)(uh + ((size_t)(r >> 6) * 2 + (fr - 14)) * F2 + c) = w;
                        if ((r & 2047) >= 2046) { float* cp = conv_p + ((size_t)(r >> 11) * 2 + (fr - 14)) * F2 + c; *(f32x4*)cp = v0; *(f32x4*)(cp + 4) = v1; } }
                    if (r >= MP && (fr & 7) >= 6) { float* cp = conv_s + ((size_t)((r - MP) >> 3) * 2 + ((fr & 7) - 6)) * F2 + c; *(f32x4*)cp = v0; *(f32x4*)(cp + 4) = v1; } } }
    }
};

struct EpiAct {
    static constexpr bool PERM = true, AFTER_DRAIN = false;
    const float *rowss, *convw, *convb; bf16_t *act, *uh, *us; float *conv_p, *conv_s; LAS float* ringbase;
    __device__ __forceinline__ void operator()(const f32x4 (&acc)[2][2][4][2], const Unit& u, int wr_, int wc_, int fr_, int fq_) const {
        int wr = wr_, wc = wc_, fr = fr_, fq = fq_;
        asm volatile("" : "+v"(fr), "+v"(fq)); asm volatile("" : "+s"(wr), "+s"(wc));
        const bool sample = u.pm >= 64;
        const int jc0 = u.pn * 128 + wc * 32 + 8 * fq;
        LAS float* ring = ringbase + (wr * 4 + wc) * 512;
#pragma unroll
        for (int ai = 0; ai < 2; ++ai) {
            const int rbase = u.pm * 256 + ai * 128 + wr * 64, grp = rbase >> 6;
#pragma unroll
            for (int m = 0; m < 4; ++m) {
                const int row = rbase + 16 * m + fr;
                const bool wuh = !sample && ((m == 0 && fr < 2) || (m == 3 && fr >= 14)), wus = sample && (fr & 7) < 2, wcs = sample && (fr & 7) >= 6;
                if (wuh || wus || wcs) {
                    const float rsm = rsqrtf(rowss[row] * (1.f / DM) + NORM_EPS);
#pragma unroll
                    for (int bj = 0; bj < 2; ++bj) { const f32x4 v0 = acc[ai][bj][m][0] * rsm, v1 = acc[ai][bj][m][1] * rsm;
                        if (wcs) { float* cp = conv_s + ((size_t)((row - MP) >> 3) * 2 + ((fr & 7) - 6)) * F2 + bj * FF + jc0; *(f32x4*)cp = v0; *(f32x4*)(cp + 4) = v1; }
                        else { u32x4 w; w.x = pk2(v0[0], v0[1]); w.y = pk2(v0[2], v0[3]); w.z = pk2(v1[0], v1[1]); w.w = pk2(v1[2], v1[3]);
                            bf16_t* dst = wuh ? uh + ((size_t)grp * 4 + (m == 0 ? fr : fr - 12)) * F2 : us + ((size_t)((row - MP) >> 3) * 2 + (fr & 7)) * F2;
                            *(u32x4*)(dst + bj * FF + jc0) = w;
                            if (wuh && m == 3 && (grp & 31) == 31) { float* cp = conv_p + ((size_t)(rbase >> 11) * 2 + (fr - 14)) * F2 + bj * FF + jc0; *(f32x4*)cp = v0; *(f32x4*)(cp + 4) = v1; } } }
                }
            }
        }
        asm volatile("" ::: "memory");
        float rsq[2][4];
#pragma unroll
        for (int ai = 0; ai < 2; ++ai)
#pragma unroll
            for (int m = 0; m < 4; ++m) rsq[ai][m] = rsqrtf(rowss[u.pm * 256 + ai * 128 + wr * 64 + 16 * m + fr] * (1.f / DM) + NORM_EPS);
#define EPIACT_STEP(AI, N) do { const int rbase = u.pm * 256 + (AI) * 128 + wr * 64; \
            _Pragma("unroll") for (int m = 0; m < 4; ++m) { const float rsm = rsq[AI][m]; \
                const f32x4 xv = acc[AI][0][m][N] * rsm, xg = acc[AI][1][m][N] * rsm; const int idx = (m & 1) * 16 + fr; \
                asm volatile("" ::: "memory"); *(LAS f32x4*)(ring + idx * 16 + fq * 4) = xv; *(LAS f32x4*)(ring + 4096 + idx * 16 + fq * 4) = xg; asm volatile("" ::: "memory");     \
                const f32x4 p1v = *(const LAS f32x4*)(ring + ((idx + 31) & 31) * 16 + fq * 4), p2v = *(const LAS f32x4*)(ring + ((idx + 30) & 31) * 16 + fq * 4); \
                const f32x4 p1g = *(const LAS f32x4*)(ring + 4096 + ((idx + 31) & 31) * 16 + fq * 4), p2g = *(const LAS f32x4*)(ring + 4096 + ((idx + 30) & 31) * 16 + fq * 4); \
                const f32x4 cv = cbv + w0v * p2v + w1v * p1v + w2v * xv, cg = cbg + w0g * p2g + w1g * p1g + w2g * xg; \
                const bool fix = sample ? ((fr & 7) < 2) : (m == 0 && fr < 2); \
                if (!fix) { u32x2 w; w.x = pk2(gelu_gate(cg[0], cv[0]), gelu_gate(cg[1], cv[1])); w.y = pk2(gelu_gate(cg[2], cv[2]), gelu_gate(cg[3], cv[3])); \
                    *(u32x2*)(act + (size_t)(rbase + 16 * m + fr) * FF + jc0 + 4 * (N)) = w; } } } while (0)
#define EPIACT_N(N) do { const int col4 = jc0 + 4 * (N); \
            const f32x4 w0v = *(const f32x4*)(convw + col4), w1v = *(const f32x4*)(convw + F2 + col4), w2v = *(const f32x4*)(convw + 2 * F2 + col4), cbv = *(const f32x4*)(convb + col4); \
            const f32x4 w0g = *(const f32x4*)(convw + FF + col4), w1g = *(const f32x4*)(convw + F2 + FF + col4), w2g = *(const f32x4*)(convw + 2 * F2 + FF + col4), cbg = *(const f32x4*)(convb + FF + col4); \
            EPIACT_STEP(0, N); EPIACT_STEP(1, N); asm volatile("" ::: "memory"); } while (0)
        EPIACT_N(0); EPIACT_N(1);
#undef EPIACT_N
#undef EPIACT_STEP
    }
};

template <class EF> __device__ __forceinline__ void tail_gemm(LAS unsigned char* lds, const bf16_t* Amat, int lda, const bf16_t* Bt, int K, const pg8::StaticOrder& S, int wave, int lane, const EF& ef) {
    const int l15 = lane & 15, q = lane >> 4, ntail = S.nwg - S.limit, nk = K / 256;
    LAS float* red = (LAS float*)lds;
    for (int item = blockIdx.x; item < ntail * 16; item += gridDim.x) {
        pg8::Unit u; S.unit_of(S.limit + (item >> 4), u);
        const int r0 = u.pm * 256 + (item & 15) * 16, c0 = u.pn * 256;
        const bf16_t* ap = Amat + (size_t)(r0 + l15) * lda + 8 * q + 32 * nk * wave; const bf16_t* bp = Bt + (size_t)(c0 + l15) * K + 8 * q + 32 * nk * wave;
        f32x4 acc[16];
#pragma unroll
        for (int n = 0; n < 16; ++n) acc[n] = (f32x4){0.f, 0.f, 0.f, 0.f};
#pragma unroll 2
        for (int ks = 0; ks < nk; ++ks) {
            const bf16x8 a = *(const bf16x8*)(ap + 32 * ks); bf16x8 b[16];
#pragma unroll
            for (int n = 0; n < 16; ++n) b[n] = *(const bf16x8*)(bp + (size_t)(16 * n) * K + 32 * ks);
#pragma unroll
            for (int n = 0; n < 16; ++n) acc[n] = __builtin_amdgcn_mfma_f32_16x16x32_bf16(a, b[n], acc[n], 0, 0, 0);
        }
        __syncthreads();
#pragma unroll
        for (int n = 0; n < 16; ++n) *(LAS f32x4*)(red + ((wave * 16 + n) * 64 + lane) * 4) = acc[n];
        __syncthreads();
        f32x4 s0 = {0.f, 0.f, 0.f, 0.f}, s1 = s0;
#pragma unroll
        for (int w2 = 0; w2 < 8; ++w2) { s0 += *(const LAS f32x4*)(red + ((w2 * 16 + 2 * wave) * 64 + lane) * 4); s1 += *(const LAS f32x4*)(red + ((w2 * 16 + 2 * wave + 1) * 64 + lane) * 4); }
        ef(r0 + 4 * q, c0 + 32 * wave + l15, s0, s1);
    }
    __syncthreads();
}
struct TfGate { bool first; bf16_t* merged; const bf16_t* gate;
    __device__ __forceinline__ void operator()(int row, int col, f32x4 a0, f32x4 a1) const {
#pragma unroll
        for (int i = 0; i < 4; ++i)
#pragma unroll
            for (int n = 0; n < 2; ++n) { const size_t r = (size_t)(row + i); const int c = col + 16 * n; float v = (n ? a1[i] : a0[i]) * fsigmoid(bf2f(gate[r * NGATE + c]));
                if (!first) v += bf2f(merged[r * DM + c]); merged[r * DM + c] = (bf16_t)f2bf(v); } } };
struct TfX1 { const float *xp, *xs; float* x1; bf16_t* x1b; float* rowss;
    __device__ __forceinline__ void operator()(int row, int col, f32x4 a0, f32x4 a1) const {
#pragma unroll
        for (int i = 0; i < 4; ++i) { const int r = row + i; const float* xr = (r < MP ? xp + (size_t)r * DM : xs + (size_t)(r - MP) * DM);
            const float v0 = xr[col] + a0[i], v1 = xr[col + 16] + a1[i];
            x1[(size_t)r * DM + col] = v0; x1[(size_t)r * DM + col + 16] = v1; x1b[(size_t)r * DM + col] = (bf16_t)f2bf(v0); x1b[(size_t)r * DM + col + 16] = (bf16_t)f2bf(v1);
            const float ss = row16_allsum(v0 * v0 + v1 * v1); if ((col & 15) == 0) atomicAdd(rowss + r, ss); } } };
struct TfX2 { float* x; float* xd;
    __device__ __forceinline__ void operator()(int row, int col, f32x4 a0, f32x4 a1) const {
#pragma unroll
        for (int i = 0; i < 4; ++i) { const size_t off = (size_t)(row + i) * DM + col; xd[off] = x[off] + a0[i]; xd[off + 16] = x[off + 16] + a1[i]; } } };

template <int MODE> __device__ __forceinline__ int map_col(int R) {
    if (MODE == 1) { if (R < 1792) return R; if (R < 3584) return (R - 1792 < 1552) ? R : -1; return R - 240; }
    if (MODE == 2) { return ((R >> 7) & 1) * FF + ((R >> 8) << 7) + (R & 127); }
    return R;
}
template <int MODE> __device__ __forceinline__ void tr_item(const float* __restrict__ W, int K, int Nsrc, int Ndst, bf16_t* WT, const float* kscale, LAS float* scr, int item, int lane) {
    const int nblk = Ndst >> 5, kb = item / nblk, nb = item - kb * nblk, k0 = kb << 6, n0 = nb << 5;
    const int col = map_col<MODE>(n0 + (lane & 31));
    float tv[32];
#pragma unroll
    for (int i = 0; i < 32; ++i) { const int kk = 2 * i + (lane >> 5); tv[i] = (col >= 0) ? W[(size_t)(k0 + kk) * Nsrc + col] : 0.f; }
#pragma unroll
    for (int i = 0; i < 32; ++i) { const int kk = 2 * i + (lane >> 5); float v = tv[i]; if (kscale) v *= kscale[k0 + kk]; scr[kk * 33 + (lane & 31)] = v; }
    LDS_WAIT();
    const int c = lane & 7;
#pragma unroll
    for (int j = 0; j < 4; ++j) { const int n = (lane >> 3) + 8 * j; const LAS float* s = scr + (8 * c) * 33 + n;
        u32x4 o; o.x = pk2(s[0 * 33], s[1 * 33]); o.y = pk2(s[2 * 33], s[3 * 33]); o.z = pk2(s[4 * 33], s[5 * 33]); o.w = pk2(s[6 * 33], s[7 * 33]);
        *(u32x4*)(WT + (size_t)(n0 + n) * K + k0 + 8 * c) = o; }
    LDS_WAIT();
}
__device__ __forceinline__ void p0_prologue(const Args& A, LAS unsigned char* lds, int gw, int NGW, int wave, int lane) {
    LAS float* scr = (LAS float*)(lds + wave * 16384);
    unsigned char* ws = A.ws;
    constexpr int I_IN = 16 * (NIN / 32), I_UP = 16 * (F2 / 32), I_DN = 44 * 32, I_O = 16 * 32, I_OA = 8 * 32, I_W2 = 16, I_G2 = 2 * 16;
    constexpr int NITEMS = I_IN + I_UP + I_DN + I_O + 2 * I_OA + 2 * I_W2 + I_G2;
    for (int it = gw; it < NITEMS; it += NGW) {
        int r = it;
        if (r < I_IN) { tr_item<1>(A.in[IN_W_IN], 1024, 5392, NIN, (bf16_t*)(ws + OFF_WIN), nullptr, scr, r, lane); continue; } r -= I_IN;
        if (r < I_UP) { tr_item<2>(A.in[IN_WUP], 1024, F2, F2, (bf16_t*)(ws + OFF_WUP), A.in[IN_NORM_FFN], scr, r, lane); continue; } r -= I_UP;
        if (r < I_DN) { tr_item<0>(A.in[IN_WDN], FF, 1024, 1024, (bf16_t*)(ws + OFF_WDN), nullptr, scr, r, lane); continue; } r -= I_DN;
        if (r < I_O) { tr_item<0>(A.in[IN_WO], 1024, 1024, 1024, (bf16_t*)(ws + OFF_WO), nullptr, scr, r, lane); continue; } r -= I_O;
        if (r < I_OA) { tr_item<0>(A.in[IN_WOA], 512, 1024, 1024, (bf16_t*)(ws + OFF_WOA), nullptr, scr, r, lane); continue; } r -= I_OA;
        if (r < I_OA) { tr_item<0>(A.in[IN_WOB], 512, 1024, 1024, (bf16_t*)(ws + OFF_WOB), nullptr, scr, r, lane); continue; } r -= I_OA;
        if (r < I_W2) { tr_item<0>(A.in[IN_W2], 64, 512, 512, (bf16_t*)(ws + OFF_W2T), nullptr, scr, r, lane); continue; } r -= I_W2;
        if (r < I_W2) { tr_item<0>(A.in[IN_A2], 64, 512, 512, (bf16_t*)(ws + OFF_A2T), nullptr, scr, r, lane); continue; } r -= I_W2;
        tr_item<0>(A.in[IN_G2], 128, 512, 512, (bf16_t*)(ws + OFF_G2T), nullptr, scr, r, lane);
    }
    bf16_t* H = (bf16_t*)((unsigned char*)A.out + OUTB_H);
    const float* gm = A.in[IN_NORM_MIX];
    for (int m = gw; m < M; m += 2 * NGW) {
        const int m2 = m + NGW; const bool has2 = m2 < M;
        const f32x4* xr = (const f32x4*)xrow_ptr(A, m) + lane; const f32x4* xr2 = (const f32x4*)xrow_ptr(A, has2 ? m2 : m) + lane; f32x4 v[4], w[4]; float s = 0.f, s2 = 0.f;
#pragma unroll
        for (int j = 0; j < 4; ++j) { v[j] = xr[64 * j]; w[j] = xr2[64 * j]; }
#pragma unroll
        for (int j = 0; j < 4; ++j) { s += (v[j].x * v[j].x + v[j].y * v[j].y) + (v[j].z * v[j].z + v[j].w * v[j].w); s2 += (w[j].x * w[j].x + w[j].y * w[j].y) + (w[j].z * w[j].z + w[j].w * w[j].w); }
        const float rstd = rsqrtf(wave_allsum(s) * (1.f / DM) + NORM_EPS), rstd2 = rsqrtf(wave_allsum(s2) * (1.f / DM) + NORM_EPS);
        u32x2* o8 = (u32x2*)(H + (size_t)m * DM) + lane; u32x2* o82 = (u32x2*)(H + (size_t)m2 * DM) + lane;
#pragma unroll
        for (int j = 0; j < 4; ++j) { const f32x4 g = *((const f32x4*)gm + lane + 64 * j); u32x2 p; p.x = pk2(v[j].x * rstd * g.x, v[j].y * rstd * g.y); p.y = pk2(v[j].z * rstd * g.z, v[j].w * rstd * g.w); o8[64 * j] = p;
            if (has2) { u32x2 p2; p2.x = pk2(w[j].x * rstd2 * g.x, w[j].y * rstd2 * g.y); p2.y = pk2(w[j].z * rstd2 * g.z, w[j].w * rstd2 * g.w); o82[64 * j] = p2; } }
    }
    float* rowss = (float*)(ws + OFF_ROWSS);
    for (int i = gw * 64 + lane; i < M; i += NGW * 64) rowss[i] = 0.f;
}

__device__ __forceinline__ void prw_mixed8(const Args& A, const bf16_t* PRW, int r, int col0, float (&xs)[8]) {
    float cur[8], prev[8];
    ld8bf(PRW + (size_t)r * NPRW + col0, cur);
    const bool first = (r < MP) ? ((r & 2047) == 0) : (((r - MP) & 7) == 0);
    if (!first) ld8bf(PRW + (size_t)(r - 1) * NPRW + col0, prev);
    else if (r < MP) {
#pragma unroll
        for (int i = 0; i < 8; ++i) prev[i] = 0.f;
    } else ld8f(A.in[IN_ST_SHIFT] + (size_t)((r - MP) >> 3) * 1792 + col0, prev);
    float mu[8]; ld8f(A.in[IN_MU] + col0, mu);
#pragma unroll
    for (int i = 0; i < 8; ++i) xs[i] = cur[i] + (prev[i] - cur[i]) * mu[i];
}
template <int ACT> __device__ __forceinline__ bf16x8 afrag(const Args& A, const bf16_t* PRW, int r, int col0) {
    float xs[8]; prw_mixed8(A, PRW, r, col0, xs);
#pragma unroll
    for (int i = 0; i < 8; ++i) xs[i] = ACT == 1 ? ftanh(xs[i]) : (ACT == 2 ? fsigmoid(xs[i]) : xs[i]);
    return __builtin_bit_cast(bf16x8, pack8(xs));
}
__device__ __forceinline__ void p2a_lora(const Args& A, int gw, int NGW, int lane) {
    const bf16_t* PRW = (const bf16_t*)(A.ws + OFF_PRW);
    const bf16_t *W2T = (const bf16_t*)(A.ws + OFF_W2T), *A2T = (const bf16_t*)(A.ws + OFF_A2T), *G2T = (const bf16_t*)(A.ws + OFF_G2T);
    bf16_t *EW = (bf16_t*)((unsigned char*)A.out + OUTB_EW), *AARR = (bf16_t*)((unsigned char*)A.out + OUTB_AARR), *G = (bf16_t*)(A.ws + OFF_G);
    for (int i = gw * 64 + lane; i < 136 * 224; i += NGW * 64) { const int sq = i / 224, c8 = (i - sq * 224) * 8; const int r = sq < 8 ? sq * 2048 + 2047 : MP + (sq - 8) * 8 + 7;
        float v[8]; ld8bf(PRW + (size_t)r * NPRW + c8, v); float* dst = (sq < 8 ? A.out + OUT_SHIFT_P + (size_t)sq * 1792 : A.out + OUT_SHIFT_S + (size_t)(sq - 8) * 1792) + c8;
        *(f32x4*)dst = (f32x4){v[0], v[1], v[2], v[3]}; *(f32x4*)(dst + 4) = (f32x4){v[4], v[5], v[6], v[7]}; }
    const int l15 = lane & 15, kq = lane >> 4;
    for (int task = gw; task < (M / 16) * 8; task += NGW) {
        const int tile = task >> 3, h = task & 7, t0 = tile * 16, r = t0 + l15;
        bf16x8 aw[2], aa[2], ag[4];
#pragma unroll
        for (int ks = 0; ks < 2; ++ks) { aw[ks] = afrag<1>(A, PRW, r, 1536 + ks * 32 + kq * 8); aa[ks] = afrag<0>(A, PRW, r, 1600 + ks * 32 + kq * 8); }
#pragma unroll
        for (int ks = 0; ks < 4; ++ks) ag[ks] = afrag<2>(A, PRW, r, 1664 + ks * 32 + kq * 8);
        f32x4 cwv[4], cav[4], cgg[4];
#pragma unroll
        for (int nt = 0; nt < 4; ++nt) {
            const int c = 64 * h + 16 * nt + l15;
            f32x4 cw = {0.f, 0.f, 0.f, 0.f}, ca = cw, cgv = cw;
#pragma unroll
            for (int ks = 0; ks < 2; ++ks) {
                const bf16x8 bw = *(const bf16x8*)(W2T + (size_t)c * 64 + ks * 32 + kq * 8), ba = *(const bf16x8*)(A2T + (size_t)c * 64 + ks * 32 + kq * 8);
                cw = __builtin_amdgcn_mfma_f32_16x16x32_bf16(bw, aw[ks], cw, 0, 0, 0); ca = __builtin_amdgcn_mfma_f32_16x16x32_bf16(ba, aa[ks], ca, 0, 0, 0); }
#pragma unroll
            for (int ks = 0; ks < 4; ++ks) { const bf16x8 bg = *(const bf16x8*)(G2T + (size_t)c * 128 + ks * 32 + kq * 8); cgv = __builtin_amdgcn_mfma_f32_16x16x32_bf16(bg, ag[ks], cgv, 0, 0, 0); }
            cwv[nt] = cw; cav[nt] = ca; cgg[nt] = cgv;
        }
#pragma unroll
        for (int nt = 0; nt < 4; ++nt) {
            const int c4 = 64 * h + 16 * nt + 4 * kq; const size_t o = (size_t)(t0 + l15) * 512 + c4;
            const f32x4 w0v = *(const f32x4*)(A.in[IN_W0] + c4), a0v = *(const f32x4*)(A.in[IN_A0] + c4);
            float ew[4], av[4];
#pragma unroll
            for (int i = 0; i < 4; ++i) { ew[i] = __expf(-fsoftplus(-(w0v[i] + cwv[nt][i])) - 0.5f); av[i] = fsigmoid(a0v[i] + cav[nt][i]); }
            u32x2 w; w.x = pk2(ew[0], ew[1]); w.y = pk2(ew[2], ew[3]); *(u32x2*)(EW + o) = w;
            w.x = pk2(av[0], av[1]); w.y = pk2(av[2], av[3]); *(u32x2*)(AARR + o) = w;
            w.x = pk2(cgg[nt][0], cgg[nt][1]); w.y = pk2(cgg[nt][2], cgg[nt][3]); *(u32x2*)(G + o) = w;
        }
    }
}

typedef short bf16x4 __attribute__((ext_vector_type(4)));
#define MFMA32(a, b, c) __builtin_amdgcn_mfma_f32_16x16x32_bf16(a, b, c, 0, 0, 0)
#define MFMA16(a, b, c) __builtin_amdgcn_mfma_f32_16x16x16bf16_1k(a, b, c, 0, 0, 0)
constexpr int SP = 72;
constexpr size_t OFF_RLT = 240 * MiB;
constexpr size_t OFF_GL = 1 * MiB, OFF_GG = 8 * MiB;
static_assert(OFF_RLT + (size_t)448 * 32768 <= 256 * MiB && OFF_GL + (size_t)224 * 32768 <= OFF_GG && OFF_GG + 224 * 256 <= OFF_WUP, "ws map (scan)");
__device__ __forceinline__ bf16x4 bf4(f32x4 v) { u32x2 w; w.x = pk2(v[0], v[1]); w.y = pk2(v[2], v[3]); return __builtin_bit_cast(bf16x4, w); }
__device__ __forceinline__ bf16x8 afr(const LAS bf16_t* X, int l15, int q, int ks) { const LAS bf16_t* p = X + l15 * SP + 32 * ks + 4 * q; const u32x2 lo = *(const LAS u32x2*)p, hi = *(const LAS u32x2*)(p + 16); u32x4 w; w.x = lo.x; w.y = lo.y; w.z = hi.x; w.w = hi.y; return __builtin_bit_cast(bf16x8, w); }
__device__ __forceinline__ bf16x8 hfrag(const f32x4& lo, const f32x4& hi) { u32x4 w; w.x = pk2(lo[0], lo[1]); w.y = pk2(lo[2], lo[3]); w.z = pk2(hi[0], hi[1]); w.w = pk2(hi[2], hi[3]); return __builtin_bit_cast(bf16x8, w); }
__device__ __forceinline__ f32x4 maskc(f32x4 v, int q, int l15, bool rows_lt_col, bool incl) {
#pragma unroll
    for (int i = 0; i < 4; ++i) { const int R = 4 * q + i; const bool keep = rows_lt_col ? (incl ? R <= l15 : R < l15) : (incl ? l15 <= R : l15 < R); v[i] = keep ? v[i] : 0.f; }
    return v;
}
template <bool GLA, int VP> __device__ __forceinline__ void scan_matrix_part(const LAS bf16_t* AT, const LAS bf16_t* RT, const LAS bf16_t* BT, const LAS bf16_t* KT, const LAS bf16_t* VS, const LAS float* GC, bf16_t* OUTP, int l15, int q, int sl, bool use_v, bool write_o, int rowb, int nv, f32x4 (&H)[4]) {
    const bf16x8 hb0 = hfrag(H[0], H[1]), hb1 = hfrag(H[2], H[3]);
    const bf16x8 rt0 = afr(RT, l15, q, 0), rt1 = afr(RT, l15, q, 1), kt0 = afr(KT, l15, q, 0), kt1 = afr(KT, l15, q, 1);
    const f32x4 z4 = {0.f, 0.f, 0.f, 0.f};
    bf16x4 vb = {0, 0, 0, 0};
    if (use_v) { const LAS bf16_t* vp = VS + (4 * q) * VP + 16 * sl + l15; u32x2 w; w.x = (unsigned)vp[0] | ((unsigned)vp[VP] << 16); w.y = (unsigned)vp[2 * VP] | ((unsigned)vp[3 * VP] << 16); vb = __builtin_bit_cast(bf16x4, w); }
    f32x4 O = MFMA32(rt0, hb0, z4); O = MFMA32(rt1, hb1, O);
    f32x4 U = z4;
    if (!GLA) {
        const bf16x8 at0 = afr(AT, l15, q, 0), at1 = afr(AT, l15, q, 1), bt0 = afr(BT, l15, q, 0), bt1 = afr(BT, l15, q, 1);
        f32x4 P = MFMA32(at0, bt0, z4); P = MFMA32(at1, bt1, P); P = maskc(P, q, l15, false, false);
        f32x4 PT = MFMA32(bt0, at0, z4); PT = MFMA32(bt1, at1, PT); PT = maskc(PT, q, l15, true, false);
        f32x4 nrbT = MFMA32(bt0, rt0, z4); nrbT = MFMA32(bt1, rt1, nrbT); nrbT = maskc(nrbT, q, l15, true, true);
        U = MFMA32(at0, hb0, z4); U = MFMA32(at1, hb1, U);
        if (use_v) { f32x4 makT = MFMA32(kt0, at0, z4); makT = MFMA32(kt1, at1, makT); makT = maskc(makT, q, l15, true, false); U = MFMA16(bf4(makT), vb, U); }
#pragma unroll
        for (int it = 0; it < 4; ++it) {
            U = MFMA16(bf4(PT), bf4(U), U);
            if (it < 3) { const f32x4 Pn = MFMA16(bf4(PT), bf4(P), z4), PTn = MFMA16(bf4(P), bf4(PT), z4); P = Pn; PT = PTn; }
        }
        O = MFMA16(bf4(nrbT), bf4(U), O);
    }
    if (use_v) { f32x4 nrkT = MFMA32(kt0, rt0, z4); nrkT = MFMA32(kt1, rt1, nrkT); nrkT = maskc(nrkT, q, l15, true, true); O = MFMA16(bf4(nrkT), vb, O); }
    if (write_o) {
#pragma unroll
        for (int i = 0; i < 4; ++i) if (4 * q + i < nv) OUTP[(size_t)(rowb + 4 * q + i) * 512] = (bf16_t)f2bf(O[i]);
    }
    const bf16x4 ub = bf4(U);
#pragma unroll
    for (int kt = 0; kt < 4; ++kt) {
        const f32x4 g4 = *(const LAS f32x4*)(GC + 16 * kt + 4 * q); const float gk = GC[16 * kt + l15];
        f32x4 acc = H[kt] * g4;
        if (!GLA) { const LAS bf16_t* p = BT + (4 * q) * SP + 16 * kt + l15; u32x2 w; w.x = pk2(bf2f(p[0]) * gk, bf2f(p[SP]) * gk); w.y = pk2(bf2f(p[2 * SP]) * gk, bf2f(p[3 * SP]) * gk); acc = MFMA16(__builtin_bit_cast(bf16x4, w), ub, acc); }
        if (use_v) { const LAS bf16_t* p = KT + (4 * q) * SP + 16 * kt + l15; u32x2 w; w.x = pk2(bf2f(p[0]) * gk, bf2f(p[SP]) * gk); w.y = pk2(bf2f(p[2 * SP]) * gk, bf2f(p[3 * SP]) * gk); acc = MFMA16(__builtin_bit_cast(bf16x4, w), vb, acc); }
        H[kt] = acc;
    }
}
constexpr int GL_RT = 2304, GL_BT = 4608, GL_KT = 6912, GL_VS = 9216, GL_GC = 13568, GL_EG = 13824, GL_BYTES = 26624;
template <bool GLA, int W> __device__ __forceinline__ void scan_block(const Args& A, LAS unsigned char* gl, int lane, int wg, int row0, int nsub, int nvalid, int first_kind, int bsamp, int hh, int sl, bool use_v, bool write_o, f32x4 (&H)[4], float& cumtot) {
    constexpr int TPW = 16 / W, VP = GLA ? 136 : 72;
    const int c = lane, l15 = lane & 15, q = lane >> 4, t0 = wg * TPW;
    const bf16_t* PRW = (const bf16_t*)(A.ws + OFF_PRW); const bf16_t* PGLA = (const bf16_t*)(A.ws + OFF_PGLA);
    const bf16_t *EW = (const bf16_t*)((unsigned char*)A.out + OUTB_EW), *AARR = (const bf16_t*)((unsigned char*)A.out + OUTB_AARR);
    bf16_t* OUTP = GLA ? (bf16_t*)((unsigned char*)A.out + OUTB_OGL) + 128 * hh + 16 * sl + l15 : (bf16_t*)((unsigned char*)A.out + OUTB_ORW) + 64 * hh + 16 * sl + l15;
    LAS bf16_t *AT = (LAS bf16_t*)gl, *RT = (LAS bf16_t*)(gl + GL_RT), *BT = (LAS bf16_t*)(gl + GL_BT), *KT = (LAS bf16_t*)(gl + GL_KT), *VS = (LAS bf16_t*)(gl + GL_VS);
    LAS float *GC = (LAS float*)(gl + GL_GC), *EG = (LAS float*)(gl + GL_EG);
    float mu_r = 0.f, mu_k = 0.f, mu_v = 0.f, kkc = 0.f, kac = 0.f, bgc = 0.f; float wgt[16];
#pragma unroll
    for (int j = 0; j < 16; ++j) wgt[j] = 0.f;
    if (!GLA) { const float* mu = A.in[IN_MU]; mu_r = mu[64 * hh + c]; mu_k = mu[512 + 64 * hh + c]; mu_v = mu[1024 + 64 * hh + c]; kkc = A.in[IN_KK][64 * hh + c]; kac = A.in[IN_KA][64 * hh + c]; }
    else { bgc = A.in[IN_BG][64 * hh + c];
#pragma unroll
        for (int j = 0; j < 16; ++j) wgt[j] = A.in[IN_WG2][j * 256 + 64 * hh + c]; }
    float pr[2] = {0.f, 0.f}, pk[2] = {0.f, 0.f}, pvv[2] = {0.f, 0.f}; bf16_t r0[2][TPW], r1[2][TPW], r2[2][TPW], r3[2][TPW], r4[2][TPW]; unsigned rvv[2][TPW]; u32x4 lg0[2][TPW], lg1[2][TPW];
#pragma unroll
    for (int p = 0; p < 2; ++p)
#pragma unroll
        for (int i = 0; i < TPW; ++i) { r0[p][i] = r1[p][i] = r2[p][i] = r3[p][i] = r4[p][i] = 0; rvv[p][i] = 0u; lg0[p][i] = (u32x4){0u, 0u, 0u, 0u}; lg1[p][i] = lg0[p][i]; }
#define SB_LOAD(SC, P) do { const int nv_ = ((SC) == nsub - 1) ? nvalid : 16; \
        if (!GLA) { if ((SC) == 0 && t0 == 0) { pr[P] = pk[P] = pvv[P] = 0.f; if (first_kind == 0) { const bf16_t* p = PRW + (size_t)(row0 - 1) * NPRW + 64 * hh + c; pr[P] = bf2f(p[0]); pk[P] = bf2f(p[512]); pvv[P] = bf2f(p[1024]); } \
                        else if (first_kind == 2) { const float* st = A.in[IN_ST_SHIFT] + (size_t)bsamp * 1792 + 64 * hh + c; pr[P] = st[0]; pk[P] = st[512]; pvv[P] = st[1024]; } } \
                    else if (t0 < nv_) { const bf16_t* p = PRW + (size_t)(row0 + 16 * (SC) + t0 - 1) * NPRW + 64 * hh + c; pr[P] = bf2f(p[0]); pk[P] = bf2f(p[512]); pvv[P] = bf2f(p[1024]); } } \
        _Pragma("unroll") for (int i = 0; i < TPW; ++i) if (t0 + i < nv_) { const size_t ro = (size_t)(row0 + 16 * (SC) + t0 + i); \
            if (!GLA) { const bf16_t* p = PRW + ro * NPRW + 64 * hh + c; r0[P][i] = p[0]; r1[P][i] = p[512]; r2[P][i] = p[1024]; r3[P][i] = EW[ro * 512 + 64 * hh + c]; r4[P][i] = AARR[ro * 512 + 64 * hh + c]; } \
            else { const bf16_t* p = PGLA + ro * NPGLA; r0[P][i] = p[64 * hh + c]; r1[P][i] = p[256 + 64 * hh + c]; rvv[P][i] = *(const unsigned*)(p + 512 + 128 * hh + 2 * lane); lg0[P][i] = *(const u32x4*)(p + 1024); lg1[P][i] = *(const u32x4*)(p + 1032); } } } while (0)
#define SB_EG(SC, P) do { const int nv_ = ((SC) == nsub - 1) ? nvalid : 16; LAS float* eg_ = EG + (P) * 1024; float tot_ = 0.f; \
        _Pragma("unroll") for (int i = 0; i < TPW; ++i) { float ev = 0.f; if (t0 + i < nv_) { if (!GLA) ev = bf2f(r3[P][i]); else { float lga[16], t8[8]; unpack8(lg0[P][i], t8); _Pragma("unroll") for (int j = 0; j < 8; ++j) lga[j] = t8[j]; \
                unpack8(lg1[P][i], t8); _Pragma("unroll") for (int j = 0; j < 8; ++j) lga[8 + j] = t8[j]; float z = bgc; _Pragma("unroll") for (int j = 0; j < 16; ++j) z += lga[j] * wgt[j]; ev = fsoftplus(-z) * 0.0625f; } } \
            eg_[(t0 + i) * 64 + c] = ev; tot_ += ev; } \
        WT[((P) * 8 + wg) * 64 + c] = tot_; } while (0)
#define SB_ITER(SC, P) do { const int sc = (SC); const int nv = (sc == nsub - 1) ? nvalid : 16; \
        __syncthreads();                                                         \
        { const LAS float* eg = EG + (P) * 1024; float cum = 0.f; \
          _Pragma("unroll") for (int w2 = 0; w2 < W - 1; ++w2) { const float tw = WT[((P) * 8 + w2) * 64 + c]; cum += (w2 < wg) ? tw : 0.f; } \
          _Pragma("unroll") for (int i = 0; i < TPW; ++i) { const int t = t0 + i; \
            if (t < nv) { \
                const float gp = __expf(-cum); cum += eg[t * 64 + c]; const float g = __expf(-cum), e = __expf(cum); \
                if (!GLA) { \
                    const float cr = bf2f(r0[P][i]), ck = bf2f(r1[P][i]), cv = bf2f(r2[P][i]), a = bf2f(r4[P][i]); \
                    const float xr = cr + (pr[P] - cr) * mu_r, xk = ck + (pk[P] - ck) * mu_k, xv = cv + (pvv[P] - cv) * mu_v; pr[P] = cr; pk[P] = ck; pvv[P] = cv; \
                    const float kkv = xk * kkc, ss = wave_allsum(kkv * kkv), kk = kkv * __builtin_amdgcn_rcpf(fmaxf(sqrtf(ss), 1e-12f)); \
                    const unsigned w01 = pk2(-kk * gp, xr * g), w23 = pk2(kk * a * e, xk * (1.f + (a - 1.f) * kac) * e); \
                    AT[t * SP + c] = (bf16_t)(w01 & 0xffffu); RT[t * SP + c] = (bf16_t)(w01 >> 16); BT[t * SP + c] = (bf16_t)(w23 & 0xffffu); KT[t * SP + c] = (bf16_t)(w23 >> 16); \
                    VS[t * VP + c] = (bf16_t)f2bf(xv); \
                } else { \
                    const unsigned w01 = pk2(bf2f(r0[P][i]) * 0.125f * g, bf2f(r1[P][i]) * e); \
                    RT[t * SP + c] = (bf16_t)(w01 & 0xffffu); KT[t * SP + c] = (bf16_t)(w01 >> 16); \
                    *(LAS unsigned*)(VS + t * VP + 2 * lane) = rvv[P][i]; \
                } \
            } else { \
                if (!GLA) { AT[t * SP + c] = 0; BT[t * SP + c] = 0; VS[t * VP + c] = 0; } else *(LAS unsigned*)(VS + t * VP + 2 * lane) = 0u; \
                RT[t * SP + c] = 0; KT[t * SP + c] = 0; \
            } \
          } \
          if (wg == W - 1) { GC[c] = __expf(-cum); cumtot += cum; } \
        } \
        if (sc + 2 < nsub) SB_LOAD(sc + 2, P); \
        __syncthreads();                                                         \
        scan_matrix_part<GLA, VP>(AT, RT, BT, KT, VS, GC, OUTP, l15, q, sl, use_v, write_o, row0 + 16 * sc, nv, H); \
        if (sc + 1 < nsub) SB_EG(sc + 1, 1 - (P)); } while (0)
    LAS float* WT = EG + 2048;
    SB_LOAD(0, 0); if (nsub > 1) SB_LOAD(1, 1); SB_EG(0, 0);
    for (int sc2 = 0; sc2 < nsub; sc2 += 2) { SB_ITER(sc2, 0); if (sc2 + 1 < nsub) SB_ITER(sc2 + 1, 1); }
#undef SB_LOAD
#undef SB_EG
#undef SB_ITER
}
constexpr int GP = 264;
__device__ __forceinline__ void gla_pass1_item(const Args& A, LAS unsigned char* lds, int wave, int lane, int b, int hh, int cc, int ig) {
    const bf16_t* PGLA = (const bf16_t*)(A.ws + OFF_PGLA);
    LAS bf16_t* KHT = (LAS bf16_t*)lds; LAS bf16_t* VT = KHT + 64 * GP; LAS float* WT = (LAS float*)(lds + (64 + 128) * GP * 2);
    const int c = lane, l15 = lane & 15, q = lane >> 4, row0 = b * 2048 + cc * 256 + 32 * wave;
    float wgt[16]; const float bgc = A.in[IN_BG][64 * hh + c];
#pragma unroll
    for (int j = 0; j < 16; ++j) wgt[j] = A.in[IN_WG2][j * 256 + 64 * hh + c];
    float cum[32]; float run = 0.f;
#pragma unroll
    for (int tb = 0; tb < 32; tb += 8) {
        u32x4 g0[8], g1[8];
#pragma unroll
        for (int j = 0; j < 8; ++j) { const bf16_t* p = PGLA + (size_t)(row0 + tb + j) * NPGLA; g0[j] = *(const u32x4*)(p + 1024); g1[j] = *(const u32x4*)(p + 1032); }
#pragma unroll
        for (int j = 0; j < 8; ++j) { float lga[16], t8[8];
            unpack8(g0[j], t8);
#pragma unroll
            for (int i = 0; i < 8; ++i) lga[i] = t8[i];
            unpack8(g1[j], t8);
#pragma unroll
            for (int i = 0; i < 8; ++i) lga[8 + i] = t8[i];
            float z = bgc;
#pragma unroll
            for (int i = 0; i < 16; ++i) z += lga[i] * wgt[i];
            run += fsoftplus(-z) * 0.0625f; cum[tb + j] = run; }
    }
    __syncthreads();
    WT[wave * 64 + c] = run;
    __syncthreads();
    float after = 0.f, tot = 0.f;
#pragma unroll
    for (int w2 = 0; w2 < 8; ++w2) { const float tw = WT[w2 * 64 + c]; tot += tw; after += (w2 > wave) ? tw : 0.f; }
#pragma unroll
    for (int tb = 0; tb < 32; tb += 16) {
        bf16_t rk[16]; unsigned rv[16];
#pragma unroll
        for (int j = 0; j < 16; ++j) { const bf16_t* p = PGLA + (size_t)(row0 + tb + j) * NPGLA; rk[j] = p[256 + 64 * hh + c]; rv[j] = *(const unsigned*)(p + 512 + 128 * hh + 2 * lane); }
#pragma unroll
        for (int j = 0; j < 16; ++j) { const int t = tb + j;
            KHT[c * GP + 32 * wave + t] = (bf16_t)f2bf(bf2f(rk[j]) * __expf(-(after + (run - cum[t]))));
            VT[(2 * lane) * GP + 32 * wave + t] = (bf16_t)(rv[j] & 0xffffu); VT[(2 * lane + 1) * GP + 32 * wave + t] = (bf16_t)(rv[j] >> 16); }
    }
    __syncthreads();
    f32x4 acc[4];
#pragma unroll
    for (int kt = 0; kt < 4; ++kt) acc[kt] = (f32x4){0.f, 0.f, 0.f, 0.f};
#pragma unroll
    for (int ks = 0; ks < 8; ++ks) { const bf16x8 bv = *(const LAS bf16x8*)(VT + (16 * wave + l15) * GP + 32 * ks + 8 * q);
#pragma unroll
        for (int kt = 0; kt < 4; ++kt) { const bf16x8 av = *(const LAS bf16x8*)(KHT + (16 * kt + l15) * GP + 32 * ks + 8 * q); acc[kt] = MFMA32(av, bv, acc[kt]); } }
    float* dst = (float*)(A.ws + OFF_GL) + (size_t)ig * 8192 + 16 * wave + l15;
#pragma unroll
    for (int kt = 0; kt < 4; ++kt)
#pragma unroll
        for (int i = 0; i < 4; ++i) dst[(16 * kt + 4 * q + i) * 128] = acc[kt][i];
    if (wave == 7) ((float*)(A.ws + OFF_GG))[ig * 64 + lane] = __expf(-tot);
}
__device__ __forceinline__ void p2x_scan1(const Args& A, LAS unsigned char* lds, int wave, int lane) {
    const int l15 = lane & 15, q = lane >> 4;
    for (int it = blockIdx.x; it < 448 + 224; it += gridDim.x) {
        f32x4 H[4]; float cumtot = 0.f;
        if (it < 448) {
            const int seq = it / 7, cc = it - seq * 7, b = seq >> 3, hh = seq & 7; const bool isT = wave >= 4; const int sl = wave & 3;
#pragma unroll
            for (int kt = 0; kt < 4; ++kt)
#pragma unroll
                for (int i = 0; i < 4; ++i) H[kt][i] = (isT && (16 * kt + 4 * q + i == 16 * sl + l15)) ? 1.f : 0.f;
            scan_block<false, 8>(A, lds, lane, wave, b * 2048 + cc * 256, 16, 16, cc == 0 ? 1 : 0, 0, hh, sl, !isT, false, H, cumtot);
            float* dst = (float*)(A.ws + OFF_RLT) + (size_t)it * 8192 + (isT ? 4096 : 0) + 16 * sl + l15;
#pragma unroll
            for (int kt = 0; kt < 4; ++kt)
#pragma unroll
                for (int i = 0; i < 4; ++i) dst[(16 * kt + 4 * q + i) * 64] = H[kt][i];
        } else {
            const int ig = it - 448, seq = ig / 7, cc = ig - seq * 7, b = seq >> 2, hh = seq & 3;
            gla_pass1_item(A, lds, wave, lane, b, hh, cc, ig);
        }
    }
    __syncthreads();
}
__device__ __forceinline__ void p2y_scan2(const Args& A, LAS unsigned char* lds, int wave, int lane) {
    const int l15 = lane & 15, q = lane >> 4;
    for (int bi = blockIdx.x; bi < 256 + 256 + 512 + 512; bi += gridDim.x) {
        f32x4 H[4]; float cumtot = 0.f;
#pragma unroll
        for (int kt = 0; kt < 4; ++kt) H[kt] = (f32x4){0.f, 0.f, 0.f, 0.f};
        if (bi < 256) {
            const int item = 2 * bi + (wave >> 2), sl = wave & 3, cc = item & 7, seq = item >> 3, b = seq >> 3, hh = seq & 7;
#pragma unroll 2
            for (int j = 0; j < cc; ++j) {
                const float* Lj = (const float*)(A.ws + OFF_RLT) + (size_t)(seq * 7 + j) * 8192; const float* Tj = Lj + 4096;
                const bf16x8 hb0 = hfrag(H[0], H[1]), hb1 = hfrag(H[2], H[3]);
#pragma unroll
                for (int kt = 0; kt < 4; ++kt) {
                    f32x4 acc;
#pragma unroll
                    for (int i = 0; i < 4; ++i) acc[i] = Lj[(16 * kt + 4 * q + i) * 64 + 16 * sl + l15];
                    const float* tr = Tj + (16 * kt + l15) * 64 + 4 * q;
                    const f32x4 t0 = *(const f32x4*)tr, t1 = *(const f32x4*)(tr + 16), t2 = *(const f32x4*)(tr + 32), t3 = *(const f32x4*)(tr + 48);
                    acc = MFMA32(hfrag(t0, t1), hb0, acc); acc = MFMA32(hfrag(t2, t3), hb1, acc);
                    H[kt] = acc;
                }
            }
            scan_block<false, 4>(A, lds + (wave >> 2) * GL_BYTES, lane, wave & 3, b * 2048 + cc * 256, 16, 16, cc == 0 ? 1 : 0, 0, hh, sl, true, true, H, cumtot);
            if (cc == 7) { float* o = A.out + OUT_WKV_P + (((size_t)b * 8 + hh) * 64 + 16 * sl + l15) * 64 + 4 * q;
#pragma unroll
                for (int kt = 0; kt < 4; ++kt) *(f32x4*)(o + 16 * kt) = H[kt]; }
        } else if (bi < 512) {
            const int item = bi - 256, sl = wave, cc = item & 7, seq = item >> 3, b = seq >> 2, hh = seq & 3;
#pragma unroll 2
            for (int j = 0; j < cc; ++j) {
                const float* Lj = (const float*)(A.ws + OFF_GL) + (size_t)(seq * 7 + j) * 8192; const float* Gj = (const float*)(A.ws + OFF_GG) + (seq * 7 + j) * 64;
#pragma unroll
                for (int kt = 0; kt < 4; ++kt)
#pragma unroll
                    for (int i = 0; i < 4; ++i) H[kt][i] = Gj[16 * kt + 4 * q + i] * H[kt][i] + Lj[(16 * kt + 4 * q + i) * 128 + 16 * sl + l15];
            }
            scan_block<true, 8>(A, lds, lane, wave, b * 2048 + cc * 256, 16, 16, 0, 0, hh, sl, true, true, H, cumtot);
            if (cc == 7) { float* o = A.out + OUT_GLA_P + (((size_t)b * 4 + hh) * 64) * 128 + 16 * sl + l15;
#pragma unroll
                for (int kt = 0; kt < 4; ++kt)
#pragma unroll
                    for (int i = 0; i < 4; ++i) o[(size_t)(16 * kt + 4 * q + i) * 128] = H[kt][i]; }
        } else if (bi < 1024) {
            const int item = 2 * (bi - 512) + (wave >> 2), sl = wave & 3, hh = item & 7, b = item >> 3;
            const float* st = A.in[IN_ST_WKV] + (((size_t)b * 8 + hh) * 64 + 16 * sl + l15) * 64 + 4 * q;
#pragma unroll
            for (int kt = 0; kt < 4; ++kt) H[kt] = *(const f32x4*)(st + 16 * kt);
            scan_block<false, 4>(A, lds + (wave >> 2) * GL_BYTES, lane, wave & 3, MP + b * 8, 1, 8, 2, b, hh, sl, true, true, H, cumtot);
            float* o = A.out + OUT_WKV_S + (((size_t)b * 8 + hh) * 64 + 16 * sl + l15) * 64 + 4 * q;
#pragma unroll
            for (int kt = 0; kt < 4; ++kt) *(f32x4*)(o + 16 * kt) = H[kt];
        } else {
            const int item = bi - 1024, sl = wave, hh = item & 3, b = item >> 2;
            const float* st = A.in[IN_ST_GLA] + (((size_t)b * 4 + hh) * 64) * 128 + 16 * sl + l15;
#pragma unroll
            for (int kt = 0; kt < 4; ++kt)
#pragma unroll
                for (int i = 0; i < 4; ++i) H[kt][i] = st[(size_t)(16 * kt + 4 * q + i) * 128];
            scan_block<true, 8>(A, lds, lane, wave, MP + b * 8, 1, 8, 0, b, hh, sl, true, true, H, cumtot);
            float* o = A.out + OUT_GLA_S + (((size_t)b * 4 + hh) * 64) * 128 + 16 * sl + l15;
#pragma unroll
            for (int kt = 0; kt < 4; ++kt)
#pragma unroll
                for (int i = 0; i < 4; ++i) o[(size_t)(16 * kt + 4 * q + i) * 128] = H[kt][i];
        }
    }
}
__device__ __forceinline__ void p2c_mix(const Args& A, int r, int col0, u32x4 rcur, u32x4 rprev, float (&xs)[8]) {
    float cur[8], prev[8]; unpack8(rcur, cur);
    const bool first = (r < MP) ? ((r & 2047) == 0) : (((r - MP) & 7) == 0);
    if (!first) unpack8(rprev, prev);
    else if (r < MP) {
#pragma unroll
        for (int i = 0; i < 8; ++i) prev[i] = 0.f;
    } else ld8f(A.in[IN_ST_SHIFT] + (size_t)((r - MP) >> 3) * 1792 + col0, prev);
    float mu[8]; ld8f(A.in[IN_MU] + col0, mu);
#pragma unroll
    for (int i = 0; i < 8; ++i) xs[i] = cur[i] + (prev[i] - cur[i]) * mu[i];
}
__device__ __forceinline__ void p2c_post(const Args& A, int gw, int NGW, int lane, bool shadow) {
    const bf16_t* PRW = (const bf16_t*)(A.ws + OFF_PRW); const bf16_t* PGLA = (const bf16_t*)(A.ws + OFF_PGLA);
    const bf16_t *AARR = (const bf16_t*)((unsigned char*)A.out + OUTB_AARR), *G = (const bf16_t*)(A.ws + OFF_G);
    bf16_t *ORW = (bf16_t*)((unsigned char*)A.out + OUTB_ORW), *OGL = (bf16_t*)((unsigned char*)A.out + OUTB_OGL);
    const int c0 = 8 * lane;
    for (int rb = gw; rb < M; rb += 2 * NGW) {
        u32x4 raw[2][11];
#pragma unroll
        for (int k = 0; k < 2; ++k) { const int r = (rb + k * NGW < M) ? rb + k * NGW : rb; const int rp = r > 0 ? r - 1 : 0;
            raw[k][0] = *(const u32x4*)(ORW + (size_t)r * 512 + c0); raw[k][1] = *(const u32x4*)(OGL + (size_t)r * 512 + c0);
            raw[k][2] = *(const u32x4*)(PRW + (size_t)r * NPRW + c0); raw[k][3] = *(const u32x4*)(PRW + (size_t)r * NPRW + 512 + c0); raw[k][4] = *(const u32x4*)(PRW + (size_t)r * NPRW + 1024 + c0);
            raw[k][5] = *(const u32x4*)(PRW + (size_t)rp * NPRW + c0); raw[k][6] = *(const u32x4*)(PRW + (size_t)rp * NPRW + 512 + c0); raw[k][7] = *(const u32x4*)(PRW + (size_t)rp * NPRW + 1024 + c0);
            raw[k][8] = *(const u32x4*)(AARR + (size_t)r * 512 + c0); raw[k][9] = *(const u32x4*)(G + (size_t)r * 512 + c0); raw[k][10] = *(const u32x4*)(PGLA + (size_t)r * NPGLA + 1040 + c0); }
#pragma unroll
        for (int k = 0; k < 2; ++k) { const int r = rb + k * NGW; if (r < M) {
            float o[8], d[8], xr[8], xk[8], xv[8], a[8], g[8], p[8], res[8];
            unpack8(raw[k][0], o);
            float s1 = 0.f;
#pragma unroll
            for (int i = 0; i < 8; ++i) s1 += o[i];
            const float mu = row8_allsum(s1) * (1.f / 64.f); float s2 = 0.f;
#pragma unroll
            for (int i = 0; i < 8; ++i) { d[i] = o[i] - mu; s2 += d[i] * d[i]; }
            const float rstd = rsqrtf(row8_allsum(s2) * (1.f / 64.f) + 64e-5f);
            p2c_mix(A, r, c0, raw[k][2], raw[k][5], xr); p2c_mix(A, r, 512 + c0, raw[k][3], raw[k][6], xk); p2c_mix(A, r, 1024 + c0, raw[k][4], raw[k][7], xv);
            unpack8(raw[k][8], a); unpack8(raw[k][9], g);
            float bs = 0.f; ld8f(A.in[IN_KA] + c0, p);
#pragma unroll
            for (int i = 0; i < 8; ++i) d[i] *= rstd, xk[i] = xk[i] * (1.f + (a[i] - 1.f) * p[i]);
            ld8f(A.in[IN_RK] + c0, p);
#pragma unroll
            for (int i = 0; i < 8; ++i) bs += xr[i] * xk[i] * p[i];
            bs = row8_allsum(bs);
            ld8f(A.in[IN_LNW] + c0, p); ld8f(A.in[IN_LNB] + c0, a);
#pragma unroll
            for (int i = 0; i < 8; ++i) res[i] = ((d[i] * p[i] + a[i]) + bs * xv[i]) * g[i];
            if (!shadow) *(u32x4*)(ORW + (size_t)r * 512 + c0) = pack8(res); else *(u32x4*)((bf16_t*)(A.ws + 240 * MiB) + (size_t)(r & 8191) * 512 + c0) = pack8(res);
            unpack8(raw[k][1], o);
            float ms = 0.f;
#pragma unroll
            for (int i = 0; i < 8; ++i) ms += o[i] * o[i];
            const float rs = rsqrtf(row16_allsum(ms) * (1.f / 128.f) + NORM_EPS);
            unpack8(raw[k][10], g); ld8f(A.in[IN_GNW] + (c0 & 127), p);
#pragma unroll
            for (int i = 0; i < 8; ++i) res[i] = o[i] * rs * p[i] * (g[i] * fsigmoid(g[i]));
            if (!shadow) *(u32x4*)(OGL + (size_t)r * 512 + c0) = pack8(res); else *(u32x4*)((bf16_t*)(A.ws + 248 * MiB) + (size_t)(r & 8191) * 512 + c0) = pack8(res);
        } }
    }
}
__device__ __forceinline__ void p6_act(const Args& A, int gtid, int NGT) {
    bf16_t* U = (bf16_t*)(A.ws + OFF_U); const bf16_t* UH = (const bf16_t*)(A.ws + OFF_UH);
    const float *convw = A.in[IN_CONVW], *convb = A.in[IN_CONVB], *cstate = A.in[IN_ST_CONV];
    for (int item = gtid; item < (M / 64) * 352; item += NGT) {
        const int rb = item / 352, jc = (item - rb * 352) * 8, r0 = rb * 64; const bool sample = r0 >= MP;
        float p1v[8], p2v[8], p1g[8], p2g[8], w0v[8], w1v[8], w2v[8], cbv[8], w0g[8], w1g[8], w2g[8], cbg[8];
        ld8f(convw + jc, w0v); ld8f(convw + F2 + jc, w1v); ld8f(convw + 2 * F2 + jc, w2v); ld8f(convb + jc, cbv);
        ld8f(convw + FF + jc, w0g); ld8f(convw + F2 + FF + jc, w1g); ld8f(convw + 2 * F2 + FF + jc, w2g); ld8f(convb + FF + jc, cbg);
#pragma unroll
        for (int i = 0; i < 8; ++i) p1v[i] = p2v[i] = p1g[i] = p2g[i] = 0.f;
        if (!sample && (rb & 31) != 0) { const bf16_t* q = UH + (size_t)(rb - 1) * 2 * F2; ld8bf(q + jc, p2v); ld8bf(q + FF + jc, p2g); ld8bf(q + F2 + jc, p1v); ld8bf(q + F2 + FF + jc, p1g); }
        for (int r8 = 0; r8 < 64; r8 += 8) {
            u32x4 rawv[8], rawg[8];
#pragma unroll
            for (int k = 0; k < 8; ++k) { const bf16_t* row = U + (size_t)(r0 + r8 + k) * F2; rawv[k] = *(const u32x4*)(row + jc); rawg[k] = *(const u32x4*)(row + FF + jc); }
            if (sample) { const float* st = cstate + (size_t)((r0 + r8 - MP) >> 3) * 2 * F2; ld8f(st + jc, p2v); ld8f(st + FF + jc, p2g); ld8f(st + F2 + jc, p1v); ld8f(st + F2 + FF + jc, p1g); }
#pragma unroll
            for (int k = 0; k < 8; ++k) {
                float cv[8], cg[8], res[8]; unpack8(rawv[k], cv); unpack8(rawg[k], cg);
#pragma unroll
                for (int i = 0; i < 8; ++i) { const float v = cbv[i] + w0v[i] * p2v[i] + w1v[i] * p1v[i] + w2v[i] * cv[i], gg = cbg[i] + w0g[i] * p2g[i] + w1g[i] * p1g[i] + w2g[i] * cg[i];
                    res[i] = gelu_gate(gg, v); p2v[i] = p1v[i]; p1v[i] = cv[i]; p2g[i] = p1g[i]; p1g[i] = cg[i]; }
                *(u32x4*)(U + (size_t)(r0 + r8 + k) * F2 + jc) = pack8(res);
            }
        }
    }
}
__device__ __forceinline__ void pfix_act(const Args& A, int gtid, int NGT) {
    const bf16_t* UH = (const bf16_t*)(A.ws + OFF_UH); const bf16_t* US = (const bf16_t*)(A.ws + OFF_US); bf16_t* ACT = (bf16_t*)(A.ws + OFF_ACT);
    const float *convw = A.in[IN_CONVW], *convb = A.in[IN_CONVB], *cstate = A.in[IN_ST_CONV];
    for (int idx = gtid; idx < (256 + 128) * 2 * 352; idx += NGT) {
        const int g = idx / 704, rem = idx - g * 704, rsel = rem / 352, jc = (rem - rsel * 352) * 8;
        float cv[8], cg[8], p1v[8], p1g[8], p2v[8], p2g[8], res[8]; int orow;
#pragma unroll
        for (int i = 0; i < 8; ++i) p1v[i] = p1g[i] = p2v[i] = p2g[i] = 0.f;
        if (g < 256) {
            const bool seq0 = (g & 31) == 0; orow = 64 * g + rsel;
            ld8bf(UH + ((size_t)g * 4 + rsel) * F2 + jc, cv); ld8bf(UH + ((size_t)g * 4 + rsel) * F2 + FF + jc, cg);
            if (rsel == 0) { if (!seq0) { const bf16_t* q = UH + ((size_t)(g - 1) * 4 + 3) * F2; ld8bf(q + jc, p1v); ld8bf(q + FF + jc, p1g); q -= F2; ld8bf(q + jc, p2v); ld8bf(q + FF + jc, p2g); } }
            else { const bf16_t* q = UH + ((size_t)g * 4) * F2; ld8bf(q + jc, p1v); ld8bf(q + FF + jc, p1g);
                if (!seq0) { q = UH + ((size_t)(g - 1) * 4 + 3) * F2; ld8bf(q + jc, p2v); ld8bf(q + FF + jc, p2g); } }
        } else {
            const int sb = g - 256; orow = MP + 8 * sb + rsel; const float* st = cstate + (size_t)sb * 2 * F2;
            ld8bf(US + ((size_t)sb * 2 + rsel) * F2 + jc, cv); ld8bf(US + ((size_t)sb * 2 + rsel) * F2 + FF + jc, cg);
            if (rsel == 0) { ld8f(st + jc, p2v); ld8f(st + FF + jc, p2g); ld8f(st + F2 + jc, p1v); ld8f(st + F2 + FF + jc, p1g); }
            else { ld8f(st + F2 + jc, p2v); ld8f(st + F2 + FF + jc, p2g); ld8bf(US + ((size_t)sb * 2) * F2 + jc, p1v); ld8bf(US + ((size_t)sb * 2) * F2 + FF + jc, p1g); }
        }
#pragma unroll
        for (int i = 0; i < 8; ++i) { const int col = jc + i;
            const float v = convb[col] + convw[col] * p2v[i] + convw[F2 + col] * p1v[i] + convw[2 * F2 + col] * cv[i];
            const float gg = convb[FF + col] + convw[FF + col] * p2g[i] + convw[F2 + FF + col] * p1g[i] + convw[2 * F2 + FF + col] * cg[i];
            res[i] = gelu_gate(gg, v); }
        *(u32x4*)(ACT + (size_t)orow * FF + jc) = pack8(res);
    }
}
__device__ __forceinline__ void p8_final(const Args& A, int gw, int NGW, int lane, float* dst) {
    const float* gf = A.in[IN_NORM_FINAL];
    for (int m = gw; m < M; m += 2 * NGW) {
        const int m2 = m + NGW; const bool has2 = m2 < M;
        const f32x4* xr = (const f32x4*)(A.out + (size_t)m * DM) + lane; const f32x4* xr2 = (const f32x4*)(A.out + (size_t)(has2 ? m2 : m) * DM) + lane; f32x4 v[4], w[4]; float s = 0.f, s2 = 0.f;
#pragma unroll
        for (int j = 0; j < 4; ++j) { v[j] = xr[64 * j]; w[j] = xr2[64 * j]; }
#pragma unroll
        for (int j = 0; j < 4; ++j) { s += (v[j].x * v[j].x + v[j].y * v[j].y) + (v[j].z * v[j].z + v[j].w * v[j].w); s2 += (w[j].x * w[j].x + w[j].y * w[j].y) + (w[j].z * w[j].z + w[j].w * w[j].w); }
        const float rstd = rsqrtf(wave_allsum(s) * (1.f / DM) + NORM_EPS), rstd2 = rsqrtf(wave_allsum(s2) * (1.f / DM) + NORM_EPS);
#pragma unroll
        for (int j = 0; j < 4; ++j) { const f32x4 g = *((const f32x4*)gf + lane + 64 * j); ((f32x4*)(dst + (size_t)m * DM) + lane)[64 * j] = v[j] * rstd * g; if (has2) ((f32x4*)(dst + (size_t)m2 * DM) + lane)[64 * j] = w[j] * rstd2 * g; }
    }
}

#ifndef PHMASK
#define PHMASK 0xFFFF
#endif
#ifndef PHREP
#define PHREP 0
#endif
#define PH(k) for (int rep_ = 0; rep_ < ((((PHMASK) >> (k)) & 1) ? ((((PHREP) >> (k)) & 1) ? 2 : 1) : 0); ++rep_)
__global__ void __launch_bounds__(NTHREADS, 2) fwd_megakernel(Args A) {
    extern __shared__ __attribute__((aligned(16))) unsigned char lds_raw[];
    LAS unsigned char* lds = (LAS unsigned char*)lds_raw;
    cg::grid_group grid = cg::this_grid();
    const int tid = threadIdx.x, lane = tid & 63, wave = __builtin_amdgcn_readfirstlane(tid >> 6);
    const int G = gridDim.x, gw = blockIdx.x * NWAVES + wave, NGW = G * NWAVES;
    unsigned char* ws = A.ws;
    if (tid < 4) ((LAS unsigned*)(lds + 131072))[tid] = 0u;
    __syncthreads();
    const XcdBarrier xbar = xcd_barrier_post((unsigned*)(ws + OFF_BAR), (volatile LAS unsigned*)(lds + 131072));
#define GSYNC() xcd_barrier(xbar)
    PH(0) p0_prologue(A, lds, gw, NGW, wave, lane);
    if (A.ws == nullptr) grid.sync();
    GSYNC();
    PH(1) { pg8::Gemm g{(const bf16_t*)((unsigned char*)A.out + OUTB_H), (const bf16_t*)(ws + OFF_WIN), M, NIN, 1024, 1024}; pg8::StaticOrder S; S.init(M, NIN, G, (int)blockIdx.x);
      EpiProj E{(bf16_t*)(ws + OFF_PRW), (bf16_t*)(ws + OFF_PGLA), (bf16_t*)(ws + OFF_PGATE), A.out + OUT_SHIFT_P, A.out + OUT_SHIFT_S};
      pg8::gemm_phase<EpiProj, pg8::StaticOrder, true, true>(lds, g, S, E); }
    GSYNC();
    PH(2) p2a_lora(A, gw, NGW, lane);
    GSYNC();
    PH(3) p2x_scan1(A, lds, wave, lane);
    GSYNC();
    PH(11) p2y_scan2(A, lds, wave, lane);
    GSYNC();
#ifdef SHADOW_P2C
    p2c_post(A, gw, NGW, lane, true);
#endif
    PH(4) p2c_post(A, gw, NGW, lane, false);
    GSYNC();
    PH(5) { pg8::StaticOrder S; S.init(M, 1024, G, (int)blockIdx.x); S.limit = __builtin_amdgcn_readfirstlane((S.nwg / G) * G);
      { pg8::Gemm g{(const bf16_t*)((unsigned char*)A.out + OUTB_ORW), (const bf16_t*)(ws + OFF_WOA), M, 1024, 512, 512};
        EpiGate<true> E{(bf16_t*)(ws + OFF_MERGED), (const bf16_t*)(ws + OFF_PGATE)};
        pg8::gemm_phase<EpiGate<true>, pg8::StaticOrder, true, true>(lds, g, S, E);
        tail_gemm(lds, (const bf16_t*)((unsigned char*)A.out + OUTB_ORW), 512, (const bf16_t*)(ws + OFF_WOA), 512, S, wave, lane, TfGate{true, (bf16_t*)(ws + OFF_MERGED), (const bf16_t*)(ws + OFF_PGATE)}); }
      { pg8::Gemm g{(const bf16_t*)((unsigned char*)A.out + OUTB_OGL), (const bf16_t*)(ws + OFF_WOB), M, 1024, 512, 512};
        EpiGate<false> E{(bf16_t*)(ws + OFF_MERGED), (const bf16_t*)(ws + OFF_PGATE) + 1024};
        pg8::gemm_phase<EpiGate<false>, pg8::StaticOrder, true, true>(lds, g, S, E);
        tail_gemm(lds, (const bf16_t*)((unsigned char*)A.out + OUTB_OGL), 512, (const bf16_t*)(ws + OFF_WOB), 512, S, wave, lane, TfGate{false, (bf16_t*)(ws + OFF_MERGED), (const bf16_t*)(ws + OFF_PGATE) + 1024}); } }
    GSYNC();
    PH(6) { pg8::Gemm g{(const bf16_t*)(ws + OFF_MERGED), (const bf16_t*)(ws + OFF_WO), M, 1024, 1024, 1024}; pg8::StaticOrder S; S.init(M, 1024, G, (int)blockIdx.x); S.limit = __builtin_amdgcn_readfirstlane((S.nwg / G) * G);
#ifdef SHADOW_G3
      float* rss = (rep_ == 0) ? (float*)(ws + OFF_ROWSS + 256 * 1024) : (float*)(ws + OFF_ROWSS);
#else
      float* rss = (float*)(ws + OFF_ROWSS);
#endif
      EpiX1 E{A.in[IN_XP], A.in[IN_XS], A.out, (bf16_t*)(ws + OFF_X1B), rss};
      pg8::gemm_phase<EpiX1, pg8::StaticOrder, true, true>(lds, g, S, E);
      tail_gemm(lds, (const bf16_t*)(ws + OFF_MERGED), 1024, (const bf16_t*)(ws + OFF_WO), 1024, S, wave, lane, TfX1{A.in[IN_XP], A.in[IN_XS], A.out, (bf16_t*)(ws + OFF_X1B), rss}); }
    GSYNC();
    PH(7) { pg8::Gemm g{(const bf16_t*)(ws + OFF_X1B), (const bf16_t*)(ws + OFF_WUP), M, F2, 1024, 1024}; pg8::StaticOrder S; S.init(M, F2, G, (int)blockIdx.x);
      EpiAct E{(const float*)(ws + OFF_ROWSS), A.in[IN_CONVW], A.in[IN_CONVB], (bf16_t*)(ws + OFF_ACT), (bf16_t*)(ws + OFF_UH), (bf16_t*)(ws + OFF_US), A.out + OUT_CONV_P, A.out + OUT_CONV_S, (LAS float*)(lds + 131072)};
      pg8::gemm_phase<EpiAct, pg8::StaticOrder, true, true>(lds, g, S, E); }
    __syncthreads(); if (tid < 4) ((LAS unsigned*)(lds + 131072))[tid] = 0u; __syncthreads();
    GSYNC();
    PH(8) pfix_act(A, blockIdx.x * NTHREADS + tid, G * NTHREADS);
    GSYNC();
    PH(9) { pg8::Gemm g{(const bf16_t*)(ws + OFF_ACT), (const bf16_t*)(ws + OFF_WDN), M, 1024, FF, FF}; pg8::StaticOrder S; S.init(M, 1024, G, (int)blockIdx.x); S.limit = __builtin_amdgcn_readfirstlane((S.nwg / G) * G);
#ifdef SHADOW_G5
      float* xd = (rep_ == 0) ? (float*)(ws + 129 * MiB) : A.out;
#else
      float* xd = A.out;
#endif
      EpiX2 E{A.out, xd};
      pg8::gemm_phase<EpiX2, pg8::StaticOrder, true, true>(lds, g, S, E);
      tail_gemm(lds, (const bf16_t*)(ws + OFF_ACT), FF, (const bf16_t*)(ws + OFF_WDN), FF, S, wave, lane, TfX2{A.out, xd}); }
    GSYNC();
#ifdef P8_SHADOW
    p8_final(A, gw, NGW, lane, (float*)(ws + OFF_U));
#endif
    PH(10) p8_final(A, gw, NGW, lane, A.out);
#ifdef EXTRA_SYNCS
    for (int i_ = 0; i_ < EXTRA_SYNCS; ++i_) GSYNC();
#endif
}

extern "C" void kernel_launch(void* const* d_in, const int* in_sizes, int n_in, void* d_out, int out_size, void* d_ws, size_t ws_size, hipStream_t stream) {
    static int grid = 0;
    if (grid == 0) {
        int dev = 0, cus = 0, per_cu = 0;
        if (n_in != 31 || ws_size < 256 * MiB) { fprintf(stderr, "kernel_launch: unexpected n_in %d / ws_size %zu\n", n_in, ws_size); grid = -1; return; }
        (void)hipGetDevice(&dev); (void)hipDeviceGetAttribute(&cus, hipDeviceAttributeMultiprocessorCount, dev);
        if (hipFuncSetAttribute((const void*)fwd_megakernel, hipFuncAttributeMaxDynamicSharedMemorySize, LDS_BYTES) != hipSuccess) { fprintf(stderr, "kernel_launch: hipFuncSetAttribute failed\n"); grid = -1; return; }
        if (hipOccupancyMaxActiveBlocksPerMultiprocessor(&per_cu, (const void*)fwd_megakernel, NTHREADS, LDS_BYTES) != hipSuccess || per_cu < 1) { fprintf(stderr, "kernel_launch: occupancy query failed (%d)\n", per_cu); (void)hipGetLastError(); grid = -1; return; }
        grid = cus * 1;
    }
    if (grid < 0) return;
    Args a{};
    for (int i = 0; i < 31; ++i) a.in[i] = (const float*)d_in[i];
    a.out = (float*)d_out; a.ws = (unsigned char*)d_ws;
    if (hipMemsetAsync((char*)d_ws + OFF_BAR, 0, XCD_BAR_WORDS * 4, stream) != hipSuccess) { fprintf(stderr, "kernel_launch: memset of the barrier words failed\n"); return; }
    void* params[] = {&a};
    hipError_t e = hipLaunchCooperativeKernel((const void*)fwd_megakernel, dim3(grid), dim3(NTHREADS), params, LDS_BYTES, stream);
    if (e != hipSuccess) fprintf(stderr, "kernel_launch: cooperative launch failed: %s (grid %d)\n", hipGetErrorString(e), grid);
}
```

```cpp
#include <hip/hip_runtime.h>
#include <hip/hip_cooperative_groups.h>
#include <cstdio>
#include <cstdint>
namespace cg = cooperative_groups;
#define PHREP 0
namespace pg8 {
#define PG8_LAS __attribute__((address_space(3)))
typedef unsigned short bf16_t;
typedef short bf16x8 __attribute__((ext_vector_type(8)));
typedef float f32x4 __attribute__((ext_vector_type(4)));
typedef unsigned u32x4 __attribute__((ext_vector_type(4)));
constexpr int BM = 256, BK = 64, HALF = 128, HTB = HALF * BK * 2  , STAGE_BYTES = 8 * HTB, NXCD = 8, WGM = 8;

__host__ __device__ __forceinline__ int lds_byte(int r, int c) { const int st = (r >> 4) * 2 + (c >> 5), rr = r & 15, cc = c & 31, ob = rr * 64 + cc * 2; return st * 1024 + (ob ^ (((ob >> 9) & 1) << 5)); }
__host__ __device__ __forceinline__ void stage_rc(int b, int& R, int& C) { const int st = b / 1024, sb = b % 1024, swz = sb ^ (((sb >> 9) & 1) << 5); R = (st >> 1) * 16 + swz / 64; C = (st & 1) * 32 + (swz % 64) / 2; }
__host__ __device__ __forceinline__ int perm32(int rho) { const int n = rho >> 4, i = rho & 15; return 8 * (i >> 2) + 4 * n + (i & 3); }

struct Unit { int pm, pn; };
struct Gemm { const bf16_t* A; const bf16_t* Bt; int M, N, K, lda; };

struct StaticOrder {
    int nM, nN, nwg, G, c;
    int limit;
    __host__ __device__ void init(int M, int N, int G_, int c_) { nM = M / BM; nN = N / BM; nwg = nM * nN; G = G_; c = c_; limit = nwg; }
    __host__ __device__ __forceinline__ bool next(int i, Unit& u) const {
        const int L = i * G + c; if (L >= limit) return false;
        unit_of(L, u); return true;
    }
    __host__ __device__ __forceinline__ void unit_of(int L, Unit& u) const {
        int wgid = L; { const int q = nwg / NXCD, r = nwg % NXCD, xcd = wgid % NXCD, off = wgid / NXCD; wgid = (xcd < r ? xcd * (q + 1) : r * (q + 1) + (xcd - r) * q) + off; }
        const int nig = WGM * nN, gid = wgid / nig, fm = gid * WGM, gsz = (nM - fm) < WGM ? (nM - fm) : WGM;
        u.pm = fm + ((wgid % nig) % gsz); u.pn = (wgid % nig) / gsz;
    }
    __device__ __forceinline__ void a_ready(const Unit&) const {}
    __device__ __forceinline__ void done(const Unit&) const {}
};
__device__ __forceinline__ unsigned cvt_pk_bf16(float lo, float hi) { unsigned r; asm volatile("v_cvt_pk_bf16_f32 %0, %1, %2" : "=v"(r) : "v"(lo), "v"(hi)); return r; }
typedef float f32x2 __attribute__((ext_vector_type(2)));
template <class Epi, class Sched, bool ALIGN_EPI = false, bool SP2 = false>
__device__ __forceinline__ void gemm_phase(PG8_LAS unsigned char* lds, const Gemm g, const Sched& S, const Epi& E) {
    int tid_ = threadIdx.x; asm volatile("" : "+v"(tid_));
    const int tid = tid_, wid = __builtin_amdgcn_readfirstlane(tid >> 6), lane = tid & 63, wr = wid >> 2, wc = wid & 3, fr = lane & 15, fq = lane >> 4;
    const int K = g.K, nt = K / BK;
    unsigned voffA[2], voffB[2];
#pragma unroll
    for (int i = 0; i < 2; ++i) { int R, C; stage_rc(tid * 16 + i * 8192, R, C); const int Rb = Epi::PERM ? ((R & ~31) + perm32(R & 31)) : R;
        voffA[i] = (unsigned)(R * g.lda + C) * 2u; voffB[i] = (unsigned)(Rb * K + C) * 2u; }
    const size_t kstep = (size_t)(BK * 2);
    const size_t hstep = (size_t)HALF * K * 2;
    const size_t tstep = 2 * hstep;
    const size_t hstepA = (size_t)HALF * g.lda * 2, tstepA = 2 * hstepA;
    const unsigned ldsw = (unsigned)wid * 1024u;
    const int aoff = lds_byte(wr * 64 + fr, fq * 8), boff = lds_byte(wc * 32 + fr, fq * 8);
#define PG8_SA(b, h) (((b) * 2 + (h)) * HTB)
#define PG8_SB(b, h) ((4 + (b) * 2 + (h)) * HTB)
#define PG8_STAGE(bufoff, gbase, voff) do { _Pragma("unroll") for (int _i = 0; _i < 2; ++_i) \
        __builtin_amdgcn_global_load_lds((const unsigned*)((const char*)(gbase) + (voff)[_i]), (PG8_LAS unsigned*)(lds + (bufoff) + ldsw + _i * 8192), 16, 0, 0); } while (0)
#define PG8_LDA(dst, b, h) do { _Pragma("unroll") for (int m = 0; m < 4; ++m) _Pragma("unroll") for (int k = 0; k < 2; ++k) dst[m][k] = *(const PG8_LAS bf16x8*)(lds + PG8_SA(b, h) + aoff + m * 2048 + k * 1024); } while (0)
#define PG8_LDB(dst, b, h) do { _Pragma("unroll") for (int n = 0; n < 2; ++n) _Pragma("unroll") for (int k = 0; k < 2; ++k) dst[n][k] = *(const PG8_LAS bf16x8*)(lds + PG8_SB(b, h) + boff + n * 2048 + k * 1024); } while (0)
#define PG8_MMA(ai, bj, At, Bt) do { __builtin_amdgcn_s_setprio(1); _Pragma("unroll") for (int m = 0; m < 4; ++m) _Pragma("unroll") for (int n = 0; n < 2; ++n) _Pragma("unroll") for (int k = 0; k < 2; ++k) \
        acc[ai][bj][m][n] = __builtin_amdgcn_mfma_f32_16x16x32_bf16(Bt[n][k], At[m][k], acc[ai][bj][m][n], 0, 0, 0); __builtin_amdgcn_s_setprio(0); } while (0)
#define PG8_WAIT_V(n) asm volatile("s_waitcnt vmcnt(" #n ")" ::: "memory")
#define PG8_WAIT_L(n) asm volatile("s_waitcnt lgkmcnt(" #n ")" ::: "memory")
#define PG8_BAR __builtin_amdgcn_s_barrier()
#define PG8_SCHED __builtin_amdgcn_sched_barrier(0)
    Unit cur, nxt; int ui = 0;
    if (!S.next(0, cur)) return;
    f32x4 acc[2][2][4][2];
#pragma unroll
    for (int a = 0; a < 2; ++a)
#pragma unroll
        for (int b = 0; b < 2; ++b)
#pragma unroll
            for (int m = 0; m < 4; ++m)
#pragma unroll
                for (int n = 0; n < 2; ++n) acc[a][b][m][n] = (f32x4){0.f, 0.f, 0.f, 0.f};
    bf16x8 At[4][2], B0[2][2], B1[2][2];
    const char* cA = (const char*)g.A + (size_t)cur.pm * tstepA; const char* cB = (const char*)g.Bt + (size_t)cur.pn * tstep;
    S.a_ready(cur);
    if constexpr (SP2) {
        PG8_STAGE(PG8_SB(0, 0), cB, voffB); PG8_STAGE(PG8_SB(0, 1), cB + hstep, voffB); PG8_STAGE(PG8_SA(0, 0), cA, voffA); PG8_STAGE(PG8_SA(0, 1), cA + hstepA, voffA);
        if (wr == 1) PG8_BAR;
        PG8_WAIT_V(2); PG8_BAR;
        PG8_STAGE(PG8_SB(1, 0), cB + kstep, voffB); PG8_STAGE(PG8_SA(1, 0), cA + kstep, voffA); PG8_STAGE(PG8_SB(1, 1), cB + hstep + kstep, voffB);
        PG8_WAIT_V(6); PG8_BAR;
    } else {
        PG8_STAGE(PG8_SB(0, 0), cB, voffB); PG8_STAGE(PG8_SA(0, 0), cA, voffA); PG8_STAGE(PG8_SB(0, 1), cB + hstep, voffB); PG8_STAGE(PG8_SA(0, 1), cA + hstepA, voffA);
        if (wr == 1) PG8_BAR;
        PG8_WAIT_V(4); PG8_BAR;
        PG8_STAGE(PG8_SB(1, 0), cB + kstep, voffB); PG8_STAGE(PG8_SA(1, 0), cA + kstep, voffA); PG8_STAGE(PG8_SB(1, 1), cB + hstep + kstep, voffB);
        PG8_WAIT_V(6); PG8_BAR;
    }
    for (;;) {
        const bool has_next = S.next(ui + 1, nxt);
        const char* nA = has_next ? (const char*)g.A + (size_t)nxt.pm * tstepA : cA; const char* nB = has_next ? (const char*)g.Bt + (size_t)nxt.pn * tstep : cB;
        for (int t = 0; t < nt; t += 2) {
            const bool last = (t == nt - 2);
            const char* a1 = cA + (size_t)(t + 1) * kstep;
            const char* a2 = last ? nA : cA + (size_t)(t + 2) * kstep; const char* b2 = last ? nB : cB + (size_t)(t + 2) * kstep;
            const char* a3 = a2 + kstep; const char* b3 = b2 + kstep;
            if (last && has_next) S.a_ready(nxt);
            if constexpr (SP2) {
            PG8_LDB(B0, 0, 0); PG8_LDB(B1, 0, 1); PG8_SCHED; PG8_LDA(At, 0, 0); PG8_STAGE(PG8_SA(1, 1), a1 + hstepA, voffA);
            PG8_WAIT_V(8); PG8_WAIT_L(0); PG8_BAR; PG8_MMA(0, 0, At, B0); PG8_MMA(0, 1, At, B1); PG8_BAR; PG8_SCHED;
            PG8_LDA(At, 0, 1); PG8_STAGE(PG8_SB(0, 0), b2, voffB); PG8_STAGE(PG8_SB(0, 1), b2 + hstep, voffB); PG8_STAGE(PG8_SA(0, 0), a2, voffA);
            PG8_WAIT_V(8); PG8_WAIT_L(0); PG8_BAR; PG8_MMA(1, 0, At, B0); PG8_MMA(1, 1, At, B1); PG8_BAR; PG8_SCHED;
            PG8_LDB(B0, 1, 0); PG8_LDB(B1, 1, 1); PG8_SCHED; PG8_LDA(At, 1, 0); PG8_STAGE(PG8_SA(0, 1), a2 + hstepA, voffA);
            PG8_WAIT_V(8); PG8_WAIT_L(0); PG8_BAR; PG8_MMA(0, 0, At, B0); PG8_MMA(0, 1, At, B1); PG8_BAR; PG8_SCHED;
            PG8_LDA(At, 1, 1); PG8_STAGE(PG8_SB(1, 0), b3, voffB); PG8_STAGE(PG8_SB(1, 1), b3 + hstep, voffB); PG8_STAGE(PG8_SA(1, 0), a3, voffA);
            PG8_WAIT_V(8); PG8_WAIT_L(0); PG8_BAR; PG8_MMA(1, 0, At, B0); PG8_MMA(1, 1, At, B1); PG8_BAR; PG8_SCHED;
            } else {
            PG8_LDB(B0, 0, 0); PG8_SCHED; PG8_LDA(At, 0, 0); PG8_STAGE(PG8_SA(1, 1), a1 + hstepA, voffA);
            PG8_WAIT_L(8); PG8_BAR; PG8_WAIT_L(0); PG8_MMA(0, 0, At, B0); PG8_BAR; PG8_SCHED;
            PG8_LDB(B1, 0, 1); PG8_STAGE(PG8_SB(0, 0), b2, voffB);
            PG8_BAR; PG8_WAIT_L(0); PG8_MMA(0, 1, At, B1); PG8_BAR;
            PG8_LDA(At, 0, 1); PG8_STAGE(PG8_SA(0, 0), a2, voffA);
            PG8_BAR; PG8_WAIT_L(0); PG8_MMA(1, 0, At, B0); PG8_BAR; PG8_SCHED;
            PG8_STAGE(PG8_SB(0, 1), b2 + hstep, voffB);
            PG8_WAIT_V(6); PG8_BAR; PG8_MMA(1, 1, At, B1); PG8_BAR;
            PG8_LDB(B0, 1, 0); PG8_SCHED; PG8_LDA(At, 1, 0); PG8_STAGE(PG8_SA(0, 1), a2 + hstepA, voffA);
            PG8_WAIT_L(8); PG8_BAR; PG8_WAIT_L(0); PG8_MMA(0, 0, At, B0); PG8_BAR; PG8_SCHED;
            PG8_LDB(B1, 1, 1); PG8_STAGE(PG8_SB(1, 0), b3, voffB);
            PG8_BAR; PG8_WAIT_L(0); PG8_MMA(0, 1, At, B1); PG8_BAR;
            PG8_LDA(At, 1, 1); PG8_STAGE(PG8_SA(1, 0), a3, voffA);
            PG8_BAR; PG8_WAIT_L(0); PG8_MMA(1, 0, At, B0); PG8_BAR; PG8_SCHED;
            PG8_STAGE(PG8_SB(1, 1), b3 + hstep, voffB);
            PG8_WAIT_V(6); PG8_BAR; PG8_MMA(1, 1, At, B1); PG8_BAR;
            }
        }
        if constexpr (ALIGN_EPI) { if (wr == 0) PG8_BAR; }
        if constexpr (!Epi::AFTER_DRAIN) { E(acc, cur, wr, wc, fr, fq); S.done(cur); }
        if (!has_next) break;
#pragma unroll
        for (int a = 0; a < 2; ++a)
#pragma unroll
            for (int b = 0; b < 2; ++b)
#pragma unroll
                for (int m = 0; m < 4; ++m)
#pragma unroll
                    for (int n = 0; n < 2; ++n) acc[a][b][m][n] = (f32x4){0.f, 0.f, 0.f, 0.f};
        cur = nxt; cA = nA; cB = nB; ++ui;
        if constexpr (ALIGN_EPI) { if (wr == 1) PG8_BAR; }
    }
    PG8_WAIT_V(0);
    if constexpr (!ALIGN_EPI) { if (wr == 0) PG8_BAR; }
    PG8_BAR;
    if constexpr (Epi::AFTER_DRAIN) { E.fused(acc, cur, wr, wc, fr, fq, lds, wid, lane); S.done(cur); }
#undef PG8_SA
#undef PG8_SB
#undef PG8_STAGE
#undef PG8_LDA
#undef PG8_LDB
#undef PG8_MMA
#undef PG8_WAIT_V
#undef PG8_WAIT_L
#undef PG8_BAR
#undef PG8_SCHED
}
}

#define LAS __attribute__((address_space(3)))
typedef unsigned short bf16_t;
typedef short bf16x8 __attribute__((ext_vector_type(8)));
typedef float f32x4 __attribute__((ext_vector_type(4)));
typedef unsigned u32x4 __attribute__((ext_vector_type(4)));
typedef unsigned u32x2 __attribute__((ext_vector_type(2)));
using pg8::Unit;

constexpr int M = 17408, MP = 16384, DM = 1024;
constexpr int NPRW = 1792, NPGLA = 1792, NGATE = 2048, NIN = 5632;
constexpr int FF = 2816, F2 = 5632;
constexpr float NORM_EPS = 1e-6f;
constexpr int NWAVES = 8, NTHREADS = 512;
constexpr int LDS_BYTES = 131072 + 32768;
constexpr size_t OFF_BAR = 512 * 1024;

constexpr size_t MiB = 1u << 20;
constexpr size_t OFF_ROWSS = 0;
constexpr size_t OFF_WIN = 1 * MiB, OFF_WUP = 12 * MiB, OFF_WDN = 23 * MiB, OFF_WO = 29 * MiB, OFF_WOA = 31 * MiB, OFF_WOB = 32 * MiB;
constexpr size_t OFF_W2T = 33 * MiB, OFF_A2T = OFF_W2T + 65536, OFF_G2T = OFF_A2T + 65536;
constexpr size_t OFF_PRW = 35 * MiB, OFF_PGLA = 95 * MiB, OFF_PGATE = 155 * MiB, OFF_G = 223 * MiB;
constexpr size_t OFF_MERGED = OFF_PRW, OFF_UH = OFF_WIN, OFF_X1B = 222 * MiB, OFF_U = OFF_PRW, OFF_ACT = OFF_PRW, OFF_US = 29 * MiB;
static_assert(OFF_PRW + (size_t)M * NPRW * 2 <= OFF_PGLA && OFF_PGLA + (size_t)M * NPGLA * 2 <= OFF_PGATE && OFF_PGATE + (size_t)M * NGATE * 2 <= OFF_G, "ws map");
static_assert(OFF_G + (size_t)M * 512 * 2 <= 256 * MiB && OFF_U + (size_t)M * F2 * 2 <= OFF_X1B && OFF_X1B + (size_t)M * DM * 2 <= 256 * MiB, "ws map");
static_assert(OFF_UH + (size_t)256 * 4 * F2 * 2 <= OFF_WUP && OFF_ACT + (size_t)M * FF * 2 <= OFF_X1B, "ws map");

constexpr size_t OUT_SHIFT_P = (size_t)M * DM, OUT_WKV_P = OUT_SHIFT_P + 8 * 1792, OUT_GLA_P = OUT_WKV_P + 8 * 8 * 64 * 64, OUT_CONV_P = OUT_GLA_P + 8 * 4 * 64 * 128;
constexpr size_t OUT_SHIFT_S = OUT_CONV_P + 8 * 2 * F2, OUT_WKV_S = OUT_SHIFT_S + 128 * 1792, OUT_GLA_S = OUT_WKV_S + (size_t)128 * 8 * 64 * 64, OUT_CONV_S = OUT_GLA_S + (size_t)128 * 4 * 64 * 128;
constexpr size_t OUTB_H = 0, OUTB_EW = 0, OUTB_AARR = (size_t)M * 512 * 2, OUTB_ORW = (size_t)M * 1024 * 2, OUTB_OGL = OUTB_ORW + (size_t)M * 512 * 2;

struct Args { const float* in[31]; float* out; unsigned char* ws; };
#define IN_XP 0
#define IN_XS 1
#define IN_ST_SHIFT 2
#define IN_ST_WKV 3
#define IN_ST_GLA 4
#define IN_ST_CONV 5
#define IN_NORM_MIX 6
#define IN_W_IN 7
#define IN_MU 8
#define IN_W0 9
#define IN_W2 10
#define IN_A0 11
#define IN_A2 12
#define IN_G2 13
#define IN_KK 14
#define IN_KA 15
#define IN_RK 16
#define IN_LNW 17
#define IN_LNB 18
#define IN_WG2 19
#define IN_BG 20
#define IN_GNW 21
#define IN_WOA 22
#define IN_WOB 23
#define IN_WO 24
#define IN_NORM_FFN 25
#define IN_WUP 26
#define IN_CONVW 27
#define IN_CONVB 28
#define IN_WDN 29
#define IN_NORM_FINAL 30

__device__ __forceinline__ float bf_lo(unsigned w) { return __builtin_bit_cast(float, w << 16); }
__device__ __forceinline__ float bf_hi(unsigned w) { return __builtin_bit_cast(float, w & 0xffff0000u); }
__device__ __forceinline__ float bf2f(bf16_t h) { return __builtin_bit_cast(float, (unsigned)h << 16); }
__device__ __forceinline__ unsigned f2bf(float f) { unsigned u = __builtin_bit_cast(unsigned, f); return (u + 0x7fffu + ((u >> 16) & 1u)) >> 16; }
typedef float f32x2_t __attribute__((ext_vector_type(2)));
typedef __bf16 bf16x2_t __attribute__((ext_vector_type(2)));
__device__ __forceinline__ unsigned pk2(float lo, float hi) { const f32x2_t v = {lo, hi}; const bf16x2_t b = __builtin_convertvector(v, bf16x2_t); return __builtin_bit_cast(unsigned, b); }
__device__ __forceinline__ void unpack8(u32x4 w, float (&o)[8]) { o[0] = bf_lo(w.x); o[1] = bf_hi(w.x); o[2] = bf_lo(w.y); o[3] = bf_hi(w.y); o[4] = bf_lo(w.z); o[5] = bf_hi(w.z); o[6] = bf_lo(w.w); o[7] = bf_hi(w.w); }
__device__ __forceinline__ u32x4 pack8(const float (&v)[8]) { u32x4 w; w.x = pk2(v[0], v[1]); w.y = pk2(v[2], v[3]); w.z = pk2(v[4], v[5]); w.w = pk2(v[6], v[7]); return w; }
__device__ __forceinline__ void ld8bf(const bf16_t* p, float (&o)[8]) { unpack8(*(const u32x4*)p, o); }
__device__ __forceinline__ void ld8f(const float* p, float (&o)[8]) { const f32x4 a = *(const f32x4*)p, b = *(const f32x4*)(p + 4); o[0] = a.x; o[1] = a.y; o[2] = a.z; o[3] = a.w; o[4] = b.x; o[5] = b.y; o[6] = b.z; o[7] = b.w; }
__device__ __forceinline__ float fsigmoid(float x) { return __builtin_amdgcn_rcpf(1.f + __expf(-x)); }
__device__ __forceinline__ float ftanh(float x) { return 1.f - 2.f * __builtin_amdgcn_rcpf(__expf(2.f * x) + 1.f); }
__device__ __forceinline__ float fsoftplus(float x) { return fmaxf(x, 0.f) + __logf(1.f + __expf(-fabsf(x))); }
template <int CTRL> __device__ __forceinline__ float dpp_mov(float x) { return __builtin_bit_cast(float, __builtin_amdgcn_mov_dpp(__builtin_bit_cast(int, x), CTRL, 0xf, 0xf, true)); }
__device__ __forceinline__ float row16_allsum(float x) { x += dpp_mov<0xB1>(x); x += dpp_mov<0x4E>(x); x += dpp_mov<0x124>(x); x += dpp_mov<0x128>(x); return x; }
__device__ __forceinline__ float row8_allsum(float x) { x += dpp_mov<0xB1>(x); x += dpp_mov<0x4E>(x); x += dpp_mov<0x141>(x); return x; }
__device__ __forceinline__ float rdlane(float x, int l) { return __builtin_bit_cast(float, __builtin_amdgcn_readlane(__builtin_bit_cast(int, x), l)); }
__device__ __forceinline__ float wave_allsum(float x) { x = row16_allsum(x); return (rdlane(x, 0) + rdlane(x, 16)) + (rdlane(x, 32) + rdlane(x, 48)); }
#define LDS_WAIT() asm volatile("s_waitcnt lgkmcnt(0)" ::: "memory")
__device__ __forceinline__ const float* xrow_ptr(const Args& A, int r) { return r < MP ? A.in[IN_XP] + (size_t)r * DM : A.in[IN_XS] + (size_t)(r - MP) * DM; }

#define XB_TMO      128
#define XB_XCNT(j)  (256  + 64 * (j))
#define XB_XSUB(j)  (1280 + 64 * (j))
#define XB_XGEN(j)  (2304 + 64 * (j))
#define XB_TOP      3328
#define XB_TOPGEN   3392
#define XCD_BAR_WORDS 3456
#define XB_SPIN_CAP (1u << 18)

__device__ __forceinline__ unsigned xb_ld(unsigned* p)              { return __hip_atomic_load(p, __ATOMIC_RELAXED, __HIP_MEMORY_SCOPE_AGENT); }
__device__ __forceinline__ unsigned xb_add(unsigned* p, unsigned v) { return __hip_atomic_fetch_add(p, v, __ATOMIC_RELAXED, __HIP_MEMORY_SCOPE_AGENT); }
__device__ __forceinline__ unsigned xb_xcc_id() { return (unsigned)__builtin_amdgcn_s_getreg((3 << 11) | 20) & 0xFu; }
#define XB_SPIN(cond, bar) do { unsigned _sp = 0; while (cond) { __builtin_amdgcn_s_sleep(1); \
    if ((++_sp & 255u) == 0u) { if (xb_ld(&(bar)[XB_TMO])) break; if (_sp > XB_SPIN_CAP) { atomicAdd(&(bar)[XB_TMO], 1u); break; } } } } while (0)

struct XcdBarrier {
    unsigned* bar; unsigned x;
    volatile LAS unsigned* st;
};

__device__ __forceinline__ XcdBarrier xcd_barrier_post(unsigned* bar, volatile LAS unsigned* st) {
    XcdBarrier b; b.bar = bar; b.x = xb_xcc_id(); b.st = st;
    if (threadIdx.x == 0) (void)xb_add(&bar[XB_XCNT(b.x)], 1u);
    return b;
}
__device__ __forceinline__ void xcd_barrier_complete(unsigned* bar, unsigned x, unsigned& nloc, unsigned& nx) {
    const unsigned G = gridDim.x * gridDim.y * gridDim.z;
    unsigned sum, cnt, mine, sp = 0u;
    for (;;) {
        sum = 0u; cnt = 0u; mine = 0u;
#pragma unroll
        for (unsigned j = 0; j < 16; ++j) { const unsigned c = xb_ld(&bar[XB_XCNT(j)]); sum += c; cnt += (c > 0u) ? 1u : 0u; mine = (j == x) ? c : mine; }
        if (sum == G) break;
        __builtin_amdgcn_s_sleep(1);
        if ((++sp & 255u) == 0u) { if (xb_ld(&bar[XB_TMO])) break; if (sp > XB_SPIN_CAP) { atomicAdd(&bar[XB_TMO], 1u); break; } }
    }
    nloc = mine > 0u ? mine : 1u; nx = cnt > 0u ? cnt : 1u;
}

__device__ __forceinline__ void xcd_barrier(const XcdBarrier& b) {
    asm volatile("s_waitcnt vmcnt(0)" ::: "memory");
    __syncthreads();
    if (threadIdx.x == 0) {
        unsigned* bar = b.bar;
        __builtin_amdgcn_s_waitcnt(0);
        unsigned nloc = b.st[0], nx = b.st[1];
        if (nloc == 0u) { xcd_barrier_complete(bar, b.x, nloc, nx); b.st[0] = nloc; b.st[1] = nx; }
        const unsigned old = xb_add(&bar[XB_XSUB(b.x)], 1u);
        const unsigned gen = old / nloc;
        if (old + 1u == (gen + 1u) * nloc) {
            __builtin_amdgcn_fence(__ATOMIC_RELEASE, "agent");
            asm volatile("s_waitcnt vmcnt(0)" ::: "memory");
            const unsigned og = xb_add(&bar[XB_TOP], 1u);
            const unsigned tg = og / nx;
            if (og + 1u == (tg + 1u) * nx) xb_add(&bar[XB_TOPGEN], 1u);
            else XB_SPIN(xb_ld(&bar[XB_TOPGEN]) == tg, bar);
            __builtin_amdgcn_fence(__ATOMIC_ACQUIRE, "agent");
            xb_add(&bar[XB_XGEN(b.x)], 1u);
            asm volatile("s_waitcnt vmcnt(0)" ::: "memory");
        } else {
            XB_SPIN(xb_ld(&bar[XB_XGEN(b.x)]) == gen, bar);
            __builtin_amdgcn_fence(__ATOMIC_ACQUIRE, "agent");
            asm volatile("s_waitcnt vmcnt(0)" ::: "memory");
        }
    }
    __syncthreads();
}


struct EpiProj {
    static constexpr bool PERM = true, AFTER_DRAIN = false;
    bf16_t *prw, *pgla, *pgate; float *shift_p, *shift_s;
    __device__ __forceinline__ void operator()(const f32x4 (&acc)[2][2][4][2], const Unit& u, int wr, int wc, int fr, int fq) const {
        asm volatile("" : "+v"(fr), "+v"(fq));
        bf16_t* base; int ld, colt;
        if (u.pn < 7) { base = prw; ld = NPRW; colt = u.pn * 256; } else if (u.pn < 14) { base = pgla; ld = NPGLA; colt = (u.pn - 7) * 256; } else { base = pgate; ld = NGATE; colt = (u.pn - 14) * 256; }
        const int row0 = u.pm * 256 + wr * 64 + fr, col0 = colt + wc * 32 + 8 * fq;
#pragma unroll
        for (int ai = 0; ai < 2; ++ai)
#pragma unroll
            for (int m = 0; m < 4; ++m) {
                const int r = row0 + ai * 128 + m * 16; bf16_t* rowp = base + (size_t)r * ld + col0;
#pragma unroll
                for (int bj = 0; bj < 2; ++bj) { const f32x4 v0 = acc[ai][bj][m][0], v1 = acc[ai][bj][m][1]; u32x4 w; w.x = pk2(v0[0], v0[1]); w.y = pk2(v0[2], v0[3]); w.z = pk2(v1[0], v1[1]); w.w = pk2(v1[2], v1[3]); *(u32x4*)(rowp + bj * 128) = w; }
            }
    }
};
template <bool FIRST> struct EpiGate {
    static constexpr bool PERM = true, AFTER_DRAIN = false;
    bf16_t* merged; const bf16_t* gate;
    __device__ __forceinline__ void operator()(const f32x4 (&acc)[2][2][4][2], const Unit& u, int wr, int wc, int fr, int fq) const {
        asm volatile("" : "+v"(fr), "+v"(fq));
        const int row0 = u.pm * 256 + wr * 64 + fr, col0 = u.pn * 256 + wc * 32 + 8 * fq;
#pragma unroll
        for (int ai = 0; ai < 2; ++ai) {
            u32x4 gr[4][2], pr[4][2];
#pragma unroll
            for (int m = 0; m < 4; ++m)
#pragma unroll
                for (int bj = 0; bj < 2; ++bj) { const size_t r = (size_t)(row0 + ai * 128 + m * 16); const int c = col0 + bj * 128; gr[m][bj] = *(const u32x4*)(gate + r * NGATE + c); if (!FIRST) pr[m][bj] = *(const u32x4*)(merged + r * DM + c); }
#pragma unroll
            for (int m = 0; m < 4; ++m)
#pragma unroll
                for (int bj = 0; bj < 2; ++bj) { const size_t r = (size_t)(row0 + ai * 128 + m * 16); const int c = col0 + bj * 128; float g[8], v[8]; unpack8(gr[m][bj], g);
                    const f32x4 v0 = acc[ai][bj][m][0], v1 = acc[ai][bj][m][1];
#pragma unroll
                    for (int i = 0; i < 4; ++i) { v[i] = v0[i] * fsigmoid(g[i]); v[4 + i] = v1[i] * fsigmoid(g[4 + i]); }
                    if (!FIRST) { float p[8]; unpack8(pr[m][bj], p);
#pragma unroll
                        for (int i = 0; i < 8; ++i) v[i] += p[i]; }
                    *(u32x4*)(merged + r * DM + c) = pack8(v); }
        }
    }
};
struct EpiX1 {
    static constexpr bool PERM = true, AFTER_DRAIN = false;
    const float *xp, *xs; float* x1; bf16_t* x1b; float* rowss;
    __device__ __forceinline__ void operator()(const f32x4 (&acc)[2][2][4][2], const Unit& u, int wr, int wc, int fr, int fq) const {
        asm volatile("" : "+v"(fr), "+v"(fq));
        const int row0 = u.pm * 256 + wr * 64 + fr, col0 = u.pn * 256 + wc * 32 + 8 * fq;
#pragma unroll
        for (int ai = 0; ai < 2; ++ai) {
            f32x4 xa[4][2][2];
#pragma unroll
            for (int m = 0; m < 4; ++m) { const int r = row0 + ai * 128 + m * 16; const float* xr = (r < MP ? xp + (size_t)r * DM : xs + (size_t)(r - MP) * DM);
#pragma unroll
                for (int bj = 0; bj < 2; ++bj) { xa[m][bj][0] = *(const f32x4*)(xr + col0 + bj * 128); xa[m][bj][1] = *(const f32x4*)(xr + col0 + bj * 128 + 4); } }
#pragma unroll
            for (int m = 0; m < 4; ++m) { const int r = row0 + ai * 128 + m * 16; float ssq = 0.f;
#pragma unroll
                for (int bj = 0; bj < 2; ++bj) { const int c = col0 + bj * 128; const f32x4 a = xa[m][bj][0] + acc[ai][bj][m][0], b = xa[m][bj][1] + acc[ai][bj][m][1];
                    ssq += (a[0] * a[0] + a[1] * a[1]) + (a[2] * a[2] + a[3] * a[3]) + (b[0] * b[0] + b[1] * b[1]) + (b[2] * b[2] + b[3] * b[3]);
                    float* o = x1 + (size_t)r * DM + c; *(f32x4*)o = a; *(f32x4*)(o + 4) = b;
                    u32x4 w; w.x = pk2(a[0], a[1]); w.y = pk2(a[2], a[3]); w.z = pk2(b[0], b[1]); w.w = pk2(b[2], b[3]); *(u32x4*)(x1b + (size_t)r * DM + c) = w; }
                ssq += __shfl_xor(ssq, 16); ssq += __shfl_xor(ssq, 32);
                if (fq == 0) atomicAdd(rowss + r, ssq); }
        }
    }
};
struct EpiX2 {
    static constexpr bool PERM = true, AFTER_DRAIN = false;
    float* x; float* xd;
    __device__ __forceinline__ void operator()(const f32x4 (&acc)[2][2][4][2], const Unit& u, int wr, int wc, int fr, int fq) const {
        asm volatile("" : "+v"(fr), "+v"(fq));
        const int row0 = u.pm * 256 + wr * 64 + fr, col0 = u.pn * 256 + wc * 32 + 8 * fq;
#pragma unroll
        for (int ai = 0; ai < 2; ++ai) {
            f32x4 xa[4][2][2];
#pragma unroll
            for (int m = 0; m < 4; ++m)
#pragma unroll
                for (int bj = 0; bj < 2; ++bj) { const float* o = x + (size_t)(row0 + ai * 128 + m * 16) * DM + col0 + bj * 128; xa[m][bj][0] = *(const f32x4*)o; xa[m][bj][1] = *(const f32x4*)(o + 4); }
#pragma unroll
            for (int m = 0; m < 4; ++m)
#pragma unroll
                for (int bj = 0; bj < 2; ++bj) { float* o = xd + (size_t)(row0 + ai * 128 + m * 16) * DM + col0 + bj * 128; *(f32x4*)o = xa[m][bj][0] + acc[ai][bj][m][0]; *(f32x4*)(o + 4) = xa[m][bj][1] + acc[ai][bj][m][1]; }
        }
    }
};
__device__ __forceinline__ float gelu_gate(float g, float v) { const float t = g * (1.f + 0.044715f * g * g) * 1.5957691216057308f; return g * fsigmoid(t) * v; }
struct EpiU {
    static constexpr bool PERM = true, AFTER_DRAIN = false;
    const float* rowss; bf16_t *U, *uh; float *conv_p, *conv_s;
    __device__ __forceinline__ void operator()(const f32x4 (&acc)[2][2][4][2], const Unit& u, int wr, int wc, int fr, int fq) const {
        asm volatile("" : "+v"(fr), "+v"(fq));
        const int row0 = u.pm * 256 + wr * 64 + fr, col0 = u.pn * 256 + wc * 32 + 8 * fq;
#pragma unroll
        for (int ai = 0; ai < 2; ++ai)
#pragma unroll
            for (int m = 0; m < 4; ++m) { const int r = row0 + ai * 128 + m * 16; const float rs = rsqrtf(rowss[r] * (1.f / DM) + NORM_EPS);
#pragma unroll
                for (int bj = 0; bj < 2; ++bj) { const int c = col0 + bj * 128; const f32x4 v0 = acc[ai][bj][m][0] * rs, v1 = acc[ai][bj][m][1] * rs;
                    u32x4 w; w.x = pk2(v0[0], v0[1]); w.y = pk2(v0[2], v0[3]); w.z = pk2(v1[0], v1[1]); w.w = pk2(v1[2], v1[3]);
                    *(u32x4*)(U + (size_t)r * F2 + c) = w;
                    if (m == 3 && fr >= 14 && r < MP) { *(u32x4*)(uh + ((size_t)(r >> 6) * 2 + (fr - 14)) * F2 + c) = w;
                        if ((r & 2047) >= 2046) { float* cp = conv_p + ((size_t)(r >> 11) * 2 + (fr - 14)) * F2 + c; *(f32x4*)cp = v0; *(f32x4*)(cp + 4) = v1; } }
                    if (r >= MP && (fr & 7) >= 6) { float* cp = conv_s + ((size_t)((r - MP) >> 3) * 2 + ((fr & 7) - 6)) * F2 + c; *(f32x4*)cp = v0; *(f32x4*)(cp + 4) = v1; } } }
    }
};

struct EpiAct {
    static constexpr bool PERM = true, AFTER_DRAIN = false;
    const float *rowss, *convw, *convb; bf16_t *act, *uh, *us; float *conv_p, *conv_s; LAS float* ringbase;
    __device__ __forceinline__ void operator()(const f32x4 (&acc)[2][2][4][2], const Unit& u, int wr_, int wc_, int fr_, int fq_) const {
        int wr = wr_, wc = wc_, fr = fr_, fq = fq_;
        asm volatile("" : "+v"(fr), "+v"(fq)); asm volatile("" : "+s"(wr), "+s"(wc));
        const bool sample = u.pm >= 64;
        const int jc0 = u.pn * 128 + wc * 32 + 8 * fq;
        LAS float* ring = ringbase + (wr * 4 + wc) * 512;
#pragma unroll
        for (int ai = 0; ai < 2; ++ai) {
            const int rbase = u.pm * 256 + ai * 128 + wr * 64, grp = rbase >> 6;
#pragma unroll
            for (int m = 0; m < 4; ++m) {
                const int row = rbase + 16 * m + fr;
                const bool wuh = !sample && ((m == 0 && fr < 2) || (m == 3 && fr >= 14)), wus = sample && (fr & 7) < 2, wcs = sample && (fr & 7) >= 6;
                if (wuh || wus || wcs) {
                    const float rsm = rsqrtf(rowss[row] * (1.f / DM) + NORM_EPS);
#pragma unroll
                    for (int bj = 0; bj < 2; ++bj) { const f32x4 v0 = acc[ai][bj][m][0] * rsm, v1 = acc[ai][bj][m][1] * rsm;
                        if (wcs) { float* cp = conv_s + ((size_t)((row - MP) >> 3) * 2 + ((fr & 7) - 6)) * F2 + bj * FF + jc0; *(f32x4*)cp = v0; *(f32x4*)(cp + 4) = v1; }
                        else { u32x4 w; w.x = pk2(v0[0], v0[1]); w.y = pk2(v0[2], v0[3]); w.z = pk2(v1[0], v1[1]); w.w = pk2(v1[2], v1[3]);
                            bf16_t* dst = wuh ? uh + ((size_t)grp * 4 + (m == 0 ? fr : fr - 12)) * F2 : us + ((size_t)((row - MP) >> 3) * 2 + (fr & 7)) * F2;
                            *(u32x4*)(dst + bj * FF + jc0) = w;
                            if (wuh && m == 3 && (grp & 31) == 31) { float* cp = conv_p + ((size_t)(rbase >> 11) * 2 + (fr - 14)) * F2 + bj * FF + jc0; *(f32x4*)cp = v0; *(f32x4*)(cp + 4) = v1; } } }
                }
            }
        }
        asm volatile("" ::: "memory");
        float rsq[2][4];
#pragma unroll
        for (int ai = 0; ai < 2; ++ai)
#pragma unroll
            for (int m = 0; m < 4; ++m) rsq[ai][m] = rsqrtf(rowss[u.pm * 256 + ai * 128 + wr * 64 + 16 * m + fr] * (1.f / DM) + NORM_EPS);
#define EPIACT_STEP(AI, N) do { const int rbase = u.pm * 256 + (AI) * 128 + wr * 64; \
            _Pragma("unroll") for (int m = 0; m < 4; ++m) { const float rsm = rsq[AI][m]; \
                const f32x4 xv = acc[AI][0][m][N] * rsm, xg = acc[AI][1][m][N] * rsm; const int idx = (m & 1) * 16 + fr; \
                asm volatile("" ::: "memory"); *(LAS f32x4*)(ring + idx * 16 + fq * 4) = xv; *(LAS f32x4*)(ring + 4096 + idx * 16 + fq * 4) = xg; asm volatile("" ::: "memory");     \
                const f32x4 p1v = *(const LAS f32x4*)(ring + ((idx + 31) & 31) * 16 + fq * 4), p2v = *(const LAS f32x4*)(ring + ((idx + 30) & 31) * 16 + fq * 4); \
                const f32x4 p1g = *(const LAS f32x4*)(ring + 4096 + ((idx + 31) & 31) * 16 + fq * 4), p2g = *(const LAS f32x4*)(ring + 4096 + ((idx + 30) & 31) * 16 + fq * 4); \
                const f32x4 cv = cbv + w0v * p2v + w1v * p1v + w2v * xv, cg = cbg + w0g * p2g + w1g * p1g + w2g * xg; \
                const bool fix = sample ? ((fr & 7) < 2) : (m == 0 && fr < 2); \
                if (!fix) { u32x2 w; w.x = pk2(gelu_gate(cg[0], cv[0]), gelu_gate(cg[1], cv[1])); w.y = pk2(gelu_gate(cg[2], cv[2]), gelu_gate(cg[3], cv[3])); \
                    *(u32x2*)(act + (size_t)(rbase + 16 * m + fr) * FF + jc0 + 4 * (N)) = w; } } } while (0)
#define EPIACT_N(N) do { const int col4 = jc0 + 4 * (N); \
            const f32x4 w0v = *(const f32x4*)(convw + col4), w1v = *(const f32x4*)(convw + F2 + col4), w2v = *(const f32x4*)(convw + 2 * F2 + col4), cbv = *(const f32x4*)(convb + col4); \
            const f32x4 w0g = *(const f32x4*)(convw + FF + col4), w1g = *(const f32x4*)(convw + F2 + FF + col4), w2g = *(const f32x4*)(convw + 2 * F2 + FF + col4), cbg = *(const f32x4*)(convb + FF + col4); \
            EPIACT_STEP(0, N); EPIACT_STEP(1, N); asm volatile("" ::: "memory"); } while (0)
        EPIACT_N(0); EPIACT_N(1);
#undef EPIACT_N
#undef EPIACT_STEP
    }
};

template <class EF> __device__ __forceinline__ void tail_gemm(LAS unsigned char* lds, const bf16_t* Amat, int lda, const bf16_t* Bt, int K, const pg8::StaticOrder& S, int wave, int lane, const EF& ef) {
    const int l15 = lane & 15, q = lane >> 4, ntail = S.nwg - S.limit, nk = K / 256;
    LAS float* red = (LAS float*)lds;
    for (int item = blockIdx.x; item < ntail * 16; item += gridDim.x) {
        pg8::Unit u; S.unit_of(S.limit + (item >> 4), u);
        const int r0 = u.pm * 256 + (item & 15) * 16, c0 = u.pn * 256;
        const bf16_t* ap = Amat + (size_t)(r0 + l15) * lda + 8 * q + 32 * nk * wave; const bf16_t* bp = Bt + (size_t)(c0 + l15) * K + 8 * q + 32 * nk * wave;
        f32x4 acc[16];
#pragma unroll
        for (int n = 0; n < 16; ++n) acc[n] = (f32x4){0.f, 0.f, 0.f, 0.f};
#pragma unroll 2
        for (int ks = 0; ks < nk; ++ks) {
            const bf16x8 a = *(const bf16x8*)(ap + 32 * ks); bf16x8 b[16];
#pragma unroll
            for (int n = 0; n < 16; ++n) b[n] = *(const bf16x8*)(bp + (size_t)(16 * n) * K + 32 * ks);
#pragma unroll
            for (int n = 0; n < 16; ++n) acc[n] = __builtin_amdgcn_mfma_f32_16x16x32_bf16(a, b[n], acc[n], 0, 0, 0);
        }
        __syncthreads();
#pragma unroll
        for (int n = 0; n < 16; ++n) *(LAS f32x4*)(red + ((wave * 16 + n) * 64 + lane) * 4) = acc[n];
        __syncthreads();
        f32x4 s0 = {0.f, 0.f, 0.f, 0.f}, s1 = s0;
#pragma unroll
        for (int w2 = 0; w2 < 8; ++w2) { s0 += *(const LAS f32x4*)(red + ((w2 * 16 + 2 * wave) * 64 + lane) * 4); s1 += *(const LAS f32x4*)(red + ((w2 * 16 + 2 * wave + 1) * 64 + lane) * 4); }
        ef(r0 + 4 * q, c0 + 32 * wave + l15, s0, s1);
    }
    __syncthreads();
}
struct TfGate { bool first; bf16_t* merged; const bf16_t* gate;
    __device__ __forceinline__ void operator()(int row, int col, f32x4 a0, f32x4 a1) const {
#pragma unroll
        for (int i = 0; i < 4; ++i)
#pragma unroll
            for (int n = 0; n < 2; ++n) { const size_t r = (size_t)(row + i); const int c = col + 16 * n; float v = (n ? a1[i] : a0[i]) * fsigmoid(bf2f(gate[r * NGATE + c]));
                if (!first) v += bf2f(merged[r * DM + c]); merged[r * DM + c] = (bf16_t)f2bf(v); } } };
struct TfX1 { const float *xp, *xs; float* x1; bf16_t* x1b; float* rowss;
    __device__ __forceinline__ void operator()(int row, int col, f32x4 a0, f32x4 a1) const {
#pragma unroll
        for (int i = 0; i < 4; ++i) { const int r = row + i; const float* xr = (r < MP ? xp + (size_t)r * DM : xs + (size_t)(r - MP) * DM);
            const float v0 = xr[col] + a0[i], v1 = xr[col + 16] + a1[i];
            x1[(size_t)r * DM + col] = v0; x1[(size_t)r * DM + col + 16] = v1; x1b[(size_t)r * DM + col] = (bf16_t)f2bf(v0); x1b[(size_t)r * DM + col + 16] = (bf16_t)f2bf(v1);
            const float ss = row16_allsum(v0 * v0 + v1 * v1); if ((col & 15) == 0) atomicAdd(rowss + r, ss); } } };
struct TfX2 { float* x; float* xd;
    __device__ __forceinline__ void operator()(int row, int col, f32x4 a0, f32x4 a1) const {
#pragma unroll
        for (int i = 0; i < 4; ++i) { const size_t off = (size_t)(row + i) * DM + col; xd[off] = x[off] + a0[i]; xd[off + 16] = x[off + 16] + a1[i]; } } };

template <int MODE> __device__ __forceinline__ int map_col(int R) {
    if (MODE == 1) { if (R < 1792) return R; if (R < 3584) return (R - 1792 < 1552) ? R : -1; return R - 240; }
    if (MODE == 2) { return ((R >> 7) & 1) * FF + ((R >> 8) << 7) + (R & 127); }
    return R;
}
template <int MODE> __device__ __forceinline__ void tr_item(const float* __restrict__ W, int K, int Nsrc, int Ndst, bf16_t* WT, const float* kscale, LAS float* scr, int item, int lane) {
    const int nblk = Ndst >> 5, kb = item / nblk, nb = item - kb * nblk, k0 = kb << 6, n0 = nb << 5;
    const int col = map_col<MODE>(n0 + (lane & 31));
    float tv[32];
#pragma unroll
    for (int i = 0; i < 32; ++i) { const int kk = 2 * i + (lane >> 5); tv[i] = (col >= 0) ? W[(size_t)(k0 + kk) * Nsrc + col] : 0.f; }
#pragma unroll
    for (int i = 0; i < 32; ++i) { const int kk = 2 * i + (lane >> 5); float v = tv[i]; if (kscale) v *= kscale[k0 + kk]; scr[kk * 33 + (lane & 31)] = v; }
    LDS_WAIT();
    const int c = lane & 7;
#pragma unroll
    for (int j = 0; j < 4; ++j) { const int n = (lane >> 3) + 8 * j; const LAS float* s = scr + (8 * c) * 33 + n;
        u32x4 o; o.x = pk2(s[0 * 33], s[1 * 33]); o.y = pk2(s[2 * 33], s[3 * 33]); o.z = pk2(s[4 * 33], s[5 * 33]); o.w = pk2(s[6 * 33], s[7 * 33]);
        *(u32x4*)(WT + (size_t)(n0 + n) * K + k0 + 8 * c) = o; }
    LDS_WAIT();
}
__device__ __forceinline__ void p0_prologue(const Args& A, LAS unsigned char* lds, int gw, int NGW, int wave, int lane) {
    LAS float* scr = (LAS float*)(lds + wave * 16384);
    unsigned char* ws = A.ws;
    constexpr int I_IN = 16 * (NIN / 32), I_UP = 16 * (F2 / 32), I_DN = 44 * 32, I_O = 16 * 32, I_OA = 8 * 32, I_W2 = 16, I_G2 = 2 * 16;
    constexpr int NITEMS = I_IN + I_UP + I_DN + I_O + 2 * I_OA + 2 * I_W2 + I_G2;
    for (int it = gw; it < NITEMS; it += NGW) {
        int r = it;
        if (r < I_IN) { tr_item<1>(A.in[IN_W_IN], 1024, 5392, NIN, (bf16_t*)(ws + OFF_WIN), nullptr, scr, r, lane); continue; } r -= I_IN;
        if (r < I_UP) { tr_item<2>(A.in[IN_WUP], 1024, F2, F2, (bf16_t*)(ws + OFF_WUP), A.in[IN_NORM_FFN], scr, r, lane); continue; } r -= I_UP;
        if (r < I_DN) { tr_item<0>(A.in[IN_WDN], FF, 1024, 1024, (bf16_t*)(ws + OFF_WDN), nullptr, scr, r, lane); continue; } r -= I_DN;
        if (r < I_O) { tr_item<0>(A.in[IN_WO], 1024, 1024, 1024, (bf16_t*)(ws + OFF_WO), nullptr, scr, r, lane); continue; } r -= I_O;
        if (r < I_OA) { tr_item<0>(A.in[IN_WOA], 512, 1024, 1024, (bf16_t*)(ws + OFF_WOA), nullptr, scr, r, lane); continue; } r -= I_OA;
        if (r < I_OA) { tr_item<0>(A.in[IN_WOB], 512, 1024, 1024, (bf16_t*)(ws + OFF_WOB), nullptr, scr, r, lane); continue; } r -= I_OA;
        if (r < I_W2) { tr_item<0>(A.in[IN_W2], 64, 512, 512, (bf16_t*)(ws + OFF_W2T), nullptr, scr, r, lane); continue; } r -= I_W2;
        if (r < I_W2) { tr_item<0>(A.in[IN_A2], 64, 512, 512, (bf16_t*)(ws + OFF_A2T), nullptr, scr, r, lane); continue; } r -= I_W2;
        tr_item<0>(A.in[IN_G2], 128, 512, 512, (bf16_t*)(ws + OFF_G2T), nullptr, scr, r, lane);
    }
    bf16_t* H = (bf16_t*)((unsigned char*)A.out + OUTB_H);
    const float* gm = A.in[IN_NORM_MIX];
    for (int m = gw; m < M; m += 2 * NGW) {
        const int m2 = m + NGW; const bool has2 = m2 < M;
        const f32x4* xr = (const f32x4*)xrow_ptr(A, m) + lane; const f32x4* xr2 = (const f32x4*)xrow_ptr(A, has2 ? m2 : m) + lane; f32x4 v[4], w[4]; float s = 0.f, s2 = 0.f;
#pragma unroll
        for (int j = 0; j < 4; ++j) { v[j] = xr[64 * j]; w[j] = xr2[64 * j]; }
#pragma unroll
        for (int j = 0; j < 4; ++j) { s += (v[j].x * v[j].x + v[j].y * v[j].y) + (v[j].z * v[j].z + v[j].w * v[j].w); s2 += (w[j].x * w[j].x + w[j].y * w[j].y) + (w[j].z * w[j].z + w[j].w * w[j].w); }
        const float rstd = rsqrtf(wave_allsum(s) * (1.f / DM) + NORM_EPS), rstd2 = rsqrtf(wave_allsum(s2) * (1.f / DM) + NORM_EPS);
        u32x2* o8 = (u32x2*)(H + (size_t)m * DM) + lane; u32x2* o82 = (u32x2*)(H + (size_t)m2 * DM) + lane;
#pragma unroll
        for (int j = 0; j < 4; ++j) { const f32x4 g = *((const f32x4*)gm + lane + 64 * j); u32x2 p; p.x = pk2(v[j].x * rstd * g.x, v[j].y * rstd * g.y); p.y = pk2(v[j].z * rstd * g.z, v[j].w * rstd * g.w); o8[64 * j] = p;
            if (has2) { u32x2 p2; p2.x = pk2(w[j].x * rstd2 * g.x, w[j].y * rstd2 * g.y); p2.y = pk2(w[j].z * rstd2 * g.z, w[j].w * rstd2 * g.w); o82[64 * j] = p2; } }
    }
    float* rowss = (float*)(ws + OFF_ROWSS);
    for (int i = gw * 64 + lane; i < M; i += NGW * 64) rowss[i] = 0.f;
}

__device__ __forceinline__ void prw_mixed8(const Args& A, const bf16_t* PRW, int r, int col0, float (&xs)[8]) {
    float cur[8], prev[8];
    ld8bf(PRW + (size_t)r * NPRW + col0, cur);
    const bool first = (r < MP) ? ((r & 2047) == 0) : (((r - MP) & 7) == 0);
    if (!first) ld8bf(PRW + (size_t)(r - 1) * NPRW + col0, prev);
    else if (r < MP) {
#pragma unroll
        for (int i = 0; i < 8; ++i) prev[i] = 0.f;
    } else ld8f(A.in[IN_ST_SHIFT] + (size_t)((r - MP) >> 3) * 1792 + col0, prev);
    float mu[8]; ld8f(A.in[IN_MU] + col0, mu);
#pragma unroll
    for (int i = 0; i < 8; ++i) xs[i] = cur[i] + (prev[i] - cur[i]) * mu[i];
}
template <int ACT> __device__ __forceinline__ bf16x8 afrag(const Args& A, const bf16_t* PRW, int r, int col0) {
    float xs[8]; prw_mixed8(A, PRW, r, col0, xs);
#pragma unroll
    for (int i = 0; i < 8; ++i) xs[i] = ACT == 1 ? ftanh(xs[i]) : (ACT == 2 ? fsigmoid(xs[i]) : xs[i]);
    return __builtin_bit_cast(bf16x8, pack8(xs));
}
__device__ __forceinline__ void p2a_lora(const Args& A, LAS unsigned char* lds, int gw, int NGW, int wave, int lane) {
    const bf16_t* PRW = (const bf16_t*)(A.ws + OFF_PRW);
    const bf16_t *W2T = (const bf16_t*)(A.ws + OFF_W2T), *A2T = (const bf16_t*)(A.ws + OFF_A2T), *G2T = (const bf16_t*)(A.ws + OFF_G2T);
    bf16_t *EW = (bf16_t*)((unsigned char*)A.out + OUTB_EW), *AARR = (bf16_t*)((unsigned char*)A.out + OUTB_AARR), *G = (bf16_t*)(A.ws + OFF_G);
    for (int i = gw * 64 + lane; i < 136 * 224; i += NGW * 64) { const int sq = i / 224, c8 = (i - sq * 224) * 8; const int r = sq < 8 ? sq * 2048 + 2047 : MP + (sq - 8) * 8 + 7;
        float v[8]; ld8bf(PRW + (size_t)r * NPRW + c8, v); float* dst = (sq < 8 ? A.out + OUT_SHIFT_P + (size_t)sq * 1792 : A.out + OUT_SHIFT_S + (size_t)(sq - 8) * 1792) + c8;
        *(f32x4*)dst = (f32x4){v[0], v[1], v[2], v[3]}; *(f32x4*)(dst + 4) = (f32x4){v[4], v[5], v[6], v[7]}; }
    const int l15 = lane & 15, kq = lane >> 4;
    LAS bf16_t* acts = (LAS bf16_t*)lds; const int tid = wave * 64 + lane;
    for (int tile = blockIdx.x; tile < M / 16; tile += gridDim.x) {
        const int h = wave, t0 = tile * 16;
        { const int tt = tid >> 5, cg = tid & 31; float xs[8]; prw_mixed8(A, PRW, t0 + tt, 1536 + 8 * cg, xs);
#pragma unroll
          for (int i = 0; i < 8; ++i) xs[i] = cg < 8 ? ftanh(xs[i]) : (cg < 16 ? xs[i] : fsigmoid(xs[i]));
          __syncthreads();
          *(LAS u32x4*)(acts + tt * 264 + 8 * cg) = pack8(xs); }
        __syncthreads();
        bf16x8 aw[2], aa[2], ag[4];
#pragma unroll
        for (int ks = 0; ks < 2; ++ks) { aw[ks] = *(const LAS bf16x8*)(acts + l15 * 264 + ks * 32 + kq * 8); aa[ks] = *(const LAS bf16x8*)(acts + l15 * 264 + 64 + ks * 32 + kq * 8); }
#pragma unroll
        for (int ks = 0; ks < 4; ++ks) ag[ks] = *(const LAS bf16x8*)(acts + l15 * 264 + 128 + ks * 32 + kq * 8);
        f32x4 cwv[4], cav[4], cgg[4];
#pragma unroll
        for (int nt = 0; nt < 4; ++nt) {
            const int c = 64 * h + 16 * nt + l15;
            f32x4 cw = {0.f, 0.f, 0.f, 0.f}, ca = cw, cgv = cw;
#pragma unroll
            for (int ks = 0; ks < 2; ++ks) {
                const bf16x8 bw = *(const bf16x8*)(W2T + (size_t)c * 64 + ks * 32 + kq * 8), ba = *(const bf16x8*)(A2T + (size_t)c * 64 + ks * 32 + kq * 8);
                cw = __builtin_amdgcn_mfma_f32_16x16x32_bf16(bw, aw[ks], cw, 0, 0, 0); ca = __builtin_amdgcn_mfma_f32_16x16x32_bf16(ba, aa[ks], ca, 0, 0, 0); }
#pragma unroll
            for (int ks = 0; ks < 4; ++ks) { const bf16x8 bg = *(const bf16x8*)(G2T + (size_t)c * 128 + ks * 32 + kq * 8); cgv = __builtin_amdgcn_mfma_f32_16x16x32_bf16(bg, ag[ks], cgv, 0, 0, 0); }
            cwv[nt] = cw; cav[nt] = ca; cgg[nt] = cgv;
        }
#pragma unroll
        for (int nt = 0; nt < 4; ++nt) {
            const int c4 = 64 * h + 16 * nt + 4 * kq; const size_t o = (size_t)(t0 + l15) * 512 + c4;
            const f32x4 w0v = *(const f32x4*)(A.in[IN_W0] + c4), a0v = *(const f32x4*)(A.in[IN_A0] + c4);
            float ew[4], av[4];
#pragma unroll
            for (int i = 0; i < 4; ++i) { ew[i] = 0.6065306597f * fsigmoid(w0v[i] + cwv[nt][i]); av[i] = fsigmoid(a0v[i] + cav[nt][i]); }
            u32x2 w; w.x = pk2(ew[0], ew[1]); w.y = pk2(ew[2], ew[3]); *(u32x2*)(EW + o) = w;
            w.x = pk2(av[0], av[1]); w.y = pk2(av[2], av[3]); *(u32x2*)(AARR + o) = w;
            w.x = pk2(cgg[nt][0], cgg[nt][1]); w.y = pk2(cgg[nt][2], cgg[nt][3]); *(u32x2*)(G + o) = w;
        }
    }
}

typedef short bf16x4 __attribute__((ext_vector_type(4)));
#define MFMA32(a, b, c) __builtin_amdgcn_mfma_f32_16x16x32_bf16(a, b, c, 0, 0, 0)
#define MFMA16(a, b, c) __builtin_amdgcn_mfma_f32_16x16x16bf16_1k(a, b, c, 0, 0, 0)
constexpr int SP = 72;
constexpr size_t OFF_RLT = 240 * MiB;
constexpr size_t OFF_GL = 1 * MiB, OFF_GG = 8 * MiB;
static_assert(OFF_RLT + (size_t)448 * 32768 <= 256 * MiB && OFF_GL + (size_t)224 * 32768 <= OFF_GG && OFF_GG + 224 * 256 <= OFF_WUP, "ws map (scan)");
__device__ __forceinline__ bf16x4 bf4(f32x4 v) { u32x2 w; w.x = pk2(v[0], v[1]); w.y = pk2(v[2], v[3]); return __builtin_bit_cast(bf16x4, w); }
__device__ __forceinline__ bf16x8 afr(const LAS bf16_t* X, int l15, int q, int ks) { const LAS bf16_t* p = X + l15 * SP + 32 * ks + 4 * q; const u32x2 lo = *(const LAS u32x2*)p, hi = *(const LAS u32x2*)(p + 16); u32x4 w; w.x = lo.x; w.y = lo.y; w.z = hi.x; w.w = hi.y; return __builtin_bit_cast(bf16x8, w); }
__device__ __forceinline__ bf16x8 hfrag(const f32x4& lo, const f32x4& hi) { u32x4 w; w.x = pk2(lo[0], lo[1]); w.y = pk2(lo[2], lo[3]); w.z = pk2(hi[0], hi[1]); w.w = pk2(hi[2], hi[3]); return __builtin_bit_cast(bf16x8, w); }
__device__ __forceinline__ f32x4 maskc(f32x4 v, int q, int l15, bool rows_lt_col, bool incl) {
#pragma unroll
    for (int i = 0; i < 4; ++i) { const int R = 4 * q + i; const bool keep = rows_lt_col ? (incl ? R <= l15 : R < l15) : (incl ? l15 <= R : l15 < R); v[i] = keep ? v[i] : 0.f; }
    return v;
}
template <bool GLA, int VP> __device__ __forceinline__ void scan_matrix_part(const LAS bf16_t* AT, const LAS bf16_t* RT, const LAS bf16_t* BT, const LAS bf16_t* KT, const LAS bf16_t* VS, const LAS float* GC, bf16_t* OUTP, int l15, int q, int sl, bool use_v, bool write_o, int rowb, int nv, f32x4 (&H)[4]) {
    const bf16x8 hb0 = hfrag(H[0], H[1]), hb1 = hfrag(H[2], H[3]);
    const bf16x8 rt0 = afr(RT, l15, q, 0), rt1 = afr(RT, l15, q, 1), kt0 = afr(KT, l15, q, 0), kt1 = afr(KT, l15, q, 1);
    const f32x4 z4 = {0.f, 0.f, 0.f, 0.f};
    bf16x4 vb = {0, 0, 0, 0};
    if (use_v) { const LAS bf16_t* vp = VS + (4 * q) * VP + 16 * sl + l15; u32x2 w; w.x = (unsigned)vp[0] | ((unsigned)vp[VP] << 16); w.y = (unsigned)vp[2 * VP] | ((unsigned)vp[3 * VP] << 16); vb = __builtin_bit_cast(bf16x4, w); }
    f32x4 O = MFMA32(rt0, hb0, z4); O = MFMA32(rt1, hb1, O);
    f32x4 U = z4;
    if (!GLA) {
        const bf16x8 at0 = afr(AT, l15, q, 0), at1 = afr(AT, l15, q, 1), bt0 = afr(BT, l15, q, 0), bt1 = afr(BT, l15, q, 1);
        f32x4 P = MFMA32(at0, bt0, z4); P = MFMA32(at1, bt1, P); P = maskc(P, q, l15, false, false);
        f32x4 PT = MFMA32(bt0, at0, z4); PT = MFMA32(bt1, at1, PT); PT = maskc(PT, q, l15, true, false);
        f32x4 nrbT = MFMA32(bt0, rt0, z4); nrbT = MFMA32(bt1, rt1, nrbT); nrbT = maskc(nrbT, q, l15, true, true);
        U = MFMA32(at0, hb0, z4); U = MFMA32(at1, hb1, U);
        if (use_v) { f32x4 makT = MFMA32(kt0, at0, z4); makT = MFMA32(kt1, at1, makT); makT = maskc(makT, q, l15, true, false); U = MFMA16(bf4(makT), vb, U); }
#pragma unroll
        for (int it = 0; it < 4; ++it) {
            U = MFMA16(bf4(PT), bf4(U), U);
            if (it < 3) { const f32x4 Pn = MFMA16(bf4(PT), bf4(P), z4), PTn = MFMA16(bf4(P), bf4(PT), z4); P = Pn; PT = PTn; }
        }
        O = MFMA16(bf4(nrbT), bf4(U), O);
    }
    if (use_v) { f32x4 nrkT = MFMA32(kt0, rt0, z4); nrkT = MFMA32(kt1, rt1, nrkT); nrkT = maskc(nrkT, q, l15, true, true); O = MFMA16(bf4(nrkT), vb, O); }
    if (write_o) {
#pragma unroll
        for (int i = 0; i < 4; ++i) if (4 * q + i < nv) OUTP[(size_t)(rowb + 4 * q + i) * 512] = (bf16_t)f2bf(O[i]);
    }
    const bf16x4 ub = bf4(U);
#pragma unroll
    for (int kt = 0; kt < 4; ++kt) {
        const f32x4 g4 = *(const LAS f32x4*)(GC + 16 * kt + 4 * q); const float gk = GC[16 * kt + l15];
        f32x4 acc = H[kt] * g4;
        if (!GLA) { const LAS bf16_t* p = BT + (4 * q) * SP + 16 * kt + l15; u32x2 w; w.x = pk2(bf2f(p[0]) * gk, bf2f(p[SP]) * gk); w.y = pk2(bf2f(p[2 * SP]) * gk, bf2f(p[3 * SP]) * gk); acc = MFMA16(__builtin_bit_cast(bf16x4, w), ub, acc); }
        if (use_v) { const LAS bf16_t* p = KT + (4 * q) * SP + 16 * kt + l15; u32x2 w; w.x = pk2(bf2f(p[0]) * gk, bf2f(p[SP]) * gk); w.y = pk2(bf2f(p[2 * SP]) * gk, bf2f(p[3 * SP]) * gk); acc = MFMA16(__builtin_bit_cast(bf16x4, w), vb, acc); }
        H[kt] = acc;
    }
}
constexpr int GL_RT = 2304, GL_BT = 4608, GL_KT = 6912, GL_VS = 9216, GL_GC = 13568, GL_EG = 13824, GL_BYTES = 26624;
template <bool GLA, int W> __device__ __forceinline__ void scan_block(const Args& A, LAS unsigned char* gl, int lane, int wg, int row0, int nsub, int nvalid, int first_kind, int bsamp, int hh, int sl, bool use_v, bool write_o, f32x4 (&H)[4], float& cumtot) {
    constexpr int TPW = 16 / W, VP = GLA ? 136 : 72;
    const int c = lane, l15 = lane & 15, q = lane >> 4, t0 = wg * TPW;
    const bf16_t* PRW = (const bf16_t*)(A.ws + OFF_PRW); const bf16_t* PGLA = (const bf16_t*)(A.ws + OFF_PGLA);
    const bf16_t *EW = (const bf16_t*)((unsigned char*)A.out + OUTB_EW), *AARR = (const bf16_t*)((unsigned char*)A.out + OUTB_AARR);
    bf16_t* OUTP = GLA ? (bf16_t*)((unsigned char*)A.out + OUTB_OGL) + 128 * hh + 16 * sl + l15 : (bf16_t*)((unsigned char*)A.out + OUTB_ORW) + 64 * hh + 16 * sl + l15;
    LAS bf16_t *AT = (LAS bf16_t*)gl, *RT = (LAS bf16_t*)(gl + GL_RT), *BT = (LAS bf16_t*)(gl + GL_BT), *KT = (LAS bf16_t*)(gl + GL_KT), *VS = (LAS bf16_t*)(gl + GL_VS);
    LAS float *GC = (LAS float*)(gl + GL_GC), *EG = (LAS float*)(gl + GL_EG);
    float mu_r = 0.f, mu_k = 0.f, mu_v = 0.f, kkc = 0.f, kac = 0.f, bgc = 0.f; float wgt[16];
#pragma unroll
    for (int j = 0; j < 16; ++j) wgt[j] = 0.f;
    if (!GLA) { const float* mu = A.in[IN_MU]; mu_r = mu[64 * hh + c]; mu_k = mu[512 + 64 * hh + c]; mu_v = mu[1024 + 64 * hh + c]; kkc = A.in[IN_KK][64 * hh + c]; kac = A.in[IN_KA][64 * hh + c]; }
    else { bgc = A.in[IN_BG][64 * hh + c];
#pragma unroll
        for (int j = 0; j < 16; ++j) wgt[j] = A.in[IN_WG2][j * 256 + 64 * hh + c]; }
    float pr[2] = {0.f, 0.f}, pk[2] = {0.f, 0.f}, pvv[2] = {0.f, 0.f}; bf16_t r0[2][TPW], r1[2][TPW], r2[2][TPW], r3[2][TPW], r4[2][TPW]; unsigned rvv[2][TPW]; u32x4 lg0[2][TPW], lg1[2][TPW];
#pragma unroll
    for (int p = 0; p < 2; ++p)
#pragma unroll
        for (int i = 0; i < TPW; ++i) { r0[p][i] = r1[p][i] = r2[p][i] = r3[p][i] = r4[p][i] = 0; rvv[p][i] = 0u; lg0[p][i] = (u32x4){0u, 0u, 0u, 0u}; lg1[p][i] = lg0[p][i]; }
#define SB_LOAD(SC, P) do { const int nv_ = ((SC) == nsub - 1) ? nvalid : 16; \
        if (!GLA) { if ((SC) == 0 && t0 == 0) { pr[P] = pk[P] = pvv[P] = 0.f; if (first_kind == 0) { const bf16_t* p = PRW + (size_t)(row0 - 1) * NPRW + 64 * hh + c; pr[P] = bf2f(p[0]); pk[P] = bf2f(p[512]); pvv[P] = bf2f(p[1024]); } \
                        else if (first_kind == 2) { const float* st = A.in[IN_ST_SHIFT] + (size_t)bsamp * 1792 + 64 * hh + c; pr[P] = st[0]; pk[P] = st[512]; pvv[P] = st[1024]; } } \
                    else if (t0 < nv_) { const bf16_t* p = PRW + (size_t)(row0 + 16 * (SC) + t0 - 1) * NPRW + 64 * hh + c; pr[P] = bf2f(p[0]); pk[P] = bf2f(p[512]); pvv[P] = bf2f(p[1024]); } } \
        _Pragma("unroll") for (int i = 0; i < TPW; ++i) if (t0 + i < nv_) { const size_t ro = (size_t)(row0 + 16 * (SC) + t0 + i); \
            if (!GLA) { const bf16_t* p = PRW + ro * NPRW + 64 * hh + c; r0[P][i] = p[0]; r1[P][i] = p[512]; r2[P][i] = p[1024]; r3[P][i] = EW[ro * 512 + 64 * hh + c]; r4[P][i] = AARR[ro * 512 + 64 * hh + c]; } \
            else { const bf16_t* p = PGLA + ro * NPGLA; r0[P][i] = p[64 * hh + c]; r1[P][i] = p[256 + 64 * hh + c]; rvv[P][i] = *(const unsigned*)(p + 512 + 128 * hh + 2 * lane); lg0[P][i] = *(const u32x4*)(p + 1024); lg1[P][i] = *(const u32x4*)(p + 1032); } } } while (0)
#define SB_EG(SC, P) do { const int nv_ = ((SC) == nsub - 1) ? nvalid : 16; LAS float* eg_ = EG + (P) * 1024; float tot_ = 0.f; \
        _Pragma("unroll") for (int i = 0; i < TPW; ++i) { float ev = 0.f; if (t0 + i < nv_) { if (!GLA) ev = bf2f(r3[P][i]); else { float lga[16], t8[8]; unpack8(lg0[P][i], t8); _Pragma("unroll") for (int j = 0; j < 8; ++j) lga[j] = t8[j]; \
                unpack8(lg1[P][i], t8); _Pragma("unroll") for (int j = 0; j < 8; ++j) lga[8 + j] = t8[j]; float z = bgc; _Pragma("unroll") for (int j = 0; j < 16; ++j) z += lga[j] * wgt[j]; ev = fsoftplus(-z) * 0.0625f; } } \
            eg_[(t0 + i) * 64 + c] = ev; tot_ += ev; } \
        WT[((P) * 8 + wg) * 64 + c] = tot_; } while (0)
#define SB_ITER(SC, P) do { const int sc = (SC); const int nv = (sc == nsub - 1) ? nvalid : 16; \
        __syncthreads();                                                         \
        { const LAS float* eg = EG + (P) * 1024; float cum = 0.f; \
          _Pragma("unroll") for (int w2 = 0; w2 < W - 1; ++w2) { const float tw = WT[((P) * 8 + w2) * 64 + c]; cum += (w2 < wg) ? tw : 0.f; } \
          _Pragma("unroll") for (int i = 0; i < TPW; ++i) { const int t = t0 + i; \
            if (t < nv) { \
                const float gp = __expf(-cum); cum += eg[t * 64 + c]; const float g = __expf(-cum), e = __expf(cum); \
                if (!GLA) { \
                    const float cr = bf2f(r0[P][i]), ck = bf2f(r1[P][i]), cv = bf2f(r2[P][i]), a = bf2f(r4[P][i]); \
                    const float xr = cr + (pr[P] - cr) * mu_r, xk = ck + (pk[P] - ck) * mu_k, xv = cv + (pvv[P] - cv) * mu_v; pr[P] = cr; pk[P] = ck; pvv[P] = cv; \
                    const float kkv = xk * kkc, ss = wave_allsum(kkv * kkv), kk = kkv * __builtin_amdgcn_rcpf(fmaxf(sqrtf(ss), 1e-12f)); \
                    const unsigned w01 = pk2(-kk * gp, xr * g), w23 = pk2(kk * a * e, xk * (1.f + (a - 1.f) * kac) * e); \
                    AT[t * SP + c] = (bf16_t)(w01 & 0xffffu); RT[t * SP + c] = (bf16_t)(w01 >> 16); BT[t * SP + c] = (bf16_t)(w23 & 0xffffu); KT[t * SP + c] = (bf16_t)(w23 >> 16); \
                    VS[t * VP + c] = (bf16_t)f2bf(xv); \
                } else { \
                    const unsigned w01 = pk2(bf2f(r0[P][i]) * 0.125f * g, bf2f(r1[P][i]) * e); \
                    RT[t * SP + c] = (bf16_t)(w01 & 0xffffu); KT[t * SP + c] = (bf16_t)(w01 >> 16); \
                    *(LAS unsigned*)(VS + t * VP + 2 * lane) = rvv[P][i]; \
                } \
            } else { \
                if (!GLA) { AT[t * SP + c] = 0; BT[t * SP + c] = 0; VS[t * VP + c] = 0; } else *(LAS unsigned*)(VS + t * VP + 2 * lane) = 0u; \
                RT[t * SP + c] = 0; KT[t * SP + c] = 0; \
            } \
          } \
          if (wg == W - 1) { GC[c] = __expf(-cum); cumtot += cum; } \
        } \
        if (sc + 2 < nsub) SB_LOAD(sc + 2, P); \
        __syncthreads();                                                         \
        scan_matrix_part<GLA, VP>(AT, RT, BT, KT, VS, GC, OUTP, l15, q, sl, use_v, write_o, row0 + 16 * sc, nv, H); \
        if (sc + 1 < nsub) SB_EG(sc + 1, 1 - (P)); } while (0)
    LAS float* WT = EG + 2048;
    SB_LOAD(0, 0); if (nsub > 1) SB_LOAD(1, 1); SB_EG(0, 0);
    for (int sc2 = 0; sc2 < nsub; sc2 += 2) { SB_ITER(sc2, 0); if (sc2 + 1 < nsub) SB_ITER(sc2 + 1, 1); }
#undef SB_LOAD
#undef SB_EG
#undef SB_ITER
}
constexpr int GP = 264;
__device__ __forceinline__ void gla_pass1_item(const Args& A, LAS unsigned char* lds, int wave, int lane, int b, int hh, int cc, int ig) {
    const bf16_t* PGLA = (const bf16_t*)(A.ws + OFF_PGLA);
    LAS bf16_t* KHT = (LAS bf16_t*)lds; LAS bf16_t* VT = KHT + 64 * GP; LAS float* WT = (LAS float*)(lds + (64 + 128) * GP * 2);
    const int c = lane, l15 = lane & 15, q = lane >> 4, row0 = b * 2048 + cc * 256 + 32 * wave;
    float wgt[16]; const float bgc = A.in[IN_BG][64 * hh + c];
#pragma unroll
    for (int j = 0; j < 16; ++j) wgt[j] = A.in[IN_WG2][j * 256 + 64 * hh + c];
    float cum[32]; float run = 0.f;
#pragma unroll
    for (int tb = 0; tb < 32; tb += 8) {
        u32x4 g0[8], g1[8];
#pragma unroll
        for (int j = 0; j < 8; ++j) { const bf16_t* p = PGLA + (size_t)(row0 + tb + j) * NPGLA; g0[j] = *(const u32x4*)(p + 1024); g1[j] = *(const u32x4*)(p + 1032); }
#pragma unroll
        for (int j = 0; j < 8; ++j) { float lga[16], t8[8];
            unpack8(g0[j], t8);
#pragma unroll
            for (int i = 0; i < 8; ++i) lga[i] = t8[i];
            unpack8(g1[j], t8);
#pragma unroll
            for (int i = 0; i < 8; ++i) lga[8 + i] = t8[i];
            float z = bgc;
#pragma unroll
            for (int i = 0; i < 16; ++i) z += lga[i] * wgt[i];
            run += fsoftplus(-z) * 0.0625f; cum[tb + j] = run; }
    }
    __syncthreads();
    WT[wave * 64 + c] = run;
    __syncthreads();
    float after = 0.f, tot = 0.f;
#pragma unroll
    for (int w2 = 0; w2 < 8; ++w2) { const float tw = WT[w2 * 64 + c]; tot += tw; after += (w2 > wave) ? tw : 0.f; }
#pragma unroll
    for (int tb = 0; tb < 32; tb += 16) {
        bf16_t rk[16]; unsigned rv[16];
#pragma unroll
        for (int j = 0; j < 16; ++j) { const bf16_t* p = PGLA + (size_t)(row0 + tb + j) * NPGLA; rk[j] = p[256 + 64 * hh + c]; rv[j] = *(const unsigned*)(p + 512 + 128 * hh + 2 * lane); }
#pragma unroll
        for (int j = 0; j < 16; ++j) { const int t = tb + j;
            KHT[c * GP + 32 * wave + t] = (bf16_t)f2bf(bf2f(rk[j]) * __expf(-(after + (run - cum[t]))));
            VT[(2 * lane) * GP + 32 * wave + t] = (bf16_t)(rv[j] & 0xffffu); VT[(2 * lane + 1) * GP + 32 * wave + t] = (bf16_t)(rv[j] >> 16); }
    }
    __syncthreads();
    f32x4 acc[4];
#pragma unroll
    for (int kt = 0; kt < 4; ++kt) acc[kt] = (f32x4){0.f, 0.f, 0.f, 0.f};
#pragma unroll
    for (int ks = 0; ks < 8; ++ks) { const bf16x8 bv = *(const LAS bf16x8*)(VT + (16 * wave + l15) * GP + 32 * ks + 8 * q);
#pragma unroll
        for (int kt = 0; kt < 4; ++kt) { const bf16x8 av = *(const LAS bf16x8*)(KHT + (16 * kt + l15) * GP + 32 * ks + 8 * q); acc[kt] = MFMA32(av, bv, acc[kt]); } }
    float* dst = (float*)(A.ws + OFF_GL) + (size_t)ig * 8192 + 16 * wave + l15;
#pragma unroll
    for (int kt = 0; kt < 4; ++kt)
#pragma unroll
        for (int i = 0; i < 4; ++i) dst[(16 * kt + 4 * q + i) * 128] = acc[kt][i];
    if (wave == 7) ((float*)(A.ws + OFF_GG))[ig * 64 + lane] = __expf(-tot);
}
__device__ __forceinline__ void p2x_scan1(const Args& A, LAS unsigned char* lds, int wave, int lane) {
    const int l15 = lane & 15, q = lane >> 4;
    for (int it = blockIdx.x; it < 448 + 224; it += gridDim.x) {
        f32x4 H[4]; float cumtot = 0.f;
        if (it < 448) {
            const int seq = it / 7, cc = it - seq * 7, b = seq >> 3, hh = seq & 7; const bool isT = wave >= 4; const int sl = wave & 3;
#pragma unroll
            for (int kt = 0; kt < 4; ++kt)
#pragma unroll
                for (int i = 0; i < 4; ++i) H[kt][i] = (isT && (16 * kt + 4 * q + i == 16 * sl + l15)) ? 1.f : 0.f;
            scan_block<false, 8>(A, lds, lane, wave, b * 2048 + cc * 256, 16, 16, cc == 0 ? 1 : 0, 0, hh, sl, !isT, false, H, cumtot);
            float* dst = (float*)(A.ws + OFF_RLT) + (size_t)it * 8192 + (isT ? 4096 : 0) + 16 * sl + l15;
#pragma unroll
            for (int kt = 0; kt < 4; ++kt)
#pragma unroll
                for (int i = 0; i < 4; ++i) dst[(16 * kt + 4 * q + i) * 64] = H[kt][i];
        } else {
            const int ig = it - 448, seq = ig / 7, cc = ig - seq * 7, b = seq >> 2, hh = seq & 3;
            gla_pass1_item(A, lds, wave, lane, b, hh, cc, ig);
        }
    }
    __syncthreads();
}
__device__ __forceinline__ void p2y_scan2(const Args& A, LAS unsigned char* lds, int wave, int lane) {
    const int l15 = lane & 15, q = lane >> 4;
    for (int bi = blockIdx.x; bi < 256 + 256 + 512 + 512; bi += gridDim.x) {
        f32x4 H[4]; float cumtot = 0.f;
#pragma unroll
        for (int kt = 0; kt < 4; ++kt) H[kt] = (f32x4){0.f, 0.f, 0.f, 0.f};
        if (bi < 256) {
            const int item = 2 * bi + (wave >> 2), sl = wave & 3, cc = item & 7, seq = item >> 3, b = seq >> 3, hh = seq & 7;
#pragma unroll 2
            for (int j = 0; j < cc; ++j) {
                const float* Lj = (const float*)(A.ws + OFF_RLT) + (size_t)(seq * 7 + j) * 8192; const float* Tj = Lj + 4096;
                const bf16x8 hb0 = hfrag(H[0], H[1]), hb1 = hfrag(H[2], H[3]);
#pragma unroll
                for (int kt = 0; kt < 4; ++kt) {
                    f32x4 acc;
#pragma unroll
                    for (int i = 0; i < 4; ++i) acc[i] = Lj[(16 * kt + 4 * q + i) * 64 + 16 * sl + l15];
                    const float* tr = Tj + (16 * kt + l15) * 64 + 4 * q;
                    const f32x4 t0 = *(const f32x4*)tr, t1 = *(const f32x4*)(tr + 16), t2 = *(const f32x4*)(tr + 32), t3 = *(const f32x4*)(tr + 48);
                    acc = MFMA32(hfrag(t0, t1), hb0, acc); acc = MFMA32(hfrag(t2, t3), hb1, acc);
                    H[kt] = acc;
                }
            }
            scan_block<false, 4>(A, lds + (wave >> 2) * GL_BYTES, lane, wave & 3, b * 2048 + cc * 256, 16, 16, cc == 0 ? 1 : 0, 0, hh, sl, true, true, H, cumtot);
            if (cc == 7) { float* o = A.out + OUT_WKV_P + (((size_t)b * 8 + hh) * 64 + 16 * sl + l15) * 64 + 4 * q;
#pragma unroll
                for (int kt = 0; kt < 4; ++kt) *(f32x4*)(o + 16 * kt) = H[kt]; }
        } else if (bi < 512) {
            const int item = bi - 256, sl = wave, cc = item & 7, seq = item >> 3, b = seq >> 2, hh = seq & 3;
#pragma unroll 2
            for (int j = 0; j < cc; ++j) {
                const float* Lj = (const float*)(A.ws + OFF_GL) + (size_t)(seq * 7 + j) * 8192; const float* Gj = (const float*)(A.ws + OFF_GG) + (seq * 7 + j) * 64;
#pragma unroll
                for (int kt = 0; kt < 4; ++kt)
#pragma unroll
                    for (int i = 0; i < 4; ++i) H[kt][i] = Gj[16 * kt + 4 * q + i] * H[kt][i] + Lj[(16 * kt + 4 * q + i) * 128 + 16 * sl + l15];
            }
            scan_block<true, 8>(A, lds, lane, wave, b * 2048 + cc * 256, 16, 16, 0, 0, hh, sl, true, true, H, cumtot);
            if (cc == 7) { float* o = A.out + OUT_GLA_P + (((size_t)b * 4 + hh) * 64) * 128 + 16 * sl + l15;
#pragma unroll
                for (int kt = 0; kt < 4; ++kt)
#pragma unroll
                    for (int i = 0; i < 4; ++i) o[(size_t)(16 * kt + 4 * q + i) * 128] = H[kt][i]; }
        } else if (bi < 1024) {
            const int item = 2 * (bi - 512) + (wave >> 2), sl = wave & 3, hh = item & 7, b = item >> 3;
            const float* st = A.in[IN_ST_WKV] + (((size_t)b * 8 + hh) * 64 + 16 * sl + l15) * 64 + 4 * q;
#pragma unroll
            for (int kt = 0; kt < 4; ++kt) H[kt] = *(const f32x4*)(st + 16 * kt);
            scan_block<false, 4>(A, lds + (wave >> 2) * GL_BYTES, lane, wave & 3, MP + b * 8, 1, 8, 2, b, hh, sl, true, true, H, cumtot);
            float* o = A.out + OUT_WKV_S + (((size_t)b * 8 + hh) * 64 + 16 * sl + l15) * 64 + 4 * q;
#pragma unroll
            for (int kt = 0; kt < 4; ++kt) *(f32x4*)(o + 16 * kt) = H[kt];
        } else {
            const int item = bi - 1024, sl = wave, hh = item & 3, b = item >> 2;
            const float* st = A.in[IN_ST_GLA] + (((size_t)b * 4 + hh) * 64) * 128 + 16 * sl + l15;
#pragma unroll
            for (int kt = 0; kt < 4; ++kt)
#pragma unroll
                for (int i = 0; i < 4; ++i) H[kt][i] = st[(size_t)(16 * kt + 4 * q + i) * 128];
            scan_block<true, 8>(A, lds, lane, wave, MP + b * 8, 1, 8, 0, b, hh, sl, true, true, H, cumtot);
            float* o = A.out + OUT_GLA_S + (((size_t)b * 4 + hh) * 64) * 128 + 16 * sl + l15;
#pragma unroll
            for (int kt = 0; kt < 4; ++kt)
#pragma unroll
                for (int i = 0; i < 4; ++i) o[(size_t)(16 * kt + 4 * q + i) * 128] = H[kt][i];
        }
    }
}
__device__ __forceinline__ void p2c_mix(const Args& A, int r, int col0, u32x4 rcur, u32x4 rprev, float (&xs)[8]) {
    float cur[8], prev[8]; unpack8(rcur, cur);
    const bool first = (r < MP) ? ((r & 2047) == 0) : (((r - MP) & 7) == 0);
    if (!first) unpack8(rprev, prev);
    else if (r < MP) {
#pragma unroll
        for (int i = 0; i < 8; ++i) prev[i] = 0.f;
    } else ld8f(A.in[IN_ST_SHIFT] + (size_t)((r - MP) >> 3) * 1792 + col0, prev);
    float mu[8]; ld8f(A.in[IN_MU] + col0, mu);
#pragma unroll
    for (int i = 0; i < 8; ++i) xs[i] = cur[i] + (prev[i] - cur[i]) * mu[i];
}
__device__ __forceinline__ void p2c_post(const Args& A, int gw, int NGW, int lane, bool shadow) {
    const bf16_t* PRW = (const bf16_t*)(A.ws + OFF_PRW); const bf16_t* PGLA = (const bf16_t*)(A.ws + OFF_PGLA);
    const bf16_t *AARR = (const bf16_t*)((unsigned char*)A.out + OUTB_AARR), *G = (const bf16_t*)(A.ws + OFF_G);
    bf16_t *ORW = (bf16_t*)((unsigned char*)A.out + OUTB_ORW), *OGL = (bf16_t*)((unsigned char*)A.out + OUTB_OGL);
    const int c0 = 8 * lane;
    for (int rb = gw; rb < M; rb += 2 * NGW) {
        u32x4 raw[2][11];
#pragma unroll
        for (int k = 0; k < 2; ++k) { const int r = (rb + k * NGW < M) ? rb + k * NGW : rb; const int rp = r > 0 ? r - 1 : 0;
            raw[k][0] = *(const u32x4*)(ORW + (size_t)r * 512 + c0); raw[k][1] = *(const u32x4*)(OGL + (size_t)r * 512 + c0);
            raw[k][2] = *(const u32x4*)(PRW + (size_t)r * NPRW + c0); raw[k][3] = *(const u32x4*)(PRW + (size_t)r * NPRW + 512 + c0); raw[k][4] = *(const u32x4*)(PRW + (size_t)r * NPRW + 1024 + c0);
            raw[k][5] = *(const u32x4*)(PRW + (size_t)rp * NPRW + c0); raw[k][6] = *(const u32x4*)(PRW + (size_t)rp * NPRW + 512 + c0); raw[k][7] = *(const u32x4*)(PRW + (size_t)rp * NPRW + 1024 + c0);
            raw[k][8] = *(const u32x4*)(AARR + (size_t)r * 512 + c0); raw[k][9] = *(const u32x4*)(G + (size_t)r * 512 + c0); raw[k][10] = *(const u32x4*)(PGLA + (size_t)r * NPGLA + 1040 + c0); }
#pragma unroll
        for (int k = 0; k < 2; ++k) { const int r = rb + k * NGW; if (r < M) {
            float o[8], d[8], xr[8], xk[8], xv[8], a[8], g[8], p[8], res[8];
            unpack8(raw[k][0], o);
            float s1 = 0.f;
#pragma unroll
            for (int i = 0; i < 8; ++i) s1 += o[i];
            const float mu = row8_allsum(s1) * (1.f / 64.f); float s2 = 0.f;
#pragma unroll
            for (int i = 0; i < 8; ++i) { d[i] = o[i] - mu; s2 += d[i] * d[i]; }
            const float rstd = rsqrtf(row8_allsum(s2) * (1.f / 64.f) + 64e-5f);
            p2c_mix(A, r, c0, raw[k][2], raw[k][5], xr); p2c_mix(A, r, 512 + c0, raw[k][3], raw[k][6], xk); p2c_mix(A, r, 1024 + c0, raw[k][4], raw[k][7], xv);
            unpack8(raw[k][8], a); unpack8(raw[k][9], g);
            float bs = 0.f; ld8f(A.in[IN_KA] + c0, p);
#pragma unroll
            for (int i = 0; i < 8; ++i) d[i] *= rstd, xk[i] = xk[i] * (1.f + (a[i] - 1.f) * p[i]);
            ld8f(A.in[IN_RK] + c0, p);
#pragma unroll
            for (int i = 0; i < 8; ++i) bs += xr[i] * xk[i] * p[i];
            bs = row8_allsum(bs);
            ld8f(A.in[IN_LNW] + c0, p); ld8f(A.in[IN_LNB] + c0, a);
#pragma unroll
            for (int i = 0; i < 8; ++i) res[i] = ((d[i] * p[i] + a[i]) + bs * xv[i]) * g[i];
            if (!shadow) *(u32x4*)(ORW + (size_t)r * 512 + c0) = pack8(res); else *(u32x4*)((bf16_t*)(A.ws + 240 * MiB) + (size_t)(r & 8191) * 512 + c0) = pack8(res);
            unpack8(raw[k][1], o);
            float ms = 0.f;
#pragma unroll
            for (int i = 0; i < 8; ++i) ms += o[i] * o[i];
            const float rs = rsqrtf(row16_allsum(ms) * (1.f / 128.f) + NORM_EPS);
            unpack8(raw[k][10], g); ld8f(A.in[IN_GNW] + (c0 & 127), p);
#pragma unroll
            for (int i = 0; i < 8; ++i) res[i] = o[i] * rs * p[i] * (g[i] * fsigmoid(g[i]));
            if (!shadow) *(u32x4*)(OGL + (size_t)r * 512 + c0) = pack8(res); else *(u32x4*)((bf16_t*)(A.ws + 248 * MiB) + (size_t)(r & 8191) * 512 + c0) = pack8(res);
        } }
    }
}
__device__ __forceinline__ void p6_act(const Args& A, int gtid, int NGT) {
    bf16_t* U = (bf16_t*)(A.ws + OFF_U); const bf16_t* UH = (const bf16_t*)(A.ws + OFF_UH);
    const float *convw = A.in[IN_CONVW], *convb = A.in[IN_CONVB], *cstate = A.in[IN_ST_CONV];
    for (int item = gtid; item < (M / 64) * 352; item += NGT) {
        const int rb = item / 352, jc = (item - rb * 352) * 8, r0 = rb * 64; const bool sample = r0 >= MP;
        float p1v[8], p2v[8], p1g[8], p2g[8], w0v[8], w1v[8], w2v[8], cbv[8], w0g[8], w1g[8], w2g[8], cbg[8];
        ld8f(convw + jc, w0v); ld8f(convw + F2 + jc, w1v); ld8f(convw + 2 * F2 + jc, w2v); ld8f(convb + jc, cbv);
        ld8f(convw + FF + jc, w0g); ld8f(convw + F2 + FF + jc, w1g); ld8f(convw + 2 * F2 + FF + jc, w2g); ld8f(convb + FF + jc, cbg);
#pragma unroll
        for (int i = 0; i < 8; ++i) p1v[i] = p2v[i] = p1g[i] = p2g[i] = 0.f;
        if (!sample && (rb & 31) != 0) { const bf16_t* q = UH + (size_t)(rb - 1) * 2 * F2; ld8bf(q + jc, p2v); ld8bf(q + FF + jc, p2g); ld8bf(q + F2 + jc, p1v); ld8bf(q + F2 + FF + jc, p1g); }
        for (int r8 = 0; r8 < 64; r8 += 8) {
            u32x4 rawv[8], rawg[8];
#pragma unroll
            for (int k = 0; k < 8; ++k) { const bf16_t* row = U + (size_t)(r0 + r8 + k) * F2; rawv[k] = *(const u32x4*)(row + jc); rawg[k] = *(const u32x4*)(row + FF + jc); }
            if (sample) { const float* st = cstate + (size_t)((r0 + r8 - MP) >> 3) * 2 * F2; ld8f(st + jc, p2v); ld8f(st + FF + jc, p2g); ld8f(st + F2 + jc, p1v); ld8f(st + F2 + FF + jc, p1g); }
#pragma unroll
            for (int k = 0; k < 8; ++k) {
                float cv[8], cg[8], res[8]; unpack8(rawv[k], cv); unpack8(rawg[k], cg);
#pragma unroll
                for (int i = 0; i < 8; ++i) { const float v = cbv[i] + w0v[i] * p2v[i] + w1v[i] * p1v[i] + w2v[i] * cv[i], gg = cbg[i] + w0g[i] * p2g[i] + w1g[i] * p1g[i] + w2g[i] * cg[i];
                    res[i] = gelu_gate(gg, v); p2v[i] = p1v[i]; p1v[i] = cv[i]; p2g[i] = p1g[i]; p1g[i] = cg[i]; }
                *(u32x4*)(U + (size_t)(r0 + r8 + k) * F2 + jc) = pack8(res);
            }
        }
    }
}
__device__ __forceinline__ void pfix_act(const Args& A, int gtid, int NGT) {
    const bf16_t* UH = (const bf16_t*)(A.ws + OFF_UH); const bf16_t* US = (const bf16_t*)(A.ws + OFF_US); bf16_t* ACT = (bf16_t*)(A.ws + OFF_ACT);
    const float *convw = A.in[IN_CONVW], *convb = A.in[IN_CONVB], *cstate = A.in[IN_ST_CONV];
    for (int idx = gtid; idx < (256 + 128) * 2 * 352; idx += NGT) {
        const int g = idx / 704, rem = idx - g * 704, rsel = rem / 352, jc = (rem - rsel * 352) * 8;
        float cv[8], cg[8], p1v[8], p1g[8], p2v[8], p2g[8], res[8]; int orow;
#pragma unroll
        for (int i = 0; i < 8; ++i) p1v[i] = p1g[i] = p2v[i] = p2g[i] = 0.f;
        if (g < 256) {
            const bool seq0 = (g & 31) == 0; orow = 64 * g + rsel;
            ld8bf(UH + ((size_t)g * 4 + rsel) * F2 + jc, cv); ld8bf(UH + ((size_t)g * 4 + rsel) * F2 + FF + jc, cg);
            if (rsel == 0) { if (!seq0) { const bf16_t* q = UH + ((size_t)(g - 1) * 4 + 3) * F2; ld8bf(q + jc, p1v); ld8bf(q + FF + jc, p1g); q -= F2; ld8bf(q + jc, p2v); ld8bf(q + FF + jc, p2g); } }
            else { const bf16_t* q = UH + ((size_t)g * 4) * F2; ld8bf(q + jc, p1v); ld8bf(q + FF + jc, p1g);
                if (!seq0) { q = UH + ((size_t)(g - 1) * 4 + 3) * F2; ld8bf(q + jc, p2v); ld8bf(q + FF + jc, p2g); } }
        } else {
            const int sb = g - 256; orow = MP + 8 * sb + rsel; const float* st = cstate + (size_t)sb * 2 * F2;
            ld8bf(US + ((size_t)sb * 2 + rsel) * F2 + jc, cv); ld8bf(US + ((size_t)sb * 2 + rsel) * F2 + FF + jc, cg);
            if (rsel == 0) { ld8f(st + jc, p2v); ld8f(st + FF + jc, p2g); ld8f(st + F2 + jc, p1v); ld8f(st + F2 + FF + jc, p1g); }
            else { ld8f(st + F2 + jc, p2v); ld8f(st + F2 + FF + jc, p2g); ld8bf(US + ((size_t)sb * 2) * F2 + jc, p1v); ld8bf(US + ((size_t)sb * 2) * F2 + FF + jc, p1g); }
        }
#pragma unroll
        for (int i = 0; i < 8; ++i) { const int col = jc + i;
            const float v = convb[col] + convw[col] * p2v[i] + convw[F2 + col] * p1v[i] + convw[2 * F2 + col] * cv[i];
            const float gg = convb[FF + col] + convw[FF + col] * p2g[i] + convw[F2 + FF + col] * p1g[i] + convw[2 * F2 + FF + col] * cg[i];
            res[i] = gelu_gate(gg, v); }
        *(u32x4*)(ACT + (size_t)orow * FF + jc) = pack8(res);
    }
}
__device__ __forceinline__ void p8_final(const Args& A, int gw, int NGW, int lane, float* dst) {
    const float* gf = A.in[IN_NORM_FINAL];
    for (int m = gw; m < M; m += 2 * NGW) {
        const int m2 = m + NGW; const bool has2 = m2 < M;
        const f32x4* xr = (const f32x4*)(A.out + (size_t)m * DM) + lane; const f32x4* xr2 = (const f32x4*)(A.out + (size_t)(has2 ? m2 : m) * DM) + lane; f32x4 v[4], w[4]; float s = 0.f, s2 = 0.f;
#pragma unroll
        for (int j = 0; j < 4; ++j) { v[j] = xr[64 * j]; w[j] = xr2[64 * j]; }
#pragma unroll
        for (int j = 0; j < 4; ++j) { s += (v[j].x * v[j].x + v[j].y * v[j].y) + (v[j].z * v[j].z + v[j].w * v[j].w); s2 += (w[j].x * w[j].x + w[j].y * w[j].y) + (w[j].z * w[j].z + w[j].w * w[j].w); }
        const float rstd = rsqrtf(wave_allsum(s) * (1.f / DM) + NORM_EPS), rstd2 = rsqrtf(wave_allsum(s2) * (1.f / DM) + NORM_EPS);
#pragma unroll
        for (int j = 0; j < 4; ++j) { const f32x4 g = *((const f32x4*)gf + lane + 64 * j); ((f32x4*)(dst + (size_t)m * DM) + lane)[64 * j] = v[j] * rstd * g; if (has2) ((f32x4*)(dst + (size_t)m2 * DM) + lane)[64 * j] = w[j] * rstd2 * g; }
    }
}

#ifndef PHMASK
#define PHMASK 0xFFFF
#endif
#ifndef PHREP
#define PHREP 0
#endif
#define PH(k) for (int rep_ = 0; rep_ < ((((PHMASK) >> (k)) & 1) ? ((((PHREP) >> (k)) & 1) ? 2 : 1) : 0); ++rep_)
__global__ void __launch_bounds__(NTHREADS, 2) fwd_megakernel(Args A) {
    extern __shared__ __attribute__((aligned(16))) unsigned char lds_raw[];
    LAS unsigned char* lds = (LAS unsigned char*)lds_raw;
    cg::grid_group grid = cg::this_grid();
    const int tid = threadIdx.x, lane = tid & 63, wave = __builtin_amdgcn_readfirstlane(tid >> 6);
    const int G = gridDim.x, gw = blockIdx.x * NWAVES + wave, NGW = G * NWAVES;
    unsigned char* ws = A.ws;
    if (tid < 4) ((LAS unsigned*)(lds + 131072))[tid] = 0u;
    __syncthreads();
    const XcdBarrier xbar = xcd_barrier_post((unsigned*)(ws + OFF_BAR), (volatile LAS unsigned*)(lds + 131072));
#define GSYNC() xcd_barrier(xbar)
    PH(0) p0_prologue(A, lds, gw, NGW, wave, lane);
    if (A.ws == nullptr) grid.sync();
    GSYNC();
    PH(1) { pg8::Gemm g{(const bf16_t*)((unsigned char*)A.out + OUTB_H), (const bf16_t*)(ws + OFF_WIN), M, NIN, 1024, 1024}; pg8::StaticOrder S; S.init(M, NIN, G, (int)blockIdx.x);
      EpiProj E{(bf16_t*)(ws + OFF_PRW), (bf16_t*)(ws + OFF_PGLA), (bf16_t*)(ws + OFF_PGATE), A.out + OUT_SHIFT_P, A.out + OUT_SHIFT_S};
      pg8::gemm_phase<EpiProj, pg8::StaticOrder, true, true>(lds, g, S, E); }
    GSYNC();
    PH(2) p2a_lora(A, lds, gw, NGW, wave, lane);
    GSYNC();
    PH(3) p2x_scan1(A, lds, wave, lane);
    GSYNC();
    PH(11) p2y_scan2(A, lds, wave, lane);
    GSYNC();
#ifdef SHADOW_P2C
    p2c_post(A, gw, NGW, lane, true);
#endif
    PH(4) p2c_post(A, gw, NGW, lane, false);
    GSYNC();
    PH(5) { pg8::StaticOrder S; S.init(M, 1024, G, (int)blockIdx.x); S.limit = __builtin_amdgcn_readfirstlane((S.nwg / G) * G);
      { pg8::Gemm g{(const bf16_t*)((unsigned char*)A.out + OUTB_ORW), (const bf16_t*)(ws + OFF_WOA), M, 1024, 512, 512};
        EpiGate<true> E{(bf16_t*)(ws + OFF_MERGED), (const bf16_t*)(ws + OFF_PGATE)};
        pg8::gemm_phase<EpiGate<true>, pg8::StaticOrder, true, true>(lds, g, S, E);
        tail_gemm(lds, (const bf16_t*)((unsigned char*)A.out + OUTB_ORW), 512, (const bf16_t*)(ws + OFF_WOA), 512, S, wave, lane, TfGate{true, (bf16_t*)(ws + OFF_MERGED), (const bf16_t*)(ws + OFF_PGATE)}); }
      { pg8::Gemm g{(const bf16_t*)((unsigned char*)A.out + OUTB_OGL), (const bf16_t*)(ws + OFF_WOB), M, 1024, 512, 512};
        EpiGate<false> E{(bf16_t*)(ws + OFF_MERGED), (const bf16_t*)(ws + OFF_PGATE) + 1024};
        pg8::gemm_phase<EpiGate<false>, pg8::StaticOrder, true, true>(lds, g, S, E);
        tail_gemm(lds, (const bf16_t*)((unsigned char*)A.out + OUTB_OGL), 512, (const bf16_t*)(ws + OFF_WOB), 512, S, wave, lane, TfGate{false, (bf16_t*)(ws + OFF_MERGED), (const bf16_t*)(ws + OFF_PGATE) + 1024}); } }
    GSYNC();
    PH(6) { pg8::Gemm g{(const bf16_t*)(ws + OFF_MERGED), (const bf16_t*)(ws + OFF_WO), M, 1024, 1024, 1024}; pg8::StaticOrder S; S.init(M, 1024, G, (int)blockIdx.x); S.limit = __builtin_amdgcn_readfirstlane((S.nwg / G) * G);
#ifdef SHADOW_G3
      float* rss = (rep_ == 0) ? (float*)(ws + OFF_ROWSS + 256 * 1024) : (float*)(ws + OFF_ROWSS);
#else
      float* rss = (float*)(ws + OFF_ROWSS);
#endif
      EpiX1 E{A.in[IN_XP], A.in[IN_XS], A.out, (bf16_t*)(ws + OFF_X1B), rss};
      pg8::gemm_phase<EpiX1, pg8::StaticOrder, true, true>(lds, g, S, E);
      tail_gemm(lds, (const bf16_t*)(ws + OFF_MERGED), 1024, (const bf16_t*)(ws + OFF_WO), 1024, S, wave, lane, TfX1{A.in[IN_XP], A.in[IN_XS], A.out, (bf16_t*)(ws + OFF_X1B), rss}); }
    GSYNC();
    PH(7) { pg8::Gemm g{(const bf16_t*)(ws + OFF_X1B), (const bf16_t*)(ws + OFF_WUP), M, F2, 1024, 1024}; pg8::StaticOrder S; S.init(M, F2, G, (int)blockIdx.x);
      EpiAct E{(const float*)(ws + OFF_ROWSS), A.in[IN_CONVW], A.in[IN_CONVB], (bf16_t*)(ws + OFF_ACT), (bf16_t*)(ws + OFF_UH), (bf16_t*)(ws + OFF_US), A.out + OUT_CONV_P, A.out + OUT_CONV_S, (LAS float*)(lds + 131072)};
      pg8::gemm_phase<EpiAct, pg8::StaticOrder, true, true>(lds, g, S, E); }
    __syncthreads(); if (tid < 4) ((LAS unsigned*)(lds + 131072))[tid] = 0u; __syncthreads();
    GSYNC();
    PH(8) pfix_act(A, blockIdx.x * NTHREADS + tid, G * NTHREADS);
    GSYNC();
    PH(9) { pg8::Gemm g{(const bf16_t*)(ws + OFF_ACT), (const bf16_t*)(ws + OFF_WDN), M, 1024, FF, FF}; pg8::StaticOrder S; S.init(M, 1024, G, (int)blockIdx.x); S.limit = __builtin_amdgcn_readfirstlane((S.nwg / G) * G);
#ifdef SHADOW_G5
      float* xd = (rep_ == 0) ? (float*)(ws + 129 * MiB) : A.out;
#else
      float* xd = A.out;
#endif
      EpiX2 E{A.out, xd};
      pg8::gemm_phase<EpiX2, pg8::StaticOrder, true, true>(lds, g, S, E);
      tail_gemm(lds, (const bf16_t*)(ws + OFF_ACT), FF, (const bf16_t*)(ws + OFF_WDN), FF, S, wave, lane, TfX2{A.out, xd}); }
    GSYNC();
#ifdef P8_SHADOW
    p8_final(A, gw, NGW, lane, (float*)(ws + OFF_U));
#endif
    PH(10) p8_final(A, gw, NGW, lane, A.out);
#ifdef EXTRA_SYNCS
    for (int i_ = 0; i_ < EXTRA_SYNCS; ++i_) GSYNC();
#endif
}

extern "C" void kernel_launch(void* const* d_in, const int* in_sizes, int n_in, void* d_out, int out_size, void* d_ws, size_t ws_size, hipStream_t stream) {
    static int grid = 0;
    if (grid == 0) {
        int dev = 0, cus = 0, per_cu = 0;
        if (n_in != 31 || ws_size < 256 * MiB) { fprintf(stderr, "kernel_launch: unexpected n_in %d / ws_size %zu\n", n_in, ws_size); grid = -1; return; }
        (void)hipGetDevice(&dev); (void)hipDeviceGetAttribute(&cus, hipDeviceAttributeMultiprocessorCount, dev);
        if (hipFuncSetAttribute((const void*)fwd_megakernel, hipFuncAttributeMaxDynamicSharedMemorySize, LDS_BYTES) != hipSuccess) { fprintf(stderr, "kernel_launch: hipFuncSetAttribute failed\n"); grid = -1; return; }
        if (hipOccupancyMaxActiveBlocksPerMultiprocessor(&per_cu, (const void*)fwd_megakernel, NTHREADS, LDS_BYTES) != hipSuccess || per_cu < 1) { fprintf(stderr, "kernel_launch: occupancy query failed (%d)\n", per_cu); (void)hipGetLastError(); grid = -1; return; }
        grid = cus * 1;
    }
    if (grid < 0) return;
    Args a{};
    for (int i = 0; i < 31; ++i) a.in[i] = (const float*)d_in[i];
    a.out = (float*)d_out; a.ws = (unsigned char*)d_ws;
    if (hipMemsetAsync((char*)d_ws + OFF_BAR, 0, XCD_BAR_WORDS * 4, stream) != hipSuccess) { fprintf(stderr, "kernel_launch: memset of the barrier words failed\n"); return; }
    void* params[] = {&a};
    hipError_t e = hipLaunchCooperativeKernel((const void*)fwd_megakernel, dim3(grid), dim3(NTHREADS), params, LDS_BYTES, stream);
    if (e != hipSuccess) fprintf(stderr, "kernel_launch: cooperative launch failed: %s (grid %d)\n", hipGetErrorString(e), grid);
}
```

```cpp
#include <hip/hip_runtime.h>
#include <hip/hip_cooperative_groups.h>
#include <cstdio>
#include <cstdint>
namespace cg = cooperative_groups;
#define PHREP 0
namespace pg8 {
#define PG8_LAS __attribute__((address_space(3)))
typedef unsigned short bf16_t;
typedef short bf16x8 __attribute__((ext_vector_type(8)));
typedef float f32x4 __attribute__((ext_vector_type(4)));
typedef unsigned u32x4 __attribute__((ext_vector_type(4)));
constexpr int BM = 256, BK = 64, HALF = 128, HTB = HALF * BK * 2  , STAGE_BYTES = 8 * HTB, NXCD = 8, WGM = 8;

__host__ __device__ __forceinline__ int lds_byte(int r, int c) { const int st = (r >> 4) * 2 + (c >> 5), rr = r & 15, cc = c & 31, ob = rr * 64 + cc * 2; return st * 1024 + (ob ^ (((ob >> 9) & 1) << 5)); }
__host__ __device__ __forceinline__ void stage_rc(int b, int& R, int& C) { const int st = b / 1024, sb = b % 1024, swz = sb ^ (((sb >> 9) & 1) << 5); R = (st >> 1) * 16 + swz / 64; C = (st & 1) * 32 + (swz % 64) / 2; }
__host__ __device__ __forceinline__ int perm32(int rho) { const int n = rho >> 4, i = rho & 15; return 8 * (i >> 2) + 4 * n + (i & 3); }

struct Unit { int pm, pn; };
struct Gemm { const bf16_t* A; const bf16_t* Bt; int M, N, K, lda; };

struct StaticOrder {
    int nM, nN, nwg, G, c;
    int limit;
    __host__ __device__ void init(int M, int N, int G_, int c_) { nM = M / BM; nN = N / BM; nwg = nM * nN; G = G_; c = c_; limit = nwg; }
    __host__ __device__ __forceinline__ bool next(int i, Unit& u) const {
        const int L = i * G + c; if (L >= limit) return false;
        unit_of(L, u); return true;
    }
    __host__ __device__ __forceinline__ void unit_of(int L, Unit& u) const {
        int wgid = L; { const int q = nwg / NXCD, r = nwg % NXCD, xcd = wgid % NXCD, off = wgid / NXCD; wgid = (xcd < r ? xcd * (q + 1) : r * (q + 1) + (xcd - r) * q) + off; }
        const int nig = WGM * nN, gid = wgid / nig, fm = gid * WGM, gsz = (nM - fm) < WGM ? (nM - fm) : WGM;
        u.pm = fm + ((wgid % nig) % gsz); u.pn = (wgid % nig) / gsz;
    }
    __device__ __forceinline__ void a_ready(const Unit&) const {}
    __device__ __forceinline__ void done(const Unit&) const {}
};
__device__ __forceinline__ unsigned cvt_pk_bf16(float lo, float hi) { unsigned r; asm volatile("v_cvt_pk_bf16_f32 %0, %1, %2" : "=v"(r) : "v"(lo), "v"(hi)); return r; }
typedef float f32x2 __attribute__((ext_vector_type(2)));
template <class Epi, class Sched, bool ALIGN_EPI = false, bool SP2 = false>
__device__ __forceinline__ void gemm_phase(PG8_LAS unsigned char* lds, const Gemm g, const Sched& S, const Epi& E) {
    int tid_ = threadIdx.x; asm volatile("" : "+v"(tid_));
    const int tid = tid_, wid = __builtin_amdgcn_readfirstlane(tid >> 6), lane = tid & 63, wr = wid >> 2, wc = wid & 3, fr = lane & 15, fq = lane >> 4;
    const int K = g.K, nt = K / BK;
    unsigned voffA[2], voffB[2];
#pragma unroll
    for (int i = 0; i < 2; ++i) { int R, C; stage_rc(tid * 16 + i * 8192, R, C); const int Rb = Epi::PERM ? ((R & ~31) + perm32(R & 31)) : R;
        voffA[i] = (unsigned)(R * g.lda + C) * 2u; voffB[i] = (unsigned)(Rb * K + C) * 2u; }
    const size_t kstep = (size_t)(BK * 2);
    const size_t hstep = (size_t)HALF * K * 2;
    const size_t tstep = 2 * hstep;
    const size_t hstepA = (size_t)HALF * g.lda * 2, tstepA = 2 * hstepA;
    const unsigned ldsw = (unsigned)wid * 1024u;
    const int aoff = lds_byte(wr * 64 + fr, fq * 8), boff = lds_byte(wc * 32 + fr, fq * 8);
#define PG8_SA(b, h) (((b) * 2 + (h)) * HTB)
#define PG8_SB(b, h) ((4 + (b) * 2 + (h)) * HTB)
#define PG8_STAGE(bufoff, gbase, voff) do { _Pragma("unroll") for (int _i = 0; _i < 2; ++_i) \
        __builtin_amdgcn_global_load_lds((const unsigned*)((const char*)(gbase) + (voff)[_i]), (PG8_LAS unsigned*)(lds + (bufoff) + ldsw + _i * 8192), 16, 0, 0); } while (0)
#define PG8_LDA(dst, b, h) do { _Pragma("unroll") for (int m = 0; m < 4; ++m) _Pragma("unroll") for (int k = 0; k < 2; ++k) dst[m][k] = *(const PG8_LAS bf16x8*)(lds + PG8_SA(b, h) + aoff + m * 2048 + k * 1024); } while (0)
#define PG8_LDB(dst, b, h) do { _Pragma("unroll") for (int n = 0; n < 2; ++n) _Pragma("unroll") for (int k = 0; k < 2; ++k) dst[n][k] = *(const PG8_LAS bf16x8*)(lds + PG8_SB(b, h) + boff + n * 2048 + k * 1024); } while (0)
#define PG8_MMA(ai, bj, At, Bt) do { __builtin_amdgcn_s_setprio(1); _Pragma("unroll") for (int m = 0; m < 4; ++m) _Pragma("unroll") for (int n = 0; n < 2; ++n) _Pragma("unroll") for (int k = 0; k < 2; ++k) \
        acc[ai][bj][m][n] = __builtin_amdgcn_mfma_f32_16x16x32_bf16(Bt[n][k], At[m][k], acc[ai][bj][m][n], 0, 0, 0); __builtin_amdgcn_s_setprio(0); } while (0)
#define PG8_WAIT_V(n) asm volatile("s_waitcnt vmcnt(" #n ")" ::: "memory")
#define PG8_WAIT_L(n) asm volatile("s_waitcnt lgkmcnt(" #n ")" ::: "memory")
#define PG8_BAR __builtin_amdgcn_s_barrier()
#define PG8_SCHED __builtin_amdgcn_sched_barrier(0)
    Unit cur, nxt; int ui = 0;
    if (!S.next(0, cur)) return;
    f32x4 acc[2][2][4][2];
#pragma unroll
    for (int a = 0; a < 2; ++a)
#pragma unroll
        for (int b = 0; b < 2; ++b)
#pragma unroll
            for (int m = 0; m < 4; ++m)
#pragma unroll
                for (int n = 0; n < 2; ++n) acc[a][b][m][n] = (f32x4){0.f, 0.f, 0.f, 0.f};
    bf16x8 At[4][2], B0[2][2], B1[2][2];
    const char* cA = (const char*)g.A + (size_t)cur.pm * tstepA; const char* cB = (const char*)g.Bt + (size_t)cur.pn * tstep;
    S.a_ready(cur);
    if constexpr (SP2) {
        PG8_STAGE(PG8_SB(0, 0), cB, voffB); PG8_STAGE(PG8_SB(0, 1), cB + hstep, voffB); PG8_STAGE(PG8_SA(0, 0), cA, voffA); PG8_STAGE(PG8_SA(0, 1), cA + hstepA, voffA);
        if (wr == 1) PG8_BAR;
        PG8_WAIT_V(2); PG8_BAR;
        PG8_STAGE(PG8_SB(1, 0), cB + kstep, voffB); PG8_STAGE(PG8_SA(1, 0), cA + kstep, voffA); PG8_STAGE(PG8_SB(1, 1), cB + hstep + kstep, voffB);
        PG8_WAIT_V(6); PG8_BAR;
    } else {
        PG8_STAGE(PG8_SB(0, 0), cB, voffB); PG8_STAGE(PG8_SA(0, 0), cA, voffA); PG8_STAGE(PG8_SB(0, 1), cB + hstep, voffB); PG8_STAGE(PG8_SA(0, 1), cA + hstepA, voffA);
        if (wr == 1) PG8_BAR;
        PG8_WAIT_V(4); PG8_BAR;
        PG8_STAGE(PG8_SB(1, 0), cB + kstep, voffB); PG8_STAGE(PG8_SA(1, 0), cA + kstep, voffA); PG8_STAGE(PG8_SB(1, 1), cB + hstep + kstep, voffB);
        PG8_WAIT_V(6); PG8_BAR;
    }
    for (;;) {
        const bool has_next = S.next(ui + 1, nxt);
        const char* nA = has_next ? (const char*)g.A + (size_t)nxt.pm * tstepA : cA; const char* nB = has_next ? (const char*)g.Bt + (size_t)nxt.pn * tstep : cB;
        for (int t = 0; t < nt; t += 2) {
            const bool last = (t == nt - 2);
            const char* a1 = cA + (size_t)(t + 1) * kstep;
            const char* a2 = last ? nA : cA + (size_t)(t + 2) * kstep; const char* b2 = last ? nB : cB + (size_t)(t + 2) * kstep;
            const char* a3 = a2 + kstep; const char* b3 = b2 + kstep;
            if (last && has_next) S.a_ready(nxt);
            if constexpr (SP2) {
            PG8_LDB(B0, 0, 0); PG8_LDB(B1, 0, 1); PG8_SCHED; PG8_LDA(At, 0, 0); PG8_STAGE(PG8_SA(1, 1), a1 + hstepA, voffA);
            PG8_WAIT_V(8); PG8_WAIT_L(0); PG8_BAR; PG8_MMA(0, 0, At, B0); PG8_MMA(0, 1, At, B1); PG8_BAR; PG8_SCHED;
            PG8_LDA(At, 0, 1); PG8_STAGE(PG8_SB(0, 0), b2, voffB); PG8_STAGE(PG8_SB(0, 1), b2 + hstep, voffB); PG8_STAGE(PG8_SA(0, 0), a2, voffA);
            PG8_WAIT_V(8); PG8_WAIT_L(0); PG8_BAR; PG8_MMA(1, 0, At, B0); PG8_MMA(1, 1, At, B1); PG8_BAR; PG8_SCHED;
            PG8_LDB(B0, 1, 0); PG8_LDB(B1, 1, 1); PG8_SCHED; PG8_LDA(At, 1, 0); PG8_STAGE(PG8_SA(0, 1), a2 + hstepA, voffA);
            PG8_WAIT_V(8); PG8_WAIT_L(0); PG8_BAR; PG8_MMA(0, 0, At, B0); PG8_MMA(0, 1, At, B1); PG8_BAR; PG8_SCHED;
            PG8_LDA(At, 1, 1); PG8_STAGE(PG8_SB(1, 0), b3, voffB); PG8_STAGE(PG8_SB(1, 1), b3 + hstep, voffB); PG8_STAGE(PG8_SA(1, 0), a3, voffA);
            PG8_WAIT_V(8); PG8_WAIT_L(0); PG8_BAR; PG8_MMA(1, 0, At, B0); PG8_MMA(1, 1, At, B1); PG8_BAR; PG8_SCHED;
            } else {
            PG8_LDB(B0, 0, 0); PG8_SCHED; PG8_LDA(At, 0, 0); PG8_STAGE(PG8_SA(1, 1), a1 + hstepA, voffA);
            PG8_WAIT_L(8); PG8_BAR; PG8_WAIT_L(0); PG8_MMA(0, 0, At, B0); PG8_BAR; PG8_SCHED;
            PG8_LDB(B1, 0, 1); PG8_STAGE(PG8_SB(0, 0), b2, voffB);
            PG8_BAR; PG8_WAIT_L(0); PG8_MMA(0, 1, At, B1); PG8_BAR;
            PG8_LDA(At, 0, 1); PG8_STAGE(PG8_SA(0, 0), a2, voffA);
            PG8_BAR; PG8_WAIT_L(0); PG8_MMA(1, 0, At, B0); PG8_BAR; PG8_SCHED;
            PG8_STAGE(PG8_SB(0, 1), b2 + hstep, voffB);
            PG8_WAIT_V(6); PG8_BAR; PG8_MMA(1, 1, At, B1); PG8_BAR;
            PG8_LDB(B0, 1, 0); PG8_SCHED; PG8_LDA(At, 1, 0); PG8_STAGE(PG8_SA(0, 1), a2 + hstepA, voffA);
            PG8_WAIT_L(8); PG8_BAR; PG8_WAIT_L(0); PG8_MMA(0, 0, At, B0); PG8_BAR; PG8_SCHED;
            PG8_LDB(B1, 1, 1); PG8_STAGE(PG8_SB(1, 0), b3, voffB);
            PG8_BAR; PG8_WAIT_L(0); PG8_MMA(0, 1, At, B1); PG8_BAR;
            PG8_LDA(At, 1, 1); PG8_STAGE(PG8_SA(1, 0), a3, voffA);
            PG8_BAR; PG8_WAIT_L(0); PG8_MMA(1, 0, At, B0); PG8_BAR; PG8_SCHED;
            PG8_STAGE(PG8_SB(1, 1), b3 + hstep, voffB);
            PG8_WAIT_V(6); PG8_BAR; PG8_MMA(1, 1, At, B1); PG8_BAR;
            }
        }
        if constexpr (ALIGN_EPI) { if (wr == 0) PG8_BAR; }
        if constexpr (!Epi::AFTER_DRAIN) { E(acc, cur, wr, wc, fr, fq); S.done(cur); }
        if (!has_next) break;
#pragma unroll
        for (int a = 0; a < 2; ++a)
#pragma unroll
            for (int b = 0; b < 2; ++b)
#pragma unroll
                for (int m = 0; m < 4; ++m)
#pragma unroll
                    for (int n = 0; n < 2; ++n) acc[a][b][m][n] = (f32x4){0.f, 0.f, 0.f, 0.f};
        cur = nxt; cA = nA; cB = nB; ++ui;
        if constexpr (ALIGN_EPI) { if (wr == 1) PG8_BAR; }
    }
    PG8_WAIT_V(0);
    if constexpr (!ALIGN_EPI) { if (wr == 0) PG8_BAR; }
    PG8_BAR;
    if constexpr (Epi::AFTER_DRAIN) { E.fused(acc, cur, wr, wc, fr, fq, lds, wid, lane); S.done(cur); }
#undef PG8_SA
#undef PG8_SB
#undef PG8_STAGE
#undef PG8_LDA
#undef PG8_LDB
#undef PG8_MMA
#undef PG8_WAIT_V
#undef PG8_WAIT_L
#undef PG8_BAR
#undef PG8_SCHED
}
}

#define LAS __attribute__((address_space(3)))
typedef unsigned short bf16_t;
typedef short bf16x8 __attribute__((ext_vector_type(8)));
typedef float f32x4 __attribute__((ext_vector_type(4)));
typedef unsigned u32x4 __attribute__((ext_vector_type(4)));
typedef unsigned u32x2 __attribute__((ext_vector_type(2)));
using pg8::Unit;

constexpr int M = 17408, MP = 16384, DM = 1024;
constexpr int NPRW = 1792, NPGLA = 1792, NGATE = 2048, NIN = 5632;
constexpr int FF = 2816, F2 = 5632;
constexpr float NORM_EPS = 1e-6f;
constexpr int NWAVES = 8, NTHREADS = 512;
constexpr int LDS_BYTES = 131072 + 32768;
constexpr size_t OFF_BAR = 512 * 1024;

constexpr size_t MiB = 1u << 20;
constexpr size_t OFF_ROWSS = 0;
constexpr size_t OFF_WIN = 1 * MiB, OFF_WUP = 12 * MiB, OFF_WDN = 23 * MiB, OFF_WO = 29 * MiB, OFF_WOA = 31 * MiB, OFF_WOB = 32 * MiB;
constexpr size_t OFF_W2T = 33 * MiB, OFF_A2T = OFF_W2T + 65536, OFF_G2T = OFF_A2T + 65536;
constexpr size_t OFF_PRW = 35 * MiB, OFF_PGLA = 95 * MiB, OFF_PGATE = 155 * MiB, OFF_G = 223 * MiB;
constexpr size_t OFF_MERGED = OFF_PRW, OFF_UH = OFF_WIN, OFF_X1B = 222 * MiB, OFF_U = OFF_PRW, OFF_ACT = OFF_PRW, OFF_US = 29 * MiB;
static_assert(OFF_PRW + (size_t)M * NPRW * 2 <= OFF_PGLA && OFF_PGLA + (size_t)M * NPGLA * 2 <= OFF_PGATE && OFF_PGATE + (size_t)M * NGATE * 2 <= OFF_G, "ws map");
static_assert(OFF_G + (size_t)M * 512 * 2 <= 256 * MiB && OFF_U + (size_t)M * F2 * 2 <= OFF_X1B && OFF_X1B + (size_t)M * DM * 2 <= 256 * MiB, "ws map");
static_assert(OFF_UH + (size_t)256 * 4 * F2 * 2 <= OFF_WUP && OFF_ACT + (size_t)M * FF * 2 <= OFF_X1B, "ws map");

constexpr size_t OUT_SHIFT_P = (size_t)M * DM, OUT_WKV_P = OUT_SHIFT_P + 8 * 1792, OUT_GLA_P = OUT_WKV_P + 8 * 8 * 64 * 64, OUT_CONV_P = OUT_GLA_P + 8 * 4 * 64 * 128;
constexpr size_t OUT_SHIFT_S = OUT_CONV_P + 8 * 2 * F2, OUT_WKV_S = OUT_SHIFT_S + 128 * 1792, OUT_GLA_S = OUT_WKV_S + (size_t)128 * 8 * 64 * 64, OUT_CONV_S = OUT_GLA_S + (size_t)128 * 4 * 64 * 128;
constexpr size_t OUTB_H = 0, OUTB_EW = 0, OUTB_AARR = (size_t)M * 512 * 2, OUTB_ORW = (size_t)M * 1024 * 2, OUTB_OGL = OUTB_ORW + (size_t)M * 512 * 2;

struct Args { const float* in[31]; float* out; unsigned char* ws; };
#define IN_XP 0
#define IN_XS 1
#define IN_ST_SHIFT 2
#define IN_ST_WKV 3
#define IN_ST_GLA 4
#define IN_ST_CONV 5
#define IN_NORM_MIX 6
#define IN_W_IN 7
#define IN_MU 8
#define IN_W0 9
#define IN_W2 10
#define IN_A0 11
#define IN_A2 12
#define IN_G2 13
#define IN_KK 14
#define IN_KA 15
#define IN_RK 16
#define IN_LNW 17
#define IN_LNB 18
#define IN_WG2 19
#define IN_BG 20
#define IN_GNW 21
#define IN_WOA 22
#define IN_WOB 23
#define IN_WO 24
#define IN_NORM_FFN 25
#define IN_WUP 26
#define IN_CONVW 27
#define IN_CONVB 28
#define IN_WDN 29
#define IN_NORM_FINAL 30

__device__ __forceinline__ float bf_lo(unsigned w) { return __builtin_bit_cast(float, w << 16); }
__device__ __forceinline__ float bf_hi(unsigned w) { return __builtin_bit_cast(float, w & 0xffff0000u); }
__device__ __forceinline__ float bf2f(bf16_t h) { return __builtin_bit_cast(float, (unsigned)h << 16); }
__device__ __forceinline__ unsigned f2bf(float f) { unsigned u = __builtin_bit_cast(unsigned, f); return (u + 0x7fffu + ((u >> 16) & 1u)) >> 16; }
typedef float f32x2_t __attribute__((ext_vector_type(2)));
typedef __bf16 bf16x2_t __attribute__((ext_vector_type(2)));
__device__ __forceinline__ unsigned pk2(float lo, float hi) { const f32x2_t v = {lo, hi}; const bf16x2_t b = __builtin_convertvector(v, bf16x2_t); return __builtin_bit_cast(unsigned, b); }
__device__ __forceinline__ void unpack8(u32x4 w, float (&o)[8]) { o[0] = bf_lo(w.x); o[1] = bf_hi(w.x); o[2] = bf_lo(w.y); o[3] = bf_hi(w.y); o[4] = bf_lo(w.z); o[5] = bf_hi(w.z); o[6] = bf_lo(w.w); o[7] = bf_hi(w.w); }
__device__ __forceinline__ u32x4 pack8(const float (&v)[8]) { u32x4 w; w.x = pk2(v[0], v[1]); w.y = pk2(v[2], v[3]); w.z = pk2(v[4], v[5]); w.w = pk2(v[6], v[7]); return w; }
__device__ __forceinline__ void ld8bf(const bf16_t* p, float (&o)[8]) { unpack8(*(const u32x4*)p, o); }
__device__ __forceinline__ void ld8f(const float* p, float (&o)[8]) { const f32x4 a = *(const f32x4*)p, b = *(const f32x4*)(p + 4); o[0] = a.x; o[1] = a.y; o[2] = a.z; o[3] = a.w; o[4] = b.x; o[5] = b.y; o[6] = b.z; o[7] = b.w; }
__device__ __forceinline__ float fsigmoid(float x) { return __builtin_amdgcn_rcpf(1.f + __expf(-x)); }
__device__ __forceinline__ float ftanh(float x) { return 1.f - 2.f * __builtin_amdgcn_rcpf(__expf(2.f * x) + 1.f); }
__device__ __forceinline__ float fsoftplus(float x) { return fmaxf(x, 0.f) + __logf(1.f + __expf(-fabsf(x))); }
template <int CTRL> __device__ __forceinline__ float dpp_mov(float x) { return __builtin_bit_cast(float, __builtin_amdgcn_mov_dpp(__builtin_bit_cast(int, x), CTRL, 0xf, 0xf, true)); }
__device__ __forceinline__ float row16_allsum(float x) { x += dpp_mov<0xB1>(x); x += dpp_mov<0x4E>(x); x += dpp_mov<0x124>(x); x += dpp_mov<0x128>(x); return x; }
__device__ __forceinline__ float row8_allsum(float x) { x += dpp_mov<0xB1>(x); x += dpp_mov<0x4E>(x); x += dpp_mov<0x141>(x); return x; }
__device__ __forceinline__ float rdlane(float x, int l) { return __builtin_bit_cast(float, __builtin_amdgcn_readlane(__builtin_bit_cast(int, x), l)); }
__device__ __forceinline__ float wave_allsum(float x) { x = row16_allsum(x); return (rdlane(x, 0) + rdlane(x, 16)) + (rdlane(x, 32) + rdlane(x, 48)); }
#define LDS_WAIT() asm volatile("s_waitcnt lgkmcnt(0)" ::: "memory")
__device__ __forceinline__ const float* xrow_ptr(const Args& A, int r) { return r < MP ? A.in[IN_XP] + (size_t)r * DM : A.in[IN_XS] + (size_t)(r - MP) * DM; }

#define XB_TMO      128
#define XB_XCNT(j)  (256  + 64 * (j))
#define XB_XSUB(j)  (1280 + 64 * (j))
#define XB_XGEN(j)  (2304 + 64 * (j))
#define XB_TOP      3328
#define XB_TOPGEN   3392
#define XCD_BAR_WORDS 3456
#define XB_SPIN_CAP (1u << 18)

__device__ __forceinline__ unsigned xb_ld(unsigned* p)              { return __hip_atomic_load(p, __ATOMIC_RELAXED, __HIP_MEMORY_SCOPE_AGENT); }
__device__ __forceinline__ unsigned xb_add(unsigned* p, unsigned v) { return __hip_atomic_fetch_add(p, v, __ATOMIC_RELAXED, __HIP_MEMORY_SCOPE_AGENT); }
__device__ __forceinline__ unsigned xb_xcc_id() { return (unsigned)__builtin_amdgcn_s_getreg((3 << 11) | 20) & 0xFu; }
#define XB_SPIN(cond, bar) do { unsigned _sp = 0; while (cond) { __builtin_amdgcn_s_sleep(1); \
    if ((++_sp & 255u) == 0u) { if (xb_ld(&(bar)[XB_TMO])) break; if (_sp > XB_SPIN_CAP) { atomicAdd(&(bar)[XB_TMO], 1u); break; } } } } while (0)

struct XcdBarrier {
    unsigned* bar; unsigned x;
    volatile LAS unsigned* st;
};

__device__ __forceinline__ XcdBarrier xcd_barrier_post(unsigned* bar, volatile LAS unsigned* st) {
    XcdBarrier b; b.bar = bar; b.x = xb_xcc_id(); b.st = st;
    if (threadIdx.x == 0) (void)xb_add(&bar[XB_XCNT(b.x)], 1u);
    return b;
}
__device__ __forceinline__ void xcd_barrier_complete(unsigned* bar, unsigned x, unsigned& nloc, unsigned& nx) {
    const unsigned G = gridDim.x * gridDim.y * gridDim.z;
    unsigned sum, cnt, mine, sp = 0u;
    for (;;) {
        sum = 0u; cnt = 0u; mine = 0u;
#pragma unroll
        for (unsigned j = 0; j < 16; ++j) { const unsigned c = xb_ld(&bar[XB_XCNT(j)]); sum += c; cnt += (c > 0u) ? 1u : 0u; mine = (j == x) ? c : mine; }
        if (sum == G) break;
        __builtin_amdgcn_s_sleep(1);
        if ((++sp & 255u) == 0u) { if (xb_ld(&bar[XB_TMO])) break; if (sp > XB_SPIN_CAP) { atomicAdd(&bar[XB_TMO], 1u); break; } }
    }
    nloc = mine > 0u ? mine : 1u; nx = cnt > 0u ? cnt : 1u;
}

__device__ __forceinline__ void xcd_barrier(const XcdBarrier& b) {
    asm volatile("s_waitcnt vmcnt(0)" ::: "memory");
    __syncthreads();
    if (threadIdx.x == 0) {
        unsigned* bar = b.bar;
        __builtin_amdgcn_s_waitcnt(0);
        unsigned nloc = b.st[0], nx = b.st[1];
        if (nloc == 0u) { xcd_barrier_complete(bar, b.x, nloc, nx); b.st[0] = nloc; b.st[1] = nx; }
        const unsigned old = xb_add(&bar[XB_XSUB(b.x)], 1u);
        const unsigned gen = old / nloc;
        if (old + 1u == (gen + 1u) * nloc) {
            __builtin_amdgcn_fence(__ATOMIC_RELEASE, "agent");
            asm volatile("s_waitcnt vmcnt(0)" ::: "memory");
            const unsigned og = xb_add(&bar[XB_TOP], 1u);
            const unsigned tg = og / nx;
            if (og + 1u == (tg + 1u) * nx) xb_add(&bar[XB_TOPGEN], 1u);
            else XB_SPIN(xb_ld(&bar[XB_TOPGEN]) == tg, bar);
            __builtin_amdgcn_fence(__ATOMIC_ACQUIRE, "agent");
            xb_add(&bar[XB_XGEN(b.x)], 1u);
            asm volatile("s_waitcnt vmcnt(0)" ::: "memory");
        } else {
            XB_SPIN(xb_ld(&bar[XB_XGEN(b.x)]) == gen, bar);
            __builtin_amdgcn_fence(__ATOMIC_ACQUIRE, "agent");
            asm volatile("s_waitcnt vmcnt(0)" ::: "memory");
        }
    }
    __syncthreads();
}


struct EpiProj {
    static constexpr bool PERM = true, AFTER_DRAIN = false;
    bf16_t *prw, *pgla, *pgate; float *shift_p, *shift_s;
    __device__ __forceinline__ void operator()(const f32x4 (&acc)[2][2][4][2], const Unit& u, int wr, int wc, int fr, int fq) const {
        asm volatile("" : "+v"(fr), "+v"(fq));
        bf16_t* base; int ld, colt;
        if (u.pn < 7) { base = prw; ld = NPRW; colt = u.pn * 256; } else if (u.pn < 14) { base = pgla; ld = NPGLA; colt = (u.pn - 7) * 256; } else { base = pgate; ld = NGATE; colt = (u.pn - 14) * 256; }
        const int row0 = u.pm * 256 + wr * 64 + fr, col0 = colt + wc * 32 + 8 * fq;
#pragma unroll
        for (int ai = 0; ai < 2; ++ai)
#pragma unroll
            for (int m = 0; m < 4; ++m) {
                const int r = row0 + ai * 128 + m * 16; bf16_t* rowp = base + (size_t)r * ld + col0;
#pragma unroll
                for (int bj = 0; bj < 2; ++bj) { const f32x4 v0 = acc[ai][bj][m][0], v1 = acc[ai][bj][m][1]; u32x4 w; w.x = pk2(v0[0], v0[1]); w.y = pk2(v0[2], v0[3]); w.z = pk2(v1[0], v1[1]); w.w = pk2(v1[2], v1[3]); *(u32x4*)(rowp + bj * 128) = w; }
            }
    }
};
template <bool FIRST> struct EpiGate {
    static constexpr bool PERM = true, AFTER_DRAIN = false;
    bf16_t* merged; const bf16_t* gate;
    __device__ __forceinline__ void operator()(const f32x4 (&acc)[2][2][4][2], const Unit& u, int wr, int wc, int fr, int fq) const {
        asm volatile("" : "+v"(fr), "+v"(fq));
        const int row0 = u.pm * 256 + wr * 64 + fr, col0 = u.pn * 256 + wc * 32 + 8 * fq;
#pragma unroll
        for (int ai = 0; ai < 2; ++ai) {
            u32x4 gr[4][2], pr[4][2];
#pragma unroll
            for (int m = 0; m < 4; ++m)
#pragma unroll
                for (int bj = 0; bj < 2; ++bj) { const size_t r = (size_t)(row0 + ai * 128 + m * 16); const int c = col0 + bj * 128; gr[m][bj] = *(const u32x4*)(gate + r * NGATE + c); if (!FIRST) pr[m][bj] = *(const u32x4*)(merged + r * DM + c); }
#pragma unroll
            for (int m = 0; m < 4; ++m)
#pragma unroll
                for (int bj = 0; bj < 2; ++bj) { const size_t r = (size_t)(row0 + ai * 128 + m * 16); const int c = col0 + bj * 128; float g[8], v[8]; unpack8(gr[m][bj], g);
                    const f32x4 v0 = acc[ai][bj][m][0], v1 = acc[ai][bj][m][1];
#pragma unroll
                    for (int i = 0; i < 4; ++i) { v[i] = v0[i] * fsigmoid(g[i]); v[4 + i] = v1[i] * fsigmoid(g[4 + i]); }
                    if (!FIRST) { float p[8]; unpack8(pr[m][bj], p);
#pragma unroll
                        for (int i = 0; i < 8; ++i) v[i] += p[i]; }
                    *(u32x4*)(merged + r * DM + c) = pack8(v); }
        }
    }
};
struct EpiX1 {
    static constexpr bool PERM = true, AFTER_DRAIN = false;
    const float *xp, *xs; float* x1; bf16_t* x1b; float* rowss;
    __device__ __forceinline__ void operator()(const f32x4 (&acc)[2][2][4][2], const Unit& u, int wr, int wc, int fr, int fq) const {
        asm volatile("" : "+v"(fr), "+v"(fq));
        const int row0 = u.pm * 256 + wr * 64 + fr, col0 = u.pn * 256 + wc * 32 + 8 * fq;
#pragma unroll
        for (int ai = 0; ai < 2; ++ai) {
            f32x4 xa[4][2][2];
#pragma unroll
            for (int m = 0; m < 4; ++m) { const int r = row0 + ai * 128 + m * 16; const float* xr = (r < MP ? xp + (size_t)r * DM : xs + (size_t)(r - MP) * DM);
#pragma unroll
                for (int bj = 0; bj < 2; ++bj) { xa[m][bj][0] = *(const f32x4*)(xr + col0 + bj * 128); xa[m][bj][1] = *(const f32x4*)(xr + col0 + bj * 128 + 4); } }
#pragma unroll
            for (int m = 0; m < 4; ++m) { const int r = row0 + ai * 128 + m * 16; float ssq = 0.f;
#pragma unroll
                for (int bj = 0; bj < 2; ++bj) { const int c = col0 + bj * 128; const f32x4 a = xa[m][bj][0] + acc[ai][bj][m][0], b = xa[m][bj][1] + acc[ai][bj][m][1];
                    ssq += (a[0] * a[0] + a[1] * a[1]) + (a[2] * a[2] + a[3] * a[3]) + (b[0] * b[0] + b[1] * b[1]) + (b[2] * b[2] + b[3] * b[3]);
                    float* o = x1 + (size_t)r * DM + c; *(f32x4*)o = a; *(f32x4*)(o + 4) = b;
                    u32x4 w; w.x = pk2(a[0], a[1]); w.y = pk2(a[2], a[3]); w.z = pk2(b[0], b[1]); w.w = pk2(b[2], b[3]); *(u32x4*)(x1b + (size_t)r * DM + c) = w; }
                ssq += __shfl_xor(ssq, 16); ssq += __shfl_xor(ssq, 32);
                if (fq == 0) atomicAdd(rowss + r, ssq); }
        }
    }
};
struct EpiX2 {
    static constexpr bool PERM = true, AFTER_DRAIN = false;
    float* x; float* xd;
    __device__ __forceinline__ void operator()(const f32x4 (&acc)[2][2][4][2], const Unit& u, int wr, int wc, int fr, int fq) const {
        asm volatile("" : "+v"(fr), "+v"(fq));
        const int row0 = u.pm * 256 + wr * 64 + fr, col0 = u.pn * 256 + wc * 32 + 8 * fq;
#pragma unroll
        for (int ai = 0; ai < 2; ++ai) {
            f32x4 xa[4][2][2];
#pragma unroll
            for (int m = 0; m < 4; ++m)
#pragma unroll
                for (int bj = 0; bj < 2; ++bj) { const float* o = x + (size_t)(row0 + ai * 128 + m * 16) * DM + col0 + bj * 128; xa[m][bj][0] = *(const f32x4*)o; xa[m][bj][1] = *(const f32x4*)(o + 4); }
#pragma unroll
            for (int m = 0; m < 4; ++m)
#pragma unroll
                for (int bj = 0; bj < 2; ++bj) { float* o = xd + (size_t)(row0 + ai * 128 + m * 16) * DM + col0 + bj * 128; *(f32x4*)o = xa[m][bj][0] + acc[ai][bj][m][0]; *(f32x4*)(o + 4) = xa[m][bj][1] + acc[ai][bj][m][1]; }
        }
    }
};
__device__ __forceinline__ float gelu_gate(float g, float v) { const float t = g * (1.f + 0.044715f * g * g) * 1.5957691216057308f; return g * fsigmoid(t) * v; }
struct EpiU {
    static constexpr bool PERM = true, AFTER_DRAIN = false;
    const float* rowss; bf16_t *U, *uh; float *conv_p, *conv_s;
    __device__ __forceinline__ void operator()(const f32x4 (&acc)[2][2][4][2], const Unit& u, int wr, int wc, int fr, int fq) const {
        asm volatile("" : "+v"(fr), "+v"(fq));
        const int row0 = u.pm * 256 + wr * 64 + fr, col0 = u.pn * 256 + wc * 32 + 8 * fq;
#pragma unroll
        for (int ai = 0; ai < 2; ++ai)
#pragma unroll
            for (int m = 0; m < 4; ++m) { const int r = row0 + ai * 128 + m * 16; const float rs = rsqrtf(rowss[r] * (1.f / DM) + NORM_EPS);
#pragma unroll
                for (int bj = 0; bj < 2; ++bj) { const int c = col0 + bj * 128; const f32x4 v0 = acc[ai][bj][m][0] * rs, v1 = acc[ai][bj][m][1] * rs;
                    u32x4 w; w.x = pk2(v0[0], v0[1]); w.y = pk2(v0[2], v0[3]); w.z = pk2(v1[0], v1[1]); w.w = pk2(v1[2], v1[3]);
                    *(u32x4*)(U + (size_t)r * F2 + c) = w;
                    if (m == 3 && fr >= 14 && r < MP) { *(u32x4*)(uh + ((size_t)(r >> 6) * 2 + (fr - 14)) * F2 + c) = w;
                        if ((r & 2047) >= 2046) { float* cp = conv_p + ((size_t)(r >> 11) * 2 + (fr - 14)) * F2 + c; *(f32x4*)cp = v0; *(f32x4*)(cp + 4) = v1; } }
                    if (r >= MP && (fr & 7) >= 6) { float* cp = conv_s + ((size_t)((r - MP) >> 3) * 2 + ((fr & 7) - 6)) * F2 + c; *(f32x4*)cp = v0; *(f32x4*)(cp + 4) = v1; } } }
    }
};

struct EpiAct {
    static constexpr bool PERM = true, AFTER_DRAIN = false;
    const float *rowss, *convw, *convb; bf16_t *act, *uh, *us; float *conv_p, *conv_s; LAS float* ringbase;
    __device__ __forceinline__ void operator()(const f32x4 (&acc)[2][2][4][2], const Unit& u, int wr_, int wc_, int fr_, int fq_) const {
        int wr = wr_, wc = wc_, fr = fr_, fq = fq_;
        asm volatile("" : "+v"(fr), "+v"(fq)); asm volatile("" : "+s"(wr), "+s"(wc));
        const bool sample = u.pm >= 64;
        const int jc0 = u.pn * 128 + wc * 32 + 8 * fq;
        LAS float* ring = ringbase + (wr * 4 + wc) * 512;
#pragma unroll
        for (int ai = 0; ai < 2; ++ai) {
            const int rbase = u.pm * 256 + ai * 128 + wr * 64, grp = rbase >> 6;
#pragma unroll
            for (int m = 0; m < 4; ++m) {
                const int row = rbase + 16 * m + fr;
                const bool wuh = !sample && ((m == 0 && fr < 2) || (m == 3 && fr >= 14)), wus = sample && (fr & 7) < 2, wcs = sample && (fr & 7) >= 6;
                if (wuh || wus || wcs) {
                    const float rsm = rsqrtf(rowss[row] * (1.f / DM) + NORM_EPS);
#pragma unroll
                    for (int bj = 0; bj < 2; ++bj) { const f32x4 v0 = acc[ai][bj][m][0] * rsm, v1 = acc[ai][bj][m][1] * rsm;
                        if (wcs) { float* cp = conv_s + ((size_t)((row - MP) >> 3) * 2 + ((fr & 7) - 6)) * F2 + bj * FF + jc0; *(f32x4*)cp = v0; *(f32x4*)(cp + 4) = v1; }
                        else { u32x4 w; w.x = pk2(v0[0], v0[1]); w.y = pk2(v0[2], v0[3]); w.z = pk2(v1[0], v1[1]); w.w = pk2(v1[2], v1[3]);
                            bf16_t* dst = wuh ? uh + ((size_t)grp * 4 + (m == 0 ? fr : fr - 12)) * F2 : us + ((size_t)((row - MP) >> 3) * 2 + (fr & 7)) * F2;
                            *(u32x4*)(dst + bj * FF + jc0) = w;
                            if (wuh && m == 3 && (grp & 31) == 31) { float* cp = conv_p + ((size_t)(rbase >> 11) * 2 + (fr - 14)) * F2 + bj * FF + jc0; *(f32x4*)cp = v0; *(f32x4*)(cp + 4) = v1; } } }
                }
            }
        }
        asm volatile("" ::: "memory");
        float rsq[2][4];
#pragma unroll
        for (int ai = 0; ai < 2; ++ai)
#pragma unroll
            for (int m = 0; m < 4; ++m) rsq[ai][m] = rsqrtf(rowss[u.pm * 256 + ai * 128 + wr * 64 + 16 * m + fr] * (1.f / DM) + NORM_EPS);
#define EPIACT_STEP(AI, N) do { const int rbase = u.pm * 256 + (AI) * 128 + wr * 64; \
            _Pragma("unroll") for (int m = 0; m < 4; ++m) { const float rsm = rsq[AI][m]; \
                const f32x4 xv = acc[AI][0][m][N] * rsm, xg = acc[AI][1][m][N] * rsm; const int idx = (m & 1) * 16 + fr; \
                asm volatile("" ::: "memory"); *(LAS f32x4*)(ring + idx * 16 + fq * 4) = xv; *(LAS f32x4*)(ring + 4096 + idx * 16 + fq * 4) = xg; asm volatile("" ::: "memory");     \
                const f32x4 p1v = *(const LAS f32x4*)(ring + ((idx + 31) & 31) * 16 + fq * 4), p2v = *(const LAS f32x4*)(ring + ((idx + 30) & 31) * 16 + fq * 4); \
                const f32x4 p1g = *(const LAS f32x4*)(ring + 4096 + ((idx + 31) & 31) * 16 + fq * 4), p2g = *(const LAS f32x4*)(ring + 4096 + ((idx + 30) & 31) * 16 + fq * 4); \
                const f32x4 cv = cbv + w0v * p2v + w1v * p1v + w2v * xv, cg = cbg + w0g * p2g + w1g * p1g + w2g * xg; \
                const bool fix = sample ? ((fr & 7) < 2) : (m == 0 && fr < 2); \
                if (!fix) { u32x2 w; w.x = pk2(gelu_gate(cg[0], cv[0]), gelu_gate(cg[1], cv[1])); w.y = pk2(gelu_gate(cg[2], cv[2]), gelu_gate(cg[3], cv[3])); \
                    *(u32x2*)(act + (size_t)(rbase + 16 * m + fr) * FF + jc0 + 4 * (N)) = w; } } } while (0)
#define EPIACT_N(N) do { const int col4 = jc0 + 4 * (N); \
            const f32x4 w0v = *(const f32x4*)(convw + col4), w1v = *(const f32x4*)(convw + F2 + col4), w2v = *(const f32x4*)(convw + 2 * F2 + col4), cbv = *(const f32x4*)(convb + col4); \
            const f32x4 w0g = *(const f32x4*)(convw + FF + col4), w1g = *(const f32x4*)(convw + F2 + FF + col4), w2g = *(const f32x4*)(convw + 2 * F2 + FF + col4), cbg = *(const f32x4*)(convb + FF + col4); \
            EPIACT_STEP(0, N); EPIACT_STEP(1, N); asm volatile("" ::: "memory"); } while (0)
        EPIACT_N(0); EPIACT_N(1);
#undef EPIACT_N
#undef EPIACT_STEP
    }
};

template <class EF> __device__ __forceinline__ void tail_gemm(LAS unsigned char* lds, const bf16_t* Amat, int lda, const bf16_t* Bt, int K, const pg8::StaticOrder& S, int wave, int lane, const EF& ef) {
    const int l15 = lane & 15, q = lane >> 4, ntail = S.nwg - S.limit, nk = K / 256;
    LAS float* red = (LAS float*)lds;
    for (int item = blockIdx.x; item < ntail * 16; item += gridDim.x) {
        pg8::Unit u; S.unit_of(S.limit + (item >> 4), u);
        const int r0 = u.pm * 256 + (item & 15) * 16, c0 = u.pn * 256;
        const bf16_t* ap = Amat + (size_t)(r0 + l15) * lda + 8 * q + 32 * nk * wave; const bf16_t* bp = Bt + (size_t)(c0 + l15) * K + 8 * q + 32 * nk * wave;
        f32x4 acc[16];
#pragma unroll
        for (int n = 0; n < 16; ++n) acc[n] = (f32x4){0.f, 0.f, 0.f, 0.f};
#pragma unroll 2
        for (int ks = 0; ks < nk; ++ks) {
            const bf16x8 a = *(const bf16x8*)(ap + 32 * ks); bf16x8 b[16];
#pragma unroll
            for (int n = 0; n < 16; ++n) b[n] = *(const bf16x8*)(bp + (size_t)(16 * n) * K + 32 * ks);
#pragma unroll
            for (int n = 0; n < 16; ++n) acc[n] = __builtin_amdgcn_mfma_f32_16x16x32_bf16(a, b[n], acc[n], 0, 0, 0);
        }
        __syncthreads();
#pragma unroll
        for (int n = 0; n < 16; ++n) *(LAS f32x4*)(red + ((wave * 16 + n) * 64 + lane) * 4) = acc[n];
        __syncthreads();
        f32x4 s0 = {0.f, 0.f, 0.f, 0.f}, s1 = s0;
#pragma unroll
        for (int w2 = 0; w2 < 8; ++w2) { s0 += *(const LAS f32x4*)(red + ((w2 * 16 + 2 * wave) * 64 + lane) * 4); s1 += *(const LAS f32x4*)(red + ((w2 * 16 + 2 * wave + 1) * 64 + lane) * 4); }
        ef(r0 + 4 * q, c0 + 32 * wave + l15, s0, s1);
    }
    __syncthreads();
}
struct TfGate { bool first; bf16_t* merged; const bf16_t* gate;
    __device__ __forceinline__ void operator()(int row, int col, f32x4 a0, f32x4 a1) const {
#pragma unroll
        for (int i = 0; i < 4; ++i)
#pragma unroll
            for (int n = 0; n < 2; ++n) { const size_t r = (size_t)(row + i); const int c = col + 16 * n; float v = (n ? a1[i] : a0[i]) * fsigmoid(bf2f(gate[r * NGATE + c]));
                if (!first) v += bf2f(merged[r * DM + c]); merged[r * DM + c] = (bf16_t)f2bf(v); } } };
struct TfX1 { const float *xp, *xs; float* x1; bf16_t* x1b; float* rowss;
    __device__ __forceinline__ void operator()(int row, int col, f32x4 a0, f32x4 a1) const {
#pragma unroll
        for (int i = 0; i < 4; ++i) { const int r = row + i; const float* xr = (r < MP ? xp + (size_t)r * DM : xs + (size_t)(r - MP) * DM);
            const float v0 = xr[col] + a0[i], v1 = xr[col + 16] + a1[i];
            x1[(size_t)r * DM + col] = v0; x1[(size_t)r * DM + col + 16] = v1; x1b[(size_t)r * DM + col] = (bf16_t)f2bf(v0); x1b[(size_t)r * DM + col + 16] = (bf16_t)f2bf(v1);
            const float ss = row16_allsum(v0 * v0 + v1 * v1); if ((col & 15) == 0) atomicAdd(rowss + r, ss); } } };
struct TfX2 { float* x; float* xd;
    __device__ __forceinline__ void operator()(int row, int col, f32x4 a0, f32x4 a1) const {
#pragma unroll
        for (int i = 0; i < 4; ++i) { const size_t off = (size_t)(row + i) * DM + col; xd[off] = x[off] + a0[i]; xd[off + 16] = x[off + 16] + a1[i]; } } };

template <int MODE> __device__ __forceinline__ int map_col(int R) {
    if (MODE == 1) { if (R < 1792) return R; if (R < 3584) return (R - 1792 < 1552) ? R : -1; return R - 240; }
    if (MODE == 2) { return ((R >> 7) & 1) * FF + ((R >> 8) << 7) + (R & 127); }
    return R;
}
template <int MODE> __device__ __forceinline__ void tr_item(const float* __restrict__ W, int K, int Nsrc, int Ndst, bf16_t* WT, const float* kscale, LAS float* scr, int item, int lane) {
    const int nblk = Ndst >> 5, kb = item / nblk, nb = item - kb * nblk, k0 = kb << 6, n0 = nb << 5;
    const int col = map_col<MODE>(n0 + (lane & 31));
    float tv[32];
#pragma unroll
    for (int i = 0; i < 32; ++i) { const int kk = 2 * i + (lane >> 5); tv[i] = (col >= 0) ? W[(size_t)(k0 + kk) * Nsrc + col] : 0.f; }
#pragma unroll
    for (int i = 0; i < 32; ++i) { const int kk = 2 * i + (lane >> 5); float v = tv[i]; if (kscale) v *= kscale[k0 + kk]; scr[kk * 33 + (lane & 31)] = v; }
    LDS_WAIT();
    const int c = lane & 7;
#pragma unroll
    for (int j = 0; j < 4; ++j) { const int n = (lane >> 3) + 8 * j; const LAS float* s = scr + (8 * c) * 33 + n;
        u32x4 o; o.x = pk2(s[0 * 33], s[1 * 33]); o.y = pk2(s[2 * 33], s[3 * 33]); o.z = pk2(s[4 * 33], s[5 * 33]); o.w = pk2(s[6 * 33], s[7 * 33]);
        *(u32x4*)(WT + (size_t)(n0 + n) * K + k0 + 8 * c) = o; }
    LDS_WAIT();
}
__device__ __forceinline__ void p0_prologue(const Args& A, LAS unsigned char* lds, int gw, int NGW, int wave, int lane) {
    LAS float* scr = (LAS float*)(lds + wave * 16384);
    unsigned char* ws = A.ws;
    constexpr int I_IN = 16 * (NIN / 32), I_UP = 16 * (F2 / 32), I_DN = 44 * 32, I_O = 16 * 32, I_OA = 8 * 32, I_W2 = 16, I_G2 = 2 * 16;
    constexpr int NITEMS = I_IN + I_UP + I_DN + I_O + 2 * I_OA + 2 * I_W2 + I_G2;
    for (int it = gw; it < NITEMS; it += NGW) {
        int r = it;
        if (r < I_IN) { tr_item<1>(A.in[IN_W_IN], 1024, 5392, NIN, (bf16_t*)(ws + OFF_WIN), nullptr, scr, r, lane); continue; } r -= I_IN;
        if (r < I_UP) { tr_item<2>(A.in[IN_WUP], 1024, F2, F2, (bf16_t*)(ws + OFF_WUP), A.in[IN_NORM_FFN], scr, r, lane); continue; } r -= I_UP;
        if (r < I_DN) { tr_item<0>(A.in[IN_WDN], FF, 1024, 1024, (bf16_t*)(ws + OFF_WDN), nullptr, scr, r, lane); continue; } r -= I_DN;
        if (r < I_O) { tr_item<0>(A.in[IN_WO], 1024, 1024, 1024, (bf16_t*)(ws + OFF_WO), nullptr, scr, r, lane); continue; } r -= I_O;
        if (r < I_OA) { tr_item<0>(A.in[IN_WOA], 512, 1024, 1024, (bf16_t*)(ws + OFF_WOA), nullptr, scr, r, lane); continue; } r -= I_OA;
        if (r < I_OA) { tr_item<0>(A.in[IN_WOB], 512, 1024, 1024, (bf16_t*)(ws + OFF_WOB), nullptr, scr, r, lane); continue; } r -= I_OA;
        if (r < I_W2) { tr_item<0>(A.in[IN_W2], 64, 512, 512, (bf16_t*)(ws + OFF_W2T), nullptr, scr, r, lane); continue; } r -= I_W2;
        if (r < I_W2) { tr_item<0>(A.in[IN_A2], 64, 512, 512, (bf16_t*)(ws + OFF_A2T), nullptr, scr, r, lane); continue; } r -= I_W2;
        tr_item<0>(A.in[IN_G2], 128, 512, 512, (bf16_t*)(ws + OFF_G2T), nullptr, scr, r, lane);
    }
    bf16_t* H = (bf16_t*)((unsigned char*)A.out + OUTB_H);
    const float* gm = A.in[IN_NORM_MIX];
    for (int m = gw; m < M; m += 2 * NGW) {
        const int m2 = m + NGW; const bool has2 = m2 < M;
        const f32x4* xr = (const f32x4*)xrow_ptr(A, m) + lane; const f32x4* xr2 = (const f32x4*)xrow_ptr(A, has2 ? m2 : m) + lane; f32x4 v[4], w[4]; float s = 0.f, s2 = 0.f;
#pragma unroll
        for (int j = 0; j < 4; ++j) { v[j] = xr[64 * j]; w[j] = xr2[64 * j]; }
#pragma unroll
        for (int j = 0; j < 4; ++j) { s += (v[j].x * v[j].x + v[j].y * v[j].y) + (v[j].z * v[j].z + v[j].w * v[j].w); s2 += (w[j].x * w[j].x + w[j].y * w[j].y) + (w[j].z * w[j].z + w[j].w * w[j].w); }
        const float rstd = rsqrtf(wave_allsum(s) * (1.f / DM) + NORM_EPS), rstd2 = rsqrtf(wave_allsum(s2) * (1.f / DM) + NORM_EPS);
        u32x2* o8 = (u32x2*)(H + (size_t)m * DM) + lane; u32x2* o82 = (u32x2*)(H + (size_t)m2 * DM) + lane;
#pragma unroll
        for (int j = 0; j < 4; ++j) { const f32x4 g = *((const f32x4*)gm + lane + 64 * j); u32x2 p; p.x = pk2(v[j].x * rstd * g.x, v[j].y * rstd * g.y); p.y = pk2(v[j].z * rstd * g.z, v[j].w * rstd * g.w); o8[64 * j] = p;
            if (has2) { u32x2 p2; p2.x = pk2(w[j].x * rstd2 * g.x, w[j].y * rstd2 * g.y); p2.y = pk2(w[j].z * rstd2 * g.z, w[j].w * rstd2 * g.w); o82[64 * j] = p2; } }
    }
    float* rowss = (float*)(ws + OFF_ROWSS);
    for (int i = gw * 64 + lane; i < M; i += NGW * 64) rowss[i] = 0.f;
}

__device__ __forceinline__ void prw_mixed8(const Args& A, const bf16_t* PRW, int r, int col0, float (&xs)[8]) {
    float cur[8], prev[8];
    ld8bf(PRW + (size_t)r * NPRW + col0, cur);
    const bool first = (r < MP) ? ((r & 2047) == 0) : (((r - MP) & 7) == 0);
    if (!first) ld8bf(PRW + (size_t)(r - 1) * NPRW + col0, prev);
    else if (r < MP) {
#pragma unroll
        for (int i = 0; i < 8; ++i) prev[i] = 0.f;
    } else ld8f(A.in[IN_ST_SHIFT] + (size_t)((r - MP) >> 3) * 1792 + col0, prev);
    float mu[8]; ld8f(A.in[IN_MU] + col0, mu);
#pragma unroll
    for (int i = 0; i < 8; ++i) xs[i] = cur[i] + (prev[i] - cur[i]) * mu[i];
}
template <int ACT> __device__ __forceinline__ bf16x8 afrag(const Args& A, const bf16_t* PRW, int r, int col0) {
    float xs[8]; prw_mixed8(A, PRW, r, col0, xs);
#pragma unroll
    for (int i = 0; i < 8; ++i) xs[i] = ACT == 1 ? ftanh(xs[i]) : (ACT == 2 ? fsigmoid(xs[i]) : xs[i]);
    return __builtin_bit_cast(bf16x8, pack8(xs));
}
__device__ __forceinline__ void p2a_lora(const Args& A, LAS unsigned char* lds, int gw, int NGW, int wave, int lane) {
    const bf16_t* PRW = (const bf16_t*)(A.ws + OFF_PRW);
    const bf16_t *W2T = (const bf16_t*)(A.ws + OFF_W2T), *A2T = (const bf16_t*)(A.ws + OFF_A2T), *G2T = (const bf16_t*)(A.ws + OFF_G2T);
    bf16_t *EW = (bf16_t*)((unsigned char*)A.out + OUTB_EW), *AARR = (bf16_t*)((unsigned char*)A.out + OUTB_AARR), *G = (bf16_t*)(A.ws + OFF_G);
    for (int i = gw * 64 + lane; i < 136 * 224; i += NGW * 64) { const int sq = i / 224, c8 = (i - sq * 224) * 8; const int r = sq < 8 ? sq * 2048 + 2047 : MP + (sq - 8) * 8 + 7;
        float v[8]; ld8bf(PRW + (size_t)r * NPRW + c8, v); float* dst = (sq < 8 ? A.out + OUT_SHIFT_P + (size_t)sq * 1792 : A.out + OUT_SHIFT_S + (size_t)(sq - 8) * 1792) + c8;
        *(f32x4*)dst = (f32x4){v[0], v[1], v[2], v[3]}; *(f32x4*)(dst + 4) = (f32x4){v[4], v[5], v[6], v[7]}; }
    const int l15 = lane & 15, kq = lane >> 4;
    LAS bf16_t* acts = (LAS bf16_t*)lds; const int tid = wave * 64 + lane;
    for (int tile = blockIdx.x; tile < M / 16; tile += gridDim.x) {
        const int h = wave, t0 = tile * 16;
        { const int tt = tid >> 5, cg = tid & 31; float xs[8]; prw_mixed8(A, PRW, t0 + tt, 1536 + 8 * cg, xs);
#pragma unroll
          for (int i = 0; i < 8; ++i) xs[i] = cg < 8 ? ftanh(xs[i]) : (cg < 16 ? xs[i] : fsigmoid(xs[i]));
          __syncthreads();
          *(LAS u32x4*)(acts + tt * 264 + 8 * cg) = pack8(xs); }
        __syncthreads();
        bf16x8 aw[2], aa[2], ag[4];
#pragma unroll
        for (int ks = 0; ks < 2; ++ks) { aw[ks] = *(const LAS bf16x8*)(acts + l15 * 264 + ks * 32 + kq * 8); aa[ks] = *(const LAS bf16x8*)(acts + l15 * 264 + 64 + ks * 32 + kq * 8); }
#pragma unroll
        for (int ks = 0; ks < 4; ++ks) ag[ks] = *(const LAS bf16x8*)(acts + l15 * 264 + 128 + ks * 32 + kq * 8);
        f32x4 cwv[4], cav[4], cgg[4];
#pragma unroll
        for (int nt = 0; nt < 4; ++nt) {
            const int c = 64 * h + 16 * nt + l15;
            f32x4 cw = {0.f, 0.f, 0.f, 0.f}, ca = cw, cgv = cw;
#pragma unroll
            for (int ks = 0; ks < 2; ++ks) {
                const bf16x8 bw = *(const bf16x8*)(W2T + (size_t)c * 64 + ks * 32 + kq * 8), ba = *(const bf16x8*)(A2T + (size_t)c * 64 + ks * 32 + kq * 8);
                cw = __builtin_amdgcn_mfma_f32_16x16x32_bf16(bw, aw[ks], cw, 0, 0, 0); ca = __builtin_amdgcn_mfma_f32_16x16x32_bf16(ba, aa[ks], ca, 0, 0, 0); }
#pragma unroll
            for (int ks = 0; ks < 4; ++ks) { const bf16x8 bg = *(const bf16x8*)(G2T + (size_t)c * 128 + ks * 32 + kq * 8); cgv = __builtin_amdgcn_mfma_f32_16x16x32_bf16(bg, ag[ks], cgv, 0, 0, 0); }
            cwv[nt] = cw; cav[nt] = ca; cgg[nt] = cgv;
        }
#pragma unroll
        for (int nt = 0; nt < 4; ++nt) {
            const int c4 = 64 * h + 16 * nt + 4 * kq; const size_t o = (size_t)(t0 + l15) * 512 + c4;
            const f32x4 w0v = *(const f32x4*)(A.in[IN_W0] + c4), a0v = *(const f32x4*)(A.in[IN_A0] + c4);
            float ew[4], av[4];
#pragma unroll
            for (int i = 0; i < 4; ++i) { ew[i] = 0.6065306597f * fsigmoid(w0v[i] + cwv[nt][i]); av[i] = fsigmoid(a0v[i] + cav[nt][i]); }
            u32x2 w; w.x = pk2(ew[0], ew[1]); w.y = pk2(ew[2], ew[3]); *(u32x2*)(EW + o) = w;
            w.x = pk2(av[0], av[1]); w.y = pk2(av[2], av[3]); *(u32x2*)(AARR + o) = w;
            w.x = pk2(cgg[nt][0], cgg[nt][1]); w.y = pk2(cgg[nt][2], cgg[nt][3]); *(u32x2*)(G + o) = w;
        }
    }
}

typedef short bf16x4 __attribute__((ext_vector_type(4)));
#define MFMA32(a, b, c) __builtin_amdgcn_mfma_f32_16x16x32_bf16(a, b, c, 0, 0, 0)
#define MFMA16(a, b, c) __builtin_amdgcn_mfma_f32_16x16x16bf16_1k(a, b, c, 0, 0, 0)
constexpr int SP = 72;
constexpr size_t OFF_RLT = 240 * MiB;
constexpr size_t OFF_GL = 1 * MiB, OFF_GG = 8 * MiB;
static_assert(OFF_RLT + (size_t)448 * 32768 <= 256 * MiB && OFF_GL + (size_t)224 * 32768 <= OFF_GG && OFF_GG + 224 * 256 <= OFF_WUP, "ws map (scan)");
__device__ __forceinline__ bf16x4 bf4(f32x4 v) { u32x2 w; w.x = pk2(v[0], v[1]); w.y = pk2(v[2], v[3]); return __builtin_bit_cast(bf16x4, w); }
__device__ __forceinline__ bf16x8 afr(const LAS bf16_t* X, int l15, int q, int ks) { const LAS bf16_t* p = X + l15 * SP + 32 * ks + 4 * q; const u32x2 lo = *(const LAS u32x2*)p, hi = *(const LAS u32x2*)(p + 16); u32x4 w; w.x = lo.x; w.y = lo.y; w.z = hi.x; w.w = hi.y; return __builtin_bit_cast(bf16x8, w); }
__device__ __forceinline__ bf16x8 hfrag(const f32x4& lo, const f32x4& hi) { u32x4 w; w.x = pk2(lo[0], lo[1]); w.y = pk2(lo[2], lo[3]); w.z = pk2(hi[0], hi[1]); w.w = pk2(hi[2], hi[3]); return __builtin_bit_cast(bf16x8, w); }
__device__ __forceinline__ f32x4 maskc(f32x4 v, int q, int l15, bool rows_lt_col, bool incl) {
#pragma unroll
    for (int i = 0; i < 4; ++i) { const int R = 4 * q + i; const bool keep = rows_lt_col ? (incl ? R <= l15 : R < l15) : (incl ? l15 <= R : l15 < R); v[i] = keep ? v[i] : 0.f; }
    return v;
}
template <bool GLA, int VP> __device__ __forceinline__ void scan_matrix_part(const LAS bf16_t* AT, const LAS bf16_t* RT, const LAS bf16_t* BT, const LAS bf16_t* KT, const LAS bf16_t* VS, const LAS float* GC, bf16_t* OUTP, int l15, int q, int sl, bool use_v, bool write_o, int rowb, int nv, f32x4 (&H)[4]) {
    const bf16x8 hb0 = hfrag(H[0], H[1]), hb1 = hfrag(H[2], H[3]);
    const bf16x8 rt0 = afr(RT, l15, q, 0), rt1 = afr(RT, l15, q, 1), kt0 = afr(KT, l15, q, 0), kt1 = afr(KT, l15, q, 1);
    const f32x4 z4 = {0.f, 0.f, 0.f, 0.f};
    bf16x4 vb = {0, 0, 0, 0};
    if (use_v) { const LAS bf16_t* vp = VS + (4 * q) * VP + 16 * sl + l15; u32x2 w; w.x = (unsigned)vp[0] | ((unsigned)vp[VP] << 16); w.y = (unsigned)vp[2 * VP] | ((unsigned)vp[3 * VP] << 16); vb = __builtin_bit_cast(bf16x4, w); }
    f32x4 O = MFMA32(rt0, hb0, z4); O = MFMA32(rt1, hb1, O);
    f32x4 U = z4;
    if (!GLA) {
        const bf16x8 at0 = afr(AT, l15, q, 0), at1 = afr(AT, l15, q, 1), bt0 = afr(BT, l15, q, 0), bt1 = afr(BT, l15, q, 1);
        f32x4 P = MFMA32(at0, bt0, z4); P = MFMA32(at1, bt1, P); P = maskc(P, q, l15, false, false);
        f32x4 PT = MFMA32(bt0, at0, z4); PT = MFMA32(bt1, at1, PT); PT = maskc(PT, q, l15, true, false);
        f32x4 nrbT = MFMA32(bt0, rt0, z4); nrbT = MFMA32(bt1, rt1, nrbT); nrbT = maskc(nrbT, q, l15, true, true);
        U = MFMA32(at0, hb0, z4); U = MFMA32(at1, hb1, U);
        if (use_v) { f32x4 makT = MFMA32(kt0, at0, z4); makT = MFMA32(kt1, at1, makT); makT = maskc(makT, q, l15, true, false); U = MFMA16(bf4(makT), vb, U); }
#pragma unroll
        for (int it = 0; it < 4; ++it) {
            U = MFMA16(bf4(PT), bf4(U), U);
            if (it < 3) { const f32x4 Pn = MFMA16(bf4(PT), bf4(P), z4), PTn = MFMA16(bf4(P), bf4(PT), z4); P = Pn; PT = PTn; }
        }
        O = MFMA16(bf4(nrbT), bf4(U), O);
    }
    if (use_v) { f32x4 nrkT = MFMA32(kt0, rt0, z4); nrkT = MFMA32(kt1, rt1, nrkT); nrkT = maskc(nrkT, q, l15, true, true); O = MFMA16(bf4(nrkT), vb, O); }
    if (write_o) {
#pragma unroll
        for (int i = 0; i < 4; ++i) if (4 * q + i < nv) OUTP[(size_t)(rowb + 4 * q + i) * 512] = (bf16_t)f2bf(O[i]);
    }
    const bf16x4 ub = bf4(U);
#pragma unroll
    for (int kt = 0; kt < 4; ++kt) {
        const f32x4 g4 = *(const LAS f32x4*)(GC + 16 * kt + 4 * q); const float gk = GC[16 * kt + l15];
        f32x4 acc = H[kt] * g4;
        if (!GLA) { const LAS bf16_t* p = BT + (4 * q) * SP + 16 * kt + l15; u32x2 w; w.x = pk2(bf2f(p[0]) * gk, bf2f(p[SP]) * gk); w.y = pk2(bf2f(p[2 * SP]) * gk, bf2f(p[3 * SP]) * gk); acc = MFMA16(__builtin_bit_cast(bf16x4, w), ub, acc); }
        if (use_v) { const LAS bf16_t* p = KT + (4 * q) * SP + 16 * kt + l15; u32x2 w; w.x = pk2(bf2f(p[0]) * gk, bf2f(p[SP]) * gk); w.y = pk2(bf2f(p[2 * SP]) * gk, bf2f(p[3 * SP]) * gk); acc = MFMA16(__builtin_bit_cast(bf16x4, w), vb, acc); }
        H[kt] = acc;
    }
}
constexpr int GL_RT = 2304, GL_BT = 4608, GL_KT = 6912, GL_VS = 9216, GL_GC = 13568, GL_EG = 13824, GL_BYTES = 26624;
template <bool GLA, int W> __device__ __forceinline__ void scan_block(const Args& A, LAS unsigned char* gl, int lane, int wg, int row0, int nsub, int nvalid, int first_kind, int bsamp, int hh, int sl, bool use_v, bool write_o, f32x4 (&H)[4], float& cumtot) {
    constexpr int TPW = 16 / W, VP = GLA ? 136 : 72;
    const int c = lane, l15 = lane & 15, q = lane >> 4, t0 = wg * TPW;
    const bf16_t* PRW = (const bf16_t*)(A.ws + OFF_PRW); const bf16_t* PGLA = (const bf16_t*)(A.ws + OFF_PGLA);
    const bf16_t *EW = (const bf16_t*)((unsigned char*)A.out + OUTB_EW), *AARR = (const bf16_t*)((unsigned char*)A.out + OUTB_AARR);
    bf16_t* OUTP = GLA ? (bf16_t*)((unsigned char*)A.out + OUTB_OGL) + 128 * hh + 16 * sl + l15 : (bf16_t*)((unsigned char*)A.out + OUTB_ORW) + 64 * hh + 16 * sl + l15;
    LAS bf16_t *AT = (LAS bf16_t*)gl, *RT = (LAS bf16_t*)(gl + GL_RT), *BT = (LAS bf16_t*)(gl + GL_BT), *KT = (LAS bf16_t*)(gl + GL_KT), *VS = (LAS bf16_t*)(gl + GL_VS);
    LAS float *GC = (LAS float*)(gl + GL_GC), *EG = (LAS float*)(gl + GL_EG);
    float mu_r = 0.f, mu_k = 0.f, mu_v = 0.f, kkc = 0.f, kac = 0.f, bgc = 0.f; float wgt[16];
#pragma unroll
    for (int j = 0; j < 16; ++j) wgt[j] = 0.f;
    if (!GLA) { const float* mu = A.in[IN_MU]; mu_r = mu[64 * hh + c]; mu_k = mu[512 + 64 * hh + c]; mu_v = mu[1024 + 64 * hh + c]; kkc = A.in[IN_KK][64 * hh + c]; kac = A.in[IN_KA][64 * hh + c]; }
    else { bgc = A.in[IN_BG][64 * hh + c];
#pragma unroll
        for (int j = 0; j < 16; ++j) wgt[j] = A.in[IN_WG2][j * 256 + 64 * hh + c]; }
    float pr[2] = {0.f, 0.f}, pk[2] = {0.f, 0.f}, pvv[2] = {0.f, 0.f}; bf16_t r0[2][TPW], r1[2][TPW], r2[2][TPW], r3[2][TPW], r4[2][TPW]; unsigned rvv[2][TPW]; u32x4 lg0[2][TPW], lg1[2][TPW];
#pragma unroll
    for (int p = 0; p < 2; ++p)
#pragma unroll
        for (int i = 0; i < TPW; ++i) { r0[p][i] = r1[p][i] = r2[p][i] = r3[p][i] = r4[p][i] = 0; rvv[p][i] = 0u; lg0[p][i] = (u32x4){0u, 0u, 0u, 0u}; lg1[p][i] = lg0[p][i]; }
#define SB_LOAD(SC, P) do { const int nv_ = ((SC) == nsub - 1) ? nvalid : 16; \
        if (!GLA) { if ((SC) == 0 && t0 == 0) { pr[P] = pk[P] = pvv[P] = 0.f; if (first_kind == 0) { const bf16_t* p = PRW + (size_t)(row0 - 1) * NPRW + 64 * hh + c; pr[P] = bf2f(p[0]); pk[P] = bf2f(p[512]); pvv[P] = bf2f(p[1024]); } \
                        else if (first_kind == 2) { const float* st = A.in[IN_ST_SHIFT] + (size_t)bsamp * 1792 + 64 * hh + c; pr[P] = st[0]; pk[P] = st[512]; pvv[P] = st[1024]; } } \
                    else if (t0 < nv_) { const bf16_t* p = PRW + (size_t)(row0 + 16 * (SC) + t0 - 1) * NPRW + 64 * hh + c; pr[P] = bf2f(p[0]); pk[P] = bf2f(p[512]); pvv[P] = bf2f(p[1024]); } } \
        _Pragma("unroll") for (int i = 0; i < TPW; ++i) if (t0 + i < nv_) { const size_t ro = (size_t)(row0 + 16 * (SC) + t0 + i); \
            if (!GLA) { const bf16_t* p = PRW + ro * NPRW + 64 * hh + c; r0[P][i] = p[0]; r1[P][i] = p[512]; r2[P][i] = p[1024]; r3[P][i] = EW[ro * 512 + 64 * hh + c]; r4[P][i] = AARR[ro * 512 + 64 * hh + c]; } \
            else { const bf16_t* p = PGLA + ro * NPGLA; r0[P][i] = p[64 * hh + c]; r1[P][i] = p[256 + 64 * hh + c]; rvv[P][i] = *(const unsigned*)(p + 512 + 128 * hh + 2 * lane); lg0[P][i] = *(const u32x4*)(p + 1024); lg1[P][i] = *(const u32x4*)(p + 1032); } } } while (0)
#define SB_EG(SC, P) do { const int nv_ = ((SC) == nsub - 1) ? nvalid : 16; LAS float* eg_ = EG + (P) * 1024; float tot_ = 0.f; \
        _Pragma("unroll") for (int i = 0; i < TPW; ++i) { float ev = 0.f; if (t0 + i < nv_) { if (!GLA) ev = bf2f(r3[P][i]); else { float lga[16], t8[8]; unpack8(lg0[P][i], t8); _Pragma("unroll") for (int j = 0; j < 8; ++j) lga[j] = t8[j]; \
                unpack8(lg1[P][i], t8); _Pragma("unroll") for (int j = 0; j < 8; ++j) lga[8 + j] = t8[j]; float z = bgc; _Pragma("unroll") for (int j = 0; j < 16; ++j) z += lga[j] * wgt[j]; ev = fsoftplus(-z) * 0.0625f; } } \
            eg_[(t0 + i) * 64 + c] = ev; tot_ += ev; } \
        WT[((P) * 8 + wg) * 64 + c] = tot_; } while (0)
#define SB_ITER(SC, P) do { const int sc = (SC); const int nv = (sc == nsub - 1) ? nvalid : 16; \
        __syncthreads();                                                         \
        { const LAS float* eg = EG + (P) * 1024; float cum = 0.f; \
          _Pragma("unroll") for (int w2 = 0; w2 < W - 1; ++w2) { const float tw = WT[((P) * 8 + w2) * 64 + c]; cum += (w2 < wg) ? tw : 0.f; } \
          _Pragma("unroll") for (int i = 0; i < TPW; ++i) { const int t = t0 + i; \
            if (t < nv) { \
                const float gp = __expf(-cum); cum += eg[t * 64 + c]; const float g = __expf(-cum), e = __expf(cum); \
                if (!GLA) { \
                    const float cr = bf2f(r0[P][i]), ck = bf2f(r1[P][i]), cv = bf2f(r2[P][i]), a = bf2f(r4[P][i]); \
                    const float xr = cr + (pr[P] - cr) * mu_r, xk = ck + (pk[P] - ck) * mu_k, xv = cv + (pvv[P] - cv) * mu_v; pr[P] = cr; pk[P] = ck; pvv[P] = cv; \
                    const float kkv = xk * kkc, ss = wave_allsum(kkv * kkv), kk = kkv * __builtin_amdgcn_rcpf(fmaxf(sqrtf(ss), 1e-12f)); \
                    const unsigned w01 = pk2(-kk * gp, xr * g), w23 = pk2(kk * a * e, xk * (1.f + (a - 1.f) * kac) * e); \
                    AT[t * SP + c] = (bf16_t)(w01 & 0xffffu); RT[t * SP + c] = (bf16_t)(w01 >> 16); BT[t * SP + c] = (bf16_t)(w23 & 0xffffu); KT[t * SP + c] = (bf16_t)(w23 >> 16); \
                    VS[t * VP + c] = (bf16_t)f2bf(xv); \
                } else { \
                    const unsigned w01 = pk2(bf2f(r0[P][i]) * 0.125f * g, bf2f(r1[P][i]) * e); \
                    RT[t * SP + c] = (bf16_t)(w01 & 0xffffu); KT[t * SP + c] = (bf16_t)(w01 >> 16); \
                    *(LAS unsigned*)(VS + t * VP + 2 * lane) = rvv[P][i]; \
                } \
            } else { \
                if (!GLA) { AT[t * SP + c] = 0; BT[t * SP + c] = 0; VS[t * VP + c] = 0; } else *(LAS unsigned*)(VS + t * VP + 2 * lane) = 0u; \
                RT[t * SP + c] = 0; KT[t * SP + c] = 0; \
            } \
          } \
          if (wg == W - 1) { GC[c] = __expf(-cum); cumtot += cum; } \
        } \
        if (sc + 2 < nsub) SB_LOAD(sc + 2, P); \
        __syncthreads();                                                         \
        scan_matrix_part<GLA, VP>(AT, RT, BT, KT, VS, GC, OUTP, l15, q, sl, use_v, write_o, row0 + 16 * sc, nv, H); \
        if (sc + 1 < nsub) SB_EG(sc + 1, 1 - (P)); } while (0)
    LAS float* WT = EG + 2048;
    SB_LOAD(0, 0); if (nsub > 1) SB_LOAD(1, 1); SB_EG(0, 0);
    for (int sc2 = 0; sc2 < nsub; sc2 += 2) { SB_ITER(sc2, 0); if (sc2 + 1 < nsub) SB_ITER(sc2 + 1, 1); }
#undef SB_LOAD
#undef SB_EG
#undef SB_ITER
}
constexpr int GP = 264;
__device__ __forceinline__ void gla_pass1_item(const Args& A, LAS unsigned char* lds, int wave, int lane, int b, int hh, int cc, int ig) {
    const bf16_t* PGLA = (const bf16_t*)(A.ws + OFF_PGLA);
    LAS bf16_t* KHT = (LAS bf16_t*)lds; LAS bf16_t* VT = KHT + 64 * GP; LAS float* WT = (LAS float*)(lds + (64 + 128) * GP * 2);
    const int c = lane, l15 = lane & 15, q = lane >> 4, row0 = b * 2048 + cc * 256 + 32 * wave;
    float wgt[16]; const float bgc = A.in[IN_BG][64 * hh + c];
#pragma unroll
    for (int j = 0; j < 16; ++j) wgt[j] = A.in[IN_WG2][j * 256 + 64 * hh + c];
    float cum[32]; float run = 0.f;
#pragma unroll
    for (int tb = 0; tb < 32; tb += 8) {
        u32x4 g0[8], g1[8];
#pragma unroll
        for (int j = 0; j < 8; ++j) { const bf16_t* p = PGLA + (size_t)(row0 + tb + j) * NPGLA; g0[j] = *(const u32x4*)(p + 1024); g1[j] = *(const u32x4*)(p + 1032); }
#pragma unroll
        for (int j = 0; j < 8; ++j) { float lga[16], t8[8];
            unpack8(g0[j], t8);
#pragma unroll
            for (int i = 0; i < 8; ++i) lga[i] = t8[i];
            unpack8(g1[j], t8);
#pragma unroll
            for (int i = 0; i < 8; ++i) lga[8 + i] = t8[i];
            float z = bgc;
#pragma unroll
            for (int i = 0; i < 16; ++i) z += lga[i] * wgt[i];
            run += fsoftplus(-z) * 0.0625f; cum[tb + j] = run; }
    }
    __syncthreads();
    WT[wave * 64 + c] = run;
    __syncthreads();
    float after = 0.f, tot = 0.f;
#pragma unroll
    for (int w2 = 0; w2 < 8; ++w2) { const float tw = WT[w2 * 64 + c]; tot += tw; after += (w2 > wave) ? tw : 0.f; }
#pragma unroll
    for (int tb = 0; tb < 32; tb += 16) {
        bf16_t rk[16]; unsigned rv[16];
#pragma unroll
        for (int j = 0; j < 16; ++j) { const bf16_t* p = PGLA + (size_t)(row0 + tb + j) * NPGLA; rk[j] = p[256 + 64 * hh + c]; rv[j] = *(const unsigned*)(p + 512 + 128 * hh + 2 * lane); }
#pragma unroll
        for (int j = 0; j < 16; ++j) { const int t = tb + j;
            KHT[c * GP + 32 * wave + t] = (bf16_t)f2bf(bf2f(rk[j]) * __expf(-(after + (run - cum[t]))));
            VT[(2 * lane) * GP + 32 * wave + t] = (bf16_t)(rv[j] & 0xffffu); VT[(2 * lane + 1) * GP + 32 * wave + t] = (bf16_t)(rv[j] >> 16); }
    }
    __syncthreads();
    f32x4 acc[4];
#pragma unroll
    for (int kt = 0; kt < 4; ++kt) acc[kt] = (f32x4){0.f, 0.f, 0.f, 0.f};
#pragma unroll
    for (int ks = 0; ks < 8; ++ks) { const bf16x8 bv = *(const LAS bf16x8*)(VT + (16 * wave + l15) * GP + 32 * ks + 8 * q);
#pragma unroll
        for (int kt = 0; kt < 4; ++kt) { const bf16x8 av = *(const LAS bf16x8*)(KHT + (16 * kt + l15) * GP + 32 * ks + 8 * q); acc[kt] = MFMA32(av, bv, acc[kt]); } }
    float* dst = (float*)(A.ws + OFF_GL) + (size_t)ig * 8192 + 16 * wave + l15;
#pragma unroll
    for (int kt = 0; kt < 4; ++kt)
#pragma unroll
        for (int i = 0; i < 4; ++i) dst[(16 * kt + 4 * q + i) * 128] = acc[kt][i];
    if (wave == 7) ((float*)(A.ws + OFF_GG))[ig * 64 + lane] = __expf(-tot);
}
__device__ __forceinline__ void p2x_scan1(const Args& A, LAS unsigned char* lds, int wave, int lane) {
    const int l15 = lane & 15, q = lane >> 4;
    for (int it = blockIdx.x; it < 448; it += gridDim.x) {
        f32x4 H[4]; float cumtot = 0.f;
        if (it < 448) {
            const int seq = it / 7, cc = it - seq * 7, b = seq >> 3, hh = seq & 7; const bool isT = wave >= 4; const int sl = wave & 3;
#pragma unroll
            for (int kt = 0; kt < 4; ++kt)
#pragma unroll
                for (int i = 0; i < 4; ++i) H[kt][i] = (isT && (16 * kt + 4 * q + i == 16 * sl + l15)) ? 1.f : 0.f;
            scan_block<false, 8>(A, lds, lane, wave, b * 2048 + cc * 256, 16, 16, cc == 0 ? 1 : 0, 0, hh, sl, !isT, false, H, cumtot);
            float* dst = (float*)(A.ws + OFF_RLT) + (size_t)it * 8192 + (isT ? 4096 : 0) + 16 * sl + l15;
#pragma unroll
            for (int kt = 0; kt < 4; ++kt)
#pragma unroll
                for (int i = 0; i < 4; ++i) dst[(16 * kt + 4 * q + i) * 64] = H[kt][i];
        }
    }
    __syncthreads();
}
__device__ __forceinline__ void p2y_scan2(const Args& A, LAS unsigned char* lds, int wave, int lane) {
    const int l15 = lane & 15, q = lane >> 4;
    for (int bi = blockIdx.x; bi < 256 + 256 + 512 + 512; bi += gridDim.x) {
        f32x4 H[4]; float cumtot = 0.f;
#pragma unroll
        for (int kt = 0; kt < 4; ++kt) H[kt] = (f32x4){0.f, 0.f, 0.f, 0.f};
        if (bi < 256) {
            const int item = 2 * bi + (wave >> 2), sl = wave & 3, cc = item & 7, seq = item >> 3, b = seq >> 3, hh = seq & 7;
#pragma unroll 2
            for (int j = 0; j < cc; ++j) {
                const float* Lj = (const float*)(A.ws + OFF_RLT) + (size_t)(seq * 7 + j) * 8192; const float* Tj = Lj + 4096;
                const bf16x8 hb0 = hfrag(H[0], H[1]), hb1 = hfrag(H[2], H[3]);
#pragma unroll
                for (int kt = 0; kt < 4; ++kt) {
                    f32x4 acc;
#pragma unroll
                    for (int i = 0; i < 4; ++i) acc[i] = Lj[(16 * kt + 4 * q + i) * 64 + 16 * sl + l15];
                    const float* tr = Tj + (16 * kt + l15) * 64 + 4 * q;
                    const f32x4 t0 = *(const f32x4*)tr, t1 = *(const f32x4*)(tr + 16), t2 = *(const f32x4*)(tr + 32), t3 = *(const f32x4*)(tr + 48);
                    acc = MFMA32(hfrag(t0, t1), hb0, acc); acc = MFMA32(hfrag(t2, t3), hb1, acc);
                    H[kt] = acc;
                }
            }
            scan_block<false, 4>(A, lds + (wave >> 2) * GL_BYTES, lane, wave & 3, b * 2048 + cc * 256, 16, 16, cc == 0 ? 1 : 0, 0, hh, sl, true, true, H, cumtot);
            if (cc == 7) { float* o = A.out + OUT_WKV_P + (((size_t)b * 8 + hh) * 64 + 16 * sl + l15) * 64 + 4 * q;
#pragma unroll
                for (int kt = 0; kt < 4; ++kt) *(f32x4*)(o + 16 * kt) = H[kt]; }
        } else if (bi < 512) {
            const int item = bi - 256, sl = wave, cc = item & 7, seq = item >> 3, b = seq >> 2, hh = seq & 3;
#pragma unroll 2
            for (int j = 0; j < cc; ++j) {
                const float* Lj = (const float*)(A.ws + OFF_GL) + (size_t)(seq * 7 + j) * 8192; const float* Gj = (const float*)(A.ws + OFF_GG) + (seq * 7 + j) * 64;
#pragma unroll
                for (int kt = 0; kt < 4; ++kt)
#pragma unroll
                    for (int i = 0; i < 4; ++i) H[kt][i] = Gj[16 * kt + 4 * q + i] * H[kt][i] + Lj[(16 * kt + 4 * q + i) * 128 + 16 * sl + l15];
            }
            scan_block<true, 8>(A, lds, lane, wave, b * 2048 + cc * 256, 16, 16, 0, 0, hh, sl, true, true, H, cumtot);
            if (cc == 7) { float* o = A.out + OUT_GLA_P + (((size_t)b * 4 + hh) * 64) * 128 + 16 * sl + l15;
#pragma unroll
                for (int kt = 0; kt < 4; ++kt)
#pragma unroll
                    for (int i = 0; i < 4; ++i) o[(size_t)(16 * kt + 4 * q + i) * 128] = H[kt][i]; }
        } else if (bi < 1024) {
            const int item = 2 * (bi - 512) + (wave >> 2), sl = wave & 3, hh = item & 7, b = item >> 3;
            const float* st = A.in[IN_ST_WKV] + (((size_t)b * 8 + hh) * 64 + 16 * sl + l15) * 64 + 4 * q;
#pragma unroll
            for (int kt = 0; kt < 4; ++kt) H[kt] = *(const f32x4*)(st + 16 * kt);
            scan_block<false, 4>(A, lds + (wave >> 2) * GL_BYTES, lane, wave & 3, MP + b * 8, 1, 8, 2, b, hh, sl, true, true, H, cumtot);
            float* o = A.out + OUT_WKV_S + (((size_t)b * 8 + hh) * 64 + 16 * sl + l15) * 64 + 4 * q;
#pragma unroll
            for (int kt = 0; kt < 4; ++kt) *(f32x4*)(o + 16 * kt) = H[kt];
        } else {
            const int item = bi - 1024, sl = wave, hh = item & 3, b = item >> 2;
            const float* st = A.in[IN_ST_GLA] + (((size_t)b * 4 + hh) * 64) * 128 + 16 * sl + l15;
#pragma unroll
            for (int kt = 0; kt < 4; ++kt)
#pragma unroll
                for (int i = 0; i < 4; ++i) H[kt][i] = st[(size_t)(16 * kt + 4 * q + i) * 128];
            scan_block<true, 8>(A, lds, lane, wave, MP + b * 8, 1, 8, 0, b, hh, sl, true, true, H, cumtot);
            float* o = A.out + OUT_GLA_S + (((size_t)b * 4 + hh) * 64) * 128 + 16 * sl + l15;
#pragma unroll
            for (int kt = 0; kt < 4; ++kt)
#pragma unroll
                for (int i = 0; i < 4; ++i) o[(size_t)(16 * kt + 4 * q + i) * 128] = H[kt][i];
        }
    }
}
__device__ __forceinline__ void p2c_mix(const Args& A, int r, int col0, u32x4 rcur, u32x4 rprev, float (&xs)[8]) {
    float cur[8], prev[8]; unpack8(rcur, cur);
    const bool first = (r < MP) ? ((r & 2047) == 0) : (((r - MP) & 7) == 0);
    if (!first) unpack8(rprev, prev);
    else if (r < MP) {
#pragma unroll
        for (int i = 0; i < 8; ++i) prev[i] = 0.f;
    } else ld8f(A.in[IN_ST_SHIFT] + (size_t)((r - MP) >> 3) * 1792 + col0, prev);
    float mu[8]; ld8f(A.in[IN_MU] + col0, mu);
#pragma unroll
    for (int i = 0; i < 8; ++i) xs[i] = cur[i] + (prev[i] - cur[i]) * mu[i];
}
__device__ __forceinline__ void p2c_post(const Args& A, int gw, int NGW, int lane, bool shadow) {
    const bf16_t* PRW = (const bf16_t*)(A.ws + OFF_PRW); const bf16_t* PGLA = (const bf16_t*)(A.ws + OFF_PGLA);
    const bf16_t *AARR = (const bf16_t*)((unsigned char*)A.out + OUTB_AARR), *G = (const bf16_t*)(A.ws + OFF_G);
    bf16_t *ORW = (bf16_t*)((unsigned char*)A.out + OUTB_ORW), *OGL = (bf16_t*)((unsigned char*)A.out + OUTB_OGL);
    const int c0 = 8 * lane;
    for (int rb = gw; rb < M; rb += 2 * NGW) {
        u32x4 raw[2][11];
#pragma unroll
        for (int k = 0; k < 2; ++k) { const int r = (rb + k * NGW < M) ? rb + k * NGW : rb; const int rp = r > 0 ? r - 1 : 0;
            raw[k][0] = *(const u32x4*)(ORW + (size_t)r * 512 + c0); raw[k][1] = *(const u32x4*)(OGL + (size_t)r * 512 + c0);
            raw[k][2] = *(const u32x4*)(PRW + (size_t)r * NPRW + c0); raw[k][3] = *(const u32x4*)(PRW + (size_t)r * NPRW + 512 + c0); raw[k][4] = *(const u32x4*)(PRW + (size_t)r * NPRW + 1024 + c0);
            raw[k][5] = *(const u32x4*)(PRW + (size_t)rp * NPRW + c0); raw[k][6] = *(const u32x4*)(PRW + (size_t)rp * NPRW + 512 + c0); raw[k][7] = *(const u32x4*)(PRW + (size_t)rp * NPRW + 1024 + c0);
            raw[k][8] = *(const u32x4*)(AARR + (size_t)r * 512 + c0); raw[k][9] = *(const u32x4*)(G + (size_t)r * 512 + c0); raw[k][10] = *(const u32x4*)(PGLA + (size_t)r * NPGLA + 1040 + c0); }
#pragma unroll
        for (int k = 0; k < 2; ++k) { const int r = rb + k * NGW; if (r < M) {
            float o[8], d[8], xr[8], xk[8], xv[8], a[8], g[8], p[8], res[8];
            unpack8(raw[k][0], o);
            float s1 = 0.f;
#pragma unroll
            for (int i = 0; i < 8; ++i) s1 += o[i];
            const float mu = row8_allsum(s1) * (1.f / 64.f); float s2 = 0.f;
#pragma unroll
            for (int i = 0; i < 8; ++i) { d[i] = o[i] - mu; s2 += d[i] * d[i]; }
            const float rstd = rsqrtf(row8_allsum(s2) * (1.f / 64.f) + 64e-5f);
            p2c_mix(A, r, c0, raw[k][2], raw[k][5], xr); p2c_mix(A, r, 512 + c0, raw[k][3], raw[k][6], xk); p2c_mix(A, r, 1024 + c0, raw[k][4], raw[k][7], xv);
            unpack8(raw[k][8], a); unpack8(raw[k][9], g);
            float bs = 0.f; ld8f(A.in[IN_KA] + c0, p);
#pragma unroll
            for (int i = 0; i < 8; ++i) d[i] *= rstd, xk[i] = xk[i] * (1.f + (a[i] - 1.f) * p[i]);
            ld8f(A.in[IN_RK] + c0, p);
#pragma unroll
            for (int i = 0; i < 8; ++i) bs += xr[i] * xk[i] * p[i];
            bs = row8_allsum(bs);
            ld8f(A.in[IN_LNW] + c0, p); ld8f(A.in[IN_LNB] + c0, a);
#pragma unroll
            for (int i = 0; i < 8; ++i) res[i] = ((d[i] * p[i] + a[i]) + bs * xv[i]) * g[i];
            if (!shadow) *(u32x4*)(ORW + (size_t)r * 512 + c0) = pack8(res); else *(u32x4*)((bf16_t*)(A.ws + 240 * MiB) + (size_t)(r & 8191) * 512 + c0) = pack8(res);
            unpack8(raw[k][1], o);
            float ms = 0.f;
#pragma unroll
            for (int i = 0; i < 8; ++i) ms += o[i] * o[i];
            const float rs = rsqrtf(row16_allsum(ms) * (1.f / 128.f) + NORM_EPS);
            unpack8(raw[k][10], g); ld8f(A.in[IN_GNW] + (c0 & 127), p);
#pragma unroll
            for (int i = 0; i < 8; ++i) res[i] = o[i] * rs * p[i] * (g[i] * fsigmoid(g[i]));
            if (!shadow) *(u32x4*)(OGL + (size_t)r * 512 + c0) = pack8(res); else *(u32x4*)((bf16_t*)(A.ws + 248 * MiB) + (size_t)(r & 8191) * 512 + c0) = pack8(res);
        } }
    }
}
__device__ __forceinline__ void p6_act(const Args& A, int gtid, int NGT) {
    bf16_t* U = (bf16_t*)(A.ws + OFF_U); const bf16_t* UH = (const bf16_t*)(A.ws + OFF_UH);
    const float *convw = A.in[IN_CONVW], *convb = A.in[IN_CONVB], *cstate = A.in[IN_ST_CONV];
    for (int item = gtid; item < (M / 64) * 352; item += NGT) {
        const int rb = item / 352, jc = (item - rb * 352) * 8, r0 = rb * 64; const bool sample = r0 >= MP;
        float p1v[8], p2v[8], p1g[8], p2g[8], w0v[8], w1v[8], w2v[8], cbv[8], w0g[8], w1g[8], w2g[8], cbg[8];
        ld8f(convw + jc, w0v); ld8f(convw + F2 + jc, w1v); ld8f(convw + 2 * F2 + jc, w2v); ld8f(convb + jc, cbv);
        ld8f(convw + FF + jc, w0g); ld8f(convw + F2 + FF + jc, w1g); ld8f(convw + 2 * F2 + FF + jc, w2g); ld8f(convb + FF + jc, cbg);
#pragma unroll
        for (int i = 0; i < 8; ++i) p1v[i] = p2v[i] = p1g[i] = p2g[i] = 0.f;
        if (!sample && (rb & 31) != 0) { const bf16_t* q = UH + (size_t)(rb - 1) * 2 * F2; ld8bf(q + jc, p2v); ld8bf(q + FF + jc, p2g); ld8bf(q + F2 + jc, p1v); ld8bf(q + F2 + FF + jc, p1g); }
        for (int r8 = 0; r8 < 64; r8 += 8) {
            u32x4 rawv[8], rawg[8];
#pragma unroll
            for (int k = 0; k < 8; ++k) { const bf16_t* row = U + (size_t)(r0 + r8 + k) * F2; rawv[k] = *(const u32x4*)(row + jc); rawg[k] = *(const u32x4*)(row + FF + jc); }
            if (sample) { const float* st = cstate + (size_t)((r0 + r8 - MP) >> 3) * 2 * F2; ld8f(st + jc, p2v); ld8f(st + FF + jc, p2g); ld8f(st + F2 + jc, p1v); ld8f(st + F2 + FF + jc, p1g); }
#pragma unroll
            for (int k = 0; k < 8; ++k) {
                float cv[8], cg[8], res[8]; unpack8(rawv[k], cv); unpack8(rawg[k], cg);
#pragma unroll
                for (int i = 0; i < 8; ++i) { const float v = cbv[i] + w0v[i] * p2v[i] + w1v[i] * p1v[i] + w2v[i] * cv[i], gg = cbg[i] + w0g[i] * p2g[i] + w1g[i] * p1g[i] + w2g[i] * cg[i];
                    res[i] = gelu_gate(gg, v); p2v[i] = p1v[i]; p1v[i] = cv[i]; p2g[i] = p1g[i]; p1g[i] = cg[i]; }
                *(u32x4*)(U + (size_t)(r0 + r8 + k) * F2 + jc) = pack8(res);
            }
        }
    }
}
__device__ __forceinline__ void pfix_act(const Args& A, int gtid, int NGT) {
    const bf16_t* UH = (const bf16_t*)(A.ws + OFF_UH); const bf16_t* US = (const bf16_t*)(A.ws + OFF_US); bf16_t* ACT = (bf16_t*)(A.ws + OFF_ACT);
    const float *convw = A.in[IN_CONVW], *convb = A.in[IN_CONVB], *cstate = A.in[IN_ST_CONV];
    for (int idx = gtid; idx < (256 + 128) * 2 * 352; idx += NGT) {
        const int g = idx / 704, rem = idx - g * 704, rsel = rem / 352, jc = (rem - rsel * 352) * 8;
        float cv[8], cg[8], p1v[8], p1g[8], p2v[8], p2g[8], res[8]; int orow;
#pragma unroll
        for (int i = 0; i < 8; ++i) p1v[i] = p1g[i] = p2v[i] = p2g[i] = 0.f;
        if (g < 256) {
            const bool seq0 = (g & 31) == 0; orow = 64 * g + rsel;
            ld8bf(UH + ((size_t)g * 4 + rsel) * F2 + jc, cv); ld8bf(UH + ((size_t)g * 4 + rsel) * F2 + FF + jc, cg);
            if (rsel == 0) { if (!seq0) { const bf16_t* q = UH + ((size_t)(g - 1) * 4 + 3) * F2; ld8bf(q + jc, p1v); ld8bf(q + FF + jc, p1g); q -= F2; ld8bf(q + jc, p2v); ld8bf(q + FF + jc, p2g); } }
            else { const bf16_t* q = UH + ((size_t)g * 4) * F2; ld8bf(q + jc, p1v); ld8bf(q + FF + jc, p1g);
                if (!seq0) { q = UH + ((size_t)(g - 1) * 4 + 3) * F2; ld8bf(q + jc, p2v); ld8bf(q + FF + jc, p2g); } }
        } else {
            const int sb = g - 256; orow = MP + 8 * sb + rsel; const float* st = cstate + (size_t)sb * 2 * F2;
            ld8bf(US + ((size_t)sb * 2 + rsel) * F2 + jc, cv); ld8bf(US + ((size_t)sb * 2 + rsel) * F2 + FF + jc, cg);
            if (rsel == 0) { ld8f(st + jc, p2v); ld8f(st + FF + jc, p2g); ld8f(st + F2 + jc, p1v); ld8f(st + F2 + FF + jc, p1g); }
            else { ld8f(st + F2 + jc, p2v); ld8f(st + F2 + FF + jc, p2g); ld8bf(US + ((size_t)sb * 2) * F2 + jc, p1v); ld8bf(US + ((size_t)sb * 2) * F2 + FF + jc, p1g); }
        }
#pragma unroll
        for (int i = 0; i < 8; ++i) { const int col = jc + i;
            const float v = convb[col] + convw[col] * p2v[i] + convw[F2 + col] * p1v[i] + convw[2 * F2 + col] * cv[i];
            const float gg = convb[FF + col] + convw[FF + col] * p2g[i] + convw[F2 + FF + col] * p1g[i] + convw[2 * F2 + FF + col] * cg[i];
            res[i] = gelu_gate(gg, v); }
        *(u32x4*)(ACT + (size_t)orow * FF + jc) = pack8(res);
    }
}
__device__ __forceinline__ void p8_final(const Args& A, int gw, int NGW, int lane, float* dst) {
    const float* gf = A.in[IN_NORM_FINAL];
    for (int m = gw; m < M; m += 2 * NGW) {
        const int m2 = m + NGW; const bool has2 = m2 < M;
        const f32x4* xr = (const f32x4*)(A.out + (size_t)m * DM) + lane; const f32x4* xr2 = (const f32x4*)(A.out + (size_t)(has2 ? m2 : m) * DM) + lane; f32x4 v[4], w[4]; float s = 0.f, s2 = 0.f;
#pragma unroll
        for (int j = 0; j < 4; ++j) { v[j] = xr[64 * j]; w[j] = xr2[64 * j]; }
#pragma unroll
        for (int j = 0; j < 4; ++j) { s += (v[j].x * v[j].x + v[j].y * v[j].y) + (v[j].z * v[j].z + v[j].w * v[j].w); s2 += (w[j].x * w[j].x + w[j].y * w[j].y) + (w[j].z * w[j].z + w[j].w * w[j].w); }
        const float rstd = rsqrtf(wave_allsum(s) * (1.f / DM) + NORM_EPS), rstd2 = rsqrtf(wave_allsum(s2) * (1.f / DM) + NORM_EPS);
#pragma unroll
        for (int j = 0; j < 4; ++j) { const f32x4 g = *((const f32x4*)gf + lane + 64 * j); ((f32x4*)(dst + (size_t)m * DM) + lane)[64 * j] = v[j] * rstd * g; if (has2) ((f32x4*)(dst + (size_t)m2 * DM) + lane)[64 * j] = w[j] * rstd2 * g; }
    }
}

#ifndef PHMASK
#define PHMASK 0xFFFF
#endif
#ifndef PHREP
#define PHREP 0
#endif
#define PH(k) for (int rep_ = 0; rep_ < ((((PHMASK) >> (k)) & 1) ? ((((PHREP) >> (k)) & 1) ? 2 : 1) : 0); ++rep_)
__global__ void __launch_bounds__(NTHREADS, 2) fwd_megakernel(Args A) {
    extern __shared__ __attribute__((aligned(16))) unsigned char lds_raw[];
    LAS unsigned char* lds = (LAS unsigned char*)lds_raw;
    cg::grid_group grid = cg::this_grid();
    const int tid = threadIdx.x, lane = tid & 63, wave = __builtin_amdgcn_readfirstlane(tid >> 6);
    const int G = gridDim.x, gw = blockIdx.x * NWAVES + wave, NGW = G * NWAVES;
    unsigned char* ws = A.ws;
    if (tid < 4) ((LAS unsigned*)(lds + 131072))[tid] = 0u;
    __syncthreads();
    const XcdBarrier xbar = xcd_barrier_post((unsigned*)(ws + OFF_BAR), (volatile LAS unsigned*)(lds + 131072));
#define GSYNC() xcd_barrier(xbar)
    PH(0) p0_prologue(A, lds, gw, NGW, wave, lane);
    if (A.ws == nullptr) grid.sync();
    GSYNC();
    PH(1) { pg8::Gemm g{(const bf16_t*)((unsigned char*)A.out + OUTB_H), (const bf16_t*)(ws + OFF_WIN), M, NIN, 1024, 1024}; pg8::StaticOrder S; S.init(M, NIN, G, (int)blockIdx.x);
      EpiProj E{(bf16_t*)(ws + OFF_PRW), (bf16_t*)(ws + OFF_PGLA), (bf16_t*)(ws + OFF_PGATE), A.out + OUT_SHIFT_P, A.out + OUT_SHIFT_S};
      pg8::gemm_phase<EpiProj, pg8::StaticOrder, true, true>(lds, g, S, E); }
    GSYNC();
    PH(2) p2a_lora(A, lds, gw, NGW, wave, lane);
    PH(2) { for (int ig = (int)gridDim.x - 1 - (int)blockIdx.x; ig < 224; ig += (int)gridDim.x) { const int seq = ig / 7, cc = ig - seq * 7; gla_pass1_item(A, lds, wave, lane, seq >> 2, seq & 3, cc, ig); }
      __syncthreads(); }
    GSYNC();
    PH(3) p2x_scan1(A, lds, wave, lane);
    GSYNC();
    PH(11) p2y_scan2(A, lds, wave, lane);
    GSYNC();
#ifdef SHADOW_P2C
    p2c_post(A, gw, NGW, lane, true);
#endif
    PH(4) p2c_post(A, gw, NGW, lane, false);
    GSYNC();
    PH(5) { pg8::StaticOrder S; S.init(M, 1024, G, (int)blockIdx.x); S.limit = __builtin_amdgcn_readfirstlane((S.nwg / G) * G);
      { pg8::Gemm g{(const bf16_t*)((unsigned char*)A.out + OUTB_ORW), (const bf16_t*)(ws + OFF_WOA), M, 1024, 512, 512};
        EpiGate<true> E{(bf16_t*)(ws + OFF_MERGED), (const bf16_t*)(ws + OFF_PGATE)};
        pg8::gemm_phase<EpiGate<true>, pg8::StaticOrder, true, true>(lds, g, S, E);
        tail_gemm(lds, (const bf16_t*)((unsigned char*)A.out + OUTB_ORW), 512, (const bf16_t*)(ws + OFF_WOA), 512, S, wave, lane, TfGate{true, (bf16_t*)(ws + OFF_MERGED), (const bf16_t*)(ws + OFF_PGATE)}); }
      { pg8::Gemm g{(const bf16_t*)((unsigned char*)A.out + OUTB_OGL), (const bf16_t*)(ws + OFF_WOB), M, 1024, 512, 512};
        EpiGate<false> E{(bf16_t*)(ws + OFF_MERGED), (const bf16_t*)(ws + OFF_PGATE) + 1024};
        pg8::gemm_phase<EpiGate<false>, pg8::StaticOrder, true, true>(lds, g, S, E);
        tail_gemm(lds, (const bf16_t*)((unsigned char*)A.out + OUTB_OGL), 512, (const bf16_t*)(ws + OFF_WOB), 512, S, wave, lane, TfGate{false, (bf16_t*)(ws + OFF_MERGED), (const bf16_t*)(ws + OFF_PGATE) + 1024}); } }
    GSYNC();
    PH(6) { pg8::Gemm g{(const bf16_t*)(ws + OFF_MERGED), (const bf16_t*)(ws + OFF_WO), M, 1024, 1024, 1024}; pg8::StaticOrder S; S.init(M, 1024, G, (int)blockIdx.x); S.limit = __builtin_amdgcn_readfirstlane((S.nwg / G) * G);
#ifdef SHADOW_G3
      float* rss = (rep_ == 0) ? (float*)(ws + OFF_ROWSS + 256 * 1024) : (float*)(ws + OFF_ROWSS);
#else
      float* rss = (float*)(ws + OFF_ROWSS);
#endif
      EpiX1 E{A.in[IN_XP], A.in[IN_XS], A.out, (bf16_t*)(ws + OFF_X1B), rss};
      pg8::gemm_phase<EpiX1, pg8::StaticOrder, true, true>(lds, g, S, E);
      tail_gemm(lds, (const bf16_t*)(ws + OFF_MERGED), 1024, (const bf16_t*)(ws + OFF_WO), 1024, S, wave, lane, TfX1{A.in[IN_XP], A.in[IN_XS], A.out, (bf16_t*)(ws + OFF_X1B), rss}); }
    GSYNC();
    PH(7) { pg8::Gemm g{(const bf16_t*)(ws + OFF_X1B), (const bf16_t*)(ws + OFF_WUP), M, F2, 1024, 1024}; pg8::StaticOrder S; S.init(M, F2, G, (int)blockIdx.x);
      EpiAct E{(const float*)(ws + OFF_ROWSS), A.in[IN_CONVW], A.in[IN_CONVB], (bf16_t*)(ws + OFF_ACT), (bf16_t*)(ws + OFF_UH), (bf16_t*)(ws + OFF_US), A.out + OUT_CONV_P, A.out + OUT_CONV_S, (LAS float*)(lds + 131072)};
      pg8::gemm_phase<EpiAct, pg8::StaticOrder, true, true>(lds, g, S, E); }
    __syncthreads(); if (tid < 4) ((LAS unsigned*)(lds + 131072))[tid] = 0u; __syncthreads();
    GSYNC();
    PH(8) pfix_act(A, blockIdx.x * NTHREADS + tid, G * NTHREADS);
    GSYNC();
    PH(9) { pg8::Gemm g{(const bf16_t*)(ws + OFF_ACT), (const bf16_t*)(ws + OFF_WDN), M, 1024, FF, FF}; pg8::StaticOrder S; S.init(M, 1024, G, (int)blockIdx.x); S.limit = __builtin_amdgcn_readfirstlane((S.nwg / G) * G);
#ifdef SHADOW_G5
      float* xd = (rep_ == 0) ? (float*)(ws + 129 * MiB) : A.out;
#else
      float* xd = A.out;
#endif
      EpiX2 E{A.out, xd};
      pg8::gemm_phase<EpiX2, pg8::StaticOrder, true, true>(lds, g, S, E);
      tail_gemm(lds, (const bf16_t*)(ws + OFF_ACT), FF, (const bf16_t*)(ws + OFF_WDN), FF, S, wave, lane, TfX2{A.out, xd}); }
    GSYNC();
#ifdef P8_SHADOW
    p8_final(A, gw, NGW, lane, (float*)(ws + OFF_U));
#endif
    PH(10) p8_final(A, gw, NGW, lane, A.out);
#ifdef EXTRA_SYNCS
    for (int i_ = 0; i_ < EXTRA_SYNCS; ++i_) GSYNC();
#endif
}

extern "C" void kernel_launch(void* const* d_in, const int* in_sizes, int n_in, void* d_out, int out_size, void* d_ws, size_t ws_size, hipStream_t stream) {
    static int grid = 0;
    if (grid == 0) {
        int dev = 0, cus = 0, per_cu = 0;
        if (n_in != 31 || ws_size < 256 * MiB) { fprintf(stderr, "kernel_launch: unexpected n_in %d / ws_size %zu\n", n_in, ws_size); grid = -1; return; }
        (void)hipGetDevice(&dev); (void)hipDeviceGetAttribute(&cus, hipDeviceAttributeMultiprocessorCount, dev);
        if (hipFuncSetAttribute((const void*)fwd_megakernel, hipFuncAttributeMaxDynamicSharedMemorySize, LDS_BYTES) != hipSuccess) { fprintf(stderr, "kernel_launch: hipFuncSetAttribute failed\n"); grid = -1; return; }
        if (hipOccupancyMaxActiveBlocksPerMultiprocessor(&per_cu, (const void*)fwd_megakernel, NTHREADS, LDS_BYTES) != hipSuccess || per_cu < 1) { fprintf(stderr, "kernel_launch: occupancy query failed (%d)\n", per_cu); (void)hipGetLastError(); grid = -1; return; }
        grid = cus * 1;
    }
    if (grid < 0) return;
    Args a{};
    for (int i = 0; i < 31; ++i) a.in[i] = (const float*)d_in[i];
    a.out = (float*)d_out; a.ws = (unsigned char*)d_ws;
    if (hipMemsetAsync((char*)d_ws + OFF_BAR, 0, XCD_BAR_WORDS * 4, stream) != hipSuccess) { fprintf(stderr, "kernel_launch: memset of the barrier words failed\n"); return; }
    void* params[] = {&a};
    hipError_t e = hipLaunchCooperativeKernel((const void*)fwd_megakernel, dim3(grid), dim3(NTHREADS), params, LDS_BYTES, stream);
    if (e != hipSuccess) fprintf(stderr, "kernel_launch: cooperative launch failed: %s (grid %d)\n", hipGetErrorString(e), grid);
}
```

```cpp
#include <hip/hip_runtime.h>
#include <hip/hip_cooperative_groups.h>
#include <cstdio>
#include <cstdint>
namespace cg = cooperative_groups;
#define PHREP 0
namespace pg8 {
#define PG8_LAS __attribute__((address_space(3)))
typedef unsigned short bf16_t;
typedef short bf16x8 __attribute__((ext_vector_type(8)));
typedef float f32x4 __attribute__((ext_vector_type(4)));
typedef unsigned u32x4 __attribute__((ext_vector_type(4)));
constexpr int BM = 256, BK = 64, HALF = 128, HTB = HALF * BK * 2  , STAGE_BYTES = 8 * HTB, NXCD = 8, WGM = 8;

__host__ __device__ __forceinline__ int lds_byte(int r, int c) { const int st = (r >> 4) * 2 + (c >> 5), rr = r & 15, cc = c & 31, ob = rr * 64 + cc * 2; return st * 1024 + (ob ^ (((ob >> 9) & 1) << 5)); }
__host__ __device__ __forceinline__ void stage_rc(int b, int& R, int& C) { const int st = b / 1024, sb = b % 1024, swz = sb ^ (((sb >> 9) & 1) << 5); R = (st >> 1) * 16 + swz / 64; C = (st & 1) * 32 + (swz % 64) / 2; }
__host__ __device__ __forceinline__ int perm32(int rho) { const int n = rho >> 4, i = rho & 15; return 8 * (i >> 2) + 4 * n + (i & 3); }

struct Unit { int pm, pn; };
struct Gemm { const bf16_t* A; const bf16_t* Bt; int M, N, K, lda; };

struct StaticOrder {
    int nM, nN, nwg, G, c;
    int limit;
    __host__ __device__ void init(int M, int N, int G_, int c_) { nM = M / BM; nN = N / BM; nwg = nM * nN; G = G_; c = c_; limit = nwg; }
    __host__ __device__ __forceinline__ bool next(int i, Unit& u) const {
        const int L = i * G + c; if (L >= limit) return false;
        unit_of(L, u); return true;
    }
    __host__ __device__ __forceinline__ void unit_of(int L, Unit& u) const {
        int wgid = L; { const int q = nwg / NXCD, r = nwg % NXCD, xcd = wgid % NXCD, off = wgid / NXCD; wgid = (xcd < r ? xcd * (q + 1) : r * (q + 1) + (xcd - r) * q) + off; }
        const int nig = WGM * nN, gid = wgid / nig, fm = gid * WGM, gsz = (nM - fm) < WGM ? (nM - fm) : WGM;
        u.pm = fm + ((wgid % nig) % gsz); u.pn = (wgid % nig) / gsz;
    }
    __device__ __forceinline__ void a_ready(const Unit&) const {}
    __device__ __forceinline__ void done(const Unit&) const {}
};
__device__ __forceinline__ unsigned cvt_pk_bf16(float lo, float hi) { unsigned r; asm volatile("v_cvt_pk_bf16_f32 %0, %1, %2" : "=v"(r) : "v"(lo), "v"(hi)); return r; }
typedef float f32x2 __attribute__((ext_vector_type(2)));
template <class Epi, class Sched, bool ALIGN_EPI = false, bool SP2 = false>
__device__ __forceinline__ void gemm_phase(PG8_LAS unsigned char* lds, const Gemm g, const Sched& S, const Epi& E) {
    int tid_ = threadIdx.x; asm volatile("" : "+v"(tid_));
    const int tid = tid_, wid = __builtin_amdgcn_readfirstlane(tid >> 6), lane = tid & 63, wr = wid >> 2, wc = wid & 3, fr = lane & 15, fq = lane >> 4;
    const int K = g.K, nt = K / BK;
    unsigned voffA[2], voffB[2];
#pragma unroll
    for (int i = 0; i < 2; ++i) { int R, C; stage_rc(tid * 16 + i * 8192, R, C); const int Rb = Epi::PERM ? ((R & ~31) + perm32(R & 31)) : R;
        voffA[i] = (unsigned)(R * g.lda + C) * 2u; voffB[i] = (unsigned)(Rb * K + C) * 2u; }
    const size_t kstep = (size_t)(BK * 2);
    const size_t hstep = (size_t)HALF * K * 2;
    const size_t tstep = 2 * hstep;
    const size_t hstepA = (size_t)HALF * g.lda * 2, tstepA = 2 * hstepA;
    const unsigned ldsw = (unsigned)wid * 1024u;
    const int aoff = lds_byte(wr * 64 + fr, fq * 8), boff = lds_byte(wc * 32 + fr, fq * 8);
#define PG8_SA(b, h) (((b) * 2 + (h)) * HTB)
#define PG8_SB(b, h) ((4 + (b) * 2 + (h)) * HTB)
#define PG8_STAGE(bufoff, gbase, voff) do { _Pragma("unroll") for (int _i = 0; _i < 2; ++_i) \
        __builtin_amdgcn_global_load_lds((const unsigned*)((const char*)(gbase) + (voff)[_i]), (PG8_LAS unsigned*)(lds + (bufoff) + ldsw + _i * 8192), 16, 0, 0); } while (0)
#define PG8_LDA(dst, b, h) do { _Pragma("unroll") for (int m = 0; m < 4; ++m) _Pragma("unroll") for (int k = 0; k < 2; ++k) dst[m][k] = *(const PG8_LAS bf16x8*)(lds + PG8_SA(b, h) + aoff + m * 2048 + k * 1024); } while (0)
#define PG8_LDB(dst, b, h) do { _Pragma("unroll") for (int n = 0; n < 2; ++n) _Pragma("unroll") for (int k = 0; k < 2; ++k) dst[n][k] = *(const PG8_LAS bf16x8*)(lds + PG8_SB(b, h) + boff + n * 2048 + k * 1024); } while (0)
#define PG8_MMA(ai, bj, At, Bt) do { __builtin_amdgcn_s_setprio(1); _Pragma("unroll") for (int m = 0; m < 4; ++m) _Pragma("unroll") for (int n = 0; n < 2; ++n) _Pragma("unroll") for (int k = 0; k < 2; ++k) \
        acc[ai][bj][m][n] = __builtin_amdgcn_mfma_f32_16x16x32_bf16(Bt[n][k], At[m][k], acc[ai][bj][m][n], 0, 0, 0); __builtin_amdgcn_s_setprio(0); } while (0)
#define PG8_WAIT_V(n) asm volatile("s_waitcnt vmcnt(" #n ")" ::: "memory")
#define PG8_WAIT_L(n) asm volatile("s_waitcnt lgkmcnt(" #n ")" ::: "memory")
#define PG8_BAR __builtin_amdgcn_s_barrier()
#define PG8_SCHED __builtin_amdgcn_sched_barrier(0)
    Unit cur, nxt; int ui = 0;
    if (!S.next(0, cur)) return;
    f32x4 acc[2][2][4][2];
#pragma unroll
    for (int a = 0; a < 2; ++a)
#pragma unroll
        for (int b = 0; b < 2; ++b)
#pragma unroll
            for (int m = 0; m < 4; ++m)
#pragma unroll
                for (int n = 0; n < 2; ++n) acc[a][b][m][n] = (f32x4){0.f, 0.f, 0.f, 0.f};
    bf16x8 At[4][2], B0[2][2], B1[2][2];
    const char* cA = (const char*)g.A + (size_t)cur.pm * tstepA; const char* cB = (const char*)g.Bt + (size_t)cur.pn * tstep;
    S.a_ready(cur);
    if constexpr (SP2) {
        PG8_STAGE(PG8_SB(0, 0), cB, voffB); PG8_STAGE(PG8_SB(0, 1), cB + hstep, voffB); PG8_STAGE(PG8_SA(0, 0), cA, voffA); PG8_STAGE(PG8_SA(0, 1), cA + hstepA, voffA);
        if (wr == 1) PG8_BAR;
        PG8_WAIT_V(2); PG8_BAR;
        PG8_STAGE(PG8_SB(1, 0), cB + kstep, voffB); PG8_STAGE(PG8_SA(1, 0), cA + kstep, voffA); PG8_STAGE(PG8_SB(1, 1), cB + hstep + kstep, voffB);
        PG8_WAIT_V(6); PG8_BAR;
    } else {
        PG8_STAGE(PG8_SB(0, 0), cB, voffB); PG8_STAGE(PG8_SA(0, 0), cA, voffA); PG8_STAGE(PG8_SB(0, 1), cB + hstep, voffB); PG8_STAGE(PG8_SA(0, 1), cA + hstepA, voffA);
        if (wr == 1) PG8_BAR;
        PG8_WAIT_V(4); PG8_BAR;
        PG8_STAGE(PG8_SB(1, 0), cB + kstep, voffB); PG8_STAGE(PG8_SA(1, 0), cA + kstep, voffA); PG8_STAGE(PG8_SB(1, 1), cB + hstep + kstep, voffB);
        PG8_WAIT_V(6); PG8_BAR;
    }
    for (;;) {
        const bool has_next = S.next(ui + 1, nxt);
        const char* nA = has_next ? (const char*)g.A + (size_t)nxt.pm * tstepA : cA; const char* nB = has_next ? (const char*)g.Bt + (size_t)nxt.pn * tstep : cB;
        for (int t = 0; t < nt; t += 2) {
            const bool last = (t == nt - 2);
            const char* a1 = cA + (size_t)(t + 1) * kstep;
            const char* a2 = last ? nA : cA + (size_t)(t + 2) * kstep; const char* b2 = last ? nB : cB + (size_t)(t + 2) * kstep;
            const char* a3 = a2 + kstep; const char* b3 = b2 + kstep;
            if (last && has_next) S.a_ready(nxt);
            if constexpr (SP2) {
            PG8_LDB(B0, 0, 0); PG8_LDB(B1, 0, 1); PG8_SCHED; PG8_LDA(At, 0, 0); PG8_STAGE(PG8_SA(1, 1), a1 + hstepA, voffA);
            PG8_WAIT_V(8); PG8_WAIT_L(0); PG8_BAR; PG8_MMA(0, 0, At, B0); PG8_MMA(0, 1, At, B1); PG8_BAR; PG8_SCHED;
            PG8_LDA(At, 0, 1); PG8_STAGE(PG8_SB(0, 0), b2, voffB); PG8_STAGE(PG8_SB(0, 1), b2 + hstep, voffB); PG8_STAGE(PG8_SA(0, 0), a2, voffA);
            PG8_WAIT_V(8); PG8_WAIT_L(0); PG8_BAR; PG8_MMA(1, 0, At, B0); PG8_MMA(1, 1, At, B1); PG8_BAR; PG8_SCHED;
            PG8_LDB(B0, 1, 0); PG8_LDB(B1, 1, 1); PG8_SCHED; PG8_LDA(At, 1, 0); PG8_STAGE(PG8_SA(0, 1), a2 + hstepA, voffA);
            PG8_WAIT_V(8); PG8_WAIT_L(0); PG8_BAR; PG8_MMA(0, 0, At, B0); PG8_MMA(0, 1, At, B1); PG8_BAR; PG8_SCHED;
            PG8_LDA(At, 1, 1); PG8_STAGE(PG8_SB(1, 0), b3, voffB); PG8_STAGE(PG8_SB(1, 1), b3 + hstep, voffB); PG8_STAGE(PG8_SA(1, 0), a3, voffA);
            PG8_WAIT_V(8); PG8_WAIT_L(0); PG8_BAR; PG8_MMA(1, 0, At, B0); PG8_MMA(1, 1, At, B1); PG8_BAR; PG8_SCHED;
            } else {
            PG8_LDB(B0, 0, 0); PG8_SCHED; PG8_LDA(At, 0, 0); PG8_STAGE(PG8_SA(1, 1), a1 + hstepA, voffA);
            PG8_WAIT_L(8); PG8_BAR; PG8_WAIT_L(0); PG8_MMA(0, 0, At, B0); PG8_BAR; PG8_SCHED;
            PG8_LDB(B1, 0, 1); PG8_STAGE(PG8_SB(0, 0), b2, voffB);
            PG8_BAR; PG8_WAIT_L(0); PG8_MMA(0, 1, At, B1); PG8_BAR;
            PG8_LDA(At, 0, 1); PG8_STAGE(PG8_SA(0, 0), a2, voffA);
            PG8_BAR; PG8_WAIT_L(0); PG8_MMA(1, 0, At, B0); PG8_BAR; PG8_SCHED;
            PG8_STAGE(PG8_SB(0, 1), b2 + hstep, voffB);
            PG8_WAIT_V(6); PG8_BAR; PG8_MMA(1, 1, At, B1); PG8_BAR;
            PG8_LDB(B0, 1, 0); PG8_SCHED; PG8_LDA(At, 1, 0); PG8_STAGE(PG8_SA(0, 1), a2 + hstepA, voffA);
            PG8_WAIT_L(8); PG8_BAR; PG8_WAIT_L(0); PG8_MMA(0, 0, At, B0); PG8_BAR; PG8_SCHED;
            PG8_LDB(B1, 1, 1); PG8_STAGE(PG8_SB(1, 0), b3, voffB);
            PG8_BAR; PG8_WAIT_L(0); PG8_MMA(0, 1, At, B1); PG8_BAR;
            PG8_LDA(At, 1, 1); PG8_STAGE(PG8_SA(1, 0), a3, voffA);
            PG8_BAR; PG8_WAIT_L(0); PG8_MMA(1, 0, At, B0); PG8_BAR; PG8_SCHED;
            PG8_STAGE(PG8_SB(1, 1), b3 + hstep, voffB);
            PG8_WAIT_V(6); PG8_BAR; PG8_MMA(1, 1, At, B1); PG8_BAR;
            }
        }
        if constexpr (ALIGN_EPI) { if (wr == 0) PG8_BAR; }
        if constexpr (!Epi::AFTER_DRAIN) { E(acc, cur, wr, wc, fr, fq); S.done(cur); }
        if (!has_next) break;
#pragma unroll
        for (int a = 0; a < 2; ++a)
#pragma unroll
            for (int b = 0; b < 2; ++b)
#pragma unroll
                for (int m = 0; m < 4; ++m)
#pragma unroll
                    for (int n = 0; n < 2; ++n) acc[a][b][m][n] = (f32x4){0.f, 0.f, 0.f, 0.f};
        cur = nxt; cA = nA; cB = nB; ++ui;
        if constexpr (ALIGN_EPI) { if (wr == 1) PG8_BAR; }
    }
    PG8_WAIT_V(0);
    if constexpr (!ALIGN_EPI) { if (wr == 0) PG8_BAR; }
    PG8_BAR;
    if constexpr (Epi::AFTER_DRAIN) { E.fused(acc, cur, wr, wc, fr, fq, lds, wid, lane); S.done(cur); }
#undef PG8_SA
#undef PG8_SB
#undef PG8_STAGE
#undef PG8_LDA
#undef PG8_LDB
#undef PG8_MMA
#undef PG8_WAIT_V
#undef PG8_WAIT_L
#undef PG8_BAR
#undef PG8_SCHED
}
}

#define LAS __attribute__((address_space(3)))
typedef unsigned short bf16_t;
typedef short bf16x8 __attribute__((ext_vector_type(8)));
typedef float f32x4 __attribute__((ext_vector_type(4)));
typedef unsigned u32x4 __attribute__((ext_vector_type(4)));
typedef unsigned u32x2 __attribute__((ext_vector_type(2)));
using pg8::Unit;

constexpr int M = 17408, MP = 16384, DM = 1024;
constexpr int NPRW = 1792, NPGLA = 1792, NGATE = 2048, NIN = 5632;
constexpr int FF = 2816, F2 = 5632;
constexpr float NORM_EPS = 1e-6f;
constexpr int NWAVES = 8, NTHREADS = 512;
constexpr int LDS_BYTES = 131072 + 32768;
constexpr size_t OFF_BAR = 512 * 1024;

constexpr size_t MiB = 1u << 20;
constexpr size_t OFF_ROWSS = 0;
constexpr size_t OFF_WIN = 1 * MiB, OFF_WUP = 12 * MiB, OFF_WDN = 23 * MiB, OFF_WO = 29 * MiB, OFF_WOA = 31 * MiB, OFF_WOB = 32 * MiB;
constexpr size_t OFF_W2T = 33 * MiB, OFF_A2T = OFF_W2T + 65536, OFF_G2T = OFF_A2T + 65536;
constexpr size_t OFF_PRW = 35 * MiB, OFF_PGLA = 95 * MiB, OFF_PGATE = 155 * MiB, OFF_G = 223 * MiB;
constexpr size_t OFF_MERGED = OFF_PRW, OFF_UH = OFF_WIN, OFF_X1B = 222 * MiB, OFF_U = OFF_PRW, OFF_ACT = OFF_PRW, OFF_US = 29 * MiB;
static_assert(OFF_PRW + (size_t)M * NPRW * 2 <= OFF_PGLA && OFF_PGLA + (size_t)M * NPGLA * 2 <= OFF_PGATE && OFF_PGATE + (size_t)M * NGATE * 2 <= OFF_G, "ws map");
static_assert(OFF_G + (size_t)M * 512 * 2 <= 256 * MiB && OFF_U + (size_t)M * F2 * 2 <= OFF_X1B && OFF_X1B + (size_t)M * DM * 2 <= 256 * MiB, "ws map");
static_assert(OFF_UH + (size_t)256 * 4 * F2 * 2 <= OFF_WUP && OFF_ACT + (size_t)M * FF * 2 <= OFF_X1B, "ws map");

constexpr size_t OUT_SHIFT_P = (size_t)M * DM, OUT_WKV_P = OUT_SHIFT_P + 8 * 1792, OUT_GLA_P = OUT_WKV_P + 8 * 8 * 64 * 64, OUT_CONV_P = OUT_GLA_P + 8 * 4 * 64 * 128;
constexpr size_t OUT_SHIFT_S = OUT_CONV_P + 8 * 2 * F2, OUT_WKV_S = OUT_SHIFT_S + 128 * 1792, OUT_GLA_S = OUT_WKV_S + (size_t)128 * 8 * 64 * 64, OUT_CONV_S = OUT_GLA_S + (size_t)128 * 4 * 64 * 128;
constexpr size_t OUTB_H = 0, OUTB_EW = 0, OUTB_AARR = (size_t)M * 512 * 2, OUTB_ORW = (size_t)M * 1024 * 2, OUTB_OGL = OUTB_ORW + (size_t)M * 512 * 2;

struct Args { const float* in[31]; float* out; unsigned char* ws; };
#define IN_XP 0
#define IN_XS 1
#define IN_ST_SHIFT 2
#define IN_ST_WKV 3
#define IN_ST_GLA 4
#define IN_ST_CONV 5
#define IN_NORM_MIX 6
#define IN_W_IN 7
#define IN_MU 8
#define IN_W0 9
#define IN_W2 10
#define IN_A0 11
#define IN_A2 12
#define IN_G2 13
#define IN_KK 14
#define IN_KA 15
#define IN_RK 16
#define IN_LNW 17
#define IN_LNB 18
#define IN_WG2 19
#define IN_BG 20
#define IN_GNW 21
#define IN_WOA 22
#define IN_WOB 23
#define IN_WO 24
#define IN_NORM_FFN 25
#define IN_WUP 26
#define IN_CONVW 27
#define IN_CONVB 28
#define IN_WDN 29
#define IN_NORM_FINAL 30

__device__ __forceinline__ float bf_lo(unsigned w) { return __builtin_bit_cast(float, w << 16); }
__device__ __forceinline__ float bf_hi(unsigned w) { return __builtin_bit_cast(float, w & 0xffff0000u); }
__device__ __forceinline__ float bf2f(bf16_t h) { return __builtin_bit_cast(float, (unsigned)h << 16); }
__device__ __forceinline__ unsigned f2bf(float f) { unsigned u = __builtin_bit_cast(unsigned, f); return (u + 0x7fffu + ((u >> 16) & 1u)) >> 16; }
typedef float f32x2_t __attribute__((ext_vector_type(2)));
typedef __bf16 bf16x2_t __attribute__((ext_vector_type(2)));
__device__ __forceinline__ unsigned pk2(float lo, float hi) { const f32x2_t v = {lo, hi}; const bf16x2_t b = __builtin_convertvector(v, bf16x2_t); return __builtin_bit_cast(unsigned, b); }
__device__ __forceinline__ void unpack8(u32x4 w, float (&o)[8]) { o[0] = bf_lo(w.x); o[1] = bf_hi(w.x); o[2] = bf_lo(w.y); o[3] = bf_hi(w.y); o[4] = bf_lo(w.z); o[5] = bf_hi(w.z); o[6] = bf_lo(w.w); o[7] = bf_hi(w.w); }
__device__ __forceinline__ u32x4 pack8(const float (&v)[8]) { u32x4 w; w.x = pk2(v[0], v[1]); w.y = pk2(v[2], v[3]); w.z = pk2(v[4], v[5]); w.w = pk2(v[6], v[7]); return w; }
__device__ __forceinline__ void ld8bf(const bf16_t* p, float (&o)[8]) { unpack8(*(const u32x4*)p, o); }
__device__ __forceinline__ void ld8f(const float* p, float (&o)[8]) { const f32x4 a = *(const f32x4*)p, b = *(const f32x4*)(p + 4); o[0] = a.x; o[1] = a.y; o[2] = a.z; o[3] = a.w; o[4] = b.x; o[5] = b.y; o[6] = b.z; o[7] = b.w; }
__device__ __forceinline__ float fsigmoid(float x) { return __builtin_amdgcn_rcpf(1.f + __expf(-x)); }
__device__ __forceinline__ float ftanh(float x) { return 1.f - 2.f * __builtin_amdgcn_rcpf(__expf(2.f * x) + 1.f); }
__device__ __forceinline__ float fsoftplus(float x) { return fmaxf(x, 0.f) + __logf(1.f + __expf(-fabsf(x))); }
template <int CTRL> __device__ __forceinline__ float dpp_mov(float x) { return __builtin_bit_cast(float, __builtin_amdgcn_mov_dpp(__builtin_bit_cast(int, x), CTRL, 0xf, 0xf, true)); }
__device__ __forceinline__ float row16_allsum(float x) { x += dpp_mov<0xB1>(x); x += dpp_mov<0x4E>(x); x += dpp_mov<0x124>(x); x += dpp_mov<0x128>(x); return x; }
__device__ __forceinline__ float row8_allsum(float x) { x += dpp_mov<0xB1>(x); x += dpp_mov<0x4E>(x); x += dpp_mov<0x141>(x); return x; }
__device__ __forceinline__ float rdlane(float x, int l) { return __builtin_bit_cast(float, __builtin_amdgcn_readlane(__builtin_bit_cast(int, x), l)); }
__device__ __forceinline__ float wave_allsum(float x) { x = row16_allsum(x); return (rdlane(x, 0) + rdlane(x, 16)) + (rdlane(x, 32) + rdlane(x, 48)); }
#define LDS_WAIT() asm volatile("s_waitcnt lgkmcnt(0)" ::: "memory")
__device__ __forceinline__ const float* xrow_ptr(const Args& A, int r) { return r < MP ? A.in[IN_XP] + (size_t)r * DM : A.in[IN_XS] + (size_t)(r - MP) * DM; }

#define XB_TMO      128
#define XB_XCNT(j)  (256  + 64 * (j))
#define XB_XSUB(j)  (1280 + 64 * (j))
#define XB_XGEN(j)  (2304 + 64 * (j))
#define XB_TOP      3328
#define XB_TOPGEN   3392
#define XCD_BAR_WORDS 3456
#define XB_SPIN_CAP (1u << 18)

__device__ __forceinline__ unsigned xb_ld(unsigned* p)              { return __hip_atomic_load(p, __ATOMIC_RELAXED, __HIP_MEMORY_SCOPE_AGENT); }
__device__ __forceinline__ unsigned xb_add(unsigned* p, unsigned v) { return __hip_atomic_fetch_add(p, v, __ATOMIC_RELAXED, __HIP_MEMORY_SCOPE_AGENT); }
__device__ __forceinline__ unsigned xb_xcc_id() { return (unsigned)__builtin_amdgcn_s_getreg((3 << 11) | 20) & 0xFu; }
#define XB_SPIN(cond, bar) do { unsigned _sp = 0; while (cond) { __builtin_amdgcn_s_sleep(1); \
    if ((++_sp & 255u) == 0u) { if (xb_ld(&(bar)[XB_TMO])) break; if (_sp > XB_SPIN_CAP) { atomicAdd(&(bar)[XB_TMO], 1u); break; } } } } while (0)

struct XcdBarrier {
    unsigned* bar; unsigned x;
    volatile LAS unsigned* st;
};

__device__ __forceinline__ XcdBarrier xcd_barrier_post(unsigned* bar, volatile LAS unsigned* st) {
    XcdBarrier b; b.bar = bar; b.x = xb_xcc_id(); b.st = st;
    if (threadIdx.x == 0) (void)xb_add(&bar[XB_XCNT(b.x)], 1u);
    return b;
}
__device__ __forceinline__ void xcd_barrier_complete(unsigned* bar, unsigned x, unsigned& nloc, unsigned& nx) {
    const unsigned G = gridDim.x * gridDim.y * gridDim.z;
    unsigned sum, cnt, mine, sp = 0u;
    for (;;) {
        sum = 0u; cnt = 0u; mine = 0u;
#pragma unroll
        for (unsigned j = 0; j < 16; ++j) { const unsigned c = xb_ld(&bar[XB_XCNT(j)]); sum += c; cnt += (c > 0u) ? 1u : 0u; mine = (j == x) ? c : mine; }
        if (sum == G) break;
        __builtin_amdgcn_s_sleep(1);
        if ((++sp & 255u) == 0u) { if (xb_ld(&bar[XB_TMO])) break; if (sp > XB_SPIN_CAP) { atomicAdd(&bar[XB_TMO], 1u); break; } }
    }
    nloc = mine > 0u ? mine : 1u; nx = cnt > 0u ? cnt : 1u;
}

__device__ __forceinline__ void xcd_barrier(const XcdBarrier& b) {
    asm volatile("s_waitcnt vmcnt(0)" ::: "memory");
    __syncthreads();
    if (threadIdx.x == 0) {
        unsigned* bar = b.bar;
        __builtin_amdgcn_s_waitcnt(0);
        unsigned nloc = b.st[0], nx = b.st[1];
        if (nloc == 0u) { xcd_barrier_complete(bar, b.x, nloc, nx); b.st[0] = nloc; b.st[1] = nx; }
        const unsigned old = xb_add(&bar[XB_XSUB(b.x)], 1u);
        const unsigned gen = old / nloc;
        if (old + 1u == (gen + 1u) * nloc) {
            __builtin_amdgcn_fence(__ATOMIC_RELEASE, "agent");
            asm volatile("s_waitcnt vmcnt(0)" ::: "memory");
            const unsigned og = xb_add(&bar[XB_TOP], 1u);
            const unsigned tg = og / nx;
            if (og + 1u == (tg + 1u) * nx) xb_add(&bar[XB_TOPGEN], 1u);
            else XB_SPIN(xb_ld(&bar[XB_TOPGEN]) == tg, bar);
            __builtin_amdgcn_fence(__ATOMIC_ACQUIRE, "agent");
            xb_add(&bar[XB_XGEN(b.x)], 1u);
            asm volatile("s_waitcnt vmcnt(0)" ::: "memory");
        } else {
            XB_SPIN(xb_ld(&bar[XB_XGEN(b.x)]) == gen, bar);
            __builtin_amdgcn_fence(__ATOMIC_ACQUIRE, "agent");
            asm volatile("s_waitcnt vmcnt(0)" ::: "memory");
        }
    }
    __syncthreads();
}


struct EpiProj {
    static constexpr bool PERM = true, AFTER_DRAIN = false;
    bf16_t *prw, *pgla, *pgate; float *shift_p, *shift_s;
    __device__ __forceinline__ void operator()(const f32x4 (&acc)[2][2][4][2], const Unit& u, int wr, int wc, int fr, int fq) const {
        asm volatile("" : "+v"(fr), "+v"(fq));
        bf16_t* base; int ld, colt;
        if (u.pn < 7) { base = prw; ld = NPRW; colt = u.pn * 256; } else if (u.pn < 14) { base = pgla; ld = NPGLA; colt = (u.pn - 7) * 256; } else { base = pgate; ld = NGATE; colt = (u.pn - 14) * 256; }
        const int row0 = u.pm * 256 + wr * 64 + fr, col0 = colt + wc * 32 + 8 * fq;
#pragma unroll
        for (int ai = 0; ai < 2; ++ai)
#pragma unroll
            for (int m = 0; m < 4; ++m) {
                const int r = row0 + ai * 128 + m * 16; bf16_t* rowp = base + (size_t)r * ld + col0;
#pragma unroll
                for (int bj = 0; bj < 2; ++bj) { const f32x4 v0 = acc[ai][bj][m][0], v1 = acc[ai][bj][m][1]; u32x4 w; w.x = pk2(v0[0], v0[1]); w.y = pk2(v0[2], v0[3]); w.z = pk2(v1[0], v1[1]); w.w = pk2(v1[2], v1[3]); *(u32x4*)(rowp + bj * 128) = w; }
            }
    }
};
template <bool FIRST> struct EpiGate {
    static constexpr bool PERM = true, AFTER_DRAIN = false;
    bf16_t* merged; const bf16_t* gate;
    __device__ __forceinline__ void operator()(const f32x4 (&acc)[2][2][4][2], const Unit& u, int wr, int wc, int fr, int fq) const {
        asm volatile("" : "+v"(fr), "+v"(fq));
        const int row0 = u.pm * 256 + wr * 64 + fr, col0 = u.pn * 256 + wc * 32 + 8 * fq;
#pragma unroll
        for (int ai = 0; ai < 2; ++ai) {
            u32x4 gr[4][2], pr[4][2];
#pragma unroll
            for (int m = 0; m < 4; ++m)
#pragma unroll
                for (int bj = 0; bj < 2; ++bj) { const size_t r = (size_t)(row0 + ai * 128 + m * 16); const int c = col0 + bj * 128; gr[m][bj] = *(const u32x4*)(gate + r * NGATE + c); if (!FIRST) pr[m][bj] = *(const u32x4*)(merged + r * DM + c); }
#pragma unroll
            for (int m = 0; m < 4; ++m)
#pragma unroll
                for (int bj = 0; bj < 2; ++bj) { const size_t r = (size_t)(row0 + ai * 128 + m * 16); const int c = col0 + bj * 128; float g[8], v[8]; unpack8(gr[m][bj], g);
                    const f32x4 v0 = acc[ai][bj][m][0], v1 = acc[ai][bj][m][1];
#pragma unroll
                    for (int i = 0; i < 4; ++i) { v[i] = v0[i] * fsigmoid(g[i]); v[4 + i] = v1[i] * fsigmoid(g[4 + i]); }
                    if (!FIRST) { float p[8]; unpack8(pr[m][bj], p);
#pragma unroll
                        for (int i = 0; i < 8; ++i) v[i] += p[i]; }
                    *(u32x4*)(merged + r * DM + c) = pack8(v); }
        }
    }
};
struct EpiX1 {
    static constexpr bool PERM = true, AFTER_DRAIN = false;
    const float *xp, *xs; float* x1; bf16_t* x1b; float* rowss;
    __device__ __forceinline__ void operator()(const f32x4 (&acc)[2][2][4][2], const Unit& u, int wr, int wc, int fr, int fq) const {
        asm volatile("" : "+v"(fr), "+v"(fq));
        const int row0 = u.pm * 256 + wr * 64 + fr, col0 = u.pn * 256 + wc * 32 + 8 * fq;
#pragma unroll
        for (int ai = 0; ai < 2; ++ai) {
            f32x4 xa[4][2][2];
#pragma unroll
            for (int m = 0; m < 4; ++m) { const int r = row0 + ai * 128 + m * 16; const float* xr = (r < MP ? xp + (size_t)r * DM : xs + (size_t)(r - MP) * DM);
#pragma unroll
                for (int bj = 0; bj < 2; ++bj) { xa[m][bj][0] = *(const f32x4*)(xr + col0 + bj * 128); xa[m][bj][1] = *(const f32x4*)(xr + col0 + bj * 128 + 4); } }
#pragma unroll
            for (int m = 0; m < 4; ++m) { const int r = row0 + ai * 128 + m * 16; float ssq = 0.f;
#pragma unroll
                for (int bj = 0; bj < 2; ++bj) { const int c = col0 + bj * 128; const f32x4 a = xa[m][bj][0] + acc[ai][bj][m][0], b = xa[m][bj][1] + acc[ai][bj][m][1];
                    ssq += (a[0] * a[0] + a[1] * a[1]) + (a[2] * a[2] + a[3] * a[3]) + (b[0] * b[0] + b[1] * b[1]) + (b[2] * b[2] + b[3] * b[3]);
                    float* o = x1 + (size_t)r * DM + c; *(f32x4*)o = a; *(f32x4*)(o + 4) = b;
                    u32x4 w; w.x = pk2(a[0], a[1]); w.y = pk2(a[2], a[3]); w.z = pk2(b[0], b[1]); w.w = pk2(b[2], b[3]); *(u32x4*)(x1b + (size_t)r * DM + c) = w; }
                ssq += __shfl_xor(ssq, 16); ssq += __shfl_xor(ssq, 32);
                if (fq == 0) atomicAdd(rowss + r, ssq); }
        }
    }
};
struct EpiX2 {
    static constexpr bool PERM = true, AFTER_DRAIN = false;
    float* x; float* xd;
    __device__ __forceinline__ void operator()(const f32x4 (&acc)[2][2][4][2], const Unit& u, int wr, int wc, int fr, int fq) const {
        asm volatile("" : "+v"(fr), "+v"(fq));
        const int row0 = u.pm * 256 + wr * 64 + fr, col0 = u.pn * 256 + wc * 32 + 8 * fq;
#pragma unroll
        for (int ai = 0; ai < 2; ++ai) {
            f32x4 xa[4][2][2];
#pragma unroll
            for (int m = 0; m < 4; ++m)
#pragma unroll
                for (int bj = 0; bj < 2; ++bj) { const float* o = x + (size_t)(row0 + ai * 128 + m * 16) * DM + col0 + bj * 128; xa[m][bj][0] = *(const f32x4*)o; xa[m][bj][1] = *(const f32x4*)(o + 4); }
#pragma unroll
            for (int m = 0; m < 4; ++m)
#pragma unroll
                for (int bj = 0; bj < 2; ++bj) { float* o = xd + (size_t)(row0 + ai * 128 + m * 16) * DM + col0 + bj * 128; *(f32x4*)o = xa[m][bj][0] + acc[ai][bj][m][0]; *(f32x4*)(o + 4) = xa[m][bj][1] + acc[ai][bj][m][1]; }
        }
    }
};
__device__ __forceinline__ float gelu_gate(float g, float v) { const float t = g * (1.f + 0.044715f * g * g) * 1.5957691216057308f; return g * fsigmoid(t) * v; }
struct EpiU {
    static constexpr bool PERM = true, AFTER_DRAIN = false;
    const float* rowss; bf16_t *U, *uh; float *conv_p, *conv_s;
    __device__ __forceinline__ void operator()(const f32x4 (&acc)[2][2][4][2], const Unit& u, int wr, int wc, int fr, int fq) const {
        asm volatile("" : "+v"(fr), "+v"(fq));
        const int row0 = u.pm * 256 + wr * 64 + fr, col0 = u.pn * 256 + wc * 32 + 8 * fq;
#pragma unroll
        for (int ai = 0; ai < 2; ++ai)
#pragma unroll
            for (int m = 0; m < 4; ++m) { const int r = row0 + ai * 128 + m * 16; const float rs = rsqrtf(rowss[r] * (1.f / DM) + NORM_EPS);
#pragma unroll
                for (int bj = 0; bj < 2; ++bj) { const int c = col0 + bj * 128; const f32x4 v0 = acc[ai][bj][m][0] * rs, v1 = acc[ai][bj][m][1] * rs;
                    u32x4 w; w.x = pk2(v0[0], v0[1]); w.y = pk2(v0[2], v0[3]); w.z = pk2(v1[0], v1[1]); w.w = pk2(v1[2], v1[3]);
                    *(u32x4*)(U + (size_t)r * F2 + c) = w;
                    if (m == 3 && fr >= 14 && r < MP) { *(u32x4*)(uh + ((size_t)(r >> 6) * 2 + (fr - 14)) * F2 + c) = w;
                        if ((r & 2047) >= 2046) { float* cp = conv_p + ((size_t)(r >> 11) * 2 + (fr - 14)) * F2 + c; *(f32x4*)cp = v0; *(f32x4*)(cp + 4) = v1; } }
                    if (r >= MP && (fr & 7) >= 6) { float* cp = conv_s + ((size_t)((r - MP) >> 3) * 2 + ((fr & 7) - 6)) * F2 + c; *(f32x4*)cp = v0; *(f32x4*)(cp + 4) = v1; } } }
    }
};

struct EpiAct {
    static constexpr bool PERM = true, AFTER_DRAIN = false;
    const float *rowss, *convw, *convb; bf16_t *act, *uh, *us; float *conv_p, *conv_s; LAS float* ringbase;
    __device__ __forceinline__ void operator()(const f32x4 (&acc)[2][2][4][2], const Unit& u, int wr_, int wc_, int fr_, int fq_) const {
        int wr = wr_, wc = wc_, fr = fr_, fq = fq_;
        asm volatile("" : "+v"(fr), "+v"(fq)); asm volatile("" : "+s"(wr), "+s"(wc));
        const bool sample = u.pm >= 64;
        const int jc0 = u.pn * 128 + wc * 32 + 8 * fq;
        LAS float* ring = ringbase + (wr * 4 + wc) * 512;
#pragma unroll
        for (int ai = 0; ai < 2; ++ai) {
            const int rbase = u.pm * 256 + ai * 128 + wr * 64, grp = rbase >> 6;
#pragma unroll
            for (int m = 0; m < 4; ++m) {
                const int row = rbase + 16 * m + fr;
                const bool wuh = !sample && ((m == 0 && fr < 2) || (m == 3 && fr >= 14)), wus = sample && (fr & 7) < 2, wcs = sample && (fr & 7) >= 6;
                if (wuh || wus || wcs) {
                    const float rsm = rsqrtf(rowss[row] * (1.f / DM) + NORM_EPS);
#pragma unroll
                    for (int bj = 0; bj < 2; ++bj) { const f32x4 v0 = acc[ai][bj][m][0] * rsm, v1 = acc[ai][bj][m][1] * rsm;
                        if (wcs) { float* cp = conv_s + ((size_t)((row - MP) >> 3) * 2 + ((fr & 7) - 6)) * F2 + bj * FF + jc0; *(f32x4*)cp = v0; *(f32x4*)(cp + 4) = v1; }
                        else { u32x4 w; w.x = pk2(v0[0], v0[1]); w.y = pk2(v0[2], v0[3]); w.z = pk2(v1[0], v1[1]); w.w = pk2(v1[2], v1[3]);
                            bf16_t* dst = wuh ? uh + ((size_t)grp * 4 + (m == 0 ? fr : fr - 12)) * F2 : us + ((size_t)((row - MP) >> 3) * 2 + (fr & 7)) * F2;
                            *(u32x4*)(dst + bj * FF + jc0) = w;
                            if (wuh && m == 3 && (grp & 31) == 31) { float* cp = conv_p + ((size_t)(rbase >> 11) * 2 + (fr - 14)) * F2 + bj * FF + jc0; *(f32x4*)cp = v0; *(f32x4*)(cp + 4) = v1; } } }
                }
            }
        }
        asm volatile("" ::: "memory");
        float rsq[2][4];
#pragma unroll
        for (int ai = 0; ai < 2; ++ai)
#pragma unroll
            for (int m = 0; m < 4; ++m) rsq[ai][m] = rsqrtf(rowss[u.pm * 256 + ai * 128 + wr * 64 + 16 * m + fr] * (1.f / DM) + NORM_EPS);
#define EPIACT_STEP(AI, N) do { const int rbase = u.pm * 256 + (AI) * 128 + wr * 64; \
            _Pragma("unroll") for (int m = 0; m < 4; ++m) { const float rsm = rsq[AI][m]; \
                const f32x4 xv = acc[AI][0][m][N] * rsm, xg = acc[AI][1][m][N] * rsm; const int idx = (m & 1) * 16 + fr; \
                asm volatile("" ::: "memory"); *(LAS f32x4*)(ring + idx * 16 + fq * 4) = xv; *(LAS f32x4*)(ring + 4096 + idx * 16 + fq * 4) = xg; asm volatile("" ::: "memory");     \
                const f32x4 p1v = *(const LAS f32x4*)(ring + ((idx + 31) & 31) * 16 + fq * 4), p2v = *(const LAS f32x4*)(ring + ((idx + 30) & 31) * 16 + fq * 4); \
                const f32x4 p1g = *(const LAS f32x4*)(ring + 4096 + ((idx + 31) & 31) * 16 + fq * 4), p2g = *(const LAS f32x4*)(ring + 4096 + ((idx + 30) & 31) * 16 + fq * 4); \
                const f32x4 cv = cbv + w0v * p2v + w1v * p1v + w2v * xv, cg = cbg + w0g * p2g + w1g * p1g + w2g * xg; \
                const bool fix = sample ? ((fr & 7) < 2) : (m == 0 && fr < 2); \
                if (!fix) { u32x2 w; w.x = pk2(gelu_gate(cg[0], cv[0]), gelu_gate(cg[1], cv[1])); w.y = pk2(gelu_gate(cg[2], cv[2]), gelu_gate(cg[3], cv[3])); \
                    *(u32x2*)(act + (size_t)(rbase + 16 * m + fr) * FF + jc0 + 4 * (N)) = w; } } } while (0)
#define EPIACT_N(N) do { const int col4 = jc0 + 4 * (N); \
            const f32x4 w0v = *(const f32x4*)(convw + col4), w1v = *(const f32x4*)(convw + F2 + col4), w2v = *(const f32x4*)(convw + 2 * F2 + col4), cbv = *(const f32x4*)(convb + col4); \
            const f32x4 w0g = *(const f32x4*)(convw + FF + col4), w1g = *(const f32x4*)(convw + F2 + FF + col4), w2g = *(const f32x4*)(convw + 2 * F2 + FF + col4), cbg = *(const f32x4*)(convb + FF + col4); \
            EPIACT_STEP(0, N); EPIACT_STEP(1, N); asm volatile("" ::: "memory"); } while (0)
        EPIACT_N(0); EPIACT_N(1);
#undef EPIACT_N
#undef EPIACT_STEP
    }
};

template <class EF> __device__ __forceinline__ void tail_gemm(LAS unsigned char* lds, const bf16_t* Amat, int lda, const bf16_t* Bt, int K, const pg8::StaticOrder& S, int wave, int lane, const EF& ef) {
    const int l15 = lane & 15, q = lane >> 4, ntail = S.nwg - S.limit, nk = K / 256;
    LAS float* red = (LAS float*)lds;
    for (int item = blockIdx.x; item < ntail * 16; item += gridDim.x) {
        pg8::Unit u; S.unit_of(S.limit + (item >> 4), u);
        const int r0 = u.pm * 256 + (item & 15) * 16, c0 = u.pn * 256;
        const bf16_t* ap = Amat + (size_t)(r0 + l15) * lda + 8 * q + 32 * nk * wave; const bf16_t* bp = Bt + (size_t)(c0 + l15) * K + 8 * q + 32 * nk * wave;
        f32x4 acc[16];
#pragma unroll
        for (int n = 0; n < 16; ++n) acc[n] = (f32x4){0.f, 0.f, 0.f, 0.f};
#pragma unroll 2
        for (int ks = 0; ks < nk; ++ks) {
            const bf16x8 a = *(const bf16x8*)(ap + 32 * ks); bf16x8 b[16];
#pragma unroll
            for (int n = 0; n < 16; ++n) b[n] = *(const bf16x8*)(bp + (size_t)(16 * n) * K + 32 * ks);
#pragma unroll
            for (int n = 0; n < 16; ++n) acc[n] = __builtin_amdgcn_mfma_f32_16x16x32_bf16(a, b[n], acc[n], 0, 0, 0);
        }
        __syncthreads();
#pragma unroll
        for (int n = 0; n < 16; ++n) *(LAS f32x4*)(red + ((wave * 16 + n) * 64 + lane) * 4) = acc[n];
        __syncthreads();
        f32x4 s0 = {0.f, 0.f, 0.f, 0.f}, s1 = s0;
#pragma unroll
        for (int w2 = 0; w2 < 8; ++w2) { s0 += *(const LAS f32x4*)(red + ((w2 * 16 + 2 * wave) * 64 + lane) * 4); s1 += *(const LAS f32x4*)(red + ((w2 * 16 + 2 * wave + 1) * 64 + lane) * 4); }
        ef(r0 + 4 * q, c0 + 32 * wave + l15, s0, s1);
    }
    __syncthreads();
}
struct TfGate { bool first; bf16_t* merged; const bf16_t* gate;
    __device__ __forceinline__ void operator()(int row, int col, f32x4 a0, f32x4 a1) const {
#pragma unroll
        for (int i = 0; i < 4; ++i)
#pragma unroll
            for (int n = 0; n < 2; ++n) { const size_t r = (size_t)(row + i); const int c = col + 16 * n; float v = (n ? a1[i] : a0[i]) * fsigmoid(bf2f(gate[r * NGATE + c]));
                if (!first) v += bf2f(merged[r * DM + c]); merged[r * DM + c] = (bf16_t)f2bf(v); } } };
struct TfX1 { const float *xp, *xs; float* x1; bf16_t* x1b; float* rowss;
    __device__ __forceinline__ void operator()(int row, int col, f32x4 a0, f32x4 a1) const {
#pragma unroll
        for (int i = 0; i < 4; ++i) { const int r = row + i; const float* xr = (r < MP ? xp + (size_t)r * DM : xs + (size_t)(r - MP) * DM);
            const float v0 = xr[col] + a0[i], v1 = xr[col + 16] + a1[i];
            x1[(size_t)r * DM + col] = v0; x1[(size_t)r * DM + col + 16] = v1; x1b[(size_t)r * DM + col] = (bf16_t)f2bf(v0); x1b[(size_t)r * DM + col + 16] = (bf16_t)f2bf(v1);
            const float ss = row16_allsum(v0 * v0 + v1 * v1); if ((col & 15) == 0) atomicAdd(rowss + r, ss); } } };
struct TfX2 { float* x; float* xd;
    __device__ __forceinline__ void operator()(int row, int col, f32x4 a0, f32x4 a1) const {
#pragma unroll
        for (int i = 0; i < 4; ++i) { const size_t off = (size_t)(row + i) * DM + col; xd[off] = x[off] + a0[i]; xd[off + 16] = x[off + 16] + a1[i]; } } };

template <int MODE> __device__ __forceinline__ int map_col(int R) {
    if (MODE == 1) { if (R < 1792) return R; if (R < 3584) return (R - 1792 < 1552) ? R : -1; return R - 240; }
    if (MODE == 2) { return ((R >> 7) & 1) * FF + ((R >> 8) << 7) + (R & 127); }
    return R;
}
template <int MODE> __device__ __forceinline__ void tr_item(const float* __restrict__ W, int K, int Nsrc, int Ndst, bf16_t* WT, const float* kscale, LAS float* scr, int item, int lane) {
    const int nblk = Ndst >> 5, kb = item / nblk, nb = item - kb * nblk, k0 = kb << 6, n0 = nb << 5;
    const int col = map_col<MODE>(n0 + (lane & 31));
    float tv[32];
#pragma unroll
    for (int i = 0; i < 32; ++i) { const int kk = 2 * i + (lane >> 5); tv[i] = (col >= 0) ? W[(size_t)(k0 + kk) * Nsrc + col] : 0.f; }
#pragma unroll
    for (int i = 0; i < 32; ++i) { const int kk = 2 * i + (lane >> 5); float v = tv[i]; if (kscale) v *= kscale[k0 + kk]; scr[kk * 33 + (lane & 31)] = v; }
    LDS_WAIT();
    const int c = lane & 7;
#pragma unroll
    for (int j = 0; j < 4; ++j) { const int n = (lane >> 3) + 8 * j; const LAS float* s = scr + (8 * c) * 33 + n;
        u32x4 o; o.x = pk2(s[0 * 33], s[1 * 33]); o.y = pk2(s[2 * 33], s[3 * 33]); o.z = pk2(s[4 * 33], s[5 * 33]); o.w = pk2(s[6 * 33], s[7 * 33]);
        *(u32x4*)(WT + (size_t)(n0 + n) * K + k0 + 8 * c) = o; }
    LDS_WAIT();
}
__device__ __forceinline__ void p0_prologue(const Args& A, LAS unsigned char* lds, int gw, int NGW, int wave, int lane) {
    LAS float* scr = (LAS float*)(lds + wave * 16384);
    unsigned char* ws = A.ws;
    constexpr int I_IN = 16 * (NIN / 32), I_UP = 16 * (F2 / 32), I_DN = 44 * 32, I_O = 16 * 32, I_OA = 8 * 32, I_W2 = 16, I_G2 = 2 * 16;
    constexpr int NITEMS = I_IN + I_UP + I_DN + I_O + 2 * I_OA + 2 * I_W2 + I_G2;
    for (int it = gw; it < NITEMS; it += NGW) {
        int r = it;
        if (r < I_IN) { tr_item<1>(A.in[IN_W_IN], 1024, 5392, NIN, (bf16_t*)(ws + OFF_WIN), nullptr, scr, r, lane); continue; } r -= I_IN;
        if (r < I_UP) { tr_item<2>(A.in[IN_WUP], 1024, F2, F2, (bf16_t*)(ws + OFF_WUP), A.in[IN_NORM_FFN], scr, r, lane); continue; } r -= I_UP;
        if (r < I_DN) { tr_item<0>(A.in[IN_WDN], FF, 1024, 1024, (bf16_t*)(ws + OFF_WDN), nullptr, scr, r, lane); continue; } r -= I_DN;
        if (r < I_O) { tr_item<0>(A.in[IN_WO], 1024, 1024, 1024, (bf16_t*)(ws + OFF_WO), nullptr, scr, r, lane); continue; } r -= I_O;
        if (r < I_OA) { tr_item<0>(A.in[IN_WOA], 512, 1024, 1024, (bf16_t*)(ws + OFF_WOA), nullptr, scr, r, lane); continue; } r -= I_OA;
        if (r < I_OA) { tr_item<0>(A.in[IN_WOB], 512, 1024, 1024, (bf16_t*)(ws + OFF_WOB), nullptr, scr, r, lane); continue; } r -= I_OA;
        if (r < I_W2) { tr_item<0>(A.in[IN_W2], 64, 512, 512, (bf16_t*)(ws + OFF_W2T), nullptr, scr, r, lane); continue; } r -= I_W2;
        if (r < I_W2) { tr_item<0>(A.in[IN_A2], 64, 512, 512, (bf16_t*)(ws + OFF_A2T), nullptr, scr, r, lane); continue; } r -= I_W2;
        tr_item<0>(A.in[IN_G2], 128, 512, 512, (bf16_t*)(ws + OFF_G2T), nullptr, scr, r, lane);
    }
    bf16_t* H = (bf16_t*)((unsigned char*)A.out + OUTB_H);
    const float* gm = A.in[IN_NORM_MIX];
    for (int m = gw; m < M; m += 2 * NGW) {
        const int m2 = m + NGW; const bool has2 = m2 < M;
        const f32x4* xr = (const f32x4*)xrow_ptr(A, m) + lane; const f32x4* xr2 = (const f32x4*)xrow_ptr(A, has2 ? m2 : m) + lane; f32x4 v[4], w[4]; float s = 0.f, s2 = 0.f;
#pragma unroll
        for (int j = 0; j < 4; ++j) { v[j] = xr[64 * j]; w[j] = xr2[64 * j]; }
#pragma unroll
        for (int j = 0; j < 4; ++j) { s += (v[j].x * v[j].x + v[j].y * v[j].y) + (v[j].z * v[j].z + v[j].w * v[j].w); s2 += (w[j].x * w[j].x + w[j].y * w[j].y) + (w[j].z * w[j].z + w[j].w * w[j].w); }
        const float rstd = rsqrtf(wave_allsum(s) * (1.f / DM) + NORM_EPS), rstd2 = rsqrtf(wave_allsum(s2) * (1.f / DM) + NORM_EPS);
        u32x2* o8 = (u32x2*)(H + (size_t)m * DM) + lane; u32x2* o82 = (u32x2*)(H + (size_t)m2 * DM) + lane;
#pragma unroll
        for (int j = 0; j < 4; ++j) { const f32x4 g = *((const f32x4*)gm + lane + 64 * j); u32x2 p; p.x = pk2(v[j].x * rstd * g.x, v[j].y * rstd * g.y); p.y = pk2(v[j].z * rstd * g.z, v[j].w * rstd * g.w); o8[64 * j] = p;
            if (has2) { u32x2 p2; p2.x = pk2(w[j].x * rstd2 * g.x, w[j].y * rstd2 * g.y); p2.y = pk2(w[j].z * rstd2 * g.z, w[j].w * rstd2 * g.w); o82[64 * j] = p2; } }
    }
    float* rowss = (float*)(ws + OFF_ROWSS);
    for (int i = gw * 64 + lane; i < M; i += NGW * 64) rowss[i] = 0.f;
}

__device__ __forceinline__ void prw_mixed8(const Args& A, const bf16_t* PRW, int r, int col0, float (&xs)[8]) {
    float cur[8], prev[8];
    ld8bf(PRW + (size_t)r * NPRW + col0, cur);
    const bool first = (r < MP) ? ((r & 2047) == 0) : (((r - MP) & 7) == 0);
    if (!first) ld8bf(PRW + (size_t)(r - 1) * NPRW + col0, prev);
    else if (r < MP) {
#pragma unroll
        for (int i = 0; i < 8; ++i) prev[i] = 0.f;
    } else ld8f(A.in[IN_ST_SHIFT] + (size_t)((r - MP) >> 3) * 1792 + col0, prev);
    float mu[8]; ld8f(A.in[IN_MU] + col0, mu);
#pragma unroll
    for (int i = 0; i < 8; ++i) xs[i] = cur[i] + (prev[i] - cur[i]) * mu[i];
}
template <int ACT> __device__ __forceinline__ bf16x8 afrag(const Args& A, const bf16_t* PRW, int r, int col0) {
    float xs[8]; prw_mixed8(A, PRW, r, col0, xs);
#pragma unroll
    for (int i = 0; i < 8; ++i) xs[i] = ACT == 1 ? ftanh(xs[i]) : (ACT == 2 ? fsigmoid(xs[i]) : xs[i]);
    return __builtin_bit_cast(bf16x8, pack8(xs));
}
__device__ __forceinline__ void p2a_lora(const Args& A, LAS unsigned char* lds, int gw, int NGW, int wave, int lane) {
    const bf16_t* PRW = (const bf16_t*)(A.ws + OFF_PRW);
    const bf16_t *W2T = (const bf16_t*)(A.ws + OFF_W2T), *A2T = (const bf16_t*)(A.ws + OFF_A2T), *G2T = (const bf16_t*)(A.ws + OFF_G2T);
    bf16_t *EW = (bf16_t*)((unsigned char*)A.out + OUTB_EW), *AARR = (bf16_t*)((unsigned char*)A.out + OUTB_AARR), *G = (bf16_t*)(A.ws + OFF_G);
    for (int i = gw * 64 + lane; i < 136 * 224; i += NGW * 64) { const int sq = i / 224, c8 = (i - sq * 224) * 8; const int r = sq < 8 ? sq * 2048 + 2047 : MP + (sq - 8) * 8 + 7;
        float v[8]; ld8bf(PRW + (size_t)r * NPRW + c8, v); float* dst = (sq < 8 ? A.out + OUT_SHIFT_P + (size_t)sq * 1792 : A.out + OUT_SHIFT_S + (size_t)(sq - 8) * 1792) + c8;
        *(f32x4*)dst = (f32x4){v[0], v[1], v[2], v[3]}; *(f32x4*)(dst + 4) = (f32x4){v[4], v[5], v[6], v[7]}; }
    const int l15 = lane & 15, kq = lane >> 4;
    LAS bf16_t* acts = (LAS bf16_t*)lds; const int tid = wave * 64 + lane;
    for (int tile = blockIdx.x; tile < M / 16; tile += gridDim.x) {
        const int h = wave, t0 = tile * 16;
        { const int tt = tid >> 5, cg = tid & 31; float xs[8]; prw_mixed8(A, PRW, t0 + tt, 1536 + 8 * cg, xs);
#pragma unroll
          for (int i = 0; i < 8; ++i) xs[i] = cg < 8 ? ftanh(xs[i]) : (cg < 16 ? xs[i] : fsigmoid(xs[i]));
          __syncthreads();
          *(LAS u32x4*)(acts + tt * 264 + 8 * cg) = pack8(xs); }
        __syncthreads();
        bf16x8 aw[2], aa[2], ag[4];
#pragma unroll
        for (int ks = 0; ks < 2; ++ks) { aw[ks] = *(const LAS bf16x8*)(acts + l15 * 264 + ks * 32 + kq * 8); aa[ks] = *(const LAS bf16x8*)(acts + l15 * 264 + 64 + ks * 32 + kq * 8); }
#pragma unroll
        for (int ks = 0; ks < 4; ++ks) ag[ks] = *(const LAS bf16x8*)(acts + l15 * 264 + 128 + ks * 32 + kq * 8);
        f32x4 cwv[4], cav[4], cgg[4];
#pragma unroll
        for (int nt = 0; nt < 4; ++nt) {
            const int c = 64 * h + 16 * nt + l15;
            f32x4 cw = {0.f, 0.f, 0.f, 0.f}, ca = cw, cgv = cw;
#pragma unroll
            for (int ks = 0; ks < 2; ++ks) {
                const bf16x8 bw = *(const bf16x8*)(W2T + (size_t)c * 64 + ks * 32 + kq * 8), ba = *(const bf16x8*)(A2T + (size_t)c * 64 + ks * 32 + kq * 8);
                cw = __builtin_amdgcn_mfma_f32_16x16x32_bf16(bw, aw[ks], cw, 0, 0, 0); ca = __builtin_amdgcn_mfma_f32_16x16x32_bf16(ba, aa[ks], ca, 0, 0, 0); }
#pragma unroll
            for (int ks = 0; ks < 4; ++ks) { const bf16x8 bg = *(const bf16x8*)(G2T + (size_t)c * 128 + ks * 32 + kq * 8); cgv = __builtin_amdgcn_mfma_f32_16x16x32_bf16(bg, ag[ks], cgv, 0, 0, 0); }
            cwv[nt] = cw; cav[nt] = ca; cgg[nt] = cgv;
        }
#pragma unroll
        for (int nt = 0; nt < 4; ++nt) {
            const int c4 = 64 * h + 16 * nt + 4 * kq; const size_t o = (size_t)(t0 + l15) * 512 + c4;
            const f32x4 w0v = *(const f32x4*)(A.in[IN_W0] + c4), a0v = *(const f32x4*)(A.in[IN_A0] + c4);
            float ew[4], av[4];
#pragma unroll
            for (int i = 0; i < 4; ++i) { ew[i] = 0.6065306597f * fsigmoid(w0v[i] + cwv[nt][i]); av[i] = fsigmoid(a0v[i] + cav[nt][i]); }
            u32x2 w; w.x = pk2(ew[0], ew[1]); w.y = pk2(ew[2], ew[3]); *(u32x2*)(EW + o) = w;
            w.x = pk2(av[0], av[1]); w.y = pk2(av[2], av[3]); *(u32x2*)(AARR + o) = w;
            w.x = pk2(cgg[nt][0], cgg[nt][1]); w.y = pk2(cgg[nt][2], cgg[nt][3]); *(u32x2*)(G + o) = w;
        }
    }
}

typedef short bf16x4 __attribute__((ext_vector_type(4)));
#define MFMA32(a, b, c) __builtin_amdgcn_mfma_f32_16x16x32_bf16(a, b, c, 0, 0, 0)
#define MFMA16(a, b, c) __builtin_amdgcn_mfma_f32_16x16x16bf16_1k(a, b, c, 0, 0, 0)
constexpr int SP = 72;
constexpr size_t OFF_RLT = 240 * MiB;
constexpr size_t OFF_GL = 1 * MiB, OFF_GG = 8 * MiB;
static_assert(OFF_RLT + (size_t)448 * 32768 <= 256 * MiB && OFF_GL + (size_t)224 * 32768 <= OFF_GG && OFF_GG + 224 * 256 <= OFF_WUP, "ws map (scan)");
__device__ __forceinline__ bf16x4 bf4(f32x4 v) { u32x2 w; w.x = pk2(v[0], v[1]); w.y = pk2(v[2], v[3]); return __builtin_bit_cast(bf16x4, w); }
__device__ __forceinline__ bf16x8 afr(const LAS bf16_t* X, int l15, int q, int ks) { const LAS bf16_t* p = X + l15 * SP + 32 * ks + 4 * q; const u32x2 lo = *(const LAS u32x2*)p, hi = *(const LAS u32x2*)(p + 16); u32x4 w; w.x = lo.x; w.y = lo.y; w.z = hi.x; w.w = hi.y; return __builtin_bit_cast(bf16x8, w); }
__device__ __forceinline__ bf16x8 hfrag(const f32x4& lo, const f32x4& hi) { u32x4 w; w.x = pk2(lo[0], lo[1]); w.y = pk2(lo[2], lo[3]); w.z = pk2(hi[0], hi[1]); w.w = pk2(hi[2], hi[3]); return __builtin_bit_cast(bf16x8, w); }
__device__ __forceinline__ f32x4 maskc(f32x4 v, int q, int l15, bool rows_lt_col, bool incl) {
#pragma unroll
    for (int i = 0; i < 4; ++i) { const int R = 4 * q + i; const bool keep = rows_lt_col ? (incl ? R <= l15 : R < l15) : (incl ? l15 <= R : l15 < R); v[i] = keep ? v[i] : 0.f; }
    return v;
}
template <bool GLA, int VP> __device__ __forceinline__ void scan_matrix_part(const LAS bf16_t* AT, const LAS bf16_t* RT, const LAS bf16_t* BT, const LAS bf16_t* KT, const LAS bf16_t* VS, const LAS float* GC, bf16_t* OUTP, int l15, int q, int sl, bool use_v, bool write_o, int rowb, int nv, f32x4 (&H)[4]) {
    const bf16x8 hb0 = hfrag(H[0], H[1]), hb1 = hfrag(H[2], H[3]);
    const bf16x8 rt0 = afr(RT, l15, q, 0), rt1 = afr(RT, l15, q, 1), kt0 = afr(KT, l15, q, 0), kt1 = afr(KT, l15, q, 1);
    const f32x4 z4 = {0.f, 0.f, 0.f, 0.f};
    bf16x4 vb = {0, 0, 0, 0};
    if (use_v) { const LAS bf16_t* vp = VS + (4 * q) * VP + 16 * sl + l15; u32x2 w; w.x = (unsigned)vp[0] | ((unsigned)vp[VP] << 16); w.y = (unsigned)vp[2 * VP] | ((unsigned)vp[3 * VP] << 16); vb = __builtin_bit_cast(bf16x4, w); }
    f32x4 O = MFMA32(rt0, hb0, z4); O = MFMA32(rt1, hb1, O);
    f32x4 U = z4;
    if (!GLA) {
        const bf16x8 at0 = afr(AT, l15, q, 0), at1 = afr(AT, l15, q, 1), bt0 = afr(BT, l15, q, 0), bt1 = afr(BT, l15, q, 1);
        f32x4 P = MFMA32(at0, bt0, z4); P = MFMA32(at1, bt1, P); P = maskc(P, q, l15, false, false);
        f32x4 PT = MFMA32(bt0, at0, z4); PT = MFMA32(bt1, at1, PT); PT = maskc(PT, q, l15, true, false);
        f32x4 nrbT = MFMA32(bt0, rt0, z4); nrbT = MFMA32(bt1, rt1, nrbT); nrbT = maskc(nrbT, q, l15, true, true);
        U = MFMA32(at0, hb0, z4); U = MFMA32(at1, hb1, U);
        if (use_v) { f32x4 makT = MFMA32(kt0, at0, z4); makT = MFMA32(kt1, at1, makT); makT = maskc(makT, q, l15, true, false); U = MFMA16(bf4(makT), vb, U); }
#pragma unroll
        for (int it = 0; it < 4; ++it) {
            U = MFMA16(bf4(PT), bf4(U), U);
            if (it < 3) { const f32x4 Pn = MFMA16(bf4(PT), bf4(P), z4), PTn = MFMA16(bf4(P), bf4(PT), z4); P = Pn; PT = PTn; }
        }
        O = MFMA16(bf4(nrbT), bf4(U), O);
    }
    if (use_v) { f32x4 nrkT = MFMA32(kt0, rt0, z4); nrkT = MFMA32(kt1, rt1, nrkT); nrkT = maskc(nrkT, q, l15, true, true); O = MFMA16(bf4(nrkT), vb, O); }
    if (write_o) {
#pragma unroll
        for (int i = 0; i < 4; ++i) if (4 * q + i < nv) OUTP[(size_t)(rowb + 4 * q + i) * 512] = (bf16_t)f2bf(O[i]);
    }
    const bf16x4 ub = bf4(U);
#pragma unroll
    for (int kt = 0; kt < 4; ++kt) {
        const f32x4 g4 = *(const LAS f32x4*)(GC + 16 * kt + 4 * q); const float gk = GC[16 * kt + l15];
        f32x4 acc = H[kt] * g4;
        if (!GLA) { const LAS bf16_t* p = BT + (4 * q) * SP + 16 * kt + l15; u32x2 w; w.x = pk2(bf2f(p[0]) * gk, bf2f(p[SP]) * gk); w.y = pk2(bf2f(p[2 * SP]) * gk, bf2f(p[3 * SP]) * gk); acc = MFMA16(__builtin_bit_cast(bf16x4, w), ub, acc); }
        if (use_v) { const LAS bf16_t* p = KT + (4 * q) * SP + 16 * kt + l15; u32x2 w; w.x = pk2(bf2f(p[0]) * gk, bf2f(p[SP]) * gk); w.y = pk2(bf2f(p[2 * SP]) * gk, bf2f(p[3 * SP]) * gk); acc = MFMA16(__builtin_bit_cast(bf16x4, w), vb, acc); }
        H[kt] = acc;
    }
}
constexpr int GL_RT = 2304, GL_BT = 4608, GL_KT = 6912, GL_VS = 9216, GL_GC = 13568, GL_EG = 13824, GL_BYTES = 26624;
template <bool GLA, int W> __device__ __forceinline__ void scan_block(const Args& A, LAS unsigned char* gl, int lane, int wg, int row0, int nsub, int nvalid, int first_kind, int bsamp, int hh, int sl, bool use_v, bool write_o, f32x4 (&H)[4], float& cumtot) {
    constexpr int TPW = 16 / W, VP = GLA ? 136 : 72;
    const int c = lane, l15 = lane & 15, q = lane >> 4, t0 = wg * TPW;
    const bf16_t* PRW = (const bf16_t*)(A.ws + OFF_PRW); const bf16_t* PGLA = (const bf16_t*)(A.ws + OFF_PGLA);
    const bf16_t *EW = (const bf16_t*)((unsigned char*)A.out + OUTB_EW), *AARR = (const bf16_t*)((unsigned char*)A.out + OUTB_AARR);
    bf16_t* OUTP = GLA ? (bf16_t*)((unsigned char*)A.out + OUTB_OGL) + 128 * hh + 16 * sl + l15 : (bf16_t*)((unsigned char*)A.out + OUTB_ORW) + 64 * hh + 16 * sl + l15;
    LAS bf16_t *AT = (LAS bf16_t*)gl, *RT = (LAS bf16_t*)(gl + GL_RT), *BT = (LAS bf16_t*)(gl + GL_BT), *KT = (LAS bf16_t*)(gl + GL_KT), *VS = (LAS bf16_t*)(gl + GL_VS);
    LAS float *GC = (LAS float*)(gl + GL_GC), *EG = (LAS float*)(gl + GL_EG);
    float mu_r = 0.f, mu_k = 0.f, mu_v = 0.f, kkc = 0.f, kac = 0.f, bgc = 0.f; float wgt[16];
#pragma unroll
    for (int j = 0; j < 16; ++j) wgt[j] = 0.f;
    if (!GLA) { const float* mu = A.in[IN_MU]; mu_r = mu[64 * hh + c]; mu_k = mu[512 + 64 * hh + c]; mu_v = mu[1024 + 64 * hh + c]; kkc = A.in[IN_KK][64 * hh + c]; kac = A.in[IN_KA][64 * hh + c]; }
    else { bgc = A.in[IN_BG][64 * hh + c];
#pragma unroll
        for (int j = 0; j < 16; ++j) wgt[j] = A.in[IN_WG2][j * 256 + 64 * hh + c]; }
    float pr[2] = {0.f, 0.f}, pk[2] = {0.f, 0.f}, pvv[2] = {0.f, 0.f}; bf16_t r0[2][TPW], r1[2][TPW], r2[2][TPW], r3[2][TPW], r4[2][TPW]; unsigned rvv[2][TPW]; u32x4 lg0[2][TPW], lg1[2][TPW];
#pragma unroll
    for (int p = 0; p < 2; ++p)
#pragma unroll
        for (int i = 0; i < TPW; ++i) { r0[p][i] = r1[p][i] = r2[p][i] = r3[p][i] = r4[p][i] = 0; rvv[p][i] = 0u; lg0[p][i] = (u32x4){0u, 0u, 0u, 0u}; lg1[p][i] = lg0[p][i]; }
#define SB_LOAD(SC, P) do { const int nv_ = ((SC) == nsub - 1) ? nvalid : 16; \
        if (!GLA) { if ((SC) == 0 && t0 == 0) { pr[P] = pk[P] = pvv[P] = 0.f; if (first_kind == 0) { const bf16_t* p = PRW + (size_t)(row0 - 1) * NPRW + 64 * hh + c; pr[P] = bf2f(p[0]); pk[P] = bf2f(p[512]); pvv[P] = bf2f(p[1024]); } \
                        else if (first_kind == 2) { const float* st = A.in[IN_ST_SHIFT] + (size_t)bsamp * 1792 + 64 * hh + c; pr[P] = st[0]; pk[P] = st[512]; pvv[P] = st[1024]; } } \
                    else if (t0 < nv_) { const bf16_t* p = PRW + (size_t)(row0 + 16 * (SC) + t0 - 1) * NPRW + 64 * hh + c; pr[P] = bf2f(p[0]); pk[P] = bf2f(p[512]); pvv[P] = bf2f(p[1024]); } } \
        _Pragma("unroll") for (int i = 0; i < TPW; ++i) if (t0 + i < nv_) { const size_t ro = (size_t)(row0 + 16 * (SC) + t0 + i); \
            if (!GLA) { const bf16_t* p = PRW + ro * NPRW + 64 * hh + c; r0[P][i] = p[0]; r1[P][i] = p[512]; r2[P][i] = p[1024]; r3[P][i] = EW[ro * 512 + 64 * hh + c]; r4[P][i] = AARR[ro * 512 + 64 * hh + c]; } \
            else { const bf16_t* p = PGLA + ro * NPGLA; r0[P][i] = p[64 * hh + c]; r1[P][i] = p[256 + 64 * hh + c]; rvv[P][i] = *(const unsigned*)(p + 512 + 128 * hh + 2 * lane); lg0[P][i] = *(const u32x4*)(p + 1024); lg1[P][i] = *(const u32x4*)(p + 1032); } } } while (0)
#define SB_EG(SC, P) do { const int nv_ = ((SC) == nsub - 1) ? nvalid : 16; LAS float* eg_ = EG + (P) * 1024; float tot_ = 0.f; \
        _Pragma("unroll") for (int i = 0; i < TPW; ++i) { float ev = 0.f; if (t0 + i < nv_) { if (!GLA) ev = bf2f(r3[P][i]); else { float lga[16], t8[8]; unpack8(lg0[P][i], t8); _Pragma("unroll") for (int j = 0; j < 8; ++j) lga[j] = t8[j]; \
                unpack8(lg1[P][i], t8); _Pragma("unroll") for (int j = 0; j < 8; ++j) lga[8 + j] = t8[j]; float z = bgc; _Pragma("unroll") for (int j = 0; j < 16; ++j) z += lga[j] * wgt[j]; ev = fsoftplus(-z) * 0.0625f; } } \
            eg_[(t0 + i) * 64 + c] = ev; tot_ += ev; } \
        WT[((P) * 8 + wg) * 64 + c] = tot_; } while (0)
#define SB_ITER(SC, P) do { const int sc = (SC); const int nv = (sc == nsub - 1) ? nvalid : 16; \
        __syncthreads();                                                         \
        { const LAS float* eg = EG + (P) * 1024; float cum = 0.f; \
          _Pragma("unroll") for (int w2 = 0; w2 < W - 1; ++w2) { const float tw = WT[((P) * 8 + w2) * 64 + c]; cum += (w2 < wg) ? tw : 0.f; } \
          _Pragma("unroll") for (int i = 0; i < TPW; ++i) { const int t = t0 + i; \
            if (t < nv) { \
                const float gp = __expf(-cum); cum += eg[t * 64 + c]; const float g = __expf(-cum), e = __expf(cum); \
                if (!GLA) { \
                    const float cr = bf2f(r0[P][i]), ck = bf2f(r1[P][i]), cv = bf2f(r2[P][i]), a = bf2f(r4[P][i]); \
                    const float xr = cr + (pr[P] - cr) * mu_r, xk = ck + (pk[P] - ck) * mu_k, xv = cv + (pvv[P] - cv) * mu_v; pr[P] = cr; pk[P] = ck; pvv[P] = cv; \
                    const float kkv = xk * kkc, ss = wave_allsum(kkv * kkv), kk = kkv * __builtin_amdgcn_rcpf(fmaxf(sqrtf(ss), 1e-12f)); \
                    const unsigned w01 = pk2(-kk * gp, xr * g), w23 = pk2(kk * a * e, xk * (1.f + (a - 1.f) * kac) * e); \
                    AT[t * SP + c] = (bf16_t)(w01 & 0xffffu); RT[t * SP + c] = (bf16_t)(w01 >> 16); BT[t * SP + c] = (bf16_t)(w23 & 0xffffu); KT[t * SP + c] = (bf16_t)(w23 >> 16); \
                    VS[t * VP + c] = (bf16_t)f2bf(xv); \
                } else { \
                    const unsigned w01 = pk2(bf2f(r0[P][i]) * 0.125f * g, bf2f(r1[P][i]) * e); \
                    RT[t * SP + c] = (bf16_t)(w01 & 0xffffu); KT[t * SP + c] = (bf16_t)(w01 >> 16); \
                    *(LAS unsigned*)(VS + t * VP + 2 * lane) = rvv[P][i]; \
                } \
            } else { \
                if (!GLA) { AT[t * SP + c] = 0; BT[t * SP + c] = 0; VS[t * VP + c] = 0; } else *(LAS unsigned*)(VS + t * VP + 2 * lane) = 0u; \
                RT[t * SP + c] = 0; KT[t * SP + c] = 0; \
            } \
          } \
          if (wg == W - 1) { GC[c] = __expf(-cum); cumtot += cum; } \
        } \
        if (sc + 2 < nsub) SB_LOAD(sc + 2, P); \
        __syncthreads();                                                         \
        scan_matrix_part<GLA, VP>(AT, RT, BT, KT, VS, GC, OUTP, l15, q, sl, use_v, write_o, row0 + 16 * sc, nv, H); \
        if (sc + 1 < nsub) SB_EG(sc + 1, 1 - (P)); } while (0)
    LAS float* WT = EG + 2048;
    SB_LOAD(0, 0); if (nsub > 1) SB_LOAD(1, 1); SB_EG(0, 0);
    for (int sc2 = 0; sc2 < nsub; sc2 += 2) { SB_ITER(sc2, 0); if (sc2 + 1 < nsub) SB_ITER(sc2 + 1, 1); }
#undef SB_LOAD
#undef SB_EG
#undef SB_ITER
}
constexpr int GP = 264;
__device__ __forceinline__ void gla_pass1_item(const Args& A, LAS unsigned char* lds, int wave, int lane, int b, int hh, int cc, int ig) {
    const bf16_t* PGLA = (const bf16_t*)(A.ws + OFF_PGLA);
    LAS bf16_t* KHT = (LAS bf16_t*)lds; LAS bf16_t* VT = KHT + 64 * GP; LAS float* WT = (LAS float*)(lds + (64 + 128) * GP * 2);
    const int c = lane, l15 = lane & 15, q = lane >> 4, row0 = b * 2048 + cc * 256 + 32 * wave;
    float wgt[16]; const float bgc = A.in[IN_BG][64 * hh + c];
#pragma unroll
    for (int j = 0; j < 16; ++j) wgt[j] = A.in[IN_WG2][j * 256 + 64 * hh + c];
    float cum[32]; float run = 0.f;
#pragma unroll
    for (int tb = 0; tb < 32; tb += 8) {
        u32x4 g0[8], g1[8];
#pragma unroll
        for (int j = 0; j < 8; ++j) { const bf16_t* p = PGLA + (size_t)(row0 + tb + j) * NPGLA; g0[j] = *(const u32x4*)(p + 1024); g1[j] = *(const u32x4*)(p + 1032); }
#pragma unroll
        for (int j = 0; j < 8; ++j) { float lga[16], t8[8];
            unpack8(g0[j], t8);
#pragma unroll
            for (int i = 0; i < 8; ++i) lga[i] = t8[i];
            unpack8(g1[j], t8);
#pragma unroll
            for (int i = 0; i < 8; ++i) lga[8 + i] = t8[i];
            float z = bgc;
#pragma unroll
            for (int i = 0; i < 16; ++i) z += lga[i] * wgt[i];
            run += fsoftplus(-z) * 0.0625f; cum[tb + j] = run; }
    }
    __syncthreads();
    WT[wave * 64 + c] = run;
    __syncthreads();
    float after = 0.f, tot = 0.f;
#pragma unroll
    for (int w2 = 0; w2 < 8; ++w2) { const float tw = WT[w2 * 64 + c]; tot += tw; after += (w2 > wave) ? tw : 0.f; }
#pragma unroll
    for (int tb = 0; tb < 32; tb += 16) {
        bf16_t rk[16]; unsigned rv[16];
#pragma unroll
        for (int j = 0; j < 16; ++j) { const bf16_t* p = PGLA + (size_t)(row0 + tb + j) * NPGLA; rk[j] = p[256 + 64 * hh + c]; rv[j] = *(const unsigned*)(p + 512 + 128 * hh + 2 * lane); }
#pragma unroll
        for (int j = 0; j < 16; ++j) { const int t = tb + j;
            KHT[c * GP + 32 * wave + t] = (bf16_t)f2bf(bf2f(rk[j]) * __expf(-(after + (run - cum[t]))));
            VT[(2 * lane) * GP + 32 * wave + t] = (bf16_t)(rv[j] & 0xffffu); VT[(2 * lane + 1) * GP + 32 * wave + t] = (bf16_t)(rv[j] >> 16); }
    }
    __syncthreads();
    f32x4 acc[4];
#pragma unroll
    for (int kt = 0; kt < 4; ++kt) acc[kt] = (f32x4){0.f, 0.f, 0.f, 0.f};
#pragma unroll
    for (int ks = 0; ks < 8; ++ks) { const bf16x8 bv = *(const LAS bf16x8*)(VT + (16 * wave + l15) * GP + 32 * ks + 8 * q);
#pragma unroll
        for (int kt = 0; kt < 4; ++kt) { const bf16x8 av = *(const LAS bf16x8*)(KHT + (16 * kt + l15) * GP + 32 * ks + 8 * q); acc[kt] = MFMA32(av, bv, acc[kt]); } }
    float* dst = (float*)(A.ws + OFF_GL) + (size_t)ig * 8192 + 16 * wave + l15;
#pragma unroll
    for (int kt = 0; kt < 4; ++kt)
#pragma unroll
        for (int i = 0; i < 4; ++i) dst[(16 * kt + 4 * q + i) * 128] = acc[kt][i];
    if (wave == 7) ((float*)(A.ws + OFF_GG))[ig * 64 + lane] = __expf(-tot);
}
__device__ __forceinline__ void rwkv_sample_iter(const Args& A, LAS unsigned char* lds, int wave, int lane, int sbi) {
    const int l15 = lane & 15, q = lane >> 4;
    f32x4 H[4]; float cumtot = 0.f;
    const int item = 2 * sbi + (wave >> 2), sl = wave & 3, hh = item & 7, b = item >> 3;
    const float* st = A.in[IN_ST_WKV] + (((size_t)b * 8 + hh) * 64 + 16 * sl + l15) * 64 + 4 * q;
#pragma unroll
    for (int kt = 0; kt < 4; ++kt) H[kt] = *(const f32x4*)(st + 16 * kt);
    scan_block<false, 4>(A, lds + (wave >> 2) * GL_BYTES, lane, wave & 3, MP + b * 8, 1, 8, 2, b, hh, sl, true, true, H, cumtot);
    float* o = A.out + OUT_WKV_S + (((size_t)b * 8 + hh) * 64 + 16 * sl + l15) * 64 + 4 * q;
#pragma unroll
    for (int kt = 0; kt < 4; ++kt) *(f32x4*)(o + 16 * kt) = H[kt];
}
__device__ __forceinline__ void p2x_scan1(const Args& A, LAS unsigned char* lds, int wave, int lane) {
    const int l15 = lane & 15, q = lane >> 4;
    for (int it = blockIdx.x; it < 448; it += gridDim.x) {
        f32x4 H[4]; float cumtot = 0.f;
        if (it < 448) {
            const int seq = it / 7, cc = it - seq * 7, b = seq >> 3, hh = seq & 7; const bool isT = wave >= 4; const int sl = wave & 3;
#pragma unroll
            for (int kt = 0; kt < 4; ++kt)
#pragma unroll
                for (int i = 0; i < 4; ++i) H[kt][i] = (isT && (16 * kt + 4 * q + i == 16 * sl + l15)) ? 1.f : 0.f;
            scan_block<false, 8>(A, lds, lane, wave, b * 2048 + cc * 256, 16, 16, cc == 0 ? 1 : 0, 0, hh, sl, !isT, false, H, cumtot);
            float* dst = (float*)(A.ws + OFF_RLT) + (size_t)it * 8192 + (isT ? 4096 : 0) + 16 * sl + l15;
#pragma unroll
            for (int kt = 0; kt < 4; ++kt)
#pragma unroll
                for (int i = 0; i < 4; ++i) dst[(16 * kt + 4 * q + i) * 64] = H[kt][i];
        }
    }
    if (gridDim.x == 256 && blockIdx.x >= 192) {
        for (int sbi = (int)blockIdx.x - 192; sbi < 512; sbi += 64) rwkv_sample_iter(A, lds, wave, lane, sbi);
    }
    __syncthreads();
}
__device__ __forceinline__ void p2y_scan2(const Args& A, LAS unsigned char* lds, int wave, int lane) {
    const int l15 = lane & 15, q = lane >> 4;
    for (int bi = blockIdx.x; bi < 256 + 256 + 512 + 512; bi += gridDim.x) {
        f32x4 H[4]; float cumtot = 0.f;
#pragma unroll
        for (int kt = 0; kt < 4; ++kt) H[kt] = (f32x4){0.f, 0.f, 0.f, 0.f};
        if (bi < 256) {
            const int item = 2 * bi + (wave >> 2), sl = wave & 3, cc = item & 7, seq = item >> 3, b = seq >> 3, hh = seq & 7;
#pragma unroll 2
            for (int j = 0; j < cc; ++j) {
                const float* Lj = (const float*)(A.ws + OFF_RLT) + (size_t)(seq * 7 + j) * 8192; const float* Tj = Lj + 4096;
                const bf16x8 hb0 = hfrag(H[0], H[1]), hb1 = hfrag(H[2], H[3]);
#pragma unroll
                for (int kt = 0; kt < 4; ++kt) {
                    f32x4 acc;
#pragma unroll
                    for (int i = 0; i < 4; ++i) acc[i] = Lj[(16 * kt + 4 * q + i) * 64 + 16 * sl + l15];
                    const float* tr = Tj + (16 * kt + l15) * 64 + 4 * q;
                    const f32x4 t0 = *(const f32x4*)tr, t1 = *(const f32x4*)(tr + 16), t2 = *(const f32x4*)(tr + 32), t3 = *(const f32x4*)(tr + 48);
                    acc = MFMA32(hfrag(t0, t1), hb0, acc); acc = MFMA32(hfrag(t2, t3), hb1, acc);
                    H[kt] = acc;
                }
            }
            scan_block<false, 4>(A, lds + (wave >> 2) * GL_BYTES, lane, wave & 3, b * 2048 + cc * 256, 16, 16, cc == 0 ? 1 : 0, 0, hh, sl, true, true, H, cumtot);
            if (cc == 7) { float* o = A.out + OUT_WKV_P + (((size_t)b * 8 + hh) * 64 + 16 * sl + l15) * 64 + 4 * q;
#pragma unroll
                for (int kt = 0; kt < 4; ++kt) *(f32x4*)(o + 16 * kt) = H[kt]; }
        } else if (bi < 512) {
            const int item = bi - 256, sl = wave, cc = item & 7, seq = item >> 3, b = seq >> 2, hh = seq & 3;
#pragma unroll 2
            for (int j = 0; j < cc; ++j) {
                const float* Lj = (const float*)(A.ws + OFF_GL) + (size_t)(seq * 7 + j) * 8192; const float* Gj = (const float*)(A.ws + OFF_GG) + (seq * 7 + j) * 64;
#pragma unroll
                for (int kt = 0; kt < 4; ++kt)
#pragma unroll
                    for (int i = 0; i < 4; ++i) H[kt][i] = Gj[16 * kt + 4 * q + i] * H[kt][i] + Lj[(16 * kt + 4 * q + i) * 128 + 16 * sl + l15];
            }
            scan_block<true, 8>(A, lds, lane, wave, b * 2048 + cc * 256, 16, 16, 0, 0, hh, sl, true, true, H, cumtot);
            if (cc == 7) { float* o = A.out + OUT_GLA_P + (((size_t)b * 4 + hh) * 64) * 128 + 16 * sl + l15;
#pragma unroll
                for (int kt = 0; kt < 4; ++kt)
#pragma unroll
                    for (int i = 0; i < 4; ++i) o[(size_t)(16 * kt + 4 * q + i) * 128] = H[kt][i]; }
        } else if (bi < 1024) {
            if (gridDim.x != 256) rwkv_sample_iter(A, lds, wave, lane, bi - 512);
        } else {
            const int item = bi - 1024, sl = wave, hh = item & 3, b = item >> 2;
            const float* st = A.in[IN_ST_GLA] + (((size_t)b * 4 + hh) * 64) * 128 + 16 * sl + l15;
#pragma unroll
            for (int kt = 0; kt < 4; ++kt)
#pragma unroll
                for (int i = 0; i < 4; ++i) H[kt][i] = st[(size_t)(16 * kt + 4 * q + i) * 128];
            scan_block<true, 8>(A, lds, lane, wave, MP + b * 8, 1, 8, 0, b, hh, sl, true, true, H, cumtot);
            float* o = A.out + OUT_GLA_S + (((size_t)b * 4 + hh) * 64) * 128 + 16 * sl + l15;
#pragma unroll
            for (int kt = 0; kt < 4; ++kt)
#pragma unroll
                for (int i = 0; i < 4; ++i) o[(size_t)(16 * kt + 4 * q + i) * 128] = H[kt][i];
        }
    }
}
__device__ __forceinline__ void p2c_mix(const Args& A, int r, int col0, u32x4 rcur, u32x4 rprev, float (&xs)[8]) {
    float cur[8], prev[8]; unpack8(rcur, cur);
    const bool first = (r < MP) ? ((r & 2047) == 0) : (((r - MP) & 7) == 0);
    if (!first) unpack8(rprev, prev);
    else if (r < MP) {
#pragma unroll
        for (int i = 0; i < 8; ++i) prev[i] = 0.f;
    } else ld8f(A.in[IN_ST_SHIFT] + (size_t)((r - MP) >> 3) * 1792 + col0, prev);
    float mu[8]; ld8f(A.in[IN_MU] + col0, mu);
#pragma unroll
    for (int i = 0; i < 8; ++i) xs[i] = cur[i] + (prev[i] - cur[i]) * mu[i];
}
__device__ __forceinline__ void p2c_post(const Args& A, int gw, int NGW, int lane, bool shadow) {
    const bf16_t* PRW = (const bf16_t*)(A.ws + OFF_PRW); const bf16_t* PGLA = (const bf16_t*)(A.ws + OFF_PGLA);
    const bf16_t *AARR = (const bf16_t*)((unsigned char*)A.out + OUTB_AARR), *G = (const bf16_t*)(A.ws + OFF_G);
    bf16_t *ORW = (bf16_t*)((unsigned char*)A.out + OUTB_ORW), *OGL = (bf16_t*)((unsigned char*)A.out + OUTB_OGL);
    const int c0 = 8 * lane;
    for (int rb = gw; rb < M; rb += 2 * NGW) {
        u32x4 raw[2][11];
#pragma unroll
        for (int k = 0; k < 2; ++k) { const int r = (rb + k * NGW < M) ? rb + k * NGW : rb; const int rp = r > 0 ? r - 1 : 0;
            raw[k][0] = *(const u32x4*)(ORW + (size_t)r * 512 + c0); raw[k][1] = *(const u32x4*)(OGL + (size_t)r * 512 + c0);
            raw[k][2] = *(const u32x4*)(PRW + (size_t)r * NPRW + c0); raw[k][3] = *(const u32x4*)(PRW + (size_t)r * NPRW + 512 + c0); raw[k][4] = *(const u32x4*)(PRW + (size_t)r * NPRW + 1024 + c0);
            raw[k][5] = *(const u32x4*)(PRW + (size_t)rp * NPRW + c0); raw[k][6] = *(const u32x4*)(PRW + (size_t)rp * NPRW + 512 + c0); raw[k][7] = *(const u32x4*)(PRW + (size_t)rp * NPRW + 1024 + c0);
            raw[k][8] = *(const u32x4*)(AARR + (size_t)r * 512 + c0); raw[k][9] = *(const u32x4*)(G + (size_t)r * 512 + c0); raw[k][10] = *(const u32x4*)(PGLA + (size_t)r * NPGLA + 1040 + c0); }
#pragma unroll
        for (int k = 0; k < 2; ++k) { const int r = rb + k * NGW; if (r < M) {
            float o[8], d[8], xr[8], xk[8], xv[8], a[8], g[8], p[8], res[8];
            unpack8(raw[k][0], o);
            float s1 = 0.f;
#pragma unroll
            for (int i = 0; i < 8; ++i) s1 += o[i];
            const float mu = row8_allsum(s1) * (1.f / 64.f); float s2 = 0.f;
#pragma unroll
            for (int i = 0; i < 8; ++i) { d[i] = o[i] - mu; s2 += d[i] * d[i]; }
            const float rstd = rsqrtf(row8_allsum(s2) * (1.f / 64.f) + 64e-5f);
            p2c_mix(A, r, c0, raw[k][2], raw[k][5], xr); p2c_mix(A, r, 512 + c0, raw[k][3], raw[k][6], xk); p2c_mix(A, r, 1024 + c0, raw[k][4], raw[k][7], xv);
            unpack8(raw[k][8], a); unpack8(raw[k][9], g);
            float bs = 0.f; ld8f(A.in[IN_KA] + c0, p);
#pragma unroll
            for (int i = 0; i < 8; ++i) d[i] *= rstd, xk[i] = xk[i] * (1.f + (a[i] - 1.f) * p[i]);
            ld8f(A.in[IN_RK] + c0, p);
#pragma unroll
            for (int i = 0; i < 8; ++i) bs += xr[i] * xk[i] * p[i];
            bs = row8_allsum(bs);
            ld8f(A.in[IN_LNW] + c0, p); ld8f(A.in[IN_LNB] + c0, a);
#pragma unroll
            for (int i = 0; i < 8; ++i) res[i] = ((d[i] * p[i] + a[i]) + bs * xv[i]) * g[i];
            if (!shadow) *(u32x4*)(ORW + (size_t)r * 512 + c0) = pack8(res); else *(u32x4*)((bf16_t*)(A.ws + 240 * MiB) + (size_t)(r & 8191) * 512 + c0) = pack8(res);
            unpack8(raw[k][1], o);
            float ms = 0.f;
#pragma unroll
            for (int i = 0; i < 8; ++i) ms += o[i] * o[i];
            const float rs = rsqrtf(row16_allsum(ms) * (1.f / 128.f) + NORM_EPS);
            unpack8(raw[k][10], g); ld8f(A.in[IN_GNW] + (c0 & 127), p);
#pragma unroll
            for (int i = 0; i < 8; ++i) res[i] = o[i] * rs * p[i] * (g[i] * fsigmoid(g[i]));
            if (!shadow) *(u32x4*)(OGL + (size_t)r * 512 + c0) = pack8(res); else *(u32x4*)((bf16_t*)(A.ws + 248 * MiB) + (size_t)(r & 8191) * 512 + c0) = pack8(res);
        } }
    }
}
__device__ __forceinline__ void p6_act(const Args& A, int gtid, int NGT) {
    bf16_t* U = (bf16_t*)(A.ws + OFF_U); const bf16_t* UH = (const bf16_t*)(A.ws + OFF_UH);
    const float *convw = A.in[IN_CONVW], *convb = A.in[IN_CONVB], *cstate = A.in[IN_ST_CONV];
    for (int item = gtid; item < (M / 64) * 352; item += NGT) {
        const int rb = item / 352, jc = (item - rb * 352) * 8, r0 = rb * 64; const bool sample = r0 >= MP;
        float p1v[8], p2v[8], p1g[8], p2g[8], w0v[8], w1v[8], w2v[8], cbv[8], w0g[8], w1g[8], w2g[8], cbg[8];
        ld8f(convw + jc, w0v); ld8f(convw + F2 + jc, w1v); ld8f(convw + 2 * F2 + jc, w2v); ld8f(convb + jc, cbv);
        ld8f(convw + FF + jc, w0g); ld8f(convw + F2 + FF + jc, w1g); ld8f(convw + 2 * F2 + FF + jc, w2g); ld8f(convb + FF + jc, cbg);
#pragma unroll
        for (int i = 0; i < 8; ++i) p1v[i] = p2v[i] = p1g[i] = p2g[i] = 0.f;
        if (!sample && (rb & 31) != 0) { const bf16_t* q = UH + (size_t)(rb - 1) * 2 * F2; ld8bf(q + jc, p2v); ld8bf(q + FF + jc, p2g); ld8bf(q + F2 + jc, p1v); ld8bf(q + F2 + FF + jc, p1g); }
        for (int r8 = 0; r8 < 64; r8 += 8) {
            u32x4 rawv[8], rawg[8];
#pragma unroll
            for (int k = 0; k < 8; ++k) { const bf16_t* row = U + (size_t)(r0 + r8 + k) * F2; rawv[k] = *(const u32x4*)(row + jc); rawg[k] = *(const u32x4*)(row + FF + jc); }
            if (sample) { const float* st = cstate + (size_t)((r0 + r8 - MP) >> 3) * 2 * F2; ld8f(st + jc, p2v); ld8f(st + FF + jc, p2g); ld8f(st + F2 + jc, p1v); ld8f(st + F2 + FF + jc, p1g); }
#pragma unroll
            for (int k = 0; k < 8; ++k) {
                float cv[8], cg[8], res[8]; unpack8(rawv[k], cv); unpack8(rawg[k], cg);
#pragma unroll
                for (int i = 0; i < 8; ++i) { const float v = cbv[i] + w0v[i] * p2v[i] + w1v[i] * p1v[i] + w2v[i] * cv[i], gg = cbg[i] + w0g[i] * p2g[i] + w1g[i] * p1g[i] + w2g[i] * cg[i];
                    res[i] = gelu_gate(gg, v); p2v[i] = p1v[i]; p1v[i] = cv[i]; p2g[i] = p1g[i]; p1g[i] = cg[i]; }
                *(u32x4*)(U + (size_t)(r0 + r8 + k) * F2 + jc) = pack8(res);
            }
        }
    }
}
__device__ __forceinline__ void pfix_act(const Args& A, int gtid, int NGT) {
    const bf16_t* UH = (const bf16_t*)(A.ws + OFF_UH); const bf16_t* US = (const bf16_t*)(A.ws + OFF_US); bf16_t* ACT = (bf16_t*)(A.ws + OFF_ACT);
    const float *convw = A.in[IN_CONVW], *convb = A.in[IN_CONVB], *cstate = A.in[IN_ST_CONV];
    for (int idx = gtid; idx < (256 + 128) * 2 * 352; idx += NGT) {
        const int g = idx / 704, rem = idx - g * 704, rsel = rem / 352, jc = (rem - rsel * 352) * 8;
        float cv[8], cg[8], p1v[8], p1g[8], p2v[8], p2g[8], res[8]; int orow;
#pragma unroll
        for (int i = 0; i < 8; ++i) p1v[i] = p1g[i] = p2v[i] = p2g[i] = 0.f;
        if (g < 256) {
            const bool seq0 = (g & 31) == 0; orow = 64 * g + rsel;
            ld8bf(UH + ((size_t)g * 4 + rsel) * F2 + jc, cv); ld8bf(UH + ((size_t)g * 4 + rsel) * F2 + FF + jc, cg);
            if (rsel == 0) { if (!seq0) { const bf16_t* q = UH + ((size_t)(g - 1) * 4 + 3) * F2; ld8bf(q + jc, p1v); ld8bf(q + FF + jc, p1g); q -= F2; ld8bf(q + jc, p2v); ld8bf(q + FF + jc, p2g); } }
            else { const bf16_t* q = UH + ((size_t)g * 4) * F2; ld8bf(q + jc, p1v); ld8bf(q + FF + jc, p1g);
                if (!seq0) { q = UH + ((size_t)(g - 1) * 4 + 3) * F2; ld8bf(q + jc, p2v); ld8bf(q + FF + jc, p2g); } }
        } else {
            const int sb = g - 256; orow = MP + 8 * sb + rsel; const float* st = cstate + (size_t)sb * 2 * F2;
            ld8bf(US + ((size_t)sb * 2 + rsel) * F2 + jc, cv); ld8bf(US + ((size_t)sb * 2 + rsel) * F2 + FF + jc, cg);
            if (rsel == 0) { ld8f(st + jc, p2v); ld8f(st + FF + jc, p2g); ld8f(st + F2 + jc, p1v); ld8f(st + F2 + FF + jc, p1g); }
            else { ld8f(st + F2 + jc, p2v); ld8f(st + F2 + FF + jc, p2g); ld8bf(US + ((size_t)sb * 2) * F2 + jc, p1v); ld8bf(US + ((size_t)sb * 2) * F2 + FF + jc, p1g); }
        }
#pragma unroll
        for (int i = 0; i < 8; ++i) { const int col = jc + i;
            const float v = convb[col] + convw[col] * p2v[i] + convw[F2 + col] * p1v[i] + convw[2 * F2 + col] * cv[i];
            const float gg = convb[FF + col] + convw[FF + col] * p2g[i] + convw[F2 + FF + col] * p1g[i] + convw[2 * F2 + FF + col] * cg[i];
            res[i] = gelu_gate(gg, v); }
        *(u32x4*)(ACT + (size_t)orow * FF + jc) = pack8(res);
    }
}
__device__ __forceinline__ void p8_final(const Args& A, int gw, int NGW, int lane, float* dst) {
    const float* gf = A.in[IN_NORM_FINAL];
    for (int m = gw; m < M; m += 2 * NGW) {
        const int m2 = m + NGW; const bool has2 = m2 < M;
        const f32x4* xr = (const f32x4*)(A.out + (size_t)m * DM) + lane; const f32x4* xr2 = (const f32x4*)(A.out + (size_t)(has2 ? m2 : m) * DM) + lane; f32x4 v[4], w[4]; float s = 0.f, s2 = 0.f;
#pragma unroll
        for (int j = 0; j < 4; ++j) { v[j] = xr[64 * j]; w[j] = xr2[64 * j]; }
#pragma unroll
        for (int j = 0; j < 4; ++j) { s += (v[j].x * v[j].x + v[j].y * v[j].y) + (v[j].z * v[j].z + v[j].w * v[j].w); s2 += (w[j].x * w[j].x + w[j].y * w[j].y) + (w[j].z * w[j].z + w[j].w * w[j].w); }
        const float rstd = rsqrtf(wave_allsum(s) * (1.f / DM) + NORM_EPS), rstd2 = rsqrtf(wave_allsum(s2) * (1.f / DM) + NORM_EPS);
#pragma unroll
        for (int j = 0; j < 4; ++j) { const f32x4 g = *((const f32x4*)gf + lane + 64 * j); ((f32x4*)(dst + (size_t)m * DM) + lane)[64 * j] = v[j] * rstd * g; if (has2) ((f32x4*)(dst + (size_t)m2 * DM) + lane)[64 * j] = w[j] * rstd2 * g; }
    }
}

#ifndef PHMASK
#define PHMASK 0xFFFF
#endif
#ifndef PHREP
#define PHREP 0
#endif
#define PH(k) for (int rep_ = 0; rep_ < ((((PHMASK) >> (k)) & 1) ? ((((PHREP) >> (k)) & 1) ? 2 : 1) : 0); ++rep_)
__global__ void __launch_bounds__(NTHREADS, 2) fwd_megakernel(Args A) {
    extern __shared__ __attribute__((aligned(16))) unsigned char lds_raw[];
    LAS unsigned char* lds = (LAS unsigned char*)lds_raw;
    cg::grid_group grid = cg::this_grid();
    const int tid = threadIdx.x, lane = tid & 63, wave = __builtin_amdgcn_readfirstlane(tid >> 6);
    const int G = gridDim.x, gw = blockIdx.x * NWAVES + wave, NGW = G * NWAVES;
    unsigned char* ws = A.ws;
    if (tid < 4) ((LAS unsigned*)(lds + 131072))[tid] = 0u;
    __syncthreads();
    const XcdBarrier xbar = xcd_barrier_post((unsigned*)(ws + OFF_BAR), (volatile LAS unsigned*)(lds + 131072));
#define GSYNC() xcd_barrier(xbar)
    PH(0) p0_prologue(A, lds, gw, NGW, wave, lane);
    if (A.ws == nullptr) grid.sync();
    GSYNC();
    PH(1) { pg8::Gemm g{(const bf16_t*)((unsigned char*)A.out + OUTB_H), (const bf16_t*)(ws + OFF_WIN), M, NIN, 1024, 1024}; pg8::StaticOrder S; S.init(M, NIN, G, (int)blockIdx.x);
      EpiProj E{(bf16_t*)(ws + OFF_PRW), (bf16_t*)(ws + OFF_PGLA), (bf16_t*)(ws + OFF_PGATE), A.out + OUT_SHIFT_P, A.out + OUT_SHIFT_S};
      pg8::gemm_phase<EpiProj, pg8::StaticOrder, true, true>(lds, g, S, E); }
    GSYNC();
    PH(2) p2a_lora(A, lds, gw, NGW, wave, lane);
    PH(2) { for (int ig = (int)gridDim.x - 1 - (int)blockIdx.x; ig < 224; ig += (int)gridDim.x) { const int seq = ig / 7, cc = ig - seq * 7; gla_pass1_item(A, lds, wave, lane, seq >> 2, seq & 3, cc, ig); }
      __syncthreads(); }
    GSYNC();
    PH(3) p2x_scan1(A, lds, wave, lane);
    GSYNC();
    PH(11) p2y_scan2(A, lds, wave, lane);
    GSYNC();
#ifdef SHADOW_P2C
    p2c_post(A, gw, NGW, lane, true);
#endif
    PH(4) p2c_post(A, gw, NGW, lane, false);
    GSYNC();
    PH(5) { pg8::StaticOrder S; S.init(M, 1024, G, (int)blockIdx.x); S.limit = __builtin_amdgcn_readfirstlane((S.nwg / G) * G);
      { pg8::Gemm g{(const bf16_t*)((unsigned char*)A.out + OUTB_ORW), (const bf16_t*)(ws + OFF_WOA), M, 1024, 512, 512};
        EpiGate<true> E{(bf16_t*)(ws + OFF_MERGED), (const bf16_t*)(ws + OFF_PGATE)};
        pg8::gemm_phase<EpiGate<true>, pg8::StaticOrder, true, true>(lds, g, S, E);
        tail_gemm(lds, (const bf16_t*)((unsigned char*)A.out + OUTB_ORW), 512, (const bf16_t*)(ws + OFF_WOA), 512, S, wave, lane, TfGate{true, (bf16_t*)(ws + OFF_MERGED), (const bf16_t*)(ws + OFF_PGATE)}); }
      { pg8::Gemm g{(const bf16_t*)((unsigned char*)A.out + OUTB_OGL), (const bf16_t*)(ws + OFF_WOB), M, 1024, 512, 512};
        EpiGate<false> E{(bf16_t*)(ws + OFF_MERGED), (const bf16_t*)(ws + OFF_PGATE) + 1024};
        pg8::gemm_phase<EpiGate<false>, pg8::StaticOrder, true, true>(lds, g, S, E);
        tail_gemm(lds, (const bf16_t*)((unsigned char*)A.out + OUTB_OGL), 512, (const bf16_t*)(ws + OFF_WOB), 512, S, wave, lane, TfGate{false, (bf16_t*)(ws + OFF_MERGED), (const bf16_t*)(ws + OFF_PGATE) + 1024}); } }
    GSYNC();
    PH(6) { pg8::Gemm g{(const bf16_t*)(ws + OFF_MERGED), (const bf16_t*)(ws + OFF_WO), M, 1024, 1024, 1024}; pg8::StaticOrder S; S.init(M, 1024, G, (int)blockIdx.x); S.limit = __builtin_amdgcn_readfirstlane((S.nwg / G) * G);
#ifdef SHADOW_G3
      float* rss = (rep_ == 0) ? (float*)(ws + OFF_ROWSS + 256 * 1024) : (float*)(ws + OFF_ROWSS);
#else
      float* rss = (float*)(ws + OFF_ROWSS);
#endif
      EpiX1 E{A.in[IN_XP], A.in[IN_XS], A.out, (bf16_t*)(ws + OFF_X1B), rss};
      pg8::gemm_phase<EpiX1, pg8::StaticOrder, true, true>(lds, g, S, E);
      tail_gemm(lds, (const bf16_t*)(ws + OFF_MERGED), 1024, (const bf16_t*)(ws + OFF_WO), 1024, S, wave, lane, TfX1{A.in[IN_XP], A.in[IN_XS], A.out, (bf16_t*)(ws + OFF_X1B), rss}); }
    GSYNC();
    PH(7) { pg8::Gemm g{(const bf16_t*)(ws + OFF_X1B), (const bf16_t*)(ws + OFF_WUP), M, F2, 1024, 1024}; pg8::StaticOrder S; S.init(M, F2, G, (int)blockIdx.x);
      EpiAct E{(const float*)(ws + OFF_ROWSS), A.in[IN_CONVW], A.in[IN_CONVB], (bf16_t*)(ws + OFF_ACT), (bf16_t*)(ws + OFF_UH), (bf16_t*)(ws + OFF_US), A.out + OUT_CONV_P, A.out + OUT_CONV_S, (LAS float*)(lds + 131072)};
      pg8::gemm_phase<EpiAct, pg8::StaticOrder, true, true>(lds, g, S, E); }
    __syncthreads(); if (tid < 4) ((LAS unsigned*)(lds + 131072))[tid] = 0u; __syncthreads();
    GSYNC();
    PH(8) pfix_act(A, blockIdx.x * NTHREADS + tid, G * NTHREADS);
    GSYNC();
    PH(9) { pg8::Gemm g{(const bf16_t*)(ws + OFF_ACT), (const bf16_t*)(ws + OFF_WDN), M, 1024, FF, FF}; pg8::StaticOrder S; S.init(M, 1024, G, (int)blockIdx.x); S.limit = __builtin_amdgcn_readfirstlane((S.nwg / G) * G);
#ifdef SHADOW_G5
      float* xd = (rep_ == 0) ? (float*)(ws + 129 * MiB) : A.out;
#else
      float* xd = A.out;
#endif
      EpiX2 E{A.out, xd};
      pg8::gemm_phase<EpiX2, pg8::StaticOrder, true, true>(lds, g, S, E);
      tail_gemm(lds, (const bf16_t*)(ws + OFF_ACT), FF, (const bf16_t*)(ws + OFF_WDN), FF, S, wave, lane, TfX2{A.out, xd}); }
    GSYNC();
#ifdef P8_SHADOW
    p8_final(A, gw, NGW, lane, (float*)(ws + OFF_U));
#endif
    PH(10) p8_final(A, gw, NGW, lane, A.out);
#ifdef EXTRA_SYNCS
    for (int i_ = 0; i_ < EXTRA_SYNCS; ++i_) GSYNC();
#endif
}

extern "C" void kernel_launch(void* const* d_in, const int* in_sizes, int n_in, void* d_out, int out_size, void* d_ws, size_t ws_size, hipStream_t stream) {
    static int grid = 0;
    if (grid == 0) {
        int dev = 0, cus = 0, per_cu = 0;
        if (n_in != 31 || ws_size < 256 * MiB) { fprintf(stderr, "kernel_launch: unexpected n_in %d / ws_size %zu\n", n_in, ws_size); grid = -1; return; }
        (void)hipGetDevice(&dev); (void)hipDeviceGetAttribute(&cus, hipDeviceAttributeMultiprocessorCount, dev);
        if (hipFuncSetAttribute((const void*)fwd_megakernel, hipFuncAttributeMaxDynamicSharedMemorySize, LDS_BYTES) != hipSuccess) { fprintf(stderr, "kernel_launch: hipFuncSetAttribute failed\n"); grid = -1; return; }
        if (hipOccupancyMaxActiveBlocksPerMultiprocessor(&per_cu, (const void*)fwd_megakernel, NTHREADS, LDS_BYTES) != hipSuccess || per_cu < 1) { fprintf(stderr, "kernel_launch: occupancy query failed (%d)\n", per_cu); (void)hipGetLastError(); grid = -1; return; }
        grid = cus * 1;
    }
    if (grid < 0) return;
    Args a{};
    for (int i = 0; i < 31; ++i) a.in[i] = (const float*)d_in[i];
    a.out = (float*)d_out; a.ws = (unsigned char*)d_ws;
    if (hipMemsetAsync((char*)d_ws + OFF_BAR, 0, XCD_BAR_WORDS * 4, stream) != hipSuccess) { fprintf(stderr, "kernel_launch: memset of the barrier words failed\n"); return; }
    void* params[] = {&a};
    hipError_t e = hipLaunchCooperativeKernel((const void*)fwd_megakernel, dim3(grid), dim3(NTHREADS), params, LDS_BYTES, stream);
    if (e != hipSuccess) fprintf(stderr, "kernel_launch: cooperative launch failed: %s (grid %d)\n", hipGetErrorString(e), grid);
}
```

```cpp
#include <hip/hip_runtime.h>
#include <hip/hip_cooperative_groups.h>
#include <cstdio>
#include <cstdint>
namespace cg = cooperative_groups;
#define PHREP 0
namespace pg8 {
#define PG8_LAS __attribute__((address_space(3)))
typedef unsigned short bf16_t;
typedef short bf16x8 __attribute__((ext_vector_type(8)));
typedef float f32x4 __attribute__((ext_vector_type(4)));
typedef unsigned u32x4 __attribute__((ext_vector_type(4)));
constexpr int BM = 256, BK = 64, HALF = 128, HTB = HALF * BK * 2  , STAGE_BYTES = 8 * HTB, NXCD = 8, WGM = 8;

__host__ __device__ __forceinline__ int lds_byte(int r, int c) { const int st = (r >> 4) * 2 + (c >> 5), rr = r & 15, cc = c & 31, ob = rr * 64 + cc * 2; return st * 1024 + (ob ^ (((ob >> 9) & 1) << 5)); }
__host__ __device__ __forceinline__ void stage_rc(int b, int& R, int& C) { const int st = b / 1024, sb = b % 1024, swz = sb ^ (((sb >> 9) & 1) << 5); R = (st >> 1) * 16 + swz / 64; C = (st & 1) * 32 + (swz % 64) / 2; }
__host__ __device__ __forceinline__ int perm32(int rho) { const int n = rho >> 4, i = rho & 15; return 8 * (i >> 2) + 4 * n + (i & 3); }

struct Unit { int pm, pn; };
struct Gemm { const bf16_t* A; const bf16_t* Bt; int M, N, K, lda; };

struct StaticOrder {
    int nM, nN, nwg, G, c;
    int limit;
    __host__ __device__ void init(int M, int N, int G_, int c_) { nM = M / BM; nN = N / BM; nwg = nM * nN; G = G_; c = c_; limit = nwg; }
    __host__ __device__ __forceinline__ bool next(int i, Unit& u) const {
        const int L = i * G + c; if (L >= limit) return false;
        unit_of(L, u); return true;
    }
    __host__ __device__ __forceinline__ void unit_of(int L, Unit& u) const {
        int wgid = L; { const int q = nwg / NXCD, r = nwg % NXCD, xcd = wgid % NXCD, off = wgid / NXCD; wgid = (xcd < r ? xcd * (q + 1) : r * (q + 1) + (xcd - r) * q) + off; }
        const int nig = WGM * nN, gid = wgid / nig, fm = gid * WGM, gsz = (nM - fm) < WGM ? (nM - fm) : WGM;
        u.pm = fm + ((wgid % nig) % gsz); u.pn = (wgid % nig) / gsz;
    }
    __device__ __forceinline__ void a_ready(const Unit&) const {}
    __device__ __forceinline__ void done(const Unit&) const {}
};
__device__ __forceinline__ unsigned cvt_pk_bf16(float lo, float hi) { unsigned r; asm volatile("v_cvt_pk_bf16_f32 %0, %1, %2" : "=v"(r) : "v"(lo), "v"(hi)); return r; }
typedef float f32x2 __attribute__((ext_vector_type(2)));
template <class Epi, class Sched, bool ALIGN_EPI = false, bool SP2 = false>
__device__ __forceinline__ void gemm_phase(PG8_LAS unsigned char* lds, const Gemm g, const Sched& S, const Epi& E) {
    int tid_ = threadIdx.x; asm volatile("" : "+v"(tid_));
    const int tid = tid_, wid = __builtin_amdgcn_readfirstlane(tid >> 6), lane = tid & 63, wr = wid >> 2, wc = wid & 3, fr = lane & 15, fq = lane >> 4;
    const int K = g.K, nt = K / BK;
    unsigned voffA[2], voffB[2];
#pragma unroll
    for (int i = 0; i < 2; ++i) { int R, C; stage_rc(tid * 16 + i * 8192, R, C); const int Rb = Epi::PERM ? ((R & ~31) + perm32(R & 31)) : R;
        voffA[i] = (unsigned)(R * g.lda + C) * 2u; voffB[i] = (unsigned)(Rb * K + C) * 2u; }
    const size_t kstep = (size_t)(BK * 2);
    const size_t hstep = (size_t)HALF * K * 2;
    const size_t tstep = 2 * hstep;
    const size_t hstepA = (size_t)HALF * g.lda * 2, tstepA = 2 * hstepA;
    const unsigned ldsw = (unsigned)wid * 1024u;
    const int aoff = lds_byte(wr * 64 + fr, fq * 8), boff = lds_byte(wc * 32 + fr, fq * 8);
#define PG8_SA(b, h) (((b) * 2 + (h)) * HTB)
#define PG8_SB(b, h) ((4 + (b) * 2 + (h)) * HTB)
#define PG8_STAGE(bufoff, gbase, voff) do { _Pragma("unroll") for (int _i = 0; _i < 2; ++_i) \
        __builtin_amdgcn_global_load_lds((const unsigned*)((const char*)(gbase) + (voff)[_i]), (PG8_LAS unsigned*)(lds + (bufoff) + ldsw + _i * 8192), 16, 0, 0); } while (0)
#define PG8_LDA(dst, b, h) do { _Pragma("unroll") for (int m = 0; m < 4; ++m) _Pragma("unroll") for (int k = 0; k < 2; ++k) dst[m][k] = *(const PG8_LAS bf16x8*)(lds + PG8_SA(b, h) + aoff + m * 2048 + k * 1024); } while (0)
#define PG8_LDB(dst, b, h) do { _Pragma("unroll") for (int n = 0; n < 2; ++n) _Pragma("unroll") for (int k = 0; k < 2; ++k) dst[n][k] = *(const PG8_LAS bf16x8*)(lds + PG8_SB(b, h) + boff + n * 2048 + k * 1024); } while (0)
#define PG8_MMA(ai, bj, At, Bt) do { __builtin_amdgcn_s_setprio(1); _Pragma("unroll") for (int m = 0; m < 4; ++m) _Pragma("unroll") for (int n = 0; n < 2; ++n) _Pragma("unroll") for (int k = 0; k < 2; ++k) \
        acc[ai][bj][m][n] = __builtin_amdgcn_mfma_f32_16x16x32_bf16(Bt[n][k], At[m][k], acc[ai][bj][m][n], 0, 0, 0); __builtin_amdgcn_s_setprio(0); } while (0)
#define PG8_WAIT_V(n) asm volatile("s_waitcnt vmcnt(" #n ")" ::: "memory")
#define PG8_WAIT_L(n) asm volatile("s_waitcnt lgkmcnt(" #n ")" ::: "memory")
#define PG8_BAR __builtin_amdgcn_s_barrier()
#define PG8_SCHED __builtin_amdgcn_sched_barrier(0)
    Unit cur, nxt; int ui = 0;
    if (!S.next(0, cur)) return;
    f32x4 acc[2][2][4][2];
#pragma unroll
    for (int a = 0; a < 2; ++a)
#pragma unroll
        for (int b = 0; b < 2; ++b)
#pragma unroll
            for (int m = 0; m < 4; ++m)
#pragma unroll
                for (int n = 0; n < 2; ++n) acc[a][b][m][n] = (f32x4){0.f, 0.f, 0.f, 0.f};
    bf16x8 At[4][2], B0[2][2], B1[2][2];
    const char* cA = (const char*)g.A + (size_t)cur.pm * tstepA; const char* cB = (const char*)g.Bt + (size_t)cur.pn * tstep;
    S.a_ready(cur);
    if constexpr (SP2) {
        PG8_STAGE(PG8_SB(0, 0), cB, voffB); PG8_STAGE(PG8_SB(0, 1), cB + hstep, voffB); PG8_STAGE(PG8_SA(0, 0), cA, voffA); PG8_STAGE(PG8_SA(0, 1), cA + hstepA, voffA);
        if (wr == 1) PG8_BAR;
        PG8_WAIT_V(2); PG8_BAR;
        PG8_STAGE(PG8_SB(1, 0), cB + kstep, voffB); PG8_STAGE(PG8_SA(1, 0), cA + kstep, voffA); PG8_STAGE(PG8_SB(1, 1), cB + hstep + kstep, voffB);
        PG8_WAIT_V(6); PG8_BAR;
    } else {
        PG8_STAGE(PG8_SB(0, 0), cB, voffB); PG8_STAGE(PG8_SA(0, 0), cA, voffA); PG8_STAGE(PG8_SB(0, 1), cB + hstep, voffB); PG8_STAGE(PG8_SA(0, 1), cA + hstepA, voffA);
        if (wr == 1) PG8_BAR;
        PG8_WAIT_V(4); PG8_BAR;
        PG8_STAGE(PG8_SB(1, 0), cB + kstep, voffB); PG8_STAGE(PG8_SA(1, 0), cA + kstep, voffA); PG8_STAGE(PG8_SB(1, 1), cB + hstep + kstep, voffB);
        PG8_WAIT_V(6); PG8_BAR;
    }
    for (;;) {
        const bool has_next = S.next(ui + 1, nxt);
        const char* nA = has_next ? (const char*)g.A + (size_t)nxt.pm * tstepA : cA; const char* nB = has_next ? (const char*)g.Bt + (size_t)nxt.pn * tstep : cB;
        for (int t = 0; t < nt; t += 2) {
            const bool last = (t == nt - 2);
            const char* a1 = cA + (size_t)(t + 1) * kstep;
            const char* a2 = last ? nA : cA + (size_t)(t + 2) * kstep; const char* b2 = last ? nB : cB + (size_t)(t + 2) * kstep;
            const char* a3 = a2 + kstep; const char* b3 = b2 + kstep;
            if (last && has_next) S.a_ready(nxt);
            if constexpr (SP2) {
            PG8_LDB(B0, 0, 0); PG8_LDB(B1, 0, 1); PG8_SCHED; PG8_LDA(At, 0, 0); PG8_STAGE(PG8_SA(1, 1), a1 + hstepA, voffA);
            PG8_WAIT_V(8); PG8_WAIT_L(0); PG8_BAR; PG8_MMA(0, 0, At, B0); PG8_MMA(0, 1, At, B1); PG8_BAR; PG8_SCHED;
            PG8_LDA(At, 0, 1); PG8_STAGE(PG8_SB(0, 0), b2, voffB); PG8_STAGE(PG8_SB(0, 1), b2 + hstep, voffB); PG8_STAGE(PG8_SA(0, 0), a2, voffA);
            PG8_WAIT_V(8); PG8_WAIT_L(0); PG8_BAR; PG8_MMA(1, 0, At, B0); PG8_MMA(1, 1, At, B1); PG8_BAR; PG8_SCHED;
            PG8_LDB(B0, 1, 0); PG8_LDB(B1, 1, 1); PG8_SCHED; PG8_LDA(At, 1, 0); PG8_STAGE(PG8_SA(0, 1), a2 + hstepA, voffA);
            PG8_WAIT_V(8); PG8_WAIT_L(0); PG8_BAR; PG8_MMA(0, 0, At, B0); PG8_MMA(0, 1, At, B1); PG8_BAR; PG8_SCHED;
            PG8_LDA(At, 1, 1); PG8_STAGE(PG8_SB(1, 0), b3, voffB); PG8_STAGE(PG8_SB(1, 1), b3 + hstep, voffB); PG8_STAGE(PG8_SA(1, 0), a3, voffA);
            PG8_WAIT_V(8); PG8_WAIT_L(0); PG8_BAR; PG8_MMA(1, 0, At, B0); PG8_MMA(1, 1, At, B1); PG8_BAR; PG8_SCHED;
            } else {
            PG8_LDB(B0, 0, 0); PG8_SCHED; PG8_LDA(At, 0, 0); PG8_STAGE(PG8_SA(1, 1), a1 + hstepA, voffA);
            PG8_WAIT_L(8); PG8_BAR; PG8_WAIT_L(0); PG8_MMA(0, 0, At, B0); PG8_BAR; PG8_SCHED;
            PG8_LDB(B1, 0, 1); PG8_STAGE(PG8_SB(0, 0), b2, voffB);
            PG8_BAR; PG8_WAIT_L(0); PG8_MMA(0, 1, At, B1); PG8_BAR;
            PG8_LDA(At, 0, 1); PG8_STAGE(PG8_SA(0, 0), a2, voffA);
            PG8_BAR; PG8_WAIT_L(0); PG8_MMA(1, 0, At, B0); PG8_BAR; PG8_SCHED;
            PG8_STAGE(PG8_SB(0, 1), b2 + hstep, voffB);
            PG8_WAIT_V(6); PG8_BAR; PG8_MMA(1, 1, At, B1); PG8_BAR;
            PG8_LDB(B0, 1, 0); PG8_SCHED; PG8_LDA(At, 1, 0); PG8_STAGE(PG8_SA(0, 1), a2 + hstepA, voffA);
            PG8_WAIT_L(8); PG8_BAR; PG8_WAIT_L(0); PG8_MMA(0, 0, At, B0); PG8_BAR; PG8_SCHED;
            PG8_LDB(B1, 1, 1); PG8_STAGE(PG8_SB(1, 0), b3, voffB);
            PG8_BAR; PG8_WAIT_L(0); PG8_MMA(0, 1, At, B1); PG8_BAR;
            PG8_LDA(At, 1, 1); PG8_STAGE(PG8_SA(1, 0), a3, voffA);
            PG8_BAR; PG8_WAIT_L(0); PG8_MMA(1, 0, At, B0); PG8_BAR; PG8_SCHED;
            PG8_STAGE(PG8_SB(1, 1), b3 + hstep, voffB);
            PG8_WAIT_V(6); PG8_BAR; PG8_MMA(1, 1, At, B1); PG8_BAR;
            }
        }
        if constexpr (ALIGN_EPI) { if (wr == 0) PG8_BAR; }
        if constexpr (!Epi::AFTER_DRAIN) { E(acc, cur, wr, wc, fr, fq); S.done(cur); }
        if (!has_next) break;
#pragma unroll
        for (int a = 0; a < 2; ++a)
#pragma unroll
            for (int b = 0; b < 2; ++b)
#pragma unroll
                for (int m = 0; m < 4; ++m)
#pragma unroll
                    for (int n = 0; n < 2; ++n) acc[a][b][m][n] = (f32x4){0.f, 0.f, 0.f, 0.f};
        cur = nxt; cA = nA; cB = nB; ++ui;
        if constexpr (ALIGN_EPI) { if (wr == 1) PG8_BAR; }
    }
    PG8_WAIT_V(0);
    if constexpr (!ALIGN_EPI) { if (wr == 0) PG8_BAR; }
    PG8_BAR;
    if constexpr (Epi::AFTER_DRAIN) { E.fused(acc, cur, wr, wc, fr, fq, lds, wid, lane); S.done(cur); }
#undef PG8_SA
#undef PG8_SB
#undef PG8_STAGE
#undef PG8_LDA
#undef PG8_LDB
#undef PG8_MMA
#undef PG8_WAIT_V
#undef PG8_WAIT_L
#undef PG8_BAR
#undef PG8_SCHED
}
}

#define LAS __attribute__((address_space(3)))
typedef unsigned short bf16_t;
typedef short bf16x8 __attribute__((ext_vector_type(8)));
typedef float f32x4 __attribute__((ext_vector_type(4)));
typedef unsigned u32x4 __attribute__((ext_vector_type(4)));
typedef unsigned u32x2 __attribute__((ext_vector_type(2)));
using pg8::Unit;

constexpr int M = 17408, MP = 16384, DM = 1024;
constexpr int NPRW = 1792, NPGLA = 1792, NGATE = 2048, NIN = 5632;
constexpr int FF = 2816, F2 = 5632;
constexpr float NORM_EPS = 1e-6f;
constexpr int NWAVES = 8, NTHREADS = 512;
constexpr int LDS_BYTES = 131072 + 32768;
constexpr size_t OFF_BAR = 512 * 1024;

constexpr size_t MiB = 1u << 20;
constexpr size_t OFF_ROWSS = 0;
constexpr size_t OFF_WIN = 1 * MiB, OFF_WUP = 12 * MiB, OFF_WDN = 23 * MiB, OFF_WO = 29 * MiB, OFF_WOA = 31 * MiB, OFF_WOB = 32 * MiB;
constexpr size_t OFF_W2T = 33 * MiB, OFF_A2T = OFF_W2T + 65536, OFF_G2T = OFF_A2T + 65536;
constexpr size_t OFF_PRW = 35 * MiB, OFF_PGLA = 95 * MiB, OFF_PGATE = 155 * MiB, OFF_G = 223 * MiB;
constexpr size_t OFF_MERGED = OFF_PRW, OFF_UH = OFF_WIN, OFF_X1B = 222 * MiB, OFF_U = OFF_PRW, OFF_ACT = OFF_PRW, OFF_US = 29 * MiB;
static_assert(OFF_PRW + (size_t)M * NPRW * 2 <= OFF_PGLA && OFF_PGLA + (size_t)M * NPGLA * 2 <= OFF_PGATE && OFF_PGATE + (size_t)M * NGATE * 2 <= OFF_G, "ws map");
static_assert(OFF_G + (size_t)M * 512 * 2 <= 256 * MiB && OFF_U + (size_t)M * F2 * 2 <= OFF_X1B && OFF_X1B + (size_t)M * DM * 2 <= 256 * MiB, "ws map");
static_assert(OFF_UH + (size_t)256 * 4 * F2 * 2 <= OFF_WUP && OFF_ACT + (size_t)M * FF * 2 <= OFF_X1B, "ws map");

constexpr size_t OUT_SHIFT_P = (size_t)M * DM, OUT_WKV_P = OUT_SHIFT_P + 8 * 1792, OUT_GLA_P = OUT_WKV_P + 8 * 8 * 64 * 64, OUT_CONV_P = OUT_GLA_P + 8 * 4 * 64 * 128;
constexpr size_t OUT_SHIFT_S = OUT_CONV_P + 8 * 2 * F2, OUT_WKV_S = OUT_SHIFT_S + 128 * 1792, OUT_GLA_S = OUT_WKV_S + (size_t)128 * 8 * 64 * 64, OUT_CONV_S = OUT_GLA_S + (size_t)128 * 4 * 64 * 128;
constexpr size_t OUTB_H = 0, OUTB_EW = 0, OUTB_AARR = (size_t)M * 512 * 2, OUTB_ORW = (size_t)M * 1024 * 2, OUTB_OGL = OUTB_ORW + (size_t)M * 512 * 2;

struct Args { const float* in[31]; float* out; unsigned char* ws; };
#define IN_XP 0
#define IN_XS 1
#define IN_ST_SHIFT 2
#define IN_ST_WKV 3
#define IN_ST_GLA 4
#define IN_ST_CONV 5
#define IN_NORM_MIX 6
#define IN_W_IN 7
#define IN_MU 8
#define IN_W0 9
#define IN_W2 10
#define IN_A0 11
#define IN_A2 12
#define IN_G2 13
#define IN_KK 14
#define IN_KA 15
#define IN_RK 16
#define IN_LNW 17
#define IN_LNB 18
#define IN_WG2 19
#define IN_BG 20
#define IN_GNW 21
#define IN_WOA 22
#define IN_WOB 23
#define IN_WO 24
#define IN_NORM_FFN 25
#define IN_WUP 26
#define IN_CONVW 27
#define IN_CONVB 28
#define IN_WDN 29
#define IN_NORM_FINAL 30

__device__ __forceinline__ float bf_lo(unsigned w) { return __builtin_bit_cast(float, w << 16); }
__device__ __forceinline__ float bf_hi(unsigned w) { return __builtin_bit_cast(float, w & 0xffff0000u); }
__device__ __forceinline__ float bf2f(bf16_t h) { return __builtin_bit_cast(float, (unsigned)h << 16); }
__device__ __forceinline__ unsigned f2bf(float f) { unsigned u = __builtin_bit_cast(unsigned, f); return (u + 0x7fffu + ((u >> 16) & 1u)) >> 16; }
typedef float f32x2_t __attribute__((ext_vector_type(2)));
typedef __bf16 bf16x2_t __attribute__((ext_vector_type(2)));
__device__ __forceinline__ unsigned pk2(float lo, float hi) { const f32x2_t v = {lo, hi}; const bf16x2_t b = __builtin_convertvector(v, bf16x2_t); return __builtin_bit_cast(unsigned, b); }
__device__ __forceinline__ void unpack8(u32x4 w, float (&o)[8]) { o[0] = bf_lo(w.x); o[1] = bf_hi(w.x); o[2] = bf_lo(w.y); o[3] = bf_hi(w.y); o[4] = bf_lo(w.z); o[5] = bf_hi(w.z); o[6] = bf_lo(w.w); o[7] = bf_hi(w.w); }
__device__ __forceinline__ u32x4 pack8(const float (&v)[8]) { u32x4 w; w.x = pk2(v[0], v[1]); w.y = pk2(v[2], v[3]); w.z = pk2(v[4], v[5]); w.w = pk2(v[6], v[7]); return w; }
__device__ __forceinline__ void ld8bf(const bf16_t* p, float (&o)[8]) { unpack8(*(const u32x4*)p, o); }
__device__ __forceinline__ void ld8f(const float* p, float (&o)[8]) { const f32x4 a = *(const f32x4*)p, b = *(const f32x4*)(p + 4); o[0] = a.x; o[1] = a.y; o[2] = a.z; o[3] = a.w; o[4] = b.x; o[5] = b.y; o[6] = b.z; o[7] = b.w; }
__device__ __forceinline__ float fsigmoid(float x) { return __builtin_amdgcn_rcpf(1.f + __expf(-x)); }
__device__ __forceinline__ float ftanh(float x) { return 1.f - 2.f * __builtin_amdgcn_rcpf(__expf(2.f * x) + 1.f); }
__device__ __forceinline__ float fsoftplus(float x) { return fmaxf(x, 0.f) + __logf(1.f + __expf(-fabsf(x))); }
template <int CTRL> __device__ __forceinline__ float dpp_mov(float x) { return __builtin_bit_cast(float, __builtin_amdgcn_mov_dpp(__builtin_bit_cast(int, x), CTRL, 0xf, 0xf, true)); }
__device__ __forceinline__ float row16_allsum(float x) { x += dpp_mov<0xB1>(x); x += dpp_mov<0x4E>(x); x += dpp_mov<0x124>(x); x += dpp_mov<0x128>(x); return x; }
__device__ __forceinline__ float row8_allsum(float x) { x += dpp_mov<0xB1>(x); x += dpp_mov<0x4E>(x); x += dpp_mov<0x141>(x); return x; }
__device__ __forceinline__ float rdlane(float x, int l) { return __builtin_bit_cast(float, __builtin_amdgcn_readlane(__builtin_bit_cast(int, x), l)); }
__device__ __forceinline__ float wave_allsum(float x) { x = row16_allsum(x); return (rdlane(x, 0) + rdlane(x, 16)) + (rdlane(x, 32) + rdlane(x, 48)); }
#define LDS_WAIT() asm volatile("s_waitcnt lgkmcnt(0)" ::: "memory")
__device__ __forceinline__ const float* xrow_ptr(const Args& A, int r) { return r < MP ? A.in[IN_XP] + (size_t)r * DM : A.in[IN_XS] + (size_t)(r - MP) * DM; }

#define XB_TMO      128
#define XB_XCNT(j)  (256  + 64 * (j))
#define XB_XSUB(j)  (1280 + 64 * (j))
#define XB_XGEN(j)  (2304 + 64 * (j))
#define XB_TOP      3328
#define XB_TOPGEN   3392
#define XCD_BAR_WORDS 3456
#define XB_SPIN_CAP (1u << 18)

__device__ __forceinline__ unsigned xb_ld(unsigned* p)              { return __hip_atomic_load(p, __ATOMIC_RELAXED, __HIP_MEMORY_SCOPE_AGENT); }
__device__ __forceinline__ unsigned xb_add(unsigned* p, unsigned v) { return __hip_atomic_fetch_add(p, v, __ATOMIC_RELAXED, __HIP_MEMORY_SCOPE_AGENT); }
__device__ __forceinline__ unsigned xb_xcc_id() { return (unsigned)__builtin_amdgcn_s_getreg((3 << 11) | 20) & 0xFu; }
#define XB_SPIN(cond, bar) do { unsigned _sp = 0; while (cond) { __builtin_amdgcn_s_sleep(1); \
    if ((++_sp & 255u) == 0u) { if (xb_ld(&(bar)[XB_TMO])) break; if (_sp > XB_SPIN_CAP) { atomicAdd(&(bar)[XB_TMO], 1u); break; } } } } while (0)

struct XcdBarrier {
    unsigned* bar; unsigned x;
    volatile LAS unsigned* st;
};

__device__ __forceinline__ XcdBarrier xcd_barrier_post(unsigned* bar, volatile LAS unsigned* st) {
    XcdBarrier b; b.bar = bar; b.x = xb_xcc_id(); b.st = st;
    if (threadIdx.x == 0) (void)xb_add(&bar[XB_XCNT(b.x)], 1u);
    return b;
}
__device__ __forceinline__ void xcd_barrier_complete(unsigned* bar, unsigned x, unsigned& nloc, unsigned& nx) {
    const unsigned G = gridDim.x * gridDim.y * gridDim.z;
    unsigned sum, cnt, mine, sp = 0u;
    for (;;) {
        sum = 0u; cnt = 0u; mine = 0u;
#pragma unroll
        for (unsigned j = 0; j < 16; ++j) { const unsigned c = xb_ld(&bar[XB_XCNT(j)]); sum += c; cnt += (c > 0u) ? 1u : 0u; mine = (j == x) ? c : mine; }
        if (sum == G) break;
        __builtin_amdgcn_s_sleep(1);
        if ((++sp & 255u) == 0u) { if (xb_ld(&bar[XB_TMO])) break; if (sp > XB_SPIN_CAP) { atomicAdd(&bar[XB_TMO], 1u); break; } }
    }
    nloc = mine > 0u ? mine : 1u; nx = cnt > 0u ? cnt : 1u;
}

__device__ __forceinline__ void xcd_barrier(const XcdBarrier& b) {
    asm volatile("s_waitcnt vmcnt(0)" ::: "memory");
    __syncthreads();
    if (threadIdx.x == 0) {
        unsigned* bar = b.bar;
        __builtin_amdgcn_s_waitcnt(0);
        unsigned nloc = b.st[0], nx = b.st[1];
        if (nloc == 0u) { xcd_barrier_complete(bar, b.x, nloc, nx); b.st[0] = nloc; b.st[1] = nx; }
        const unsigned old = xb_add(&bar[XB_XSUB(b.x)], 1u);
        const unsigned gen = old / nloc;
        if (old + 1u == (gen + 1u) * nloc) {
            __builtin_amdgcn_fence(__ATOMIC_RELEASE, "agent");
            asm volatile("s_waitcnt vmcnt(0)" ::: "memory");
            const unsigned og = xb_add(&bar[XB_TOP], 1u);
            const unsigned tg = og / nx;
            if (og + 1u == (tg + 1u) * nx) xb_add(&bar[XB_TOPGEN], 1u);
            else XB_SPIN(xb_ld(&bar[XB_TOPGEN]) == tg, bar);
            __builtin_amdgcn_fence(__ATOMIC_ACQUIRE, "agent");
            xb_add(&bar[XB_XGEN(b.x)], 1u);
            asm volatile("s_waitcnt vmcnt(0)" ::: "memory");
        } else {
            XB_SPIN(xb_ld(&bar[XB_XGEN(b.x)]) == gen, bar);
            __builtin_amdgcn_fence(__ATOMIC_ACQUIRE, "agent");
            asm volatile("s_waitcnt vmcnt(0)" ::: "memory");
        }
    }
    __syncthreads();
}


struct EpiProj {
    static constexpr bool PERM = true, AFTER_DRAIN = false;
    bf16_t *prw, *pgla, *pgate; float *shift_p, *shift_s;
    __device__ __forceinline__ void operator()(const f32x4 (&acc)[2][2][4][2], const Unit& u, int wr, int wc, int fr, int fq) const {
        asm volatile("" : "+v"(fr), "+v"(fq));
        bf16_t* base; int ld, colt;
        if (u.pn < 7) { base = prw; ld = NPRW; colt = u.pn * 256; } else if (u.pn < 14) { base = pgla; ld = NPGLA; colt = (u.pn - 7) * 256; } else { base = pgate; ld = NGATE; colt = (u.pn - 14) * 256; }
        const int row0 = u.pm * 256 + wr * 64 + fr, col0 = colt + wc * 32 + 8 * fq;
#pragma unroll
        for (int ai = 0; ai < 2; ++ai)
#pragma unroll
            for (int m = 0; m < 4; ++m) {
                const int r = row0 + ai * 128 + m * 16; bf16_t* rowp = base + (size_t)r * ld + col0;
#pragma unroll
                for (int bj = 0; bj < 2; ++bj) { const f32x4 v0 = acc[ai][bj][m][0], v1 = acc[ai][bj][m][1]; u32x4 w; w.x = pk2(v0[0], v0[1]); w.y = pk2(v0[2], v0[3]); w.z = pk2(v1[0], v1[1]); w.w = pk2(v1[2], v1[3]); *(u32x4*)(rowp + bj * 128) = w; }
            }
    }
};
template <bool FIRST> struct EpiGate {
    static constexpr bool PERM = true, AFTER_DRAIN = false;
    bf16_t* merged; const bf16_t* gate;
    __device__ __forceinline__ void operator()(const f32x4 (&acc)[2][2][4][2], const Unit& u, int wr, int wc, int fr, int fq) const {
        asm volatile("" : "+v"(fr), "+v"(fq));
        const int row0 = u.pm * 256 + wr * 64 + fr, col0 = u.pn * 256 + wc * 32 + 8 * fq;
#pragma unroll
        for (int ai = 0; ai < 2; ++ai) {
            u32x4 gr[4][2], pr[4][2];
#pragma unroll
            for (int m = 0; m < 4; ++m)
#pragma unroll
                for (int bj = 0; bj < 2; ++bj) { const size_t r = (size_t)(row0 + ai * 128 + m * 16); const int c = col0 + bj * 128; gr[m][bj] = *(const u32x4*)(gate + r * NGATE + c); if (!FIRST) pr[m][bj] = *(const u32x4*)(merged + r * DM + c); }
#pragma unroll
            for (int m = 0; m < 4; ++m)
#pragma unroll
                for (int bj = 0; bj < 2; ++bj) { const size_t r = (size_t)(row0 + ai * 128 + m * 16); const int c = col0 + bj * 128; float g[8], v[8]; unpack8(gr[m][bj], g);
                    const f32x4 v0 = acc[ai][bj][m][0], v1 = acc[ai][bj][m][1];
#pragma unroll
                    for (int i = 0; i < 4; ++i) { v[i] = v0[i] * fsigmoid(g[i]); v[4 + i] = v1[i] * fsigmoid(g[4 + i]); }
                    if (!FIRST) { float p[8]; unpack8(pr[m][bj], p);
#pragma unroll
                        for (int i = 0; i < 8; ++i) v[i] += p[i]; }
                    *(u32x4*)(merged + r * DM + c) = pack8(v); }
        }
    }
};
struct EpiX1 {
    static constexpr bool PERM = true, AFTER_DRAIN = false;
    const float *xp, *xs; float* x1; bf16_t* x1b; float* rowss;
    __device__ __forceinline__ void operator()(const f32x4 (&acc)[2][2][4][2], const Unit& u, int wr, int wc, int fr, int fq) const {
        asm volatile("" : "+v"(fr), "+v"(fq));
        const int row0 = u.pm * 256 + wr * 64 + fr, col0 = u.pn * 256 + wc * 32 + 8 * fq;
#pragma unroll
        for (int ai = 0; ai < 2; ++ai) {
            f32x4 xa[4][2][2];
#pragma unroll
            for (int m = 0; m < 4; ++m) { const int r = row0 + ai * 128 + m * 16; const float* xr = (r < MP ? xp + (size_t)r * DM : xs + (size_t)(r - MP) * DM);
#pragma unroll
                for (int bj = 0; bj < 2; ++bj) { xa[m][bj][0] = *(const f32x4*)(xr + col0 + bj * 128); xa[m][bj][1] = *(const f32x4*)(xr + col0 + bj * 128 + 4); } }
#pragma unroll
            for (int m = 0; m < 4; ++m) { const int r = row0 + ai * 128 + m * 16; float ssq = 0.f;
#pragma unroll
                for (int bj = 0; bj < 2; ++bj) { const int c = col0 + bj * 128; const f32x4 a = xa[m][bj][0] + acc[ai][bj][m][0], b = xa[m][bj][1] + acc[ai][bj][m][1];
                    ssq += (a[0] * a[0] + a[1] * a[1]) + (a[2] * a[2] + a[3] * a[3]) + (b[0] * b[0] + b[1] * b[1]) + (b[2] * b[2] + b[3] * b[3]);
                    u32x4 w; w.x = pk2(a[0], a[1]); w.y = pk2(a[2], a[3]); w.z = pk2(b[0], b[1]); w.w = pk2(b[2], b[3]); *(u32x4*)(x1b + (size_t)r * DM + c) = w; }
                ssq += __shfl_xor(ssq, 16); ssq += __shfl_xor(ssq, 32);
                if (fq == 0) atomicAdd(rowss + r, ssq); }
        }
    }
};
struct EpiX2 {
    static constexpr bool PERM = true, AFTER_DRAIN = false;
    const bf16_t* xb; float* xd;
    __device__ __forceinline__ void operator()(const f32x4 (&acc)[2][2][4][2], const Unit& u, int wr, int wc, int fr, int fq) const {
        asm volatile("" : "+v"(fr), "+v"(fq));
        const int row0 = u.pm * 256 + wr * 64 + fr, col0 = u.pn * 256 + wc * 32 + 8 * fq;
#pragma unroll
        for (int ai = 0; ai < 2; ++ai) {
            u32x4 xa[4][2];
#pragma unroll
            for (int m = 0; m < 4; ++m)
#pragma unroll
                for (int bj = 0; bj < 2; ++bj) xa[m][bj] = *(const u32x4*)(xb + (size_t)(row0 + ai * 128 + m * 16) * DM + col0 + bj * 128);
#pragma unroll
            for (int m = 0; m < 4; ++m)
#pragma unroll
                for (int bj = 0; bj < 2; ++bj) { float* o = xd + (size_t)(row0 + ai * 128 + m * 16) * DM + col0 + bj * 128; float x8[8]; unpack8(xa[m][bj], x8);
                    *(f32x4*)o = (f32x4){x8[0], x8[1], x8[2], x8[3]} + acc[ai][bj][m][0]; *(f32x4*)(o + 4) = (f32x4){x8[4], x8[5], x8[6], x8[7]} + acc[ai][bj][m][1]; }
        }
    }
};
__device__ __forceinline__ float gelu_gate(float g, float v) { const float t = g * (1.f + 0.044715f * g * g) * 1.5957691216057308f; return g * fsigmoid(t) * v; }
struct EpiU {
    static constexpr bool PERM = true, AFTER_DRAIN = false;
    const float* rowss; bf16_t *U, *uh; float *conv_p, *conv_s;
    __device__ __forceinline__ void operator()(const f32x4 (&acc)[2][2][4][2], const Unit& u, int wr, int wc, int fr, int fq) const {
        asm volatile("" : "+v"(fr), "+v"(fq));
        const int row0 = u.pm * 256 + wr * 64 + fr, col0 = u.pn * 256 + wc * 32 + 8 * fq;
#pragma unroll
        for (int ai = 0; ai < 2; ++ai)
#pragma unroll
            for (int m = 0; m < 4; ++m) { const int r = row0 + ai * 128 + m * 16; const float rs = rsqrtf(rowss[r] * (1.f / DM) + NORM_EPS);
#pragma unroll
                for (int bj = 0; bj < 2; ++bj) { const int c = col0 + bj * 128; const f32x4 v0 = acc[ai][bj][m][0] * rs, v1 = acc[ai][bj][m][1] * rs;
                    u32x4 w; w.x = pk2(v0[0], v0[1]); w.y = pk2(v0[2], v0[3]); w.z = pk2(v1[0], v1[1]); w.w = pk2(v1[2], v1[3]);
                    *(u32x4*)(U + (size_t)r * F2 + c) = w;
                    if (m == 3 && fr >= 14 && r < MP) { *(u32x4*)(uh + ((size_t)(r >> 6) * 2 + (fr - 14)) * F2 + c) = w;
                        if ((r & 2047) >= 2046) { float* cp = conv_p + ((size_t)(r >> 11) * 2 + (fr - 14)) * F2 + c; *(f32x4*)cp = v0; *(f32x4*)(cp + 4) = v1; } }
                    if (r >= MP && (fr & 7) >= 6) { float* cp = conv_s + ((size_t)((r - MP) >> 3) * 2 + ((fr & 7) - 6)) * F2 + c; *(f32x4*)cp = v0; *(f32x4*)(cp + 4) = v1; } } }
    }
};

struct EpiAct {
    static constexpr bool PERM = true, AFTER_DRAIN = false;
    const float *rowss, *convw, *convb; bf16_t *act, *uh, *us; float *conv_p, *conv_s; LAS float* ringbase;
    __device__ __forceinline__ void operator()(const f32x4 (&acc)[2][2][4][2], const Unit& u, int wr_, int wc_, int fr_, int fq_) const {
        int wr = wr_, wc = wc_, fr = fr_, fq = fq_;
        asm volatile("" : "+v"(fr), "+v"(fq)); asm volatile("" : "+s"(wr), "+s"(wc));
        const bool sample = u.pm >= 64;
        const int jc0 = u.pn * 128 + wc * 32 + 8 * fq;
        LAS float* ring = ringbase + (wr * 4 + wc) * 512;
#pragma unroll
        for (int ai = 0; ai < 2; ++ai) {
            const int rbase = u.pm * 256 + ai * 128 + wr * 64, grp = rbase >> 6;
#pragma unroll
            for (int m = 0; m < 4; ++m) {
                const int row = rbase + 16 * m + fr;
                const bool wuh = !sample && ((m == 0 && fr < 2) || (m == 3 && fr >= 14)), wus = sample && (fr & 7) < 2, wcs = sample && (fr & 7) >= 6;
                if (wuh || wus || wcs) {
                    const float rsm = rsqrtf(rowss[row] * (1.f / DM) + NORM_EPS);
#pragma unroll
                    for (int bj = 0; bj < 2; ++bj) { const f32x4 v0 = acc[ai][bj][m][0] * rsm, v1 = acc[ai][bj][m][1] * rsm;
                        if (wcs) { float* cp = conv_s + ((size_t)((row - MP) >> 3) * 2 + ((fr & 7) - 6)) * F2 + bj * FF + jc0; *(f32x4*)cp = v0; *(f32x4*)(cp + 4) = v1; }
                        else { u32x4 w; w.x = pk2(v0[0], v0[1]); w.y = pk2(v0[2], v0[3]); w.z = pk2(v1[0], v1[1]); w.w = pk2(v1[2], v1[3]);
                            bf16_t* dst = wuh ? uh + ((size_t)grp * 4 + (m == 0 ? fr : fr - 12)) * F2 : us + ((size_t)((row - MP) >> 3) * 2 + (fr & 7)) * F2;
                            *(u32x4*)(dst + bj * FF + jc0) = w;
                            if (wuh && m == 3 && (grp & 31) == 31) { float* cp = conv_p + ((size_t)(rbase >> 11) * 2 + (fr - 14)) * F2 + bj * FF + jc0; *(f32x4*)cp = v0; *(f32x4*)(cp + 4) = v1; } } }
                }
            }
        }
        asm volatile("" ::: "memory");
        float rsq[2][4];
#pragma unroll
        for (int ai = 0; ai < 2; ++ai)
#pragma unroll
            for (int m = 0; m < 4; ++m) rsq[ai][m] = rsqrtf(rowss[u.pm * 256 + ai * 128 + wr * 64 + 16 * m + fr] * (1.f / DM) + NORM_EPS);
#define EPIACT_STEP(AI, N) do { const int rbase = u.pm * 256 + (AI) * 128 + wr * 64; \
            _Pragma("unroll") for (int m = 0; m < 4; ++m) { const float rsm = rsq[AI][m]; \
                const f32x4 xv = acc[AI][0][m][N] * rsm, xg = acc[AI][1][m][N] * rsm; const int idx = (m & 1) * 16 + fr; \
                asm volatile("" ::: "memory"); *(LAS f32x4*)(ring + idx * 16 + fq * 4) = xv; *(LAS f32x4*)(ring + 4096 + idx * 16 + fq * 4) = xg; asm volatile("" ::: "memory");     \
                const f32x4 p1v = *(const LAS f32x4*)(ring + ((idx + 31) & 31) * 16 + fq * 4), p2v = *(const LAS f32x4*)(ring + ((idx + 30) & 31) * 16 + fq * 4); \
                const f32x4 p1g = *(const LAS f32x4*)(ring + 4096 + ((idx + 31) & 31) * 16 + fq * 4), p2g = *(const LAS f32x4*)(ring + 4096 + ((idx + 30) & 31) * 16 + fq * 4); \
                const f32x4 cv = cbv + w0v * p2v + w1v * p1v + w2v * xv, cg = cbg + w0g * p2g + w1g * p1g + w2g * xg; \
                const bool fix = sample ? ((fr & 7) < 2) : (m == 0 && fr < 2); \
                if (!fix) { u32x2 w; w.x = pk2(gelu_gate(cg[0], cv[0]), gelu_gate(cg[1], cv[1])); w.y = pk2(gelu_gate(cg[2], cv[2]), gelu_gate(cg[3], cv[3])); \
                    *(u32x2*)(act + (size_t)(rbase + 16 * m + fr) * FF + jc0 + 4 * (N)) = w; } } } while (0)
#define EPIACT_N(N) do { const int col4 = jc0 + 4 * (N); \
            const f32x4 w0v = *(const f32x4*)(convw + col4), w1v = *(const f32x4*)(convw + F2 + col4), w2v = *(const f32x4*)(convw + 2 * F2 + col4), cbv = *(const f32x4*)(convb + col4); \
            const f32x4 w0g = *(const f32x4*)(convw + FF + col4), w1g = *(const f32x4*)(convw + F2 + FF + col4), w2g = *(const f32x4*)(convw + 2 * F2 + FF + col4), cbg = *(const f32x4*)(convb + FF + col4); \
            EPIACT_STEP(0, N); EPIACT_STEP(1, N); asm volatile("" ::: "memory"); } while (0)
        EPIACT_N(0); EPIACT_N(1);
#undef EPIACT_N
#undef EPIACT_STEP
    }
};

template <class EF> __device__ __forceinline__ void tail_gemm(LAS unsigned char* lds, const bf16_t* Amat, int lda, const bf16_t* Bt, int K, const pg8::StaticOrder& S, int wave, int lane, const EF& ef) {
    const int l15 = lane & 15, q = lane >> 4, ntail = S.nwg - S.limit, nk = K / 256;
    LAS float* red = (LAS float*)lds;
    for (int item = blockIdx.x; item < ntail * 16; item += gridDim.x) {
        pg8::Unit u; S.unit_of(S.limit + (item >> 4), u);
        const int r0 = u.pm * 256 + (item & 15) * 16, c0 = u.pn * 256;
        const bf16_t* ap = Amat + (size_t)(r0 + l15) * lda + 8 * q + 32 * nk * wave; const bf16_t* bp = Bt + (size_t)(c0 + l15) * K + 8 * q + 32 * nk * wave;
        f32x4 acc[16];
#pragma unroll
        for (int n = 0; n < 16; ++n) acc[n] = (f32x4){0.f, 0.f, 0.f, 0.f};
#pragma unroll 2
        for (int ks = 0; ks < nk; ++ks) {
            const bf16x8 a = *(const bf16x8*)(ap + 32 * ks); bf16x8 b[16];
#pragma unroll
            for (int n = 0; n < 16; ++n) b[n] = *(const bf16x8*)(bp + (size_t)(16 * n) * K + 32 * ks);
#pragma unroll
            for (int n = 0; n < 16; ++n) acc[n] = __builtin_amdgcn_mfma_f32_16x16x32_bf16(a, b[n], acc[n], 0, 0, 0);
        }
        __syncthreads();
#pragma unroll
        for (int n = 0; n < 16; ++n) *(LAS f32x4*)(red + ((wave * 16 + n) * 64 + lane) * 4) = acc[n];
        __syncthreads();
        f32x4 s0 = {0.f, 0.f, 0.f, 0.f}, s1 = s0;
#pragma unroll
        for (int w2 = 0; w2 < 8; ++w2) { s0 += *(const LAS f32x4*)(red + ((w2 * 16 + 2 * wave) * 64 + lane) * 4); s1 += *(const LAS f32x4*)(red + ((w2 * 16 + 2 * wave + 1) * 64 + lane) * 4); }
        ef(r0 + 4 * q, c0 + 32 * wave + l15, s0, s1);
    }
    __syncthreads();
}
struct TfGate { bool first; bf16_t* merged; const bf16_t* gate;
    __device__ __forceinline__ void operator()(int row, int col, f32x4 a0, f32x4 a1) const {
#pragma unroll
        for (int i = 0; i < 4; ++i)
#pragma unroll
            for (int n = 0; n < 2; ++n) { const size_t r = (size_t)(row + i); const int c = col + 16 * n; float v = (n ? a1[i] : a0[i]) * fsigmoid(bf2f(gate[r * NGATE + c]));
                if (!first) v += bf2f(merged[r * DM + c]); merged[r * DM + c] = (bf16_t)f2bf(v); } } };
struct TfX1 { const float *xp, *xs; float* x1; bf16_t* x1b; float* rowss;
    __device__ __forceinline__ void operator()(int row, int col, f32x4 a0, f32x4 a1) const {
#pragma unroll
        for (int i = 0; i < 4; ++i) { const int r = row + i; const float* xr = (r < MP ? xp + (size_t)r * DM : xs + (size_t)(r - MP) * DM);
            const float v0 = xr[col] + a0[i], v1 = xr[col + 16] + a1[i];
            x1b[(size_t)r * DM + col] = (bf16_t)f2bf(v0); x1b[(size_t)r * DM + col + 16] = (bf16_t)f2bf(v1);
            const float ss = row16_allsum(v0 * v0 + v1 * v1); if ((col & 15) == 0) atomicAdd(rowss + r, ss); } } };
struct TfX2 { const bf16_t* xb; float* xd;
    __device__ __forceinline__ void operator()(int row, int col, f32x4 a0, f32x4 a1) const {
#pragma unroll
        for (int i = 0; i < 4; ++i) { const size_t off = (size_t)(row + i) * DM + col; xd[off] = bf2f(xb[off]) + a0[i]; xd[off + 16] = bf2f(xb[off + 16]) + a1[i]; } } };

template <int MODE> __device__ __forceinline__ int map_col(int R) {
    if (MODE == 1) { if (R < 1792) return R; if (R < 3584) return (R - 1792 < 1552) ? R : -1; return R - 240; }
    if (MODE == 2) { return ((R >> 7) & 1) * FF + ((R >> 8) << 7) + (R & 127); }
    return R;
}
template <int MODE> __device__ __forceinline__ void tr_item(const float* __restrict__ W, int K, int Nsrc, int Ndst, bf16_t* WT, const float* kscale, LAS float* scr, int item, int lane) {
    const int nblk = Ndst >> 5, kb = item / nblk, nb = item - kb * nblk, k0 = kb << 6, n0 = nb << 5;
    const int col = map_col<MODE>(n0 + (lane & 31));
    float tv[32];
#pragma unroll
    for (int i = 0; i < 32; ++i) { const int kk = 2 * i + (lane >> 5); tv[i] = (col >= 0) ? W[(size_t)(k0 + kk) * Nsrc + col] : 0.f; }
#pragma unroll
    for (int i = 0; i < 32; ++i) { const int kk = 2 * i + (lane >> 5); float v = tv[i]; if (kscale) v *= kscale[k0 + kk]; scr[kk * 33 + (lane & 31)] = v; }
    LDS_WAIT();
    const int c = lane & 7;
#pragma unroll
    for (int j = 0; j < 4; ++j) { const int n = (lane >> 3) + 8 * j; const LAS float* s = scr + (8 * c) * 33 + n;
        u32x4 o; o.x = pk2(s[0 * 33], s[1 * 33]); o.y = pk2(s[2 * 33], s[3 * 33]); o.z = pk2(s[4 * 33], s[5 * 33]); o.w = pk2(s[6 * 33], s[7 * 33]);
        *(u32x4*)(WT + (size_t)(n0 + n) * K + k0 + 8 * c) = o; }
    LDS_WAIT();
}
__device__ __forceinline__ void p0_prologue(const Args& A, LAS unsigned char* lds, int gw, int NGW, int wave, int lane) {
    LAS float* scr = (LAS float*)(lds + wave * 16384);
    unsigned char* ws = A.ws;
    constexpr int I_IN = 16 * (NIN / 32), I_UP = 16 * (F2 / 32), I_DN = 44 * 32, I_O = 16 * 32, I_OA = 8 * 32, I_W2 = 16, I_G2 = 2 * 16;
    constexpr int NITEMS = I_IN + I_UP + I_DN + I_O + 2 * I_OA + 2 * I_W2 + I_G2;
    for (int it = gw; it < NITEMS; it += NGW) {
        int r = it;
        if (r < I_IN) { tr_item<1>(A.in[IN_W_IN], 1024, 5392, NIN, (bf16_t*)(ws + OFF_WIN), nullptr, scr, r, lane); continue; } r -= I_IN;
        if (r < I_UP) { tr_item<2>(A.in[IN_WUP], 1024, F2, F2, (bf16_t*)(ws + OFF_WUP), A.in[IN_NORM_FFN], scr, r, lane); continue; } r -= I_UP;
        if (r < I_DN) { tr_item<0>(A.in[IN_WDN], FF, 1024, 1024, (bf16_t*)(ws + OFF_WDN), nullptr, scr, r, lane); continue; } r -= I_DN;
        if (r < I_O) { tr_item<0>(A.in[IN_WO], 1024, 1024, 1024, (bf16_t*)(ws + OFF_WO), nullptr, scr, r, lane); continue; } r -= I_O;
        if (r < I_OA) { tr_item<0>(A.in[IN_WOA], 512, 1024, 1024, (bf16_t*)(ws + OFF_WOA), nullptr, scr, r, lane); continue; } r -= I_OA;
        if (r < I_OA) { tr_item<0>(A.in[IN_WOB], 512, 1024, 1024, (bf16_t*)(ws + OFF_WOB), nullptr, scr, r, lane); continue; } r -= I_OA;
        if (r < I_W2) { tr_item<0>(A.in[IN_W2], 64, 512, 512, (bf16_t*)(ws + OFF_W2T), nullptr, scr, r, lane); continue; } r -= I_W2;
        if (r < I_W2) { tr_item<0>(A.in[IN_A2], 64, 512, 512, (bf16_t*)(ws + OFF_A2T), nullptr, scr, r, lane); continue; } r -= I_W2;
        tr_item<0>(A.in[IN_G2], 128, 512, 512, (bf16_t*)(ws + OFF_G2T), nullptr, scr, r, lane);
    }
    bf16_t* H = (bf16_t*)((unsigned char*)A.out + OUTB_H);
    const float* gm = A.in[IN_NORM_MIX];
    for (int m = gw; m < M; m += 2 * NGW) {
        const int m2 = m + NGW; const bool has2 = m2 < M;
        const f32x4* xr = (const f32x4*)xrow_ptr(A, m) + lane; const f32x4* xr2 = (const f32x4*)xrow_ptr(A, has2 ? m2 : m) + lane; f32x4 v[4], w[4]; float s = 0.f, s2 = 0.f;
#pragma unroll
        for (int j = 0; j < 4; ++j) { v[j] = xr[64 * j]; w[j] = xr2[64 * j]; }
#pragma unroll
        for (int j = 0; j < 4; ++j) { s += (v[j].x * v[j].x + v[j].y * v[j].y) + (v[j].z * v[j].z + v[j].w * v[j].w); s2 += (w[j].x * w[j].x + w[j].y * w[j].y) + (w[j].z * w[j].z + w[j].w * w[j].w); }
        const float rstd = rsqrtf(wave_allsum(s) * (1.f / DM) + NORM_EPS), rstd2 = rsqrtf(wave_allsum(s2) * (1.f / DM) + NORM_EPS);
        u32x2* o8 = (u32x2*)(H + (size_t)m * DM) + lane; u32x2* o82 = (u32x2*)(H + (size_t)m2 * DM) + lane;
#pragma unroll
        for (int j = 0; j < 4; ++j) { const f32x4 g = *((const f32x4*)gm + lane + 64 * j); u32x2 p; p.x = pk2(v[j].x * rstd * g.x, v[j].y * rstd * g.y); p.y = pk2(v[j].z * rstd * g.z, v[j].w * rstd * g.w); o8[64 * j] = p;
            if (has2) { u32x2 p2; p2.x = pk2(w[j].x * rstd2 * g.x, w[j].y * rstd2 * g.y); p2.y = pk2(w[j].z * rstd2 * g.z, w[j].w * rstd2 * g.w); o82[64 * j] = p2; } }
    }
    float* rowss = (float*)(ws + OFF_ROWSS);
    for (int i = gw * 64 + lane; i < M; i += NGW * 64) rowss[i] = 0.f;
}

__device__ __forceinline__ void prw_mixed8(const Args& A, const bf16_t* PRW, int r, int col0, float (&xs)[8]) {
    float cur[8], prev[8];
    ld8bf(PRW + (size_t)r * NPRW + col0, cur);
    const bool first = (r < MP) ? ((r & 2047) == 0) : (((r - MP) & 7) == 0);
    if (!first) ld8bf(PRW + (size_t)(r - 1) * NPRW + col0, prev);
    else if (r < MP) {
#pragma unroll
        for (int i = 0; i < 8; ++i) prev[i] = 0.f;
    } else ld8f(A.in[IN_ST_SHIFT] + (size_t)((r - MP) >> 3) * 1792 + col0, prev);
    float mu[8]; ld8f(A.in[IN_MU] + col0, mu);
#pragma unroll
    for (int i = 0; i < 8; ++i) xs[i] = cur[i] + (prev[i] - cur[i]) * mu[i];
}
template <int ACT> __device__ __forceinline__ bf16x8 afrag(const Args& A, const bf16_t* PRW, int r, int col0) {
    float xs[8]; prw_mixed8(A, PRW, r, col0, xs);
#pragma unroll
    for (int i = 0; i < 8; ++i) xs[i] = ACT == 1 ? ftanh(xs[i]) : (ACT == 2 ? fsigmoid(xs[i]) : xs[i]);
    return __builtin_bit_cast(bf16x8, pack8(xs));
}
__device__ __forceinline__ void p2a_lora(const Args& A, LAS unsigned char* lds, int gw, int NGW, int wave, int lane) {
    const bf16_t* PRW = (const bf16_t*)(A.ws + OFF_PRW);
    const bf16_t *W2T = (const bf16_t*)(A.ws + OFF_W2T), *A2T = (const bf16_t*)(A.ws + OFF_A2T), *G2T = (const bf16_t*)(A.ws + OFF_G2T);
    bf16_t *EW = (bf16_t*)((unsigned char*)A.out + OUTB_EW), *AARR = (bf16_t*)((unsigned char*)A.out + OUTB_AARR), *G = (bf16_t*)(A.ws + OFF_G);
    for (int i = gw * 64 + lane; i < 136 * 224; i += NGW * 64) { const int sq = i / 224, c8 = (i - sq * 224) * 8; const int r = sq < 8 ? sq * 2048 + 2047 : MP + (sq - 8) * 8 + 7;
        float v[8]; ld8bf(PRW + (size_t)r * NPRW + c8, v); float* dst = (sq < 8 ? A.out + OUT_SHIFT_P + (size_t)sq * 1792 : A.out + OUT_SHIFT_S + (size_t)(sq - 8) * 1792) + c8;
        *(f32x4*)dst = (f32x4){v[0], v[1], v[2], v[3]}; *(f32x4*)(dst + 4) = (f32x4){v[4], v[5], v[6], v[7]}; }
    const int l15 = lane & 15, kq = lane >> 4;
    LAS bf16_t* acts = (LAS bf16_t*)lds; const int tid = wave * 64 + lane;
    for (int tile = blockIdx.x; tile < M / 16; tile += gridDim.x) {
        const int h = wave, t0 = tile * 16;
        { const int tt = tid >> 5, cg = tid & 31; float xs[8]; prw_mixed8(A, PRW, t0 + tt, 1536 + 8 * cg, xs);
#pragma unroll
          for (int i = 0; i < 8; ++i) xs[i] = cg < 8 ? ftanh(xs[i]) : (cg < 16 ? xs[i] : fsigmoid(xs[i]));
          __syncthreads();
          *(LAS u32x4*)(acts + tt * 264 + 8 * cg) = pack8(xs); }
        __syncthreads();
        bf16x8 aw[2], aa[2], ag[4];
#pragma unroll
        for (int ks = 0; ks < 2; ++ks) { aw[ks] = *(const LAS bf16x8*)(acts + l15 * 264 + ks * 32 + kq * 8); aa[ks] = *(const LAS bf16x8*)(acts + l15 * 264 + 64 + ks * 32 + kq * 8); }
#pragma unroll
        for (int ks = 0; ks < 4; ++ks) ag[ks] = *(const LAS bf16x8*)(acts + l15 * 264 + 128 + ks * 32 + kq * 8);
        f32x4 cwv[4], cav[4], cgg[4];
#pragma unroll
        for (int nt = 0; nt < 4; ++nt) {
            const int c = 64 * h + 16 * nt + l15;
            f32x4 cw = {0.f, 0.f, 0.f, 0.f}, ca = cw, cgv = cw;
#pragma unroll
            for (int ks = 0; ks < 2; ++ks) {
                const bf16x8 bw = *(const bf16x8*)(W2T + (size_t)c * 64 + ks * 32 + kq * 8), ba = *(const bf16x8*)(A2T + (size_t)c * 64 + ks * 32 + kq * 8);
                cw = __builtin_amdgcn_mfma_f32_16x16x32_bf16(bw, aw[ks], cw, 0, 0, 0); ca = __builtin_amdgcn_mfma_f32_16x16x32_bf16(ba, aa[ks], ca, 0, 0, 0); }
#pragma unroll
            for (int ks = 0; ks < 4; ++ks) { const bf16x8 bg = *(const bf16x8*)(G2T + (size_t)c * 128 + ks * 32 + kq * 8); cgv = __builtin_amdgcn_mfma_f32_16x16x32_bf16(bg, ag[ks], cgv, 0, 0, 0); }
            cwv[nt] = cw; cav[nt] = ca; cgg[nt] = cgv;
        }
#pragma unroll
        for (int nt = 0; nt < 4; ++nt) {
            const int c4 = 64 * h + 16 * nt + 4 * kq; const size_t o = (size_t)(t0 + l15) * 512 + c4;
            const f32x4 w0v = *(const f32x4*)(A.in[IN_W0] + c4), a0v = *(const f32x4*)(A.in[IN_A0] + c4);
            float ew[4], av[4];
#pragma unroll
            for (int i = 0; i < 4; ++i) { ew[i] = 0.6065306597f * fsigmoid(w0v[i] + cwv[nt][i]); av[i] = fsigmoid(a0v[i] + cav[nt][i]); }
            u32x2 w; w.x = pk2(ew[0], ew[1]); w.y = pk2(ew[2], ew[3]); *(u32x2*)(EW + o) = w;
            w.x = pk2(av[0], av[1]); w.y = pk2(av[2], av[3]); *(u32x2*)(AARR + o) = w;
            w.x = pk2(cgg[nt][0], cgg[nt][1]); w.y = pk2(cgg[nt][2], cgg[nt][3]); *(u32x2*)(G + o) = w;
        }
    }
}

typedef short bf16x4 __attribute__((ext_vector_type(4)));
#define MFMA32(a, b, c) __builtin_amdgcn_mfma_f32_16x16x32_bf16(a, b, c, 0, 0, 0)
#define MFMA16(a, b, c) __builtin_amdgcn_mfma_f32_16x16x16bf16_1k(a, b, c, 0, 0, 0)
constexpr int SP = 72;
constexpr size_t OFF_RLT = 240 * MiB;
constexpr size_t OFF_GL = 1 * MiB, OFF_GG = 8 * MiB;
static_assert(OFF_RLT + (size_t)448 * 32768 <= 256 * MiB && OFF_GL + (size_t)224 * 32768 <= OFF_GG && OFF_GG + 224 * 256 <= OFF_WUP, "ws map (scan)");
__device__ __forceinline__ bf16x4 bf4(f32x4 v) { u32x2 w; w.x = pk2(v[0], v[1]); w.y = pk2(v[2], v[3]); return __builtin_bit_cast(bf16x4, w); }
__device__ __forceinline__ bf16x8 afr(const LAS bf16_t* X, int l15, int q, int ks) { const LAS bf16_t* p = X + l15 * SP + 32 * ks + 4 * q; const u32x2 lo = *(const LAS u32x2*)p, hi = *(const LAS u32x2*)(p + 16); u32x4 w; w.x = lo.x; w.y = lo.y; w.z = hi.x; w.w = hi.y; return __builtin_bit_cast(bf16x8, w); }
__device__ __forceinline__ bf16x8 hfrag(const f32x4& lo, const f32x4& hi) { u32x4 w; w.x = pk2(lo[0], lo[1]); w.y = pk2(lo[2], lo[3]); w.z = pk2(hi[0], hi[1]); w.w = pk2(hi[2], hi[3]); return __builtin_bit_cast(bf16x8, w); }
__device__ __forceinline__ f32x4 maskc(f32x4 v, int q, int l15, bool rows_lt_col, bool incl) {
#pragma unroll
    for (int i = 0; i < 4; ++i) { const int R = 4 * q + i; const bool keep = rows_lt_col ? (incl ? R <= l15 : R < l15) : (incl ? l15 <= R : l15 < R); v[i] = keep ? v[i] : 0.f; }
    return v;
}
template <bool GLA, int VP> __device__ __forceinline__ void scan_matrix_part(const LAS bf16_t* AT, const LAS bf16_t* RT, const LAS bf16_t* BT, const LAS bf16_t* KT, const LAS bf16_t* VS, const LAS float* GC, bf16_t* OUTP, int l15, int q, int sl, bool use_v, bool write_o, int rowb, int nv, f32x4 (&H)[4]) {
    const bf16x8 hb0 = hfrag(H[0], H[1]), hb1 = hfrag(H[2], H[3]);
    const bf16x8 rt0 = afr(RT, l15, q, 0), rt1 = afr(RT, l15, q, 1), kt0 = afr(KT, l15, q, 0), kt1 = afr(KT, l15, q, 1);
    const f32x4 z4 = {0.f, 0.f, 0.f, 0.f};
    bf16x4 vb = {0, 0, 0, 0};
    if (use_v) { const LAS bf16_t* vp = VS + (4 * q) * VP + 16 * sl + l15; u32x2 w; w.x = (unsigned)vp[0] | ((unsigned)vp[VP] << 16); w.y = (unsigned)vp[2 * VP] | ((unsigned)vp[3 * VP] << 16); vb = __builtin_bit_cast(bf16x4, w); }
    f32x4 O = MFMA32(rt0, hb0, z4); O = MFMA32(rt1, hb1, O);
    f32x4 U = z4;
    if (!GLA) {
        const bf16x8 at0 = afr(AT, l15, q, 0), at1 = afr(AT, l15, q, 1), bt0 = afr(BT, l15, q, 0), bt1 = afr(BT, l15, q, 1);
        f32x4 P = MFMA32(at0, bt0, z4); P = MFMA32(at1, bt1, P); P = maskc(P, q, l15, false, false);
        f32x4 PT = MFMA32(bt0, at0, z4); PT = MFMA32(bt1, at1, PT); PT = maskc(PT, q, l15, true, false);
        f32x4 nrbT = MFMA32(bt0, rt0, z4); nrbT = MFMA32(bt1, rt1, nrbT); nrbT = maskc(nrbT, q, l15, true, true);
        U = MFMA32(at0, hb0, z4); U = MFMA32(at1, hb1, U);
        if (use_v) { f32x4 makT = MFMA32(kt0, at0, z4); makT = MFMA32(kt1, at1, makT); makT = maskc(makT, q, l15, true, false); U = MFMA16(bf4(makT), vb, U); }
#pragma unroll
        for (int it = 0; it < 4; ++it) {
            U = MFMA16(bf4(PT), bf4(U), U);
            if (it < 3) { const f32x4 Pn = MFMA16(bf4(PT), bf4(P), z4), PTn = MFMA16(bf4(P), bf4(PT), z4); P = Pn; PT = PTn; }
        }
        O = MFMA16(bf4(nrbT), bf4(U), O);
    }
    if (use_v) { f32x4 nrkT = MFMA32(kt0, rt0, z4); nrkT = MFMA32(kt1, rt1, nrkT); nrkT = maskc(nrkT, q, l15, true, true); O = MFMA16(bf4(nrkT), vb, O); }
    if (write_o) {
#pragma unroll
        for (int i = 0; i < 4; ++i) if (4 * q + i < nv) OUTP[(size_t)(rowb + 4 * q + i) * 512] = (bf16_t)f2bf(O[i]);
    }
    const bf16x4 ub = bf4(U);
#pragma unroll
    for (int kt = 0; kt < 4; ++kt) {
        const f32x4 g4 = *(const LAS f32x4*)(GC + 16 * kt + 4 * q); const float gk = GC[16 * kt + l15];
        f32x4 acc = H[kt] * g4;
        if (!GLA) { const LAS bf16_t* p = BT + (4 * q) * SP + 16 * kt + l15; u32x2 w; w.x = pk2(bf2f(p[0]) * gk, bf2f(p[SP]) * gk); w.y = pk2(bf2f(p[2 * SP]) * gk, bf2f(p[3 * SP]) * gk); acc = MFMA16(__builtin_bit_cast(bf16x4, w), ub, acc); }
        if (use_v) { const LAS bf16_t* p = KT + (4 * q) * SP + 16 * kt + l15; u32x2 w; w.x = pk2(bf2f(p[0]) * gk, bf2f(p[SP]) * gk); w.y = pk2(bf2f(p[2 * SP]) * gk, bf2f(p[3 * SP]) * gk); acc = MFMA16(__builtin_bit_cast(bf16x4, w), vb, acc); }
        H[kt] = acc;
    }
}
constexpr int GL_RT = 2304, GL_BT = 4608, GL_KT = 6912, GL_VS = 9216, GL_GC = 13568, GL_EG = 13824, GL_BYTES = 26624;
template <bool GLA, int W> __device__ __forceinline__ void scan_block(const Args& A, LAS unsigned char* gl, int lane, int wg, int row0, int nsub, int nvalid, int first_kind, int bsamp, int hh, int sl, bool use_v, bool write_o, f32x4 (&H)[4], float& cumtot) {
    constexpr int TPW = 16 / W, VP = GLA ? 136 : 72;
    const int c = lane, l15 = lane & 15, q = lane >> 4, t0 = wg * TPW;
    const bf16_t* PRW = (const bf16_t*)(A.ws + OFF_PRW); const bf16_t* PGLA = (const bf16_t*)(A.ws + OFF_PGLA);
    const bf16_t *EW = (const bf16_t*)((unsigned char*)A.out + OUTB_EW), *AARR = (const bf16_t*)((unsigned char*)A.out + OUTB_AARR);
    bf16_t* OUTP = GLA ? (bf16_t*)((unsigned char*)A.out + OUTB_OGL) + 128 * hh + 16 * sl + l15 : (bf16_t*)((unsigned char*)A.out + OUTB_ORW) + 64 * hh + 16 * sl + l15;
    LAS bf16_t *AT = (LAS bf16_t*)gl, *RT = (LAS bf16_t*)(gl + GL_RT), *BT = (LAS bf16_t*)(gl + GL_BT), *KT = (LAS bf16_t*)(gl + GL_KT), *VS = (LAS bf16_t*)(gl + GL_VS);
    LAS float *GC = (LAS float*)(gl + GL_GC), *EG = (LAS float*)(gl + GL_EG);
    float mu_r = 0.f, mu_k = 0.f, mu_v = 0.f, kkc = 0.f, kac = 0.f, bgc = 0.f; float wgt[16];
#pragma unroll
    for (int j = 0; j < 16; ++j) wgt[j] = 0.f;
    if (!GLA) { const float* mu = A.in[IN_MU]; mu_r = mu[64 * hh + c]; mu_k = mu[512 + 64 * hh + c]; mu_v = mu[1024 + 64 * hh + c]; kkc = A.in[IN_KK][64 * hh + c]; kac = A.in[IN_KA][64 * hh + c]; }
    else { bgc = A.in[IN_BG][64 * hh + c];
#pragma unroll
        for (int j = 0; j < 16; ++j) wgt[j] = A.in[IN_WG2][j * 256 + 64 * hh + c]; }
    float pr[2] = {0.f, 0.f}, pk[2] = {0.f, 0.f}, pvv[2] = {0.f, 0.f}; bf16_t r0[2][TPW], r1[2][TPW], r2[2][TPW], r3[2][TPW], r4[2][TPW]; unsigned rvv[2][TPW]; u32x4 lg0[2][TPW], lg1[2][TPW];
#pragma unroll
    for (int p = 0; p < 2; ++p)
#pragma unroll
        for (int i = 0; i < TPW; ++i) { r0[p][i] = r1[p][i] = r2[p][i] = r3[p][i] = r4[p][i] = 0; rvv[p][i] = 0u; lg0[p][i] = (u32x4){0u, 0u, 0u, 0u}; lg1[p][i] = lg0[p][i]; }
#define SB_LOAD(SC, P) do { const int nv_ = ((SC) == nsub - 1) ? nvalid : 16; \
        if (!GLA) { if ((SC) == 0 && t0 == 0) { pr[P] = pk[P] = pvv[P] = 0.f; if (first_kind == 0) { const bf16_t* p = PRW + (size_t)(row0 - 1) * NPRW + 64 * hh + c; pr[P] = bf2f(p[0]); pk[P] = bf2f(p[512]); pvv[P] = bf2f(p[1024]); } \
                        else if (first_kind == 2) { const float* st = A.in[IN_ST_SHIFT] + (size_t)bsamp * 1792 + 64 * hh + c; pr[P] = st[0]; pk[P] = st[512]; pvv[P] = st[1024]; } } \
                    else if (t0 < nv_) { const bf16_t* p = PRW + (size_t)(row0 + 16 * (SC) + t0 - 1) * NPRW + 64 * hh + c; pr[P] = bf2f(p[0]); pk[P] = bf2f(p[512]); pvv[P] = bf2f(p[1024]); } } \
        _Pragma("unroll") for (int i = 0; i < TPW; ++i) if (t0 + i < nv_) { const size_t ro = (size_t)(row0 + 16 * (SC) + t0 + i); \
            if (!GLA) { const bf16_t* p = PRW + ro * NPRW + 64 * hh + c; r0[P][i] = p[0]; r1[P][i] = p[512]; r2[P][i] = p[1024]; r3[P][i] = EW[ro * 512 + 64 * hh + c]; r4[P][i] = AARR[ro * 512 + 64 * hh + c]; } \
            else { const bf16_t* p = PGLA + ro * NPGLA; r0[P][i] = p[64 * hh + c]; r1[P][i] = p[256 + 64 * hh + c]; rvv[P][i] = *(const unsigned*)(p + 512 + 128 * hh + 2 * lane); lg0[P][i] = *(const u32x4*)(p + 1024); lg1[P][i] = *(const u32x4*)(p + 1032); } } } while (0)
#define SB_EG(SC, P) do { const int nv_ = ((SC) == nsub - 1) ? nvalid : 16; LAS float* eg_ = EG + (P) * 1024; float tot_ = 0.f; \
        _Pragma("unroll") for (int i = 0; i < TPW; ++i) { float ev = 0.f; if (t0 + i < nv_) { if (!GLA) ev = bf2f(r3[P][i]); else { float lga[16], t8[8]; unpack8(lg0[P][i], t8); _Pragma("unroll") for (int j = 0; j < 8; ++j) lga[j] = t8[j]; \
                unpack8(lg1[P][i], t8); _Pragma("unroll") for (int j = 0; j < 8; ++j) lga[8 + j] = t8[j]; float z = bgc; _Pragma("unroll") for (int j = 0; j < 16; ++j) z += lga[j] * wgt[j]; ev = fsoftplus(-z) * 0.0625f; } } \
            eg_[(t0 + i) * 64 + c] = ev; tot_ += ev; } \
        WT[((P) * 8 + wg) * 64 + c] = tot_; } while (0)
#define SB_ITER(SC, P) do { const int sc = (SC); const int nv = (sc == nsub - 1) ? nvalid : 16; \
        __syncthreads();                                                         \
        { const LAS float* eg = EG + (P) * 1024; float cum = 0.f; \
          _Pragma("unroll") for (int w2 = 0; w2 < W - 1; ++w2) { const float tw = WT[((P) * 8 + w2) * 64 + c]; cum += (w2 < wg) ? tw : 0.f; } \
          _Pragma("unroll") for (int i = 0; i < TPW; ++i) { const int t = t0 + i; \
            if (t < nv) { \
                const float gp = __expf(-cum); cum += eg[t * 64 + c]; const float g = __expf(-cum), e = __expf(cum); \
                if (!GLA) { \
                    const float cr = bf2f(r0[P][i]), ck = bf2f(r1[P][i]), cv = bf2f(r2[P][i]), a = bf2f(r4[P][i]); \
                    const float xr = cr + (pr[P] - cr) * mu_r, xk = ck + (pk[P] - ck) * mu_k, xv = cv + (pvv[P] - cv) * mu_v; pr[P] = cr; pk[P] = ck; pvv[P] = cv; \
                    const float kkv = xk * kkc, ss = wave_allsum(kkv * kkv), kk = kkv * __builtin_amdgcn_rcpf(fmaxf(sqrtf(ss), 1e-12f)); \
                    const unsigned w01 = pk2(-kk * gp, xr * g), w23 = pk2(kk * a * e, xk * (1.f + (a - 1.f) * kac) * e); \
                    AT[t * SP + c] = (bf16_t)(w01 & 0xffffu); RT[t * SP + c] = (bf16_t)(w01 >> 16); BT[t * SP + c] = (bf16_t)(w23 & 0xffffu); KT[t * SP + c] = (bf16_t)(w23 >> 16); \
                    VS[t * VP + c] = (bf16_t)f2bf(xv); \
                } else { \
                    const unsigned w01 = pk2(bf2f(r0[P][i]) * 0.125f * g, bf2f(r1[P][i]) * e); \
                    RT[t * SP + c] = (bf16_t)(w01 & 0xffffu); KT[t * SP + c] = (bf16_t)(w01 >> 16); \
                    *(LAS unsigned*)(VS + t * VP + 2 * lane) = rvv[P][i]; \
                } \
            } else { \
                if (!GLA) { AT[t * SP + c] = 0; BT[t * SP + c] = 0; VS[t * VP + c] = 0; } else *(LAS unsigned*)(VS + t * VP + 2 * lane) = 0u; \
                RT[t * SP + c] = 0; KT[t * SP + c] = 0; \
            } \
          } \
          if (wg == W - 1) { GC[c] = __expf(-cum); cumtot += cum; } \
        } \
        if (sc + 2 < nsub) SB_LOAD(sc + 2, P); \
        __syncthreads();                                                         \
        scan_matrix_part<GLA, VP>(AT, RT, BT, KT, VS, GC, OUTP, l15, q, sl, use_v, write_o, row0 + 16 * sc, nv, H); \
        if (sc + 1 < nsub) SB_EG(sc + 1, 1 - (P)); } while (0)
    LAS float* WT = EG + 2048;
    SB_LOAD(0, 0); if (nsub > 1) SB_LOAD(1, 1); SB_EG(0, 0);
    for (int sc2 = 0; sc2 < nsub; sc2 += 2) { SB_ITER(sc2, 0); if (sc2 + 1 < nsub) SB_ITER(sc2 + 1, 1); }
#undef SB_LOAD
#undef SB_EG
#undef SB_ITER
}
constexpr int GP = 264;
__device__ __forceinline__ void gla_pass1_item(const Args& A, LAS unsigned char* lds, int wave, int lane, int b, int hh, int cc, int ig) {
    const bf16_t* PGLA = (const bf16_t*)(A.ws + OFF_PGLA);
    LAS bf16_t* KHT = (LAS bf16_t*)lds; LAS bf16_t* VT = KHT + 64 * GP; LAS float* WT = (LAS float*)(lds + (64 + 128) * GP * 2);
    const int c = lane, l15 = lane & 15, q = lane >> 4, row0 = b * 2048 + cc * 256 + 32 * wave;
    float wgt[16]; const float bgc = A.in[IN_BG][64 * hh + c];
#pragma unroll
    for (int j = 0; j < 16; ++j) wgt[j] = A.in[IN_WG2][j * 256 + 64 * hh + c];
    float cum[32]; float run = 0.f;
#pragma unroll
    for (int tb = 0; tb < 32; tb += 8) {
        u32x4 g0[8], g1[8];
#pragma unroll
        for (int j = 0; j < 8; ++j) { const bf16_t* p = PGLA + (size_t)(row0 + tb + j) * NPGLA; g0[j] = *(const u32x4*)(p + 1024); g1[j] = *(const u32x4*)(p + 1032); }
#pragma unroll
        for (int j = 0; j < 8; ++j) { float lga[16], t8[8];
            unpack8(g0[j], t8);
#pragma unroll
            for (int i = 0; i < 8; ++i) lga[i] = t8[i];
            unpack8(g1[j], t8);
#pragma unroll
            for (int i = 0; i < 8; ++i) lga[8 + i] = t8[i];
            float z = bgc;
#pragma unroll
            for (int i = 0; i < 16; ++i) z += lga[i] * wgt[i];
            run += fsoftplus(-z) * 0.0625f; cum[tb + j] = run; }
    }
    __syncthreads();
    WT[wave * 64 + c] = run;
    __syncthreads();
    float after = 0.f, tot = 0.f;
#pragma unroll
    for (int w2 = 0; w2 < 8; ++w2) { const float tw = WT[w2 * 64 + c]; tot += tw; after += (w2 > wave) ? tw : 0.f; }
#pragma unroll
    for (int tb = 0; tb < 32; tb += 16) {
        bf16_t rk[16]; unsigned rv[16];
#pragma unroll
        for (int j = 0; j < 16; ++j) { const bf16_t* p = PGLA + (size_t)(row0 + tb + j) * NPGLA; rk[j] = p[256 + 64 * hh + c]; rv[j] = *(const unsigned*)(p + 512 + 128 * hh + 2 * lane); }
#pragma unroll
        for (int j = 0; j < 16; ++j) { const int t = tb + j;
            KHT[c * GP + 32 * wave + t] = (bf16_t)f2bf(bf2f(rk[j]) * __expf(-(after + (run - cum[t]))));
            VT[(2 * lane) * GP + 32 * wave + t] = (bf16_t)(rv[j] & 0xffffu); VT[(2 * lane + 1) * GP + 32 * wave + t] = (bf16_t)(rv[j] >> 16); }
    }
    __syncthreads();
    f32x4 acc[4];
#pragma unroll
    for (int kt = 0; kt < 4; ++kt) acc[kt] = (f32x4){0.f, 0.f, 0.f, 0.f};
#pragma unroll
    for (int ks = 0; ks < 8; ++ks) { const bf16x8 bv = *(const LAS bf16x8*)(VT + (16 * wave + l15) * GP + 32 * ks + 8 * q);
#pragma unroll
        for (int kt = 0; kt < 4; ++kt) { const bf16x8 av = *(const LAS bf16x8*)(KHT + (16 * kt + l15) * GP + 32 * ks + 8 * q); acc[kt] = MFMA32(av, bv, acc[kt]); } }
    float* dst = (float*)(A.ws + OFF_GL) + (size_t)ig * 8192 + 16 * wave + l15;
#pragma unroll
    for (int kt = 0; kt < 4; ++kt)
#pragma unroll
        for (int i = 0; i < 4; ++i) dst[(16 * kt + 4 * q + i) * 128] = acc[kt][i];
    if (wave == 7) ((float*)(A.ws + OFF_GG))[ig * 64 + lane] = __expf(-tot);
}
__device__ __forceinline__ void rwkv_sample_iter(const Args& A, LAS unsigned char* lds, int wave, int lane, int sbi) {
    const int l15 = lane & 15, q = lane >> 4;
    f32x4 H[4]; float cumtot = 0.f;
    const int item = 2 * sbi + (wave >> 2), sl = wave & 3, hh = item & 7, b = item >> 3;
    const float* st = A.in[IN_ST_WKV] + (((size_t)b * 8 + hh) * 64 + 16 * sl + l15) * 64 + 4 * q;
#pragma unroll
    for (int kt = 0; kt < 4; ++kt) H[kt] = *(const f32x4*)(st + 16 * kt);
    scan_block<false, 4>(A, lds + (wave >> 2) * GL_BYTES, lane, wave & 3, MP + b * 8, 1, 8, 2, b, hh, sl, true, true, H, cumtot);
    float* o = A.out + OUT_WKV_S + (((size_t)b * 8 + hh) * 64 + 16 * sl + l15) * 64 + 4 * q;
#pragma unroll
    for (int kt = 0; kt < 4; ++kt) *(f32x4*)(o + 16 * kt) = H[kt];
}
__device__ __forceinline__ void p2x_scan1(const Args& A, LAS unsigned char* lds, int wave, int lane) {
    const int l15 = lane & 15, q = lane >> 4;
    for (int it = blockIdx.x; it < 448; it += gridDim.x) {
        f32x4 H[4]; float cumtot = 0.f;
        if (it < 448) {
            const int seq = it / 7, cc = it - seq * 7, b = seq >> 3, hh = seq & 7; const bool isT = wave >= 4; const int sl = wave & 3;
#pragma unroll
            for (int kt = 0; kt < 4; ++kt)
#pragma unroll
                for (int i = 0; i < 4; ++i) H[kt][i] = (isT && (16 * kt + 4 * q + i == 16 * sl + l15)) ? 1.f : 0.f;
            scan_block<false, 8>(A, lds, lane, wave, b * 2048 + cc * 256, 16, 16, cc == 0 ? 1 : 0, 0, hh, sl, !isT, false, H, cumtot);
            float* dst = (float*)(A.ws + OFF_RLT) + (size_t)it * 8192 + (isT ? 4096 : 0) + 16 * sl + l15;
#pragma unroll
            for (int kt = 0; kt < 4; ++kt)
#pragma unroll
                for (int i = 0; i < 4; ++i) dst[(16 * kt + 4 * q + i) * 64] = H[kt][i];
        }
    }
    if (gridDim.x == 256 && blockIdx.x >= 192) {
        for (int sbi = (int)blockIdx.x - 192; sbi < 512; sbi += 64) rwkv_sample_iter(A, lds, wave, lane, sbi);
    }
    __syncthreads();
}
__device__ __forceinline__ void p2y_scan2(const Args& A, LAS unsigned char* lds, int wave, int lane) {
    const int l15 = lane & 15, q = lane >> 4;
    for (int bi = blockIdx.x; bi < 256 + 256 + 512 + 512; bi += gridDim.x) {
        f32x4 H[4]; float cumtot = 0.f;
#pragma unroll
        for (int kt = 0; kt < 4; ++kt) H[kt] = (f32x4){0.f, 0.f, 0.f, 0.f};
        if (bi < 256) {
            const int item = 2 * bi + (wave >> 2), sl = wave & 3, cc = item & 7, seq = item >> 3, b = seq >> 3, hh = seq & 7;
#pragma unroll 2
            for (int j = 0; j < cc; ++j) {
                const float* Lj = (const float*)(A.ws + OFF_RLT) + (size_t)(seq * 7 + j) * 8192; const float* Tj = Lj + 4096;
                const bf16x8 hb0 = hfrag(H[0], H[1]), hb1 = hfrag(H[2], H[3]);
#pragma unroll
                for (int kt = 0; kt < 4; ++kt) {
                    f32x4 acc;
#pragma unroll
                    for (int i = 0; i < 4; ++i) acc[i] = Lj[(16 * kt + 4 * q + i) * 64 + 16 * sl + l15];
                    const float* tr = Tj + (16 * kt + l15) * 64 + 4 * q;
                    const f32x4 t0 = *(const f32x4*)tr, t1 = *(const f32x4*)(tr + 16), t2 = *(const f32x4*)(tr + 32), t3 = *(const f32x4*)(tr + 48);
                    acc = MFMA32(hfrag(t0, t1), hb0, acc); acc = MFMA32(hfrag(t2, t3), hb1, acc);
                    H[kt] = acc;
                }
            }
            scan_block<false, 4>(A, lds + (wave >> 2) * GL_BYTES, lane, wave & 3, b * 2048 + cc * 256, 16, 16, cc == 0 ? 1 : 0, 0, hh, sl, true, true, H, cumtot);
            if (cc == 7) { float* o = A.out + OUT_WKV_P + (((size_t)b * 8 + hh) * 64 + 16 * sl + l15) * 64 + 4 * q;
#pragma unroll
                for (int kt = 0; kt < 4; ++kt) *(f32x4*)(o + 16 * kt) = H[kt]; }
        } else if (bi < 512) {
            const int item = bi - 256, sl = wave, cc = item & 7, seq = item >> 3, b = seq >> 2, hh = seq & 3;
#pragma unroll 2
            for (int j = 0; j < cc; ++j) {
                const float* Lj = (const float*)(A.ws + OFF_GL) + (size_t)(seq * 7 + j) * 8192; const float* Gj = (const float*)(A.ws + OFF_GG) + (seq * 7 + j) * 64;
#pragma unroll
                for (int kt = 0; kt < 4; ++kt)
#pragma unroll
                    for (int i = 0; i < 4; ++i) H[kt][i] = Gj[16 * kt + 4 * q + i] * H[kt][i] + Lj[(16 * kt + 4 * q + i) * 128 + 16 * sl + l15];
            }
            scan_block<true, 8>(A, lds, lane, wave, b * 2048 + cc * 256, 16, 16, 0, 0, hh, sl, true, true, H, cumtot);
            if (cc == 7) { float* o = A.out + OUT_GLA_P + (((size_t)b * 4 + hh) * 64) * 128 + 16 * sl + l15;
#pragma unroll
                for (int kt = 0; kt < 4; ++kt)
#pragma unroll
                    for (int i = 0; i < 4; ++i) o[(size_t)(16 * kt + 4 * q + i) * 128] = H[kt][i]; }
        } else if (bi < 1024) {
            if (gridDim.x != 256) rwkv_sample_iter(A, lds, wave, lane, bi - 512);
        } else {
            const int item = bi - 1024, sl = wave, hh = item & 3, b = item >> 2;
            const float* st = A.in[IN_ST_GLA] + (((size_t)b * 4 + hh) * 64) * 128 + 16 * sl + l15;
#pragma unroll
            for (int kt = 0; kt < 4; ++kt)
#pragma unroll
                for (int i = 0; i < 4; ++i) H[kt][i] = st[(size_t)(16 * kt + 4 * q + i) * 128];
            scan_block<true, 8>(A, lds, lane, wave, MP + b * 8, 1, 8, 0, b, hh, sl, true, true, H, cumtot);
            float* o = A.out + OUT_GLA_S + (((size_t)b * 4 + hh) * 64) * 128 + 16 * sl + l15;
#pragma unroll
            for (int kt = 0; kt < 4; ++kt)
#pragma unroll
                for (int i = 0; i < 4; ++i) o[(size_t)(16 * kt + 4 * q + i) * 128] = H[kt][i];
        }
    }
}
__device__ __forceinline__ void p2c_mix(const Args& A, int r, int col0, u32x4 rcur, u32x4 rprev, float (&xs)[8]) {
    float cur[8], prev[8]; unpack8(rcur, cur);
    const bool first = (r < MP) ? ((r & 2047) == 0) : (((r - MP) & 7) == 0);
    if (!first) unpack8(rprev, prev);
    else if (r < MP) {
#pragma unroll
        for (int i = 0; i < 8; ++i) prev[i] = 0.f;
    } else ld8f(A.in[IN_ST_SHIFT] + (size_t)((r - MP) >> 3) * 1792 + col0, prev);
    float mu[8]; ld8f(A.in[IN_MU] + col0, mu);
#pragma unroll
    for (int i = 0; i < 8; ++i) xs[i] = cur[i] + (prev[i] - cur[i]) * mu[i];
}
__device__ __forceinline__ void p2c_post(const Args& A, int gw, int NGW, int lane, bool shadow) {
    const bf16_t* PRW = (const bf16_t*)(A.ws + OFF_PRW); const bf16_t* PGLA = (const bf16_t*)(A.ws + OFF_PGLA);
    const bf16_t *AARR = (const bf16_t*)((unsigned char*)A.out + OUTB_AARR), *G = (const bf16_t*)(A.ws + OFF_G);
    bf16_t *ORW = (bf16_t*)((unsigned char*)A.out + OUTB_ORW), *OGL = (bf16_t*)((unsigned char*)A.out + OUTB_OGL);
    const int c0 = 8 * lane;
    for (int rb = gw; rb < M; rb += 2 * NGW) {
        u32x4 raw[2][11];
#pragma unroll
        for (int k = 0; k < 2; ++k) { const int r = (rb + k * NGW < M) ? rb + k * NGW : rb; const int rp = r > 0 ? r - 1 : 0;
            raw[k][0] = *(const u32x4*)(ORW + (size_t)r * 512 + c0); raw[k][1] = *(const u32x4*)(OGL + (size_t)r * 512 + c0);
            raw[k][2] = *(const u32x4*)(PRW + (size_t)r * NPRW + c0); raw[k][3] = *(const u32x4*)(PRW + (size_t)r * NPRW + 512 + c0); raw[k][4] = *(const u32x4*)(PRW + (size_t)r * NPRW + 1024 + c0);
            raw[k][5] = *(const u32x4*)(PRW + (size_t)rp * NPRW + c0); raw[k][6] = *(const u32x4*)(PRW + (size_t)rp * NPRW + 512 + c0); raw[k][7] = *(const u32x4*)(PRW + (size_t)rp * NPRW + 1024 + c0);
            raw[k][8] = *(const u32x4*)(AARR + (size_t)r * 512 + c0); raw[k][9] = *(const u32x4*)(G + (size_t)r * 512 + c0); raw[k][10] = *(const u32x4*)(PGLA + (size_t)r * NPGLA + 1040 + c0); }
#pragma unroll
        for (int k = 0; k < 2; ++k) { const int r = rb + k * NGW; if (r < M) {
            float o[8], d[8], xr[8], xk[8], xv[8], a[8], g[8], p[8], res[8];
            unpack8(raw[k][0], o);
            float s1 = 0.f;
#pragma unroll
            for (int i = 0; i < 8; ++i) s1 += o[i];
            const float mu = row8_allsum(s1) * (1.f / 64.f); float s2 = 0.f;
#pragma unroll
            for (int i = 0; i < 8; ++i) { d[i] = o[i] - mu; s2 += d[i] * d[i]; }
            const float rstd = rsqrtf(row8_allsum(s2) * (1.f / 64.f) + 64e-5f);
            p2c_mix(A, r, c0, raw[k][2], raw[k][5], xr); p2c_mix(A, r, 512 + c0, raw[k][3], raw[k][6], xk); p2c_mix(A, r, 1024 + c0, raw[k][4], raw[k][7], xv);
            unpack8(raw[k][8], a); unpack8(raw[k][9], g);
            float bs = 0.f; ld8f(A.in[IN_KA] + c0, p);
#pragma unroll
            for (int i = 0; i < 8; ++i) d[i] *= rstd, xk[i] = xk[i] * (1.f + (a[i] - 1.f) * p[i]);
            ld8f(A.in[IN_RK] + c0, p);
#pragma unroll
            for (int i = 0; i < 8; ++i) bs += xr[i] * xk[i] * p[i];
            bs = row8_allsum(bs);
            ld8f(A.in[IN_LNW] + c0, p); ld8f(A.in[IN_LNB] + c0, a);
#pragma unroll
            for (int i = 0; i < 8; ++i) res[i] = ((d[i] * p[i] + a[i]) + bs * xv[i]) * g[i];
            if (!shadow) *(u32x4*)(ORW + (size_t)r * 512 + c0) = pack8(res); else *(u32x4*)((bf16_t*)(A.ws + 240 * MiB) + (size_t)(r & 8191) * 512 + c0) = pack8(res);
            unpack8(raw[k][1], o);
            float ms = 0.f;
#pragma unroll
            for (int i = 0; i < 8; ++i) ms += o[i] * o[i];
            const float rs = rsqrtf(row16_allsum(ms) * (1.f / 128.f) + NORM_EPS);
            unpack8(raw[k][10], g); ld8f(A.in[IN_GNW] + (c0 & 127), p);
#pragma unroll
            for (int i = 0; i < 8; ++i) res[i] = o[i] * rs * p[i] * (g[i] * fsigmoid(g[i]));
            if (!shadow) *(u32x4*)(OGL + (size_t)r * 512 + c0) = pack8(res); else *(u32x4*)((bf16_t*)(A.ws + 248 * MiB) + (size_t)(r & 8191) * 512 + c0) = pack8(res);
        } }
    }
}
__device__ __forceinline__ void p6_act(const Args& A, int gtid, int NGT) {
    bf16_t* U = (bf16_t*)(A.ws + OFF_U); const bf16_t* UH = (const bf16_t*)(A.ws + OFF_UH);
    const float *convw = A.in[IN_CONVW], *convb = A.in[IN_CONVB], *cstate = A.in[IN_ST_CONV];
    for (int item = gtid; item < (M / 64) * 352; item += NGT) {
        const int rb = item / 352, jc = (item - rb * 352) * 8, r0 = rb * 64; const bool sample = r0 >= MP;
        float p1v[8], p2v[8], p1g[8], p2g[8], w0v[8], w1v[8], w2v[8], cbv[8], w0g[8], w1g[8], w2g[8], cbg[8];
        ld8f(convw + jc, w0v); ld8f(convw + F2 + jc, w1v); ld8f(convw + 2 * F2 + jc, w2v); ld8f(convb + jc, cbv);
        ld8f(convw + FF + jc, w0g); ld8f(convw + F2 + FF + jc, w1g); ld8f(convw + 2 * F2 + FF + jc, w2g); ld8f(convb + FF + jc, cbg);
#pragma unroll
        for (int i = 0; i < 8; ++i) p1v[i] = p2v[i] = p1g[i] = p2g[i] = 0.f;
        if (!sample && (rb & 31) != 0) { const bf16_t* q = UH + (size_t)(rb - 1) * 2 * F2; ld8bf(q + jc, p2v); ld8bf(q + FF + jc, p2g); ld8bf(q + F2 + jc, p1v); ld8bf(q + F2 + FF + jc, p1g); }
        for (int r8 = 0; r8 < 64; r8 += 8) {
            u32x4 rawv[8], rawg[8];
#pragma unroll
            for (int k = 0; k < 8; ++k) { const bf16_t* row = U + (size_t)(r0 + r8 + k) * F2; rawv[k] = *(const u32x4*)(row + jc); rawg[k] = *(const u32x4*)(row + FF + jc); }
            if (sample) { const float* st = cstate + (size_t)((r0 + r8 - MP) >> 3) * 2 * F2; ld8f(st + jc, p2v); ld8f(st + FF + jc, p2g); ld8f(st + F2 + jc, p1v); ld8f(st + F2 + FF + jc, p1g); }
#pragma unroll
            for (int k = 0; k < 8; ++k) {
                float cv[8], cg[8], res[8]; unpack8(rawv[k], cv); unpack8(rawg[k], cg);
#pragma unroll
                for (int i = 0; i < 8; ++i) { const float v = cbv[i] + w0v[i] * p2v[i] + w1v[i] * p1v[i] + w2v[i] * cv[i], gg = cbg[i] + w0g[i] * p2g[i] + w1g[i] * p1g[i] + w2g[i] * cg[i];
                    res[i] = gelu_gate(gg, v); p2v[i] = p1v[i]; p1v[i] = cv[i]; p2g[i] = p1g[i]; p1g[i] = cg[i]; }
                *(u32x4*)(U + (size_t)(r0 + r8 + k) * F2 + jc) = pack8(res);
            }
        }
    }
}
__device__ __forceinline__ void pfix_act(const Args& A, int gtid, int NGT) {
    const bf16_t* UH = (const bf16_t*)(A.ws + OFF_UH); const bf16_t* US = (const bf16_t*)(A.ws + OFF_US); bf16_t* ACT = (bf16_t*)(A.ws + OFF_ACT);
    const float *convw = A.in[IN_CONVW], *convb = A.in[IN_CONVB], *cstate = A.in[IN_ST_CONV];
    for (int idx = gtid; idx < (256 + 128) * 2 * 352; idx += NGT) {
        const int g = idx / 704, rem = idx - g * 704, rsel = rem / 352, jc = (rem - rsel * 352) * 8;
        float cv[8], cg[8], p1v[8], p1g[8], p2v[8], p2g[8], res[8]; int orow;
#pragma unroll
        for (int i = 0; i < 8; ++i) p1v[i] = p1g[i] = p2v[i] = p2g[i] = 0.f;
        if (g < 256) {
            const bool seq0 = (g & 31) == 0; orow = 64 * g + rsel;
            ld8bf(UH + ((size_t)g * 4 + rsel) * F2 + jc, cv); ld8bf(UH + ((size_t)g * 4 + rsel) * F2 + FF + jc, cg);
            if (rsel == 0) { if (!seq0) { const bf16_t* q = UH + ((size_t)(g - 1) * 4 + 3) * F2; ld8bf(q + jc, p1v); ld8bf(q + FF + jc, p1g); q -= F2; ld8bf(q + jc, p2v); ld8bf(q + FF + jc, p2g); } }
            else { const bf16_t* q = UH + ((size_t)g * 4) * F2; ld8bf(q + jc, p1v); ld8bf(q + FF + jc, p1g);
                if (!seq0) { q = UH + ((size_t)(g - 1) * 4 + 3) * F2; ld8bf(q + jc, p2v); ld8bf(q + FF + jc, p2g); } }
        } else {
            const int sb = g - 256; orow = MP + 8 * sb + rsel; const float* st = cstate + (size_t)sb * 2 * F2;
            ld8bf(US + ((size_t)sb * 2 + rsel) * F2 + jc, cv); ld8bf(US + ((size_t)sb * 2 + rsel) * F2 + FF + jc, cg);
            if (rsel == 0) { ld8f(st + jc, p2v); ld8f(st + FF + jc, p2g); ld8f(st + F2 + jc, p1v); ld8f(st + F2 + FF + jc, p1g); }
            else { ld8f(st + F2 + jc, p2v); ld8f(st + F2 + FF + jc, p2g); ld8bf(US + ((size_t)sb * 2) * F2 + jc, p1v); ld8bf(US + ((size_t)sb * 2) * F2 + FF + jc, p1g); }
        }
#pragma unroll
        for (int i = 0; i < 8; ++i) { const int col = jc + i;
            const float v = convb[col] + convw[col] * p2v[i] + convw[F2 + col] * p1v[i] + convw[2 * F2 + col] * cv[i];
            const float gg = convb[FF + col] + convw[FF + col] * p2g[i] + convw[F2 + FF + col] * p1g[i] + convw[2 * F2 + FF + col] * cg[i];
            res[i] = gelu_gate(gg, v); }
        *(u32x4*)(ACT + (size_t)orow * FF + jc) = pack8(res);
    }
}
__device__ __forceinline__ void p8_final(const Args& A, int gw, int NGW, int lane, float* dst) {
    const float* gf = A.in[IN_NORM_FINAL];
    for (int m = gw; m < M; m += 2 * NGW) {
        const int m2 = m + NGW; const bool has2 = m2 < M;
        const f32x4* xr = (const f32x4*)(A.out + (size_t)m * DM) + lane; const f32x4* xr2 = (const f32x4*)(A.out + (size_t)(has2 ? m2 : m) * DM) + lane; f32x4 v[4], w[4]; float s = 0.f, s2 = 0.f;
#pragma unroll
        for (int j = 0; j < 4; ++j) { v[j] = xr[64 * j]; w[j] = xr2[64 * j]; }
#pragma unroll
        for (int j = 0; j < 4; ++j) { s += (v[j].x * v[j].x + v[j].y * v[j].y) + (v[j].z * v[j].z + v[j].w * v[j].w); s2 += (w[j].x * w[j].x + w[j].y * w[j].y) + (w[j].z * w[j].z + w[j].w * w[j].w); }
        const float rstd = rsqrtf(wave_allsum(s) * (1.f / DM) + NORM_EPS), rstd2 = rsqrtf(wave_allsum(s2) * (1.f / DM) + NORM_EPS);
#pragma unroll
        for (int j = 0; j < 4; ++j) { const f32x4 g = *((const f32x4*)gf + lane + 64 * j); ((f32x4*)(dst + (size_t)m * DM) + lane)[64 * j] = v[j] * rstd * g; if (has2) ((f32x4*)(dst + (size_t)m2 * DM) + lane)[64 * j] = w[j] * rstd2 * g; }
    }
}

#ifndef PHMASK
#define PHMASK 0xFFFF
#endif
#ifndef PHREP
#define PHREP 0
#endif
#define PH(k) for (int rep_ = 0; rep_ < ((((PHMASK) >> (k)) & 1) ? ((((PHREP) >> (k)) & 1) ? 2 : 1) : 0); ++rep_)
__global__ void __launch_bounds__(NTHREADS, 2) fwd_megakernel(Args A) {
    extern __shared__ __attribute__((aligned(16))) unsigned char lds_raw[];
    LAS unsigned char* lds = (LAS unsigned char*)lds_raw;
    cg::grid_group grid = cg::this_grid();
    const int tid = threadIdx.x, lane = tid & 63, wave = __builtin_amdgcn_readfirstlane(tid >> 6);
    const int G = gridDim.x, gw = blockIdx.x * NWAVES + wave, NGW = G * NWAVES;
    unsigned char* ws = A.ws;
    if (tid < 4) ((LAS unsigned*)(lds + 131072))[tid] = 0u;
    __syncthreads();
    const XcdBarrier xbar = xcd_barrier_post((unsigned*)(ws + OFF_BAR), (volatile LAS unsigned*)(lds + 131072));
#define GSYNC() xcd_barrier(xbar)
    PH(0) p0_prologue(A, lds, gw, NGW, wave, lane);
    if (A.ws == nullptr) grid.sync();
    GSYNC();
    PH(1) { pg8::Gemm g{(const bf16_t*)((unsigned char*)A.out + OUTB_H), (const bf16_t*)(ws + OFF_WIN), M, NIN, 1024, 1024}; pg8::StaticOrder S; S.init(M, NIN, G, (int)blockIdx.x);
      EpiProj E{(bf16_t*)(ws + OFF_PRW), (bf16_t*)(ws + OFF_PGLA), (bf16_t*)(ws + OFF_PGATE), A.out + OUT_SHIFT_P, A.out + OUT_SHIFT_S};
      pg8::gemm_phase<EpiProj, pg8::StaticOrder, true, true>(lds, g, S, E); }
    GSYNC();
    PH(2) p2a_lora(A, lds, gw, NGW, wave, lane);
    PH(2) { for (int ig = (int)gridDim.x - 1 - (int)blockIdx.x; ig < 224; ig += (int)gridDim.x) { const int seq = ig / 7, cc = ig - seq * 7; gla_pass1_item(A, lds, wave, lane, seq >> 2, seq & 3, cc, ig); }
      __syncthreads(); }
    GSYNC();
    PH(3) p2x_scan1(A, lds, wave, lane);
    GSYNC();
    PH(11) p2y_scan2(A, lds, wave, lane);
    GSYNC();
#ifdef SHADOW_P2C
    p2c_post(A, gw, NGW, lane, true);
#endif
    PH(4) p2c_post(A, gw, NGW, lane, false);
    GSYNC();
    PH(5) { pg8::StaticOrder S; S.init(M, 1024, G, (int)blockIdx.x); S.limit = __builtin_amdgcn_readfirstlane((S.nwg / G) * G);
      { pg8::Gemm g{(const bf16_t*)((unsigned char*)A.out + OUTB_ORW), (const bf16_t*)(ws + OFF_WOA), M, 1024, 512, 512};
        EpiGate<true> E{(bf16_t*)(ws + OFF_MERGED), (const bf16_t*)(ws + OFF_PGATE)};
        pg8::gemm_phase<EpiGate<true>, pg8::StaticOrder, true, true>(lds, g, S, E);
        tail_gemm(lds, (const bf16_t*)((unsigned char*)A.out + OUTB_ORW), 512, (const bf16_t*)(ws + OFF_WOA), 512, S, wave, lane, TfGate{true, (bf16_t*)(ws + OFF_MERGED), (const bf16_t*)(ws + OFF_PGATE)}); }
      { pg8::Gemm g{(const bf16_t*)((unsigned char*)A.out + OUTB_OGL), (const bf16_t*)(ws + OFF_WOB), M, 1024, 512, 512};
        EpiGate<false> E{(bf16_t*)(ws + OFF_MERGED), (const bf16_t*)(ws + OFF_PGATE) + 1024};
        pg8::gemm_phase<EpiGate<false>, pg8::StaticOrder, true, true>(lds, g, S, E);
        tail_gemm(lds, (const bf16_t*)((unsigned char*)A.out + OUTB_OGL), 512, (const bf16_t*)(ws + OFF_WOB), 512, S, wave, lane, TfGate{false, (bf16_t*)(ws + OFF_MERGED), (const bf16_t*)(ws + OFF_PGATE) + 1024}); } }
    GSYNC();
    PH(6) { pg8::Gemm g{(const bf16_t*)(ws + OFF_MERGED), (const bf16_t*)(ws + OFF_WO), M, 1024, 1024, 1024}; pg8::StaticOrder S; S.init(M, 1024, G, (int)blockIdx.x); S.limit = __builtin_amdgcn_readfirstlane((S.nwg / G) * G);
#ifdef SHADOW_G3
      float* rss = (rep_ == 0) ? (float*)(ws + OFF_ROWSS + 256 * 1024) : (float*)(ws + OFF_ROWSS);
#else
      float* rss = (float*)(ws + OFF_ROWSS);
#endif
      EpiX1 E{A.in[IN_XP], A.in[IN_XS], A.out, (bf16_t*)(ws + OFF_X1B), rss};
      pg8::gemm_phase<EpiX1, pg8::StaticOrder, true, true>(lds, g, S, E);
      tail_gemm(lds, (const bf16_t*)(ws + OFF_MERGED), 1024, (const bf16_t*)(ws + OFF_WO), 1024, S, wave, lane, TfX1{A.in[IN_XP], A.in[IN_XS], A.out, (bf16_t*)(ws + OFF_X1B), rss}); }
    GSYNC();
    PH(7) { pg8::Gemm g{(const bf16_t*)(ws + OFF_X1B), (const bf16_t*)(ws + OFF_WUP), M, F2, 1024, 1024}; pg8::StaticOrder S; S.init(M, F2, G, (int)blockIdx.x);
      EpiAct E{(const float*)(ws + OFF_ROWSS), A.in[IN_CONVW], A.in[IN_CONVB], (bf16_t*)(ws + OFF_ACT), (bf16_t*)(ws + OFF_UH), (bf16_t*)(ws + OFF_US), A.out + OUT_CONV_P, A.out + OUT_CONV_S, (LAS float*)(lds + 131072)};
      pg8::gemm_phase<EpiAct, pg8::StaticOrder, true, true>(lds, g, S, E); }
    __syncthreads(); if (tid < 4) ((LAS unsigned*)(lds + 131072))[tid] = 0u; __syncthreads();
    GSYNC();
    PH(8) pfix_act(A, blockIdx.x * NTHREADS + tid, G * NTHREADS);
    GSYNC();
    PH(9) { pg8::Gemm g{(const bf16_t*)(ws + OFF_ACT), (const bf16_t*)(ws + OFF_WDN), M, 1024, FF, FF}; pg8::StaticOrder S; S.init(M, 1024, G, (int)blockIdx.x); S.limit = __builtin_amdgcn_readfirstlane((S.nwg / G) * G);
#ifdef SHADOW_G5
      float* xd = (rep_ == 0) ? (float*)(ws + 129 * MiB) : A.out;
#else
      float* xd = A.out;
#endif
      EpiX2 E{(const bf16_t*)(ws + OFF_X1B), xd};
      pg8::gemm_phase<EpiX2, pg8::StaticOrder, true, true>(lds, g, S, E);
      tail_gemm(lds, (const bf16_t*)(ws + OFF_ACT), FF, (const bf16_t*)(ws + OFF_WDN), FF, S, wave, lane, TfX2{(const bf16_t*)(ws + OFF_X1B), xd}); }
    GSYNC();
#ifdef P8_SHADOW
    p8_final(A, gw, NGW, lane, (float*)(ws + OFF_U));
#endif
    PH(10) p8_final(A, gw, NGW, lane, A.out);
#ifdef EXTRA_SYNCS
    for (int i_ = 0; i_ < EXTRA_SYNCS; ++i_) GSYNC();
#endif
}

extern "C" void kernel_launch(void* const* d_in, const int* in_sizes, int n_in, void* d_out, int out_size, void* d_ws, size_t ws_size, hipStream_t stream) {
    static int grid = 0;
    if (grid == 0) {
        int dev = 0, cus = 0, per_cu = 0;
        if (n_in != 31 || ws_size < 256 * MiB) { fprintf(stderr, "kernel_launch: unexpected n_in %d / ws_size %zu\n", n_in, ws_size); grid = -1; return; }
        (void)hipGetDevice(&dev); (void)hipDeviceGetAttribute(&cus, hipDeviceAttributeMultiprocessorCount, dev);
        if (hipFuncSetAttribute((const void*)fwd_megakernel, hipFuncAttributeMaxDynamicSharedMemorySize, LDS_BYTES) != hipSuccess) { fprintf(stderr, "kernel_launch: hipFuncSetAttribute failed\n"); grid = -1; return; }
        if (hipOccupancyMaxActiveBlocksPerMultiprocessor(&per_cu, (const void*)fwd_megakernel, NTHREADS, LDS_BYTES) != hipSuccess || per_cu < 1) { fprintf(stderr, "kernel_launch: occupancy query failed (%d)\n", per_cu); (void)hipGetLastError(); grid = -1; return; }
        grid = cus * 1;
    }
    if (grid < 0) return;
    Args a{};
    for (int i = 0; i < 31; ++i) a.in[i] = (const float*)d_in[i];
    a.out = (float*)d_out; a.ws = (unsigned char*)d_ws;
    if (hipMemsetAsync((char*)d_ws + OFF_BAR, 0, XCD_BAR_WORDS * 4, stream) != hipSuccess) { fprintf(stderr, "kernel_launch: memset of the barrier words failed\n"); return; }
    void* params[] = {&a};
    hipError_t e = hipLaunchCooperativeKernel((const void*)fwd_megakernel, dim3(grid), dim3(NTHREADS), params, LDS_BYTES, stream);
    if (e != hipSuccess) fprintf(stderr, "kernel_launch: cooperative launch failed: %s (grid %d)\n", hipGetErrorString(e), grid);
}
```

```cpp
#include <hip/hip_runtime.h>
#include <hip/hip_cooperative_groups.h>
#include <cstdio>
#include <cstdint>
namespace cg = cooperative_groups;
#define PHREP 0
namespace pg8 {
#define PG8_LAS __attribute__((address_space(3)))
typedef unsigned short bf16_t;
typedef short bf16x8 __attribute__((ext_vector_type(8)));
typedef float f32x4 __attribute__((ext_vector_type(4)));
typedef unsigned u32x4 __attribute__((ext_vector_type(4)));
constexpr int BM = 256, BK = 64, HALF = 128, HTB = HALF * BK * 2  , STAGE_BYTES = 8 * HTB, NXCD = 8, WGM = 8;

__host__ __device__ __forceinline__ int lds_byte(int r, int c) { const int st = (r >> 4) * 2 + (c >> 5), rr = r & 15, cc = c & 31, ob = rr * 64 + cc * 2; return st * 1024 + (ob ^ (((ob >> 9) & 1) << 5)); }
__host__ __device__ __forceinline__ void stage_rc(int b, int& R, int& C) { const int st = b / 1024, sb = b % 1024, swz = sb ^ (((sb >> 9) & 1) << 5); R = (st >> 1) * 16 + swz / 64; C = (st & 1) * 32 + (swz % 64) / 2; }
__host__ __device__ __forceinline__ int perm32(int rho) { const int n = rho >> 4, i = rho & 15; return 8 * (i >> 2) + 4 * n + (i & 3); }

struct Unit { int pm, pn; };
struct Gemm { const bf16_t* A; const bf16_t* Bt; int M, N, K, lda; };

struct StaticOrder {
    int nM, nN, nwg, G, c;
    int limit;
    __host__ __device__ void init(int M, int N, int G_, int c_) { nM = M / BM; nN = N / BM; nwg = nM * nN; G = G_; c = c_; limit = nwg; }
    __host__ __device__ __forceinline__ bool next(int i, Unit& u) const {
        const int L = i * G + c; if (L >= limit) return false;
        unit_of(L, u); return true;
    }
    __host__ __device__ __forceinline__ void unit_of(int L, Unit& u) const {
        int wgid = L; { const int q = nwg / NXCD, r = nwg % NXCD, xcd = wgid % NXCD, off = wgid / NXCD; wgid = (xcd < r ? xcd * (q + 1) : r * (q + 1) + (xcd - r) * q) + off; }
        const int nig = WGM * nN, gid = wgid / nig, fm = gid * WGM, gsz = (nM - fm) < WGM ? (nM - fm) : WGM;
        u.pm = fm + ((wgid % nig) % gsz); u.pn = (wgid % nig) / gsz;
    }
    __device__ __forceinline__ void a_ready(const Unit&) const {}
    __device__ __forceinline__ void done(const Unit&) const {}
};
__device__ __forceinline__ unsigned cvt_pk_bf16(float lo, float hi) { unsigned r; asm volatile("v_cvt_pk_bf16_f32 %0, %1, %2" : "=v"(r) : "v"(lo), "v"(hi)); return r; }
typedef float f32x2 __attribute__((ext_vector_type(2)));
template <class Epi, class Sched, bool ALIGN_EPI = false, bool SP2 = false>
__device__ __forceinline__ void gemm_phase(PG8_LAS unsigned char* lds, const Gemm g, const Sched& S, const Epi& E) {
    int tid_ = threadIdx.x; asm volatile("" : "+v"(tid_));
    const int tid = tid_, wid = __builtin_amdgcn_readfirstlane(tid >> 6), lane = tid & 63, wr = wid >> 2, wc = wid & 3, fr = lane & 15, fq = lane >> 4;
    const int K = g.K, nt = K / BK;
    unsigned voffA[2], voffB[2];
#pragma unroll
    for (int i = 0; i < 2; ++i) { int R, C; stage_rc(tid * 16 + i * 8192, R, C); const int Rb = Epi::PERM ? ((R & ~31) + perm32(R & 31)) : R;
        voffA[i] = (unsigned)(R * g.lda + C) * 2u; voffB[i] = (unsigned)(Rb * K + C) * 2u; }
    const size_t kstep = (size_t)(BK * 2);
    const size_t hstep = (size_t)HALF * K * 2;
    const size_t tstep = 2 * hstep;
    const size_t hstepA = (size_t)HALF * g.lda * 2, tstepA = 2 * hstepA;
    const unsigned ldsw = (unsigned)wid * 1024u;
    const int aoff = lds_byte(wr * 64 + fr, fq * 8), boff = lds_byte(wc * 32 + fr, fq * 8);
#define PG8_SA(b, h) (((b) * 2 + (h)) * HTB)
#define PG8_SB(b, h) ((4 + (b) * 2 + (h)) * HTB)
#define PG8_STAGE(bufoff, gbase, voff) do { _Pragma("unroll") for (int _i = 0; _i < 2; ++_i) \
        __builtin_amdgcn_global_load_lds((const unsigned*)((const char*)(gbase) + (voff)[_i]), (PG8_LAS unsigned*)(lds + (bufoff) + ldsw + _i * 8192), 16, 0, 0); } while (0)
#define PG8_LDA(dst, b, h) do { _Pragma("unroll") for (int m = 0; m < 4; ++m) _Pragma("unroll") for (int k = 0; k < 2; ++k) dst[m][k] = *(const PG8_LAS bf16x8*)(lds + PG8_SA(b, h) + aoff + m * 2048 + k * 1024); } while (0)
#define PG8_LDB(dst, b, h) do { _Pragma("unroll") for (int n = 0; n < 2; ++n) _Pragma("unroll") for (int k = 0; k < 2; ++k) dst[n][k] = *(const PG8_LAS bf16x8*)(lds + PG8_SB(b, h) + boff + n * 2048 + k * 1024); } while (0)
#define PG8_MMA(ai, bj, At, Bt) do { __builtin_amdgcn_s_setprio(1); _Pragma("unroll") for (int m = 0; m < 4; ++m) _Pragma("unroll") for (int n = 0; n < 2; ++n) _Pragma("unroll") for (int k = 0; k < 2; ++k) \
        acc[ai][bj][m][n] = __builtin_amdgcn_mfma_f32_16x16x32_bf16(Bt[n][k], At[m][k], acc[ai][bj][m][n], 0, 0, 0); __builtin_amdgcn_s_setprio(0); } while (0)
#define PG8_WAIT_V(n) asm volatile("s_waitcnt vmcnt(" #n ")" ::: "memory")
#define PG8_WAIT_L(n) asm volatile("s_waitcnt lgkmcnt(" #n ")" ::: "memory")
#define PG8_BAR __builtin_amdgcn_s_barrier()
#define PG8_SCHED __builtin_amdgcn_sched_barrier(0)
    Unit cur, nxt; int ui = 0;
    if (!S.next(0, cur)) return;
    f32x4 acc[2][2][4][2];
#pragma unroll
    for (int a = 0; a < 2; ++a)
#pragma unroll
        for (int b = 0; b < 2; ++b)
#pragma unroll
            for (int m = 0; m < 4; ++m)
#pragma unroll
                for (int n = 0; n < 2; ++n) acc[a][b][m][n] = (f32x4){0.f, 0.f, 0.f, 0.f};
    bf16x8 At[4][2], B0[2][2], B1[2][2];
    const char* cA = (const char*)g.A + (size_t)cur.pm * tstepA; const char* cB = (const char*)g.Bt + (size_t)cur.pn * tstep;
    S.a_ready(cur);
    if constexpr (SP2) {
        PG8_STAGE(PG8_SB(0, 0), cB, voffB); PG8_STAGE(PG8_SB(0, 1), cB + hstep, voffB); PG8_STAGE(PG8_SA(0, 0), cA, voffA); PG8_STAGE(PG8_SA(0, 1), cA + hstepA, voffA);
        if (wr == 1) PG8_BAR;
        PG8_WAIT_V(2); PG8_BAR;
        PG8_STAGE(PG8_SB(1, 0), cB + kstep, voffB); PG8_STAGE(PG8_SA(1, 0), cA + kstep, voffA); PG8_STAGE(PG8_SB(1, 1), cB + hstep + kstep, voffB);
        PG8_WAIT_V(6); PG8_BAR;
    } else {
        PG8_STAGE(PG8_SB(0, 0), cB, voffB); PG8_STAGE(PG8_SA(0, 0), cA, voffA); PG8_STAGE(PG8_SB(0, 1), cB + hstep, voffB); PG8_STAGE(PG8_SA(0, 1), cA + hstepA, voffA);
        if (wr == 1) PG8_BAR;
        PG8_WAIT_V(4); PG8_BAR;
        PG8_STAGE(PG8_SB(1, 0), cB + kstep, voffB); PG8_STAGE(PG8_SA(1, 0), cA + kstep, voffA); PG8_STAGE(PG8_SB(1, 1), cB + hstep + kstep, voffB);
        PG8_WAIT_V(6); PG8_BAR;
    }
    for (;;) {
        const bool has_next = S.next(ui + 1, nxt);
        const char* nA = has_next ? (const char*)g.A + (size_t)nxt.pm * tstepA : cA; const char* nB = has_next ? (const char*)g.Bt + (size_t)nxt.pn * tstep : cB;
        for (int t = 0; t < nt; t += 2) {
            const bool last = (t == nt - 2);
            const char* a1 = cA + (size_t)(t + 1) * kstep;
            const char* a2 = last ? nA : cA + (size_t)(t + 2) * kstep; const char* b2 = last ? nB : cB + (size_t)(t + 2) * kstep;
            const char* a3 = a2 + kstep; const char* b3 = b2 + kstep;
            if (last && has_next) S.a_ready(nxt);
            if constexpr (SP2) {
            PG8_LDB(B0, 0, 0); PG8_LDB(B1, 0, 1); PG8_SCHED; PG8_LDA(At, 0, 0); PG8_STAGE(PG8_SA(1, 1), a1 + hstepA, voffA);
            PG8_WAIT_V(8); PG8_WAIT_L(0); PG8_BAR; PG8_MMA(0, 0, At, B0); PG8_MMA(0, 1, At, B1); PG8_BAR; PG8_SCHED;
            PG8_LDA(At, 0, 1); PG8_STAGE(PG8_SB(0, 0), b2, voffB); PG8_STAGE(PG8_SB(0, 1), b2 + hstep, voffB); PG8_STAGE(PG8_SA(0, 0), a2, voffA);
            PG8_WAIT_V(8); PG8_WAIT_L(0); PG8_BAR; PG8_MMA(1, 0, At, B0); PG8_MMA(1, 1, At, B1); PG8_BAR; PG8_SCHED;
            PG8_LDB(B0, 1, 0); PG8_LDB(B1, 1, 1); PG8_SCHED; PG8_LDA(At, 1, 0); PG8_STAGE(PG8_SA(0, 1), a2 + hstepA, voffA);
            PG8_WAIT_V(8); PG8_WAIT_L(0); PG8_BAR; PG8_MMA(0, 0, At, B0); PG8_MMA(0, 1, At, B1); PG8_BAR; PG8_SCHED;
            PG8_LDA(At, 1, 1); PG8_STAGE(PG8_SB(1, 0), b3, voffB); PG8_STAGE(PG8_SB(1, 1), b3 + hstep, voffB); PG8_STAGE(PG8_SA(1, 0), a3, voffA);
            PG8_WAIT_V(8); PG8_WAIT_L(0); PG8_BAR; PG8_MMA(1, 0, At, B0); PG8_MMA(1, 1, At, B1); PG8_BAR; PG8_SCHED;
            } else {
            PG8_LDB(B0, 0, 0); PG8_SCHED; PG8_LDA(At, 0, 0); PG8_STAGE(PG8_SA(1, 1), a1 + hstepA, voffA);
            PG8_WAIT_L(8); PG8_BAR; PG8_WAIT_L(0); PG8_MMA(0, 0, At, B0); PG8_BAR; PG8_SCHED;
            PG8_LDB(B1, 0, 1); PG8_STAGE(PG8_SB(0, 0), b2, voffB);
            PG8_BAR; PG8_WAIT_L(0); PG8_MMA(0, 1, At, B1); PG8_BAR;
            PG8_LDA(At, 0, 1); PG8_STAGE(PG8_SA(0, 0), a2, voffA);
            PG8_BAR; PG8_WAIT_L(0); PG8_MMA(1, 0, At, B0); PG8_BAR; PG8_SCHED;
            PG8_STAGE(PG8_SB(0, 1), b2 + hstep, voffB);
            PG8_WAIT_V(6); PG8_BAR; PG8_MMA(1, 1, At, B1); PG8_BAR;
            PG8_LDB(B0, 1, 0); PG8_SCHED; PG8_LDA(At, 1, 0); PG8_STAGE(PG8_SA(0, 1), a2 + hstepA, voffA);
            PG8_WAIT_L(8); PG8_BAR; PG8_WAIT_L(0); PG8_MMA(0, 0, At, B0); PG8_BAR; PG8_SCHED;
            PG8_LDB(B1, 1, 1); PG8_STAGE(PG8_SB(1, 0), b3, voffB);
            PG8_BAR; PG8_WAIT_L(0); PG8_MMA(0, 1, At, B1); PG8_BAR;
            PG8_LDA(At, 1, 1); PG8_STAGE(PG8_SA(1, 0), a3, voffA);
            PG8_BAR; PG8_WAIT_L(0); PG8_MMA(1, 0, At, B0); PG8_BAR; PG8_SCHED;
            PG8_STAGE(PG8_SB(1, 1), b3 + hstep, voffB);
            PG8_WAIT_V(6); PG8_BAR; PG8_MMA(1, 1, At, B1); PG8_BAR;
            }
        }
        if constexpr (ALIGN_EPI) { if (wr == 0) PG8_BAR; }
        if constexpr (!Epi::AFTER_DRAIN) { E(acc, cur, wr, wc, fr, fq); S.done(cur); }
        if (!has_next) break;
#pragma unroll
        for (int a = 0; a < 2; ++a)
#pragma unroll
            for (int b = 0; b < 2; ++b)
#pragma unroll
                for (int m = 0; m < 4; ++m)
#pragma unroll
                    for (int n = 0; n < 2; ++n) acc[a][b][m][n] = (f32x4){0.f, 0.f, 0.f, 0.f};
        cur = nxt; cA = nA; cB = nB; ++ui;
        if constexpr (ALIGN_EPI) { if (wr == 1) PG8_BAR; }
    }
    PG8_WAIT_V(0);
    if constexpr (!ALIGN_EPI) { if (wr == 0) PG8_BAR; }
    PG8_BAR;
    if constexpr (Epi::AFTER_DRAIN) { E.fused(acc, cur, wr, wc, fr, fq, lds, wid, lane); S.done(cur); }
#undef PG8_SA
#undef PG8_SB
#undef PG8_STAGE
#undef PG8_LDA
#undef PG8_LDB
#undef PG8_MMA
#undef PG8_WAIT_V
#undef PG8_WAIT_L
#undef PG8_BAR
#undef PG8_SCHED
}
}

#define LAS __attribute__((address_space(3)))
typedef unsigned short bf16_t;
typedef short bf16x8 __attribute__((ext_vector_type(8)));
typedef float f32x4 __attribute__((ext_vector_type(4)));
typedef unsigned u32x4 __attribute__((ext_vector_type(4)));
typedef unsigned u32x2 __attribute__((ext_vector_type(2)));
using pg8::Unit;

constexpr int M = 17408, MP = 16384, DM = 1024;
constexpr int NPRW = 1792, NPGLA = 1792, NGATE = 2048, NIN = 5632;
constexpr int FF = 2816, F2 = 5632;
constexpr float NORM_EPS = 1e-6f;
constexpr int NWAVES = 8, NTHREADS = 512;
constexpr int LDS_BYTES = 131072 + 32768;
constexpr size_t OFF_BAR = 512 * 1024;

constexpr size_t MiB = 1u << 20;
constexpr size_t OFF_ROWSS = 0;
constexpr size_t OFF_WIN = 1 * MiB, OFF_WUP = 12 * MiB, OFF_WDN = 23 * MiB, OFF_WO = 29 * MiB, OFF_WOA = 31 * MiB, OFF_WOB = 32 * MiB;
constexpr size_t OFF_W2T = 33 * MiB, OFF_A2T = OFF_W2T + 65536, OFF_G2T = OFF_A2T + 65536;
constexpr size_t OFF_PRW = 35 * MiB, OFF_PGLA = 95 * MiB, OFF_PGATE = 155 * MiB, OFF_G = 223 * MiB;
constexpr size_t OFF_MERGED = OFF_PRW, OFF_UH = OFF_WIN, OFF_X1B = 222 * MiB, OFF_U = OFF_PRW, OFF_ACT = OFF_PRW, OFF_US = 29 * MiB;
static_assert(OFF_PRW + (size_t)M * NPRW * 2 <= OFF_PGLA && OFF_PGLA + (size_t)M * NPGLA * 2 <= OFF_PGATE && OFF_PGATE + (size_t)M * NGATE * 2 <= OFF_G, "ws map");
static_assert(OFF_G + (size_t)M * 512 * 2 <= 256 * MiB && OFF_U + (size_t)M * F2 * 2 <= OFF_X1B && OFF_X1B + (size_t)M * DM * 2 <= 256 * MiB, "ws map");
static_assert(OFF_UH + (size_t)256 * 4 * F2 * 2 <= OFF_WUP && OFF_ACT + (size_t)M * FF * 2 <= OFF_X1B, "ws map");

constexpr size_t OUT_SHIFT_P = (size_t)M * DM, OUT_WKV_P = OUT_SHIFT_P + 8 * 1792, OUT_GLA_P = OUT_WKV_P + 8 * 8 * 64 * 64, OUT_CONV_P = OUT_GLA_P + 8 * 4 * 64 * 128;
constexpr size_t OUT_SHIFT_S = OUT_CONV_P + 8 * 2 * F2, OUT_WKV_S = OUT_SHIFT_S + 128 * 1792, OUT_GLA_S = OUT_WKV_S + (size_t)128 * 8 * 64 * 64, OUT_CONV_S = OUT_GLA_S + (size_t)128 * 4 * 64 * 128;
constexpr size_t OUTB_H = 0, OUTB_EW = 0, OUTB_AARR = (size_t)M * 512 * 2, OUTB_ORW = (size_t)M * 1024 * 2, OUTB_OGL = OUTB_ORW + (size_t)M * 512 * 2;

struct Args { const float* in[31]; float* out; unsigned char* ws; };
#define IN_XP 0
#define IN_XS 1
#define IN_ST_SHIFT 2
#define IN_ST_WKV 3
#define IN_ST_GLA 4
#define IN_ST_CONV 5
#define IN_NORM_MIX 6
#define IN_W_IN 7
#define IN_MU 8
#define IN_W0 9
#define IN_W2 10
#define IN_A0 11
#define IN_A2 12
#define IN_G2 13
#define IN_KK 14
#define IN_KA 15
#define IN_RK 16
#define IN_LNW 17
#define IN_LNB 18
#define IN_WG2 19
#define IN_BG 20
#define IN_GNW 21
#define IN_WOA 22
#define IN_WOB 23
#define IN_WO 24
#define IN_NORM_FFN 25
#define IN_WUP 26
#define IN_CONVW 27
#define IN_CONVB 28
#define IN_WDN 29
#define IN_NORM_FINAL 30

__device__ __forceinline__ float bf_lo(unsigned w) { return __builtin_bit_cast(float, w << 16); }
__device__ __forceinline__ float bf_hi(unsigned w) { return __builtin_bit_cast(float, w & 0xffff0000u); }
__device__ __forceinline__ float bf2f(bf16_t h) { return __builtin_bit_cast(float, (unsigned)h << 16); }
__device__ __forceinline__ unsigned f2bf(float f) { unsigned u = __builtin_bit_cast(unsigned, f); return (u + 0x7fffu + ((u >> 16) & 1u)) >> 16; }
typedef float f32x2_t __attribute__((ext_vector_type(2)));
typedef __bf16 bf16x2_t __attribute__((ext_vector_type(2)));
__device__ __forceinline__ unsigned pk2(float lo, float hi) { const f32x2_t v = {lo, hi}; const bf16x2_t b = __builtin_convertvector(v, bf16x2_t); return __builtin_bit_cast(unsigned, b); }
__device__ __forceinline__ void unpack8(u32x4 w, float (&o)[8]) { o[0] = bf_lo(w.x); o[1] = bf_hi(w.x); o[2] = bf_lo(w.y); o[3] = bf_hi(w.y); o[4] = bf_lo(w.z); o[5] = bf_hi(w.z); o[6] = bf_lo(w.w); o[7] = bf_hi(w.w); }
__device__ __forceinline__ u32x4 pack8(const float (&v)[8]) { u32x4 w; w.x = pk2(v[0], v[1]); w.y = pk2(v[2], v[3]); w.z = pk2(v[4], v[5]); w.w = pk2(v[6], v[7]); return w; }
__device__ __forceinline__ void ld8bf(const bf16_t* p, float (&o)[8]) { unpack8(*(const u32x4*)p, o); }
__device__ __forceinline__ void ld8f(const float* p, float (&o)[8]) { const f32x4 a = *(const f32x4*)p, b = *(const f32x4*)(p + 4); o[0] = a.x; o[1] = a.y; o[2] = a.z; o[3] = a.w; o[4] = b.x; o[5] = b.y; o[6] = b.z; o[7] = b.w; }
__device__ __forceinline__ float fsigmoid(float x) { return __builtin_amdgcn_rcpf(1.f + __expf(-x)); }
__device__ __forceinline__ float ftanh(float x) { return 1.f - 2.f * __builtin_amdgcn_rcpf(__expf(2.f * x) + 1.f); }
__device__ __forceinline__ float fsoftplus(float x) { return fmaxf(x, 0.f) + __logf(1.f + __expf(-fabsf(x))); }
template <int CTRL> __device__ __forceinline__ float dpp_mov(float x) { return __builtin_bit_cast(float, __builtin_amdgcn_mov_dpp(__builtin_bit_cast(int, x), CTRL, 0xf, 0xf, true)); }
__device__ __forceinline__ float row16_allsum(float x) { x += dpp_mov<0xB1>(x); x += dpp_mov<0x4E>(x); x += dpp_mov<0x124>(x); x += dpp_mov<0x128>(x); return x; }
__device__ __forceinline__ float row8_allsum(float x) { x += dpp_mov<0xB1>(x); x += dpp_mov<0x4E>(x); x += dpp_mov<0x141>(x); return x; }
__device__ __forceinline__ float rdlane(float x, int l) { return __builtin_bit_cast(float, __builtin_amdgcn_readlane(__builtin_bit_cast(int, x), l)); }
__device__ __forceinline__ float wave_allsum(float x) { x = row16_allsum(x); return (rdlane(x, 0) + rdlane(x, 16)) + (rdlane(x, 32) + rdlane(x, 48)); }
#define LDS_WAIT() asm volatile("s_waitcnt lgkmcnt(0)" ::: "memory")
__device__ __forceinline__ const float* xrow_ptr(const Args& A, int r) { return r < MP ? A.in[IN_XP] + (size_t)r * DM : A.in[IN_XS] + (size_t)(r - MP) * DM; }

#define XB_TMO      128
#define XB_XCNT(j)  (256  + 64 * (j))
#define XB_XSUB(j)  (1280 + 64 * (j))
#define XB_XGEN(j)  (2304 + 64 * (j))
#define XB_TOP      3328
#define XB_TOPGEN   3392
#define XCD_BAR_WORDS 3456
#define XB_SPIN_CAP (1u << 18)

__device__ __forceinline__ unsigned xb_ld(unsigned* p)              { return __hip_atomic_load(p, __ATOMIC_RELAXED, __HIP_MEMORY_SCOPE_AGENT); }
__device__ __forceinline__ unsigned xb_add(unsigned* p, unsigned v) { return __hip_atomic_fetch_add(p, v, __ATOMIC_RELAXED, __HIP_MEMORY_SCOPE_AGENT); }
__device__ __forceinline__ unsigned xb_xcc_id() { return (unsigned)__builtin_amdgcn_s_getreg((3 << 11) | 20) & 0xFu; }
#define XB_SPIN(cond, bar) do { unsigned _sp = 0; while (cond) { __builtin_amdgcn_s_sleep(1); \
    if ((++_sp & 255u) == 0u) { if (xb_ld(&(bar)[XB_TMO])) break; if (_sp > XB_SPIN_CAP) { atomicAdd(&(bar)[XB_TMO], 1u); break; } } } } while (0)

struct XcdBarrier {
    unsigned* bar; unsigned x;
    volatile LAS unsigned* st;
};

__device__ __forceinline__ XcdBarrier xcd_barrier_post(unsigned* bar, volatile LAS unsigned* st) {
    XcdBarrier b; b.bar = bar; b.x = xb_xcc_id(); b.st = st;
    if (threadIdx.x == 0) (void)xb_add(&bar[XB_XCNT(b.x)], 1u);
    return b;
}
__device__ __forceinline__ void xcd_barrier_complete(unsigned* bar, unsigned x, unsigned& nloc, unsigned& nx) {
    const unsigned G = gridDim.x * gridDim.y * gridDim.z;
    unsigned sum, cnt, mine, sp = 0u;
    for (;;) {
        sum = 0u; cnt = 0u; mine = 0u;
#pragma unroll
        for (unsigned j = 0; j < 16; ++j) { const unsigned c = xb_ld(&bar[XB_XCNT(j)]); sum += c; cnt += (c > 0u) ? 1u : 0u; mine = (j == x) ? c : mine; }
        if (sum == G) break;
        __builtin_amdgcn_s_sleep(1);
        if ((++sp & 255u) == 0u) { if (xb_ld(&bar[XB_TMO])) break; if (sp > XB_SPIN_CAP) { atomicAdd(&bar[XB_TMO], 1u); break; } }
    }
    nloc = mine > 0u ? mine : 1u; nx = cnt > 0u ? cnt : 1u;
}

__device__ __forceinline__ void xcd_barrier(const XcdBarrier& b) {
    asm volatile("s_waitcnt vmcnt(0)" ::: "memory");
    __syncthreads();
    if (threadIdx.x == 0) {
        unsigned* bar = b.bar;
        __builtin_amdgcn_s_waitcnt(0);
        unsigned nloc = b.st[0], nx = b.st[1];
        if (nloc == 0u) { xcd_barrier_complete(bar, b.x, nloc, nx); b.st[0] = nloc; b.st[1] = nx; }
        const unsigned old = xb_add(&bar[XB_XSUB(b.x)], 1u);
        const unsigned gen = old / nloc;
        if (old + 1u == (gen + 1u) * nloc) {
            __builtin_amdgcn_fence(__ATOMIC_RELEASE, "agent");
            asm volatile("s_waitcnt vmcnt(0)" ::: "memory");
            const unsigned og = xb_add(&bar[XB_TOP], 1u);
            const unsigned tg = og / nx;
            if (og + 1u == (tg + 1u) * nx) xb_add(&bar[XB_TOPGEN], 1u);
            else XB_SPIN(xb_ld(&bar[XB_TOPGEN]) == tg, bar);
            __builtin_amdgcn_fence(__ATOMIC_ACQUIRE, "agent");
            xb_add(&bar[XB_XGEN(b.x)], 1u);
            asm volatile("s_waitcnt vmcnt(0)" ::: "memory");
        } else {
            XB_SPIN(xb_ld(&bar[XB_XGEN(b.x)]) == gen, bar);
            __builtin_amdgcn_fence(__ATOMIC_ACQUIRE, "agent");
            asm volatile("s_waitcnt vmcnt(0)" ::: "memory");
        }
    }
    __syncthreads();
}


struct EpiProj {
    static constexpr bool PERM = true, AFTER_DRAIN = false;
    bf16_t *prw, *pgla, *pgate; float *shift_p, *shift_s;
    __device__ __forceinline__ void operator()(const f32x4 (&acc)[2][2][4][2], const Unit& u, int wr, int wc, int fr, int fq) const {
        asm volatile("" : "+v"(fr), "+v"(fq));
        bf16_t* base; int ld, colt;
        if (u.pn < 7) { base = prw; ld = NPRW; colt = u.pn * 256; } else if (u.pn < 14) { base = pgla; ld = NPGLA; colt = (u.pn - 7) * 256; } else { base = pgate; ld = NGATE; colt = (u.pn - 14) * 256; }
        const int row0 = u.pm * 256 + wr * 64 + fr, col0 = colt + wc * 32 + 8 * fq;
#pragma unroll
        for (int ai = 0; ai < 2; ++ai)
#pragma unroll
            for (int m = 0; m < 4; ++m) {
                const int r = row0 + ai * 128 + m * 16; bf16_t* rowp = base + (size_t)r * ld + col0;
#pragma unroll
                for (int bj = 0; bj < 2; ++bj) { const f32x4 v0 = acc[ai][bj][m][0], v1 = acc[ai][bj][m][1]; u32x4 w; w.x = pk2(v0[0], v0[1]); w.y = pk2(v0[2], v0[3]); w.z = pk2(v1[0], v1[1]); w.w = pk2(v1[2], v1[3]); *(u32x4*)(rowp + bj * 128) = w; }
            }
    }
};
template <bool FIRST> struct EpiGate {
    static constexpr bool PERM = true, AFTER_DRAIN = false;
    bf16_t* merged; const bf16_t* gate;
    __device__ __forceinline__ void operator()(const f32x4 (&acc)[2][2][4][2], const Unit& u, int wr, int wc, int fr, int fq) const {
        asm volatile("" : "+v"(fr), "+v"(fq));
        const int row0 = u.pm * 256 + wr * 64 + fr, col0 = u.pn * 256 + wc * 32 + 8 * fq;
#pragma unroll
        for (int ai = 0; ai < 2; ++ai) {
            u32x4 gr[4][2], pr[4][2];
#pragma unroll
            for (int m = 0; m < 4; ++m)
#pragma unroll
                for (int bj = 0; bj < 2; ++bj) { const size_t r = (size_t)(row0 + ai * 128 + m * 16); const int c = col0 + bj * 128; gr[m][bj] = *(const u32x4*)(gate + r * NGATE + c); if (!FIRST) pr[m][bj] = *(const u32x4*)(merged + r * DM + c); }
#pragma unroll
            for (int m = 0; m < 4; ++m)
#pragma unroll
                for (int bj = 0; bj < 2; ++bj) { const size_t r = (size_t)(row0 + ai * 128 + m * 16); const int c = col0 + bj * 128; float g[8], v[8]; unpack8(gr[m][bj], g);
                    const f32x4 v0 = acc[ai][bj][m][0], v1 = acc[ai][bj][m][1];
#pragma unroll
                    for (int i = 0; i < 4; ++i) { v[i] = v0[i] * fsigmoid(g[i]); v[4 + i] = v1[i] * fsigmoid(g[4 + i]); }
                    if (!FIRST) { float p[8]; unpack8(pr[m][bj], p);
#pragma unroll
                        for (int i = 0; i < 8; ++i) v[i] += p[i]; }
                    *(u32x4*)(merged + r * DM + c) = pack8(v); }
        }
    }
};
struct EpiX1 {
    static constexpr bool PERM = true, AFTER_DRAIN = false;
    const float *xp, *xs; float* x1; bf16_t* x1b; float* rowss;
    __device__ __forceinline__ void operator()(const f32x4 (&acc)[2][2][4][2], const Unit& u, int wr, int wc, int fr, int fq) const {
        asm volatile("" : "+v"(fr), "+v"(fq));
        const int row0 = u.pm * 256 + wr * 64 + fr, col0 = u.pn * 256 + wc * 32 + 8 * fq;
#pragma unroll
        for (int ai = 0; ai < 2; ++ai) {
            f32x4 xa[4][2][2];
#pragma unroll
            for (int m = 0; m < 4; ++m) { const int r = row0 + ai * 128 + m * 16; const float* xr = (r < MP ? xp + (size_t)r * DM : xs + (size_t)(r - MP) * DM);
#pragma unroll
                for (int bj = 0; bj < 2; ++bj) { xa[m][bj][0] = *(const f32x4*)(xr + col0 + bj * 128); xa[m][bj][1] = *(const f32x4*)(xr + col0 + bj * 128 + 4); } }
#pragma unroll
            for (int m = 0; m < 4; ++m) { const int r = row0 + ai * 128 + m * 16; float ssq = 0.f;
#pragma unroll
                for (int bj = 0; bj < 2; ++bj) { const int c = col0 + bj * 128; const f32x4 a = xa[m][bj][0] + acc[ai][bj][m][0], b = xa[m][bj][1] + acc[ai][bj][m][1];
                    ssq += (a[0] * a[0] + a[1] * a[1]) + (a[2] * a[2] + a[3] * a[3]) + (b[0] * b[0] + b[1] * b[1]) + (b[2] * b[2] + b[3] * b[3]);
                    u32x4 w; w.x = pk2(a[0], a[1]); w.y = pk2(a[2], a[3]); w.z = pk2(b[0], b[1]); w.w = pk2(b[2], b[3]); *(u32x4*)(x1b + (size_t)r * DM + c) = w; }
                ssq += __shfl_xor(ssq, 16); ssq += __shfl_xor(ssq, 32);
                if (fq == 0) atomicAdd(rowss + r, ssq); }
        }
    }
};
struct EpiX2 {
    static constexpr bool PERM = true, AFTER_DRAIN = false;
    bf16_t* xb;
    __device__ __forceinline__ void operator()(const f32x4 (&acc)[2][2][4][2], const Unit& u, int wr, int wc, int fr, int fq) const {
        asm volatile("" : "+v"(fr), "+v"(fq));
        const int row0 = u.pm * 256 + wr * 64 + fr, col0 = u.pn * 256 + wc * 32 + 8 * fq;
#pragma unroll
        for (int ai = 0; ai < 2; ++ai) {
            u32x4 xa[4][2];
#pragma unroll
            for (int m = 0; m < 4; ++m)
#pragma unroll
                for (int bj = 0; bj < 2; ++bj) xa[m][bj] = *(const u32x4*)(xb + (size_t)(row0 + ai * 128 + m * 16) * DM + col0 + bj * 128);
#pragma unroll
            for (int m = 0; m < 4; ++m)
#pragma unroll
                for (int bj = 0; bj < 2; ++bj) { float x8[8]; unpack8(xa[m][bj], x8);
#pragma unroll
                    for (int i = 0; i < 4; ++i) { x8[i] += acc[ai][bj][m][0][i]; x8[4 + i] += acc[ai][bj][m][1][i]; }
                    *(u32x4*)(xb + (size_t)(row0 + ai * 128 + m * 16) * DM + col0 + bj * 128) = pack8(x8); }
        }
    }
};
__device__ __forceinline__ float gelu_gate(float g, float v) { const float t = g * (1.f + 0.044715f * g * g) * 1.5957691216057308f; return g * fsigmoid(t) * v; }
struct EpiU {
    static constexpr bool PERM = true, AFTER_DRAIN = false;
    const float* rowss; bf16_t *U, *uh; float *conv_p, *conv_s;
    __device__ __forceinline__ void operator()(const f32x4 (&acc)[2][2][4][2], const Unit& u, int wr, int wc, int fr, int fq) const {
        asm volatile("" : "+v"(fr), "+v"(fq));
        const int row0 = u.pm * 256 + wr * 64 + fr, col0 = u.pn * 256 + wc * 32 + 8 * fq;
#pragma unroll
        for (int ai = 0; ai < 2; ++ai)
#pragma unroll
            for (int m = 0; m < 4; ++m) { const int r = row0 + ai * 128 + m * 16; const float rs = rsqrtf(rowss[r] * (1.f / DM) + NORM_EPS);
#pragma unroll
                for (int bj = 0; bj < 2; ++bj) { const int c = col0 + bj * 128; const f32x4 v0 = acc[ai][bj][m][0] * rs, v1 = acc[ai][bj][m][1] * rs;
                    u32x4 w; w.x = pk2(v0[0], v0[1]); w.y = pk2(v0[2], v0[3]); w.z = pk2(v1[0], v1[1]); w.w = pk2(v1[2], v1[3]);
                    *(u32x4*)(U + (size_t)r * F2 + c) = w;
                    if (m == 3 && fr >= 14 && r < MP) { *(u32x4*)(uh + ((size_t)(r >> 6) * 2 + (fr - 14)) * F2 + c) = w;
                        if ((r & 2047) >= 2046) { float* cp = conv_p + ((size_t)(r >> 11) * 2 + (fr - 14)) * F2 + c; *(f32x4*)cp = v0; *(f32x4*)(cp + 4) = v1; } }
                    if (r >= MP && (fr & 7) >= 6) { float* cp = conv_s + ((size_t)((r - MP) >> 3) * 2 + ((fr & 7) - 6)) * F2 + c; *(f32x4*)cp = v0; *(f32x4*)(cp + 4) = v1; } } }
    }
};

struct EpiAct {
    static constexpr bool PERM = true, AFTER_DRAIN = false;
    const float *rowss, *convw, *convb; bf16_t *act, *uh, *us; float *conv_p, *conv_s; LAS float* ringbase;
    __device__ __forceinline__ void operator()(const f32x4 (&acc)[2][2][4][2], const Unit& u, int wr_, int wc_, int fr_, int fq_) const {
        int wr = wr_, wc = wc_, fr = fr_, fq = fq_;
        asm volatile("" : "+v"(fr), "+v"(fq)); asm volatile("" : "+s"(wr), "+s"(wc));
        const bool sample = u.pm >= 64;
        const int jc0 = u.pn * 128 + wc * 32 + 8 * fq;
        LAS float* ring = ringbase + (wr * 4 + wc) * 512;
#pragma unroll
        for (int ai = 0; ai < 2; ++ai) {
            const int rbase = u.pm * 256 + ai * 128 + wr * 64, grp = rbase >> 6;
#pragma unroll
            for (int m = 0; m < 4; ++m) {
                const int row = rbase + 16 * m + fr;
                const bool wuh = !sample && ((m == 0 && fr < 2) || (m == 3 && fr >= 14)), wus = sample && (fr & 7) < 2, wcs = sample && (fr & 7) >= 6;
                if (wuh || wus || wcs) {
                    const float rsm = rsqrtf(rowss[row] * (1.f / DM) + NORM_EPS);
#pragma unroll
                    for (int bj = 0; bj < 2; ++bj) { const f32x4 v0 = acc[ai][bj][m][0] * rsm, v1 = acc[ai][bj][m][1] * rsm;
                        if (wcs) { float* cp = conv_s + ((size_t)((row - MP) >> 3) * 2 + ((fr & 7) - 6)) * F2 + bj * FF + jc0; *(f32x4*)cp = v0; *(f32x4*)(cp + 4) = v1; }
                        else { u32x4 w; w.x = pk2(v0[0], v0[1]); w.y = pk2(v0[2], v0[3]); w.z = pk2(v1[0], v1[1]); w.w = pk2(v1[2], v1[3]);
                            bf16_t* dst = wuh ? uh + ((size_t)grp * 4 + (m == 0 ? fr : fr - 12)) * F2 : us + ((size_t)((row - MP) >> 3) * 2 + (fr & 7)) * F2;
                            *(u32x4*)(dst + bj * FF + jc0) = w;
                            if (wuh && m == 3 && (grp & 31) == 31) { float* cp = conv_p + ((size_t)(rbase >> 11) * 2 + (fr - 14)) * F2 + bj * FF + jc0; *(f32x4*)cp = v0; *(f32x4*)(cp + 4) = v1; } } }
                }
            }
        }
        asm volatile("" ::: "memory");
        float rsq[2][4];
#pragma unroll
        for (int ai = 0; ai < 2; ++ai)
#pragma unroll
            for (int m = 0; m < 4; ++m) rsq[ai][m] = rsqrtf(rowss[u.pm * 256 + ai * 128 + wr * 64 + 16 * m + fr] * (1.f / DM) + NORM_EPS);
#define EPIACT_STEP(AI, N) do { const int rbase = u.pm * 256 + (AI) * 128 + wr * 64; \
            _Pragma("unroll") for (int m = 0; m < 4; ++m) { const float rsm = rsq[AI][m]; \
                const f32x4 xv = acc[AI][0][m][N] * rsm, xg = acc[AI][1][m][N] * rsm; const int idx = (m & 1) * 16 + fr; \
                asm volatile("" ::: "memory"); *(LAS f32x4*)(ring + idx * 16 + fq * 4) = xv; *(LAS f32x4*)(ring + 4096 + idx * 16 + fq * 4) = xg; asm volatile("" ::: "memory");     \
                const f32x4 p1v = *(const LAS f32x4*)(ring + ((idx + 31) & 31) * 16 + fq * 4), p2v = *(const LAS f32x4*)(ring + ((idx + 30) & 31) * 16 + fq * 4); \
                const f32x4 p1g = *(const LAS f32x4*)(ring + 4096 + ((idx + 31) & 31) * 16 + fq * 4), p2g = *(const LAS f32x4*)(ring + 4096 + ((idx + 30) & 31) * 16 + fq * 4); \
                const f32x4 cv = cbv + w0v * p2v + w1v * p1v + w2v * xv, cg = cbg + w0g * p2g + w1g * p1g + w2g * xg; \
                const bool fix = sample ? ((fr & 7) < 2) : (m == 0 && fr < 2); \
                if (!fix) { u32x2 w; w.x = pk2(gelu_gate(cg[0], cv[0]), gelu_gate(cg[1], cv[1])); w.y = pk2(gelu_gate(cg[2], cv[2]), gelu_gate(cg[3], cv[3])); \
                    *(u32x2*)(act + (size_t)(rbase + 16 * m + fr) * FF + jc0 + 4 * (N)) = w; } } } while (0)
#define EPIACT_N(N) do { const int col4 = jc0 + 4 * (N); \
            const f32x4 w0v = *(const f32x4*)(convw + col4), w1v = *(const f32x4*)(convw + F2 + col4), w2v = *(const f32x4*)(convw + 2 * F2 + col4), cbv = *(const f32x4*)(convb + col4); \
            const f32x4 w0g = *(const f32x4*)(convw + FF + col4), w1g = *(const f32x4*)(convw + F2 + FF + col4), w2g = *(const f32x4*)(convw + 2 * F2 + FF + col4), cbg = *(const f32x4*)(convb + FF + col4); \
            EPIACT_STEP(0, N); EPIACT_STEP(1, N); asm volatile("" ::: "memory"); } while (0)
        EPIACT_N(0); EPIACT_N(1);
#undef EPIACT_N
#undef EPIACT_STEP
    }
};

template <class EF> __device__ __forceinline__ void tail_gemm(LAS unsigned char* lds, const bf16_t* Amat, int lda, const bf16_t* Bt, int K, const pg8::StaticOrder& S, int wave, int lane, const EF& ef) {
    const int l15 = lane & 15, q = lane >> 4, ntail = S.nwg - S.limit, nk = K / 256;
    LAS float* red = (LAS float*)lds;
    for (int item = blockIdx.x; item < ntail * 16; item += gridDim.x) {
        pg8::Unit u; S.unit_of(S.limit + (item >> 4), u);
        const int r0 = u.pm * 256 + (item & 15) * 16, c0 = u.pn * 256;
        const bf16_t* ap = Amat + (size_t)(r0 + l15) * lda + 8 * q + 32 * nk * wave; const bf16_t* bp = Bt + (size_t)(c0 + l15) * K + 8 * q + 32 * nk * wave;
        f32x4 acc[16];
#pragma unroll
        for (int n = 0; n < 16; ++n) acc[n] = (f32x4){0.f, 0.f, 0.f, 0.f};
#pragma unroll 2
        for (int ks = 0; ks < nk; ++ks) {
            const bf16x8 a = *(const bf16x8*)(ap + 32 * ks); bf16x8 b[16];
#pragma unroll
            for (int n = 0; n < 16; ++n) b[n] = *(const bf16x8*)(bp + (size_t)(16 * n) * K + 32 * ks);
#pragma unroll
            for (int n = 0; n < 16; ++n) acc[n] = __builtin_amdgcn_mfma_f32_16x16x32_bf16(a, b[n], acc[n], 0, 0, 0);
        }
        __syncthreads();
#pragma unroll
        for (int n = 0; n < 16; ++n) *(LAS f32x4*)(red + ((wave * 16 + n) * 64 + lane) * 4) = acc[n];
        __syncthreads();
        f32x4 s0 = {0.f, 0.f, 0.f, 0.f}, s1 = s0;
#pragma unroll
        for (int w2 = 0; w2 < 8; ++w2) { s0 += *(const LAS f32x4*)(red + ((w2 * 16 + 2 * wave) * 64 + lane) * 4); s1 += *(const LAS f32x4*)(red + ((w2 * 16 + 2 * wave + 1) * 64 + lane) * 4); }
        ef(r0 + 4 * q, c0 + 32 * wave + l15, s0, s1);
    }
    __syncthreads();
}
struct TfGate { bool first; bf16_t* merged; const bf16_t* gate;
    __device__ __forceinline__ void operator()(int row, int col, f32x4 a0, f32x4 a1) const {
#pragma unroll
        for (int i = 0; i < 4; ++i)
#pragma unroll
            for (int n = 0; n < 2; ++n) { const size_t r = (size_t)(row + i); const int c = col + 16 * n; float v = (n ? a1[i] : a0[i]) * fsigmoid(bf2f(gate[r * NGATE + c]));
                if (!first) v += bf2f(merged[r * DM + c]); merged[r * DM + c] = (bf16_t)f2bf(v); } } };
struct TfX1 { const float *xp, *xs; float* x1; bf16_t* x1b; float* rowss;
    __device__ __forceinline__ void operator()(int row, int col, f32x4 a0, f32x4 a1) const {
#pragma unroll
        for (int i = 0; i < 4; ++i) { const int r = row + i; const float* xr = (r < MP ? xp + (size_t)r * DM : xs + (size_t)(r - MP) * DM);
            const float v0 = xr[col] + a0[i], v1 = xr[col + 16] + a1[i];
            x1b[(size_t)r * DM + col] = (bf16_t)f2bf(v0); x1b[(size_t)r * DM + col + 16] = (bf16_t)f2bf(v1);
            const float ss = row16_allsum(v0 * v0 + v1 * v1); if ((col & 15) == 0) atomicAdd(rowss + r, ss); } } };
struct TfX2 { bf16_t* xb;
    __device__ __forceinline__ void operator()(int row, int col, f32x4 a0, f32x4 a1) const {
#pragma unroll
        for (int i = 0; i < 4; ++i) { const size_t off = (size_t)(row + i) * DM + col; xb[off] = (bf16_t)f2bf(bf2f(xb[off]) + a0[i]); xb[off + 16] = (bf16_t)f2bf(bf2f(xb[off + 16]) + a1[i]); } } };

template <int MODE> __device__ __forceinline__ int map_col(int R) {
    if (MODE == 1) { if (R < 1792) return R; if (R < 3584) return (R - 1792 < 1552) ? R : -1; return R - 240; }
    if (MODE == 2) { return ((R >> 7) & 1) * FF + ((R >> 8) << 7) + (R & 127); }
    return R;
}
template <int MODE> __device__ __forceinline__ void tr_item(const float* __restrict__ W, int K, int Nsrc, int Ndst, bf16_t* WT, const float* kscale, LAS float* scr, int item, int lane) {
    const int nblk = Ndst >> 5, kb = item / nblk, nb = item - kb * nblk, k0 = kb << 6, n0 = nb << 5;
    const int col = map_col<MODE>(n0 + (lane & 31));
    float tv[32];
#pragma unroll
    for (int i = 0; i < 32; ++i) { const int kk = 2 * i + (lane >> 5); tv[i] = (col >= 0) ? W[(size_t)(k0 + kk) * Nsrc + col] : 0.f; }
#pragma unroll
    for (int i = 0; i < 32; ++i) { const int kk = 2 * i + (lane >> 5); float v = tv[i]; if (kscale) v *= kscale[k0 + kk]; scr[kk * 33 + (lane & 31)] = v; }
    LDS_WAIT();
    const int c = lane & 7;
#pragma unroll
    for (int j = 0; j < 4; ++j) { const int n = (lane >> 3) + 8 * j; const LAS float* s = scr + (8 * c) * 33 + n;
        u32x4 o; o.x = pk2(s[0 * 33], s[1 * 33]); o.y = pk2(s[2 * 33], s[3 * 33]); o.z = pk2(s[4 * 33], s[5 * 33]); o.w = pk2(s[6 * 33], s[7 * 33]);
        *(u32x4*)(WT + (size_t)(n0 + n) * K + k0 + 8 * c) = o; }
    LDS_WAIT();
}
__device__ __forceinline__ void p0_prologue(const Args& A, LAS unsigned char* lds, int gw, int NGW, int wave, int lane) {
    LAS float* scr = (LAS float*)(lds + wave * 16384);
    unsigned char* ws = A.ws;
    constexpr int I_IN = 16 * (NIN / 32), I_UP = 16 * (F2 / 32), I_DN = 44 * 32, I_O = 16 * 32, I_OA = 8 * 32, I_W2 = 16, I_G2 = 2 * 16;
    constexpr int NITEMS = I_IN + I_UP + I_DN + I_O + 2 * I_OA + 2 * I_W2 + I_G2;
    for (int it = gw; it < NITEMS; it += NGW) {
        int r = it;
        if (r < I_IN) { tr_item<1>(A.in[IN_W_IN], 1024, 5392, NIN, (bf16_t*)(ws + OFF_WIN), nullptr, scr, r, lane); continue; } r -= I_IN;
        if (r < I_UP) { tr_item<2>(A.in[IN_WUP], 1024, F2, F2, (bf16_t*)(ws + OFF_WUP), A.in[IN_NORM_FFN], scr, r, lane); continue; } r -= I_UP;
        if (r < I_DN) { tr_item<0>(A.in[IN_WDN], FF, 1024, 1024, (bf16_t*)(ws + OFF_WDN), nullptr, scr, r, lane); continue; } r -= I_DN;
        if (r < I_O) { tr_item<0>(A.in[IN_WO], 1024, 1024, 1024, (bf16_t*)(ws + OFF_WO), nullptr, scr, r, lane); continue; } r -= I_O;
        if (r < I_OA) { tr_item<0>(A.in[IN_WOA], 512, 1024, 1024, (bf16_t*)(ws + OFF_WOA), nullptr, scr, r, lane); continue; } r -= I_OA;
        if (r < I_OA) { tr_item<0>(A.in[IN_WOB], 512, 1024, 1024, (bf16_t*)(ws + OFF_WOB), nullptr, scr, r, lane); continue; } r -= I_OA;
        if (r < I_W2) { tr_item<0>(A.in[IN_W2], 64, 512, 512, (bf16_t*)(ws + OFF_W2T), nullptr, scr, r, lane); continue; } r -= I_W2;
        if (r < I_W2) { tr_item<0>(A.in[IN_A2], 64, 512, 512, (bf16_t*)(ws + OFF_A2T), nullptr, scr, r, lane); continue; } r -= I_W2;
        tr_item<0>(A.in[IN_G2], 128, 512, 512, (bf16_t*)(ws + OFF_G2T), nullptr, scr, r, lane);
    }
    bf16_t* H = (bf16_t*)((unsigned char*)A.out + OUTB_H);
    const float* gm = A.in[IN_NORM_MIX];
    for (int m = gw; m < M; m += 2 * NGW) {
        const int m2 = m + NGW; const bool has2 = m2 < M;
        const f32x4* xr = (const f32x4*)xrow_ptr(A, m) + lane; const f32x4* xr2 = (const f32x4*)xrow_ptr(A, has2 ? m2 : m) + lane; f32x4 v[4], w[4]; float s = 0.f, s2 = 0.f;
#pragma unroll
        for (int j = 0; j < 4; ++j) { v[j] = xr[64 * j]; w[j] = xr2[64 * j]; }
#pragma unroll
        for (int j = 0; j < 4; ++j) { s += (v[j].x * v[j].x + v[j].y * v[j].y) + (v[j].z * v[j].z + v[j].w * v[j].w); s2 += (w[j].x * w[j].x + w[j].y * w[j].y) + (w[j].z * w[j].z + w[j].w * w[j].w); }
        const float rstd = rsqrtf(wave_allsum(s) * (1.f / DM) + NORM_EPS), rstd2 = rsqrtf(wave_allsum(s2) * (1.f / DM) + NORM_EPS);
        u32x2* o8 = (u32x2*)(H + (size_t)m * DM) + lane; u32x2* o82 = (u32x2*)(H + (size_t)m2 * DM) + lane;
#pragma unroll
        for (int j = 0; j < 4; ++j) { const f32x4 g = *((const f32x4*)gm + lane + 64 * j); u32x2 p; p.x = pk2(v[j].x * rstd * g.x, v[j].y * rstd * g.y); p.y = pk2(v[j].z * rstd * g.z, v[j].w * rstd * g.w); o8[64 * j] = p;
            if (has2) { u32x2 p2; p2.x = pk2(w[j].x * rstd2 * g.x, w[j].y * rstd2 * g.y); p2.y = pk2(w[j].z * rstd2 * g.z, w[j].w * rstd2 * g.w); o82[64 * j] = p2; } }
    }
    float* rowss = (float*)(ws + OFF_ROWSS);
    for (int i = gw * 64 + lane; i < M; i += NGW * 64) rowss[i] = 0.f;
}

__device__ __forceinline__ void prw_mixed8(const Args& A, const bf16_t* PRW, int r, int col0, float (&xs)[8]) {
    float cur[8], prev[8];
    ld8bf(PRW + (size_t)r * NPRW + col0, cur);
    const bool first = (r < MP) ? ((r & 2047) == 0) : (((r - MP) & 7) == 0);
    if (!first) ld8bf(PRW + (size_t)(r - 1) * NPRW + col0, prev);
    else if (r < MP) {
#pragma unroll
        for (int i = 0; i < 8; ++i) prev[i] = 0.f;
    } else ld8f(A.in[IN_ST_SHIFT] + (size_t)((r - MP) >> 3) * 1792 + col0, prev);
    float mu[8]; ld8f(A.in[IN_MU] + col0, mu);
#pragma unroll
    for (int i = 0; i < 8; ++i) xs[i] = cur[i] + (prev[i] - cur[i]) * mu[i];
}
template <int ACT> __device__ __forceinline__ bf16x8 afrag(const Args& A, const bf16_t* PRW, int r, int col0) {
    float xs[8]; prw_mixed8(A, PRW, r, col0, xs);
#pragma unroll
    for (int i = 0; i < 8; ++i) xs[i] = ACT == 1 ? ftanh(xs[i]) : (ACT == 2 ? fsigmoid(xs[i]) : xs[i]);
    return __builtin_bit_cast(bf16x8, pack8(xs));
}
__device__ __forceinline__ void p2a_lora(const Args& A, LAS unsigned char* lds, int gw, int NGW, int wave, int lane) {
    const bf16_t* PRW = (const bf16_t*)(A.ws + OFF_PRW);
    const bf16_t *W2T = (const bf16_t*)(A.ws + OFF_W2T), *A2T = (const bf16_t*)(A.ws + OFF_A2T), *G2T = (const bf16_t*)(A.ws + OFF_G2T);
    bf16_t *EW = (bf16_t*)((unsigned char*)A.out + OUTB_EW), *AARR = (bf16_t*)((unsigned char*)A.out + OUTB_AARR), *G = (bf16_t*)(A.ws + OFF_G);
    for (int i = gw * 64 + lane; i < 136 * 224; i += NGW * 64) { const int sq = i / 224, c8 = (i - sq * 224) * 8; const int r = sq < 8 ? sq * 2048 + 2047 : MP + (sq - 8) * 8 + 7;
        float v[8]; ld8bf(PRW + (size_t)r * NPRW + c8, v); float* dst = (sq < 8 ? A.out + OUT_SHIFT_P + (size_t)sq * 1792 : A.out + OUT_SHIFT_S + (size_t)(sq - 8) * 1792) + c8;
        *(f32x4*)dst = (f32x4){v[0], v[1], v[2], v[3]}; *(f32x4*)(dst + 4) = (f32x4){v[4], v[5], v[6], v[7]}; }
    const int l15 = lane & 15, kq = lane >> 4;
    LAS bf16_t* acts = (LAS bf16_t*)lds; const int tid = wave * 64 + lane;
    for (int tile = blockIdx.x; tile < M / 16; tile += gridDim.x) {
        const int h = wave, t0 = tile * 16;
        { const int tt = tid >> 5, cg = tid & 31; float xs[8]; prw_mixed8(A, PRW, t0 + tt, 1536 + 8 * cg, xs);
#pragma unroll
          for (int i = 0; i < 8; ++i) xs[i] = cg < 8 ? ftanh(xs[i]) : (cg < 16 ? xs[i] : fsigmoid(xs[i]));
          __syncthreads();
          *(LAS u32x4*)(acts + tt * 264 + 8 * cg) = pack8(xs); }
        __syncthreads();
        bf16x8 aw[2], aa[2], ag[4];
#pragma unroll
        for (int ks = 0; ks < 2; ++ks) { aw[ks] = *(const LAS bf16x8*)(acts + l15 * 264 + ks * 32 + kq * 8); aa[ks] = *(const LAS bf16x8*)(acts + l15 * 264 + 64 + ks * 32 + kq * 8); }
#pragma unroll
        for (int ks = 0; ks < 4; ++ks) ag[ks] = *(const LAS bf16x8*)(acts + l15 * 264 + 128 + ks * 32 + kq * 8);
        f32x4 cwv[4], cav[4], cgg[4];
#pragma unroll
        for (int nt = 0; nt < 4; ++nt) {
            const int c = 64 * h + 16 * nt + l15;
            f32x4 cw = {0.f, 0.f, 0.f, 0.f}, ca = cw, cgv = cw;
#pragma unroll
            for (int ks = 0; ks < 2; ++ks) {
                const bf16x8 bw = *(const bf16x8*)(W2T + (size_t)c * 64 + ks * 32 + kq * 8), ba = *(const bf16x8*)(A2T + (size_t)c * 64 + ks * 32 + kq * 8);
                cw = __builtin_amdgcn_mfma_f32_16x16x32_bf16(bw, aw[ks], cw, 0, 0, 0); ca = __builtin_amdgcn_mfma_f32_16x16x32_bf16(ba, aa[ks], ca, 0, 0, 0); }
#pragma unroll
            for (int ks = 0; ks < 4; ++ks) { const bf16x8 bg = *(const bf16x8*)(G2T + (size_t)c * 128 + ks * 32 + kq * 8); cgv = __builtin_amdgcn_mfma_f32_16x16x32_bf16(bg, ag[ks], cgv, 0, 0, 0); }
            cwv[nt] = cw; cav[nt] = ca; cgg[nt] = cgv;
        }
#pragma unroll
        for (int nt = 0; nt < 4; ++nt) {
            const int c4 = 64 * h + 16 * nt + 4 * kq; const size_t o = (size_t)(t0 + l15) * 512 + c4;
            const f32x4 w0v = *(const f32x4*)(A.in[IN_W0] + c4), a0v = *(const f32x4*)(A.in[IN_A0] + c4);
            float ew[4], av[4];
#pragma unroll
            for (int i = 0; i < 4; ++i) { ew[i] = 0.6065306597f * fsigmoid(w0v[i] + cwv[nt][i]); av[i] = fsigmoid(a0v[i] + cav[nt][i]); }
            u32x2 w; w.x = pk2(ew[0], ew[1]); w.y = pk2(ew[2], ew[3]); *(u32x2*)(EW + o) = w;
            w.x = pk2(av[0], av[1]); w.y = pk2(av[2], av[3]); *(u32x2*)(AARR + o) = w;
            w.x = pk2(cgg[nt][0], cgg[nt][1]); w.y = pk2(cgg[nt][2], cgg[nt][3]); *(u32x2*)(G + o) = w;
        }
    }
}

typedef short bf16x4 __attribute__((ext_vector_type(4)));
#define MFMA32(a, b, c) __builtin_amdgcn_mfma_f32_16x16x32_bf16(a, b, c, 0, 0, 0)
#define MFMA16(a, b, c) __builtin_amdgcn_mfma_f32_16x16x16bf16_1k(a, b, c, 0, 0, 0)
constexpr int SP = 72;
constexpr size_t OFF_RLT = 240 * MiB;
constexpr size_t OFF_GL = 1 * MiB, OFF_GG = 8 * MiB;
static_assert(OFF_RLT + (size_t)448 * 32768 <= 256 * MiB && OFF_GL + (size_t)224 * 32768 <= OFF_GG && OFF_GG + 224 * 256 <= OFF_WUP, "ws map (scan)");
__device__ __forceinline__ bf16x4 bf4(f32x4 v) { u32x2 w; w.x = pk2(v[0], v[1]); w.y = pk2(v[2], v[3]); return __builtin_bit_cast(bf16x4, w); }
__device__ __forceinline__ bf16x8 afr(const LAS bf16_t* X, int l15, int q, int ks) { const LAS bf16_t* p = X + l15 * SP + 32 * ks + 4 * q; const u32x2 lo = *(const LAS u32x2*)p, hi = *(const LAS u32x2*)(p + 16); u32x4 w; w.x = lo.x; w.y = lo.y; w.z = hi.x; w.w = hi.y; return __builtin_bit_cast(bf16x8, w); }
__device__ __forceinline__ bf16x8 hfrag(const f32x4& lo, const f32x4& hi) { u32x4 w; w.x = pk2(lo[0], lo[1]); w.y = pk2(lo[2], lo[3]); w.z = pk2(hi[0], hi[1]); w.w = pk2(hi[2], hi[3]); return __builtin_bit_cast(bf16x8, w); }
__device__ __forceinline__ f32x4 maskc(f32x4 v, int q, int l15, bool rows_lt_col, bool incl) {
#pragma unroll
    for (int i = 0; i < 4; ++i) { const int R = 4 * q + i; const bool keep = rows_lt_col ? (incl ? R <= l15 : R < l15) : (incl ? l15 <= R : l15 < R); v[i] = keep ? v[i] : 0.f; }
    return v;
}
template <bool GLA, int VP> __device__ __forceinline__ void scan_matrix_part(const LAS bf16_t* AT, const LAS bf16_t* RT, const LAS bf16_t* BT, const LAS bf16_t* KT, const LAS bf16_t* VS, const LAS float* GC, bf16_t* OUTP, int l15, int q, int sl, bool use_v, bool write_o, int rowb, int nv, f32x4 (&H)[4]) {
    const bf16x8 hb0 = hfrag(H[0], H[1]), hb1 = hfrag(H[2], H[3]);
    const bf16x8 rt0 = afr(RT, l15, q, 0), rt1 = afr(RT, l15, q, 1), kt0 = afr(KT, l15, q, 0), kt1 = afr(KT, l15, q, 1);
    const f32x4 z4 = {0.f, 0.f, 0.f, 0.f};
    bf16x4 vb = {0, 0, 0, 0};
    if (use_v) { const LAS bf16_t* vp = VS + (4 * q) * VP + 16 * sl + l15; u32x2 w; w.x = (unsigned)vp[0] | ((unsigned)vp[VP] << 16); w.y = (unsigned)vp[2 * VP] | ((unsigned)vp[3 * VP] << 16); vb = __builtin_bit_cast(bf16x4, w); }
    f32x4 O = MFMA32(rt0, hb0, z4); O = MFMA32(rt1, hb1, O);
    f32x4 U = z4;
    if (!GLA) {
        const bf16x8 at0 = afr(AT, l15, q, 0), at1 = afr(AT, l15, q, 1), bt0 = afr(BT, l15, q, 0), bt1 = afr(BT, l15, q, 1);
        f32x4 P = MFMA32(at0, bt0, z4); P = MFMA32(at1, bt1, P); P = maskc(P, q, l15, false, false);
        f32x4 PT = MFMA32(bt0, at0, z4); PT = MFMA32(bt1, at1, PT); PT = maskc(PT, q, l15, true, false);
        f32x4 nrbT = MFMA32(bt0, rt0, z4); nrbT = MFMA32(bt1, rt1, nrbT); nrbT = maskc(nrbT, q, l15, true, true);
        U = MFMA32(at0, hb0, z4); U = MFMA32(at1, hb1, U);
        if (use_v) { f32x4 makT = MFMA32(kt0, at0, z4); makT = MFMA32(kt1, at1, makT); makT = maskc(makT, q, l15, true, false); U = MFMA16(bf4(makT), vb, U); }
#pragma unroll
        for (int it = 0; it < 4; ++it) {
            U = MFMA16(bf4(PT), bf4(U), U);
            if (it < 3) { const f32x4 Pn = MFMA16(bf4(PT), bf4(P), z4), PTn = MFMA16(bf4(P), bf4(PT), z4); P = Pn; PT = PTn; }
        }
        O = MFMA16(bf4(nrbT), bf4(U), O);
    }
    if (use_v) { f32x4 nrkT = MFMA32(kt0, rt0, z4); nrkT = MFMA32(kt1, rt1, nrkT); nrkT = maskc(nrkT, q, l15, true, true); O = MFMA16(bf4(nrkT), vb, O); }
    if (write_o) {
#pragma unroll
        for (int i = 0; i < 4; ++i) if (4 * q + i < nv) OUTP[(size_t)(rowb + 4 * q + i) * 512] = (bf16_t)f2bf(O[i]);
    }
    const bf16x4 ub = bf4(U);
#pragma unroll
    for (int kt = 0; kt < 4; ++kt) {
        const f32x4 g4 = *(const LAS f32x4*)(GC + 16 * kt + 4 * q); const float gk = GC[16 * kt + l15];
        f32x4 acc = H[kt] * g4;
        if (!GLA) { const LAS bf16_t* p = BT + (4 * q) * SP + 16 * kt + l15; u32x2 w; w.x = pk2(bf2f(p[0]) * gk, bf2f(p[SP]) * gk); w.y = pk2(bf2f(p[2 * SP]) * gk, bf2f(p[3 * SP]) * gk); acc = MFMA16(__builtin_bit_cast(bf16x4, w), ub, acc); }
        if (use_v) { const LAS bf16_t* p = KT + (4 * q) * SP + 16 * kt + l15; u32x2 w; w.x = pk2(bf2f(p[0]) * gk, bf2f(p[SP]) * gk); w.y = pk2(bf2f(p[2 * SP]) * gk, bf2f(p[3 * SP]) * gk); acc = MFMA16(__builtin_bit_cast(bf16x4, w), vb, acc); }
        H[kt] = acc;
    }
}
constexpr int GL_RT = 2304, GL_BT = 4608, GL_KT = 6912, GL_VS = 9216, GL_GC = 13568, GL_EG = 13824, GL_BYTES = 26624;
template <bool GLA, int W> __device__ __forceinline__ void scan_block(const Args& A, LAS unsigned char* gl, int lane, int wg, int row0, int nsub, int nvalid, int first_kind, int bsamp, int hh, int sl, bool use_v, bool write_o, f32x4 (&H)[4], float& cumtot) {
    constexpr int TPW = 16 / W, VP = GLA ? 136 : 72;
    const int c = lane, l15 = lane & 15, q = lane >> 4, t0 = wg * TPW;
    const bf16_t* PRW = (const bf16_t*)(A.ws + OFF_PRW); const bf16_t* PGLA = (const bf16_t*)(A.ws + OFF_PGLA);
    const bf16_t *EW = (const bf16_t*)((unsigned char*)A.out + OUTB_EW), *AARR = (const bf16_t*)((unsigned char*)A.out + OUTB_AARR);
    bf16_t* OUTP = GLA ? (bf16_t*)((unsigned char*)A.out + OUTB_OGL) + 128 * hh + 16 * sl + l15 : (bf16_t*)((unsigned char*)A.out + OUTB_ORW) + 64 * hh + 16 * sl + l15;
    LAS bf16_t *AT = (LAS bf16_t*)gl, *RT = (LAS bf16_t*)(gl + GL_RT), *BT = (LAS bf16_t*)(gl + GL_BT), *KT = (LAS bf16_t*)(gl + GL_KT), *VS = (LAS bf16_t*)(gl + GL_VS);
    LAS float *GC = (LAS float*)(gl + GL_GC), *EG = (LAS float*)(gl + GL_EG);
    float mu_r = 0.f, mu_k = 0.f, mu_v = 0.f, kkc = 0.f, kac = 0.f, bgc = 0.f; float wgt[16];
#pragma unroll
    for (int j = 0; j < 16; ++j) wgt[j] = 0.f;
    if (!GLA) { const float* mu = A.in[IN_MU]; mu_r = mu[64 * hh + c]; mu_k = mu[512 + 64 * hh + c]; mu_v = mu[1024 + 64 * hh + c]; kkc = A.in[IN_KK][64 * hh + c]; kac = A.in[IN_KA][64 * hh + c]; }
    else { bgc = A.in[IN_BG][64 * hh + c];
#pragma unroll
        for (int j = 0; j < 16; ++j) wgt[j] = A.in[IN_WG2][j * 256 + 64 * hh + c]; }
    float pr[2] = {0.f, 0.f}, pk[2] = {0.f, 0.f}, pvv[2] = {0.f, 0.f}; bf16_t r0[2][TPW], r1[2][TPW], r2[2][TPW], r3[2][TPW], r4[2][TPW]; unsigned rvv[2][TPW]; u32x4 lg0[2][TPW], lg1[2][TPW];
#pragma unroll
    for (int p = 0; p < 2; ++p)
#pragma unroll
        for (int i = 0; i < TPW; ++i) { r0[p][i] = r1[p][i] = r2[p][i] = r3[p][i] = r4[p][i] = 0; rvv[p][i] = 0u; lg0[p][i] = (u32x4){0u, 0u, 0u, 0u}; lg1[p][i] = lg0[p][i]; }
#define SB_LOAD(SC, P) do { const int nv_ = ((SC) == nsub - 1) ? nvalid : 16; \
        if (!GLA) { if ((SC) == 0 && t0 == 0) { pr[P] = pk[P] = pvv[P] = 0.f; if (first_kind == 0) { const bf16_t* p = PRW + (size_t)(row0 - 1) * NPRW + 64 * hh + c; pr[P] = bf2f(p[0]); pk[P] = bf2f(p[512]); pvv[P] = bf2f(p[1024]); } \
                        else if (first_kind == 2) { const float* st = A.in[IN_ST_SHIFT] + (size_t)bsamp * 1792 + 64 * hh + c; pr[P] = st[0]; pk[P] = st[512]; pvv[P] = st[1024]; } } \
                    else if (t0 < nv_) { const bf16_t* p = PRW + (size_t)(row0 + 16 * (SC) + t0 - 1) * NPRW + 64 * hh + c; pr[P] = bf2f(p[0]); pk[P] = bf2f(p[512]); pvv[P] = bf2f(p[1024]); } } \
        _Pragma("unroll") for (int i = 0; i < TPW; ++i) if (t0 + i < nv_) { const size_t ro = (size_t)(row0 + 16 * (SC) + t0 + i); \
            if (!GLA) { const bf16_t* p = PRW + ro * NPRW + 64 * hh + c; r0[P][i] = p[0]; r1[P][i] = p[512]; r2[P][i] = p[1024]; r3[P][i] = EW[ro * 512 + 64 * hh + c]; r4[P][i] = AARR[ro * 512 + 64 * hh + c]; } \
            else { const bf16_t* p = PGLA + ro * NPGLA; r0[P][i] = p[64 * hh + c]; r1[P][i] = p[256 + 64 * hh + c]; rvv[P][i] = *(const unsigned*)(p + 512 + 128 * hh + 2 * lane); lg0[P][i] = *(const u32x4*)(p + 1024); lg1[P][i] = *(const u32x4*)(p + 1032); } } } while (0)
#define SB_EG(SC, P) do { const int nv_ = ((SC) == nsub - 1) ? nvalid : 16; LAS float* eg_ = EG + (P) * 1024; float tot_ = 0.f; \
        _Pragma("unroll") for (int i = 0; i < TPW; ++i) { float ev = 0.f; if (t0 + i < nv_) { if (!GLA) ev = bf2f(r3[P][i]); else { float lga[16], t8[8]; unpack8(lg0[P][i], t8); _Pragma("unroll") for (int j = 0; j < 8; ++j) lga[j] = t8[j]; \
                unpack8(lg1[P][i], t8); _Pragma("unroll") for (int j = 0; j < 8; ++j) lga[8 + j] = t8[j]; float z = bgc; _Pragma("unroll") for (int j = 0; j < 16; ++j) z += lga[j] * wgt[j]; ev = fsoftplus(-z) * 0.0625f; } } \
            eg_[(t0 + i) * 64 + c] = ev; tot_ += ev; } \
        WT[((P) * 8 + wg) * 64 + c] = tot_; } while (0)
#define SB_ITER(SC, P) do { const int sc = (SC); const int nv = (sc == nsub - 1) ? nvalid : 16; \
        __syncthreads();                                                         \
        { const LAS float* eg = EG + (P) * 1024; float cum = 0.f; \
          _Pragma("unroll") for (int w2 = 0; w2 < W - 1; ++w2) { const float tw = WT[((P) * 8 + w2) * 64 + c]; cum += (w2 < wg) ? tw : 0.f; } \
          _Pragma("unroll") for (int i = 0; i < TPW; ++i) { const int t = t0 + i; \
            if (t < nv) { \
                const float gp = __expf(-cum); cum += eg[t * 64 + c]; const float g = __expf(-cum), e = __expf(cum); \
                if (!GLA) { \
                    const float cr = bf2f(r0[P][i]), ck = bf2f(r1[P][i]), cv = bf2f(r2[P][i]), a = bf2f(r4[P][i]); \
                    const float xr = cr + (pr[P] - cr) * mu_r, xk = ck + (pk[P] - ck) * mu_k, xv = cv + (pvv[P] - cv) * mu_v; pr[P] = cr; pk[P] = ck; pvv[P] = cv; \
                    const float kkv = xk * kkc, ss = wave_allsum(kkv * kkv), kk = kkv * __builtin_amdgcn_rcpf(fmaxf(sqrtf(ss), 1e-12f)); \
                    const unsigned w01 = pk2(-kk * gp, xr * g), w23 = pk2(kk * a * e, xk * (1.f + (a - 1.f) * kac) * e); \
                    AT[t * SP + c] = (bf16_t)(w01 & 0xffffu); RT[t * SP + c] = (bf16_t)(w01 >> 16); BT[t * SP + c] = (bf16_t)(w23 & 0xffffu); KT[t * SP + c] = (bf16_t)(w23 >> 16); \
                    VS[t * VP + c] = (bf16_t)f2bf(xv); \
                } else { \
                    const unsigned w01 = pk2(bf2f(r0[P][i]) * 0.125f * g, bf2f(r1[P][i]) * e); \
                    RT[t * SP + c] = (bf16_t)(w01 & 0xffffu); KT[t * SP + c] = (bf16_t)(w01 >> 16); \
                    *(LAS unsigned*)(VS + t * VP + 2 * lane) = rvv[P][i]; \
                } \
            } else { \
                if (!GLA) { AT[t * SP + c] = 0; BT[t * SP + c] = 0; VS[t * VP + c] = 0; } else *(LAS unsigned*)(VS + t * VP + 2 * lane) = 0u; \
                RT[t * SP + c] = 0; KT[t * SP + c] = 0; \
            } \
          } \
          if (wg == W - 1) { GC[c] = __expf(-cum); cumtot += cum; } \
        } \
        if (sc + 2 < nsub) SB_LOAD(sc + 2, P); \
        __syncthreads();                                                         \
        scan_matrix_part<GLA, VP>(AT, RT, BT, KT, VS, GC, OUTP, l15, q, sl, use_v, write_o, row0 + 16 * sc, nv, H); \
        if (sc + 1 < nsub) SB_EG(sc + 1, 1 - (P)); } while (0)
    LAS float* WT = EG + 2048;
    SB_LOAD(0, 0); if (nsub > 1) SB_LOAD(1, 1); SB_EG(0, 0);
    for (int sc2 = 0; sc2 < nsub; sc2 += 2) { SB_ITER(sc2, 0); if (sc2 + 1 < nsub) SB_ITER(sc2 + 1, 1); }
#undef SB_LOAD
#undef SB_EG
#undef SB_ITER
}
constexpr int GP = 264;
__device__ __forceinline__ void gla_pass1_item(const Args& A, LAS unsigned char* lds, int wave, int lane, int b, int hh, int cc, int ig) {
    const bf16_t* PGLA = (const bf16_t*)(A.ws + OFF_PGLA);
    LAS bf16_t* KHT = (LAS bf16_t*)lds; LAS bf16_t* VT = KHT + 64 * GP; LAS float* WT = (LAS float*)(lds + (64 + 128) * GP * 2);
    const int c = lane, l15 = lane & 15, q = lane >> 4, row0 = b * 2048 + cc * 256 + 32 * wave;
    float wgt[16]; const float bgc = A.in[IN_BG][64 * hh + c];
#pragma unroll
    for (int j = 0; j < 16; ++j) wgt[j] = A.in[IN_WG2][j * 256 + 64 * hh + c];
    float cum[32]; float run = 0.f;
#pragma unroll
    for (int tb = 0; tb < 32; tb += 8) {
        u32x4 g0[8], g1[8];
#pragma unroll
        for (int j = 0; j < 8; ++j) { const bf16_t* p = PGLA + (size_t)(row0 + tb + j) * NPGLA; g0[j] = *(const u32x4*)(p + 1024); g1[j] = *(const u32x4*)(p + 1032); }
#pragma unroll
        for (int j = 0; j < 8; ++j) { float lga[16], t8[8];
            unpack8(g0[j], t8);
#pragma unroll
            for (int i = 0; i < 8; ++i) lga[i] = t8[i];
            unpack8(g1[j], t8);
#pragma unroll
            for (int i = 0; i < 8; ++i) lga[8 + i] = t8[i];
            float z = bgc;
#pragma unroll
            for (int i = 0; i < 16; ++i) z += lga[i] * wgt[i];
            run += fsoftplus(-z) * 0.0625f; cum[tb + j] = run; }
    }
    __syncthreads();
    WT[wave * 64 + c] = run;
    __syncthreads();
    float after = 0.f, tot = 0.f;
#pragma unroll
    for (int w2 = 0; w2 < 8; ++w2) { const float tw = WT[w2 * 64 + c]; tot += tw; after += (w2 > wave) ? tw : 0.f; }
#pragma unroll
    for (int tb = 0; tb < 32; tb += 16) {
        bf16_t rk[16]; unsigned rv[16];
#pragma unroll
        for (int j = 0; j < 16; ++j) { const bf16_t* p = PGLA + (size_t)(row0 + tb + j) * NPGLA; rk[j] = p[256 + 64 * hh + c]; rv[j] = *(const unsigned*)(p + 512 + 128 * hh + 2 * lane); }
#pragma unroll
        for (int j = 0; j < 16; ++j) { const int t = tb + j;
            KHT[c * GP + 32 * wave + t] = (bf16_t)f2bf(bf2f(rk[j]) * __expf(-(after + (run - cum[t]))));
            VT[(2 * lane) * GP + 32 * wave + t] = (bf16_t)(rv[j] & 0xffffu); VT[(2 * lane + 1) * GP + 32 * wave + t] = (bf16_t)(rv[j] >> 16); }
    }
    __syncthreads();
    f32x4 acc[4];
#pragma unroll
    for (int kt = 0; kt < 4; ++kt) acc[kt] = (f32x4){0.f, 0.f, 0.f, 0.f};
#pragma unroll
    for (int ks = 0; ks < 8; ++ks) { const bf16x8 bv = *(const LAS bf16x8*)(VT + (16 * wave + l15) * GP + 32 * ks + 8 * q);
#pragma unroll
        for (int kt = 0; kt < 4; ++kt) { const bf16x8 av = *(const LAS bf16x8*)(KHT + (16 * kt + l15) * GP + 32 * ks + 8 * q); acc[kt] = MFMA32(av, bv, acc[kt]); } }
    float* dst = (float*)(A.ws + OFF_GL) + (size_t)ig * 8192 + 16 * wave + l15;
#pragma unroll
    for (int kt = 0; kt < 4; ++kt)
#pragma unroll
        for (int i = 0; i < 4; ++i) dst[(16 * kt + 4 * q + i) * 128] = acc[kt][i];
    if (wave == 7) ((float*)(A.ws + OFF_GG))[ig * 64 + lane] = __expf(-tot);
}
__device__ __forceinline__ void rwkv_sample_iter(const Args& A, LAS unsigned char* lds, int wave, int lane, int sbi) {
    const int l15 = lane & 15, q = lane >> 4;
    f32x4 H[4]; float cumtot = 0.f;
    const int item = 2 * sbi + (wave >> 2), sl = wave & 3, hh = item & 7, b = item >> 3;
    const float* st = A.in[IN_ST_WKV] + (((size_t)b * 8 + hh) * 64 + 16 * sl + l15) * 64 + 4 * q;
#pragma unroll
    for (int kt = 0; kt < 4; ++kt) H[kt] = *(const f32x4*)(st + 16 * kt);
    scan_block<false, 4>(A, lds + (wave >> 2) * GL_BYTES, lane, wave & 3, MP + b * 8, 1, 8, 2, b, hh, sl, true, true, H, cumtot);
    float* o = A.out + OUT_WKV_S + (((size_t)b * 8 + hh) * 64 + 16 * sl + l15) * 64 + 4 * q;
#pragma unroll
    for (int kt = 0; kt < 4; ++kt) *(f32x4*)(o + 16 * kt) = H[kt];
}
__device__ __forceinline__ void p2x_scan1(const Args& A, LAS unsigned char* lds, int wave, int lane) {
    const int l15 = lane & 15, q = lane >> 4;
    for (int it = blockIdx.x; it < 448; it += gridDim.x) {
        f32x4 H[4]; float cumtot = 0.f;
        if (it < 448) {
            const int seq = it / 7, cc = it - seq * 7, b = seq >> 3, hh = seq & 7; const bool isT = wave >= 4; const int sl = wave & 3;
#pragma unroll
            for (int kt = 0; kt < 4; ++kt)
#pragma unroll
                for (int i = 0; i < 4; ++i) H[kt][i] = (isT && (16 * kt + 4 * q + i == 16 * sl + l15)) ? 1.f : 0.f;
            scan_block<false, 8>(A, lds, lane, wave, b * 2048 + cc * 256, 16, 16, cc == 0 ? 1 : 0, 0, hh, sl, !isT, false, H, cumtot);
            float* dst = (float*)(A.ws + OFF_RLT) + (size_t)it * 8192 + (isT ? 4096 : 0) + 16 * sl + l15;
#pragma unroll
            for (int kt = 0; kt < 4; ++kt)
#pragma unroll
                for (int i = 0; i < 4; ++i) dst[(16 * kt + 4 * q + i) * 64] = H[kt][i];
        }
    }
    if (gridDim.x == 256 && blockIdx.x >= 192) {
        for (int sbi = (int)blockIdx.x - 192; sbi < 512; sbi += 64) rwkv_sample_iter(A, lds, wave, lane, sbi);
    }
    __syncthreads();
}
__device__ __forceinline__ void p2y_scan2(const Args& A, LAS unsigned char* lds, int wave, int lane) {
    const int l15 = lane & 15, q = lane >> 4;
    for (int bi = blockIdx.x; bi < 256 + 256 + 512 + 512; bi += gridDim.x) {
        f32x4 H[4]; float cumtot = 0.f;
#pragma unroll
        for (int kt = 0; kt < 4; ++kt) H[kt] = (f32x4){0.f, 0.f, 0.f, 0.f};
        if (bi < 256) {
            const int item = 2 * bi + (wave >> 2), sl = wave & 3, cc = item & 7, seq = item >> 3, b = seq >> 3, hh = seq & 7;
#pragma unroll 2
            for (int j = 0; j < cc; ++j) {
                const float* Lj = (const float*)(A.ws + OFF_RLT) + (size_t)(seq * 7 + j) * 8192; const float* Tj = Lj + 4096;
                const bf16x8 hb0 = hfrag(H[0], H[1]), hb1 = hfrag(H[2], H[3]);
#pragma unroll
                for (int kt = 0; kt < 4; ++kt) {
                    f32x4 acc;
#pragma unroll
                    for (int i = 0; i < 4; ++i) acc[i] = Lj[(16 * kt + 4 * q + i) * 64 + 16 * sl + l15];
                    const float* tr = Tj + (16 * kt + l15) * 64 + 4 * q;
                    const f32x4 t0 = *(const f32x4*)tr, t1 = *(const f32x4*)(tr + 16), t2 = *(const f32x4*)(tr + 32), t3 = *(const f32x4*)(tr + 48);
                    acc = MFMA32(hfrag(t0, t1), hb0, acc); acc = MFMA32(hfrag(t2, t3), hb1, acc);
                    H[kt] = acc;
                }
            }
            scan_block<false, 4>(A, lds + (wave >> 2) * GL_BYTES, lane, wave & 3, b * 2048 + cc * 256, 16, 16, cc == 0 ? 1 : 0, 0, hh, sl, true, true, H, cumtot);
            if (cc == 7) { float* o = A.out + OUT_WKV_P + (((size_t)b * 8 + hh) * 64 + 16 * sl + l15) * 64 + 4 * q;
#pragma unroll
                for (int kt = 0; kt < 4; ++kt) *(f32x4*)(o + 16 * kt) = H[kt]; }
        } else if (bi < 512) {
            const int item = bi - 256, sl = wave, cc = item & 7, seq = item >> 3, b = seq >> 2, hh = seq & 3;
#pragma unroll 2
            for (int j = 0; j < cc; ++j) {
                const float* Lj = (const float*)(A.ws + OFF_GL) + (size_t)(seq * 7 + j) * 8192; const float* Gj = (const float*)(A.ws + OFF_GG) + (seq * 7 + j) * 64;
#pragma unroll
                for (int kt = 0; kt < 4; ++kt)
#pragma unroll
                    for (int i = 0; i < 4; ++i) H[kt][i] = Gj[16 * kt + 4 * q + i] * H[kt][i] + Lj[(16 * kt + 4 * q + i) * 128 + 16 * sl + l15];
            }
            scan_block<true, 8>(A, lds, lane, wave, b * 2048 + cc * 256, 16, 16, 0, 0, hh, sl, true, true, H, cumtot);
            if (cc == 7) { float* o = A.out + OUT_GLA_P + (((size_t)b * 4 + hh) * 64) * 128 + 16 * sl + l15;
#pragma unroll
                for (int kt = 0; kt < 4; ++kt)
#pragma unroll
                    for (int i = 0; i < 4; ++i) o[(size_t)(16 * kt + 4 * q + i) * 128] = H[kt][i]; }
        } else if (bi < 1024) {
            if (gridDim.x != 256) rwkv_sample_iter(A, lds, wave, lane, bi - 512);
        } else {
            const int item = bi - 1024, sl = wave, hh = item & 3, b = item >> 2;
            const float* st = A.in[IN_ST_GLA] + (((size_t)b * 4 + hh) * 64) * 128 + 16 * sl + l15;
#pragma unroll
            for (int kt = 0; kt < 4; ++kt)
#pragma unroll
                for (int i = 0; i < 4; ++i) H[kt][i] = st[(size_t)(16 * kt + 4 * q + i) * 128];
            scan_block<true, 8>(A, lds, lane, wave, MP + b * 8, 1, 8, 0, b, hh, sl, true, true, H, cumtot);
            float* o = A.out + OUT_GLA_S + (((size_t)b * 4 + hh) * 64) * 128 + 16 * sl + l15;
#pragma unroll
            for (int kt = 0; kt < 4; ++kt)
#pragma unroll
                for (int i = 0; i < 4; ++i) o[(size_t)(16 * kt + 4 * q + i) * 128] = H[kt][i];
        }
    }
}
__device__ __forceinline__ void p2c_mix(const Args& A, int r, int col0, u32x4 rcur, u32x4 rprev, float (&xs)[8]) {
    float cur[8], prev[8]; unpack8(rcur, cur);
    const bool first = (r < MP) ? ((r & 2047) == 0) : (((r - MP) & 7) == 0);
    if (!first) unpack8(rprev, prev);
    else if (r < MP) {
#pragma unroll
        for (int i = 0; i < 8; ++i) prev[i] = 0.f;
    } else ld8f(A.in[IN_ST_SHIFT] + (size_t)((r - MP) >> 3) * 1792 + col0, prev);
    float mu[8]; ld8f(A.in[IN_MU] + col0, mu);
#pragma unroll
    for (int i = 0; i < 8; ++i) xs[i] = cur[i] + (prev[i] - cur[i]) * mu[i];
}
__device__ __forceinline__ void p2c_post(const Args& A, int gw, int NGW, int lane, bool shadow) {
    const bf16_t* PRW = (const bf16_t*)(A.ws + OFF_PRW); const bf16_t* PGLA = (const bf16_t*)(A.ws + OFF_PGLA);
    const bf16_t *AARR = (const bf16_t*)((unsigned char*)A.out + OUTB_AARR), *G = (const bf16_t*)(A.ws + OFF_G);
    bf16_t *ORW = (bf16_t*)((unsigned char*)A.out + OUTB_ORW), *OGL = (bf16_t*)((unsigned char*)A.out + OUTB_OGL);
    const int c0 = 8 * lane;
    for (int rb = gw; rb < M; rb += 2 * NGW) {
        u32x4 raw[2][11];
#pragma unroll
        for (int k = 0; k < 2; ++k) { const int r = (rb + k * NGW < M) ? rb + k * NGW : rb; const int rp = r > 0 ? r - 1 : 0;
            raw[k][0] = *(const u32x4*)(ORW + (size_t)r * 512 + c0); raw[k][1] = *(const u32x4*)(OGL + (size_t)r * 512 + c0);
            raw[k][2] = *(const u32x4*)(PRW + (size_t)r * NPRW + c0); raw[k][3] = *(const u32x4*)(PRW + (size_t)r * NPRW + 512 + c0); raw[k][4] = *(const u32x4*)(PRW + (size_t)r * NPRW + 1024 + c0);
            raw[k][5] = *(const u32x4*)(PRW + (size_t)rp * NPRW + c0); raw[k][6] = *(const u32x4*)(PRW + (size_t)rp * NPRW + 512 + c0); raw[k][7] = *(const u32x4*)(PRW + (size_t)rp * NPRW + 1024 + c0);
            raw[k][8] = *(const u32x4*)(AARR + (size_t)r * 512 + c0); raw[k][9] = *(const u32x4*)(G + (size_t)r * 512 + c0); raw[k][10] = *(const u32x4*)(PGLA + (size_t)r * NPGLA + 1040 + c0); }
#pragma unroll
        for (int k = 0; k < 2; ++k) { const int r = rb + k * NGW; if (r < M) {
            float o[8], d[8], xr[8], xk[8], xv[8], a[8], g[8], p[8], res[8];
            unpack8(raw[k][0], o);
            float s1 = 0.f;
#pragma unroll
            for (int i = 0; i < 8; ++i) s1 += o[i];
            const float mu = row8_allsum(s1) * (1.f / 64.f); float s2 = 0.f;
#pragma unroll
            for (int i = 0; i < 8; ++i) { d[i] = o[i] - mu; s2 += d[i] * d[i]; }
            const float rstd = rsqrtf(row8_allsum(s2) * (1.f / 64.f) + 64e-5f);
            p2c_mix(A, r, c0, raw[k][2], raw[k][5], xr); p2c_mix(A, r, 512 + c0, raw[k][3], raw[k][6], xk); p2c_mix(A, r, 1024 + c0, raw[k][4], raw[k][7], xv);
            unpack8(raw[k][8], a); unpack8(raw[k][9], g);
            float bs = 0.f; ld8f(A.in[IN_KA] + c0, p);
#pragma unroll
            for (int i = 0; i < 8; ++i) d[i] *= rstd, xk[i] = xk[i] * (1.f + (a[i] - 1.f) * p[i]);
            ld8f(A.in[IN_RK] + c0, p);
#pragma unroll
            for (int i = 0; i < 8; ++i) bs += xr[i] * xk[i] * p[i];
            bs = row8_allsum(bs);
            ld8f(A.in[IN_LNW] + c0, p); ld8f(A.in[IN_LNB] + c0, a);
#pragma unroll
            for (int i = 0; i < 8; ++i) res[i] = ((d[i] * p[i] + a[i]) + bs * xv[i]) * g[i];
            if (!shadow) *(u32x4*)(ORW + (size_t)r * 512 + c0) = pack8(res); else *(u32x4*)((bf16_t*)(A.ws + 240 * MiB) + (size_t)(r & 8191) * 512 + c0) = pack8(res);
            unpack8(raw[k][1], o);
            float ms = 0.f;
#pragma unroll
            for (int i = 0; i < 8; ++i) ms += o[i] * o[i];
            const float rs = rsqrtf(row16_allsum(ms) * (1.f / 128.f) + NORM_EPS);
            unpack8(raw[k][10], g); ld8f(A.in[IN_GNW] + (c0 & 127), p);
#pragma unroll
            for (int i = 0; i < 8; ++i) res[i] = o[i] * rs * p[i] * (g[i] * fsigmoid(g[i]));
            if (!shadow) *(u32x4*)(OGL + (size_t)r * 512 + c0) = pack8(res); else *(u32x4*)((bf16_t*)(A.ws + 248 * MiB) + (size_t)(r & 8191) * 512 + c0) = pack8(res);
        } }
    }
}
__device__ __forceinline__ void p6_act(const Args& A, int gtid, int NGT) {
    bf16_t* U = (bf16_t*)(A.ws + OFF_U); const bf16_t* UH = (const bf16_t*)(A.ws + OFF_UH);
    const float *convw = A.in[IN_CONVW], *convb = A.in[IN_CONVB], *cstate = A.in[IN_ST_CONV];
    for (int item = gtid; item < (M / 64) * 352; item += NGT) {
        const int rb = item / 352, jc = (item - rb * 352) * 8, r0 = rb * 64; const bool sample = r0 >= MP;
        float p1v[8], p2v[8], p1g[8], p2g[8], w0v[8], w1v[8], w2v[8], cbv[8], w0g[8], w1g[8], w2g[8], cbg[8];
        ld8f(convw + jc, w0v); ld8f(convw + F2 + jc, w1v); ld8f(convw + 2 * F2 + jc, w2v); ld8f(convb + jc, cbv);
        ld8f(convw + FF + jc, w0g); ld8f(convw + F2 + FF + jc, w1g); ld8f(convw + 2 * F2 + FF + jc, w2g); ld8f(convb + FF + jc, cbg);
#pragma unroll
        for (int i = 0; i < 8; ++i) p1v[i] = p2v[i] = p1g[i] = p2g[i] = 0.f;
        if (!sample && (rb & 31) != 0) { const bf16_t* q = UH + (size_t)(rb - 1) * 2 * F2; ld8bf(q + jc, p2v); ld8bf(q + FF + jc, p2g); ld8bf(q + F2 + jc, p1v); ld8bf(q + F2 + FF + jc, p1g); }
        for (int r8 = 0; r8 < 64; r8 += 8) {
            u32x4 rawv[8], rawg[8];
#pragma unroll
            for (int k = 0; k < 8; ++k) { const bf16_t* row = U + (size_t)(r0 + r8 + k) * F2; rawv[k] = *(const u32x4*)(row + jc); rawg[k] = *(const u32x4*)(row + FF + jc); }
            if (sample) { const float* st = cstate + (size_t)((r0 + r8 - MP) >> 3) * 2 * F2; ld8f(st + jc, p2v); ld8f(st + FF + jc, p2g); ld8f(st + F2 + jc, p1v); ld8f(st + F2 + FF + jc, p1g); }
#pragma unroll
            for (int k = 0; k < 8; ++k) {
                float cv[8], cg[8], res[8]; unpack8(rawv[k], cv); unpack8(rawg[k], cg);
#pragma unroll
                for (int i = 0; i < 8; ++i) { const float v = cbv[i] + w0v[i] * p2v[i] + w1v[i] * p1v[i] + w2v[i] * cv[i], gg = cbg[i] + w0g[i] * p2g[i] + w1g[i] * p1g[i] + w2g[i] * cg[i];
                    res[i] = gelu_gate(gg, v); p2v[i] = p1v[i]; p1v[i] = cv[i]; p2g[i] = p1g[i]; p1g[i] = cg[i]; }
                *(u32x4*)(U + (size_t)(r0 + r8 + k) * F2 + jc) = pack8(res);
            }
        }
    }
}
__device__ __forceinline__ void pfix_act(const Args& A, int gtid, int NGT) {
    const bf16_t* UH = (const bf16_t*)(A.ws + OFF_UH); const bf16_t* US = (const bf16_t*)(A.ws + OFF_US); bf16_t* ACT = (bf16_t*)(A.ws + OFF_ACT);
    const float *convw = A.in[IN_CONVW], *convb = A.in[IN_CONVB], *cstate = A.in[IN_ST_CONV];
    for (int idx = gtid; idx < (256 + 128) * 2 * 352; idx += NGT) {
        const int g = idx / 704, rem = idx - g * 704, rsel = rem / 352, jc = (rem - rsel * 352) * 8;
        float cv[8], cg[8], p1v[8], p1g[8], p2v[8], p2g[8], res[8]; int orow;
#pragma unroll
        for (int i = 0; i < 8; ++i) p1v[i] = p1g[i] = p2v[i] = p2g[i] = 0.f;
        if (g < 256) {
            const bool seq0 = (g & 31) == 0; orow = 64 * g + rsel;
            ld8bf(UH + ((size_t)g * 4 + rsel) * F2 + jc, cv); ld8bf(UH + ((size_t)g * 4 + rsel) * F2 + FF + jc, cg);
            if (rsel == 0) { if (!seq0) { const bf16_t* q = UH + ((size_t)(g - 1) * 4 + 3) * F2; ld8bf(q + jc, p1v); ld8bf(q + FF + jc, p1g); q -= F2; ld8bf(q + jc, p2v); ld8bf(q + FF + jc, p2g); } }
            else { const bf16_t* q = UH + ((size_t)g * 4) * F2; ld8bf(q + jc, p1v); ld8bf(q + FF + jc, p1g);
                if (!seq0) { q = UH + ((size_t)(g - 1) * 4 + 3) * F2; ld8bf(q + jc, p2v); ld8bf(q + FF + jc, p2g); } }
        } else {
            const int sb = g - 256; orow = MP + 8 * sb + rsel; const float* st = cstate + (size_t)sb * 2 * F2;
            ld8bf(US + ((size_t)sb * 2 + rsel) * F2 + jc, cv); ld8bf(US + ((size_t)sb * 2 + rsel) * F2 + FF + jc, cg);
            if (rsel == 0) { ld8f(st + jc, p2v); ld8f(st + FF + jc, p2g); ld8f(st + F2 + jc, p1v); ld8f(st + F2 + FF + jc, p1g); }
            else { ld8f(st + F2 + jc, p2v); ld8f(st + F2 + FF + jc, p2g); ld8bf(US + ((size_t)sb * 2) * F2 + jc, p1v); ld8bf(US + ((size_t)sb * 2) * F2 + FF + jc, p1g); }
        }
#pragma unroll
        for (int i = 0; i < 8; ++i) { const int col = jc + i;
            const float v = convb[col] + convw[col] * p2v[i] + convw[F2 + col] * p1v[i] + convw[2 * F2 + col] * cv[i];
            const float gg = convb[FF + col] + convw[FF + col] * p2g[i] + convw[F2 + FF + col] * p1g[i] + convw[2 * F2 + FF + col] * cg[i];
            res[i] = gelu_gate(gg, v); }
        *(u32x4*)(ACT + (size_t)orow * FF + jc) = pack8(res);
    }
}
__device__ __forceinline__ void p8_final(const Args& A, int gw, int NGW, int lane, float* dst) {
    const float* gf = A.in[IN_NORM_FINAL]; const bf16_t* X2 = (const bf16_t*)(A.ws + OFF_X1B);
    for (int m = gw; m < M; m += 2 * NGW) {
        const int m2 = m + NGW; const bool has2 = m2 < M;
        const u32x2* xr = (const u32x2*)(X2 + (size_t)m * DM) + lane; const u32x2* xr2 = (const u32x2*)(X2 + (size_t)(has2 ? m2 : m) * DM) + lane; u32x2 rv[4], rw[4]; f32x4 v[4], w[4]; float s = 0.f, s2 = 0.f;
#pragma unroll
        for (int j = 0; j < 4; ++j) { rv[j] = xr[64 * j]; rw[j] = xr2[64 * j]; }
#pragma unroll
        for (int j = 0; j < 4; ++j) { v[j] = (f32x4){bf_lo(rv[j].x), bf_hi(rv[j].x), bf_lo(rv[j].y), bf_hi(rv[j].y)}; w[j] = (f32x4){bf_lo(rw[j].x), bf_hi(rw[j].x), bf_lo(rw[j].y), bf_hi(rw[j].y)};
            s += (v[j].x * v[j].x + v[j].y * v[j].y) + (v[j].z * v[j].z + v[j].w * v[j].w); s2 += (w[j].x * w[j].x + w[j].y * w[j].y) + (w[j].z * w[j].z + w[j].w * w[j].w); }
        const float rstd = rsqrtf(wave_allsum(s) * (1.f / DM) + NORM_EPS), rstd2 = rsqrtf(wave_allsum(s2) * (1.f / DM) + NORM_EPS);
#pragma unroll
        for (int j = 0; j < 4; ++j) { const f32x4 g = *((const f32x4*)gf + lane + 64 * j); ((f32x4*)(dst + (size_t)m * DM) + lane)[64 * j] = v[j] * rstd * g; if (has2) ((f32x4*)(dst + (size_t)m2 * DM) + lane)[64 * j] = w[j] * rstd2 * g; }
    }
}

#ifndef PHMASK
#define PHMASK 0xFFFF
#endif
#ifndef PHREP
#define PHREP 0
#endif
#define PH(k) for (int rep_ = 0; rep_ < ((((PHMASK) >> (k)) & 1) ? ((((PHREP) >> (k)) & 1) ? 2 : 1) : 0); ++rep_)
__global__ void __launch_bounds__(NTHREADS, 2) fwd_megakernel(Args A) {
    extern __shared__ __attribute__((aligned(16))) unsigned char lds_raw[];
    LAS unsigned char* lds = (LAS unsigned char*)lds_raw;
    cg::grid_group grid = cg::this_grid();
    const int tid = threadIdx.x, lane = tid & 63, wave = __builtin_amdgcn_readfirstlane(tid >> 6);
    const int G = gridDim.x, gw = blockIdx.x * NWAVES + wave, NGW = G * NWAVES;
    unsigned char* ws = A.ws;
    if (tid < 4) ((LAS unsigned*)(lds + 131072))[tid] = 0u;
    __syncthreads();
    const XcdBarrier xbar = xcd_barrier_post((unsigned*)(ws + OFF_BAR), (volatile LAS unsigned*)(lds + 131072));
#define GSYNC() xcd_barrier(xbar)
    PH(0) p0_prologue(A, lds, gw, NGW, wave, lane);
    if (A.ws == nullptr) grid.sync();
    GSYNC();
    PH(1) { pg8::Gemm g{(const bf16_t*)((unsigned char*)A.out + OUTB_H), (const bf16_t*)(ws + OFF_WIN), M, NIN, 1024, 1024}; pg8::StaticOrder S; S.init(M, NIN, G, (int)blockIdx.x);
      EpiProj E{(bf16_t*)(ws + OFF_PRW), (bf16_t*)(ws + OFF_PGLA), (bf16_t*)(ws + OFF_PGATE), A.out + OUT_SHIFT_P, A.out + OUT_SHIFT_S};
      pg8::gemm_phase<EpiProj, pg8::StaticOrder, true, true>(lds, g, S, E); }
    GSYNC();
    PH(2) p2a_lora(A, lds, gw, NGW, wave, lane);
    PH(2) { for (int ig = (int)gridDim.x - 1 - (int)blockIdx.x; ig < 224; ig += (int)gridDim.x) { const int seq = ig / 7, cc = ig - seq * 7; gla_pass1_item(A, lds, wave, lane, seq >> 2, seq & 3, cc, ig); }
      __syncthreads(); }
    GSYNC();
    PH(3) p2x_scan1(A, lds, wave, lane);
    GSYNC();
    PH(11) p2y_scan2(A, lds, wave, lane);
    GSYNC();
#ifdef SHADOW_P2C
    p2c_post(A, gw, NGW, lane, true);
#endif
    PH(4) p2c_post(A, gw, NGW, lane, false);
    GSYNC();
    PH(5) { pg8::StaticOrder S; S.init(M, 1024, G, (int)blockIdx.x); S.limit = __builtin_amdgcn_readfirstlane((S.nwg / G) * G);
      { pg8::Gemm g{(const bf16_t*)((unsigned char*)A.out + OUTB_ORW), (const bf16_t*)(ws + OFF_WOA), M, 1024, 512, 512};
        EpiGate<true> E{(bf16_t*)(ws + OFF_MERGED), (const bf16_t*)(ws + OFF_PGATE)};
        pg8::gemm_phase<EpiGate<true>, pg8::StaticOrder, true, true>(lds, g, S, E);
        tail_gemm(lds, (const bf16_t*)((unsigned char*)A.out + OUTB_ORW), 512, (const bf16_t*)(ws + OFF_WOA), 512, S, wave, lane, TfGate{true, (bf16_t*)(ws + OFF_MERGED), (const bf16_t*)(ws + OFF_PGATE)}); }
      { pg8::Gemm g{(const bf16_t*)((unsigned char*)A.out + OUTB_OGL), (const bf16_t*)(ws + OFF_WOB), M, 1024, 512, 512};
        EpiGate<false> E{(bf16_t*)(ws + OFF_MERGED), (const bf16_t*)(ws + OFF_PGATE) + 1024};
        pg8::gemm_phase<EpiGate<false>, pg8::StaticOrder, true, true>(lds, g, S, E);
        tail_gemm(lds, (const bf16_t*)((unsigned char*)A.out + OUTB_OGL), 512, (const bf16_t*)(ws + OFF_WOB), 512, S, wave, lane, TfGate{false, (bf16_t*)(ws + OFF_MERGED), (const bf16_t*)(ws + OFF_PGATE) + 1024}); } }
    GSYNC();
    PH(6) { pg8::Gemm g{(const bf16_t*)(ws + OFF_MERGED), (const bf16_t*)(ws + OFF_WO), M, 1024, 1024, 1024}; pg8::StaticOrder S; S.init(M, 1024, G, (int)blockIdx.x); S.limit = __builtin_amdgcn_readfirstlane((S.nwg / G) * G);
#ifdef SHADOW_G3
      float* rss = (rep_ == 0) ? (float*)(ws + OFF_ROWSS + 256 * 1024) : (float*)(ws + OFF_ROWSS);
#else
      float* rss = (float*)(ws + OFF_ROWSS);
#endif
      EpiX1 E{A.in[IN_XP], A.in[IN_XS], A.out, (bf16_t*)(ws + OFF_X1B), rss};
      pg8::gemm_phase<EpiX1, pg8::StaticOrder, true, true>(lds, g, S, E);
      tail_gemm(lds, (const bf16_t*)(ws + OFF_MERGED), 1024, (const bf16_t*)(ws + OFF_WO), 1024, S, wave, lane, TfX1{A.in[IN_XP], A.in[IN_XS], A.out, (bf16_t*)(ws + OFF_X1B), rss}); }
    GSYNC();
    PH(7) { pg8::Gemm g{(const bf16_t*)(ws + OFF_X1B), (const bf16_t*)(ws + OFF_WUP), M, F2, 1024, 1024}; pg8::StaticOrder S; S.init(M, F2, G, (int)blockIdx.x);
      EpiAct E{(const float*)(ws + OFF_ROWSS), A.in[IN_CONVW], A.in[IN_CONVB], (bf16_t*)(ws + OFF_ACT), (bf16_t*)(ws + OFF_UH), (bf16_t*)(ws + OFF_US), A.out + OUT_CONV_P, A.out + OUT_CONV_S, (LAS float*)(lds + 131072)};
      pg8::gemm_phase<EpiAct, pg8::StaticOrder, true, true>(lds, g, S, E); }
    __syncthreads(); if (tid < 4) ((LAS unsigned*)(lds + 131072))[tid] = 0u; __syncthreads();
    GSYNC();
    PH(8) pfix_act(A, blockIdx.x * NTHREADS + tid, G * NTHREADS);
    GSYNC();
    PH(9) { pg8::Gemm g{(const bf16_t*)(ws + OFF_ACT), (const bf16_t*)(ws + OFF_WDN), M, 1024, FF, FF}; pg8::StaticOrder S; S.init(M, 1024, G, (int)blockIdx.x); S.limit = __builtin_amdgcn_readfirstlane((S.nwg / G) * G);
      EpiX2 E{(bf16_t*)(ws + OFF_X1B)};
      pg8::gemm_phase<EpiX2, pg8::StaticOrder, true, true>(lds, g, S, E);
      tail_gemm(lds, (const bf16_t*)(ws + OFF_ACT), FF, (const bf16_t*)(ws + OFF_WDN), FF, S, wave, lane, TfX2{(bf16_t*)(ws + OFF_X1B)}); }
    GSYNC();
#ifdef P8_SHADOW
    p8_final(A, gw, NGW, lane, (float*)(ws + OFF_U));
#endif
    PH(10) p8_final(A, gw, NGW, lane, A.out);
#ifdef EXTRA_SYNCS
    for (int i_ = 0; i_ < EXTRA_SYNCS; ++i_) GSYNC();
#endif
}

extern "C" void kernel_launch(void* const* d_in, const int* in_sizes, int n_in, void* d_out, int out_size, void* d_ws, size_t ws_size, hipStream_t stream) {
    static int grid = 0;
    if (grid == 0) {
        int dev = 0, cus = 0, per_cu = 0;
        if (n_in != 31 || ws_size < 256 * MiB) { fprintf(stderr, "kernel_launch: unexpected n_in %d / ws_size %zu\n", n_in, ws_size); grid = -1; return; }
        (void)hipGetDevice(&dev); (void)hipDeviceGetAttribute(&cus, hipDeviceAttributeMultiprocessorCount, dev);
        if (hipFuncSetAttribute((const void*)fwd_megakernel, hipFuncAttributeMaxDynamicSharedMemorySize, LDS_BYTES) != hipSuccess) { fprintf(stderr, "kernel_launch: hipFuncSetAttribute failed\n"); grid = -1; return; }
        if (hipOccupancyMaxActiveBlocksPerMultiprocessor(&per_cu, (const void*)fwd_megakernel, NTHREADS, LDS_BYTES) != hipSuccess || per_cu < 1) { fprintf(stderr, "kernel_launch: occupancy query failed (%d)\n", per_cu); (void)hipGetLastError(); grid = -1; return; }
        grid = cus * 1;
    }
    if (grid < 0) return;
    Args a{};
    for (int i = 0; i < 31; ++i) a.in[i] = (const float*)d_in[i];
    a.out = (float*)d_out; a.ws = (unsigned char*)d_ws;
    if (hipMemsetAsync((char*)d_ws + OFF_BAR, 0, XCD_BAR_WORDS * 4, stream) != hipSuccess) { fprintf(stderr, "kernel_launch: memset of the barrier words failed\n"); return; }
    void* params[] = {&a};
    hipError_t e = hipLaunchCooperativeKernel((const void*)fwd_megakernel, dim3(grid), dim3(NTHREADS), params, LDS_BYTES, stream);
    if (e != hipSuccess) fprintf(stderr, "kernel_launch: cooperative launch failed: %s (grid %d)\n", hipGetErrorString(e), grid);
}
```

```cpp
#include <hip/hip_runtime.h>
#include <hip/hip_cooperative_groups.h>
#include <cstdio>
#include <cstdint>
namespace cg = cooperative_groups;
#define PHREP 0
namespace pg8 {
#define PG8_LAS __attribute__((address_space(3)))
typedef unsigned short bf16_t;
typedef short bf16x8 __attribute__((ext_vector_type(8)));
typedef float f32x4 __attribute__((ext_vector_type(4)));
typedef unsigned u32x4 __attribute__((ext_vector_type(4)));
constexpr int BM = 256, BK = 64, HALF = 128, HTB = HALF * BK * 2  , STAGE_BYTES = 8 * HTB, NXCD = 8, WGM = 8;

__host__ __device__ __forceinline__ int lds_byte(int r, int c) { const int st = (r >> 4) * 2 + (c >> 5), rr = r & 15, cc = c & 31, ob = rr * 64 + cc * 2; return st * 1024 + (ob ^ (((ob >> 9) & 1) << 5)); }
__host__ __device__ __forceinline__ void stage_rc(int b, int& R, int& C) { const int st = b / 1024, sb = b % 1024, swz = sb ^ (((sb >> 9) & 1) << 5); R = (st >> 1) * 16 + swz / 64; C = (st & 1) * 32 + (swz % 64) / 2; }
__host__ __device__ __forceinline__ int perm32(int rho) { const int n = rho >> 4, i = rho & 15; return 8 * (i >> 2) + 4 * n + (i & 3); }

struct Unit { int pm, pn; };
struct Gemm { const bf16_t* A; const bf16_t* Bt; int M, N, K, lda; };

struct StaticOrder {
    int nM, nN, nwg, G, c;
    int limit;
    __host__ __device__ void init(int M, int N, int G_, int c_) { nM = M / BM; nN = N / BM; nwg = nM * nN; G = G_; c = c_; limit = nwg; }
    __host__ __device__ __forceinline__ bool next(int i, Unit& u) const {
        const int L = i * G + c; if (L >= limit) return false;
        unit_of(L, u); return true;
    }
    __host__ __device__ __forceinline__ void unit_of(int L, Unit& u) const {
        int wgid = L; { const int q = nwg / NXCD, r = nwg % NXCD, xcd = wgid % NXCD, off = wgid / NXCD; wgid = (xcd < r ? xcd * (q + 1) : r * (q + 1) + (xcd - r) * q) + off; }
        const int nig = WGM * nN, gid = wgid / nig, fm = gid * WGM, gsz = (nM - fm) < WGM ? (nM - fm) : WGM;
        u.pm = fm + ((wgid % nig) % gsz); u.pn = (wgid % nig) / gsz;
    }
    __device__ __forceinline__ void a_ready(const Unit&) const {}
    __device__ __forceinline__ void done(const Unit&) const {}
};
__device__ __forceinline__ unsigned cvt_pk_bf16(float lo, float hi) { unsigned r; asm volatile("v_cvt_pk_bf16_f32 %0, %1, %2" : "=v"(r) : "v"(lo), "v"(hi)); return r; }
typedef float f32x2 __attribute__((ext_vector_type(2)));
template <class Epi, class Sched, bool ALIGN_EPI = false, bool SP2 = false>
__device__ __forceinline__ void gemm_phase(PG8_LAS unsigned char* lds, const Gemm g, const Sched& S, const Epi& E) {
    int tid_ = threadIdx.x; asm volatile("" : "+v"(tid_));
    const int tid = tid_, wid = __builtin_amdgcn_readfirstlane(tid >> 6), lane = tid & 63, wr = wid >> 2, wc = wid & 3, fr = lane & 15, fq = lane >> 4;
    const int K = g.K, nt = K / BK;
    unsigned voffA[2], voffB[2];
#pragma unroll
    for (int i = 0; i < 2; ++i) { int R, C; stage_rc(tid * 16 + i * 8192, R, C); const int Rb = Epi::PERM ? ((R & ~31) + perm32(R & 31)) : R;
        voffA[i] = (unsigned)(R * g.lda + C) * 2u; voffB[i] = (unsigned)(Rb * K + C) * 2u; }
    const size_t kstep = (size_t)(BK * 2);
    const size_t hstep = (size_t)HALF * K * 2;
    const size_t tstep = 2 * hstep;
    const size_t hstepA = (size_t)HALF * g.lda * 2, tstepA = 2 * hstepA;
    const unsigned ldsw = (unsigned)wid * 1024u;
    const int aoff = lds_byte(wr * 64 + fr, fq * 8), boff = lds_byte(wc * 32 + fr, fq * 8);
#define PG8_SA(b, h) (((b) * 2 + (h)) * HTB)
#define PG8_SB(b, h) ((4 + (b) * 2 + (h)) * HTB)
#define PG8_STAGE(bufoff, gbase, voff) do { _Pragma("unroll") for (int _i = 0; _i < 2; ++_i) \
        __builtin_amdgcn_global_load_lds((const unsigned*)((const char*)(gbase) + (voff)[_i]), (PG8_LAS unsigned*)(lds + (bufoff) + ldsw + _i * 8192), 16, 0, 0); } while (0)
#define PG8_LDA(dst, b, h) do { _Pragma("unroll") for (int m = 0; m < 4; ++m) _Pragma("unroll") for (int k = 0; k < 2; ++k) dst[m][k] = *(const PG8_LAS bf16x8*)(lds + PG8_SA(b, h) + aoff + m * 2048 + k * 1024); } while (0)
#define PG8_LDB(dst, b, h) do { _Pragma("unroll") for (int n = 0; n < 2; ++n) _Pragma("unroll") for (int k = 0; k < 2; ++k) dst[n][k] = *(const PG8_LAS bf16x8*)(lds + PG8_SB(b, h) + boff + n * 2048 + k * 1024); } while (0)
#define PG8_MMA(ai, bj, At, Bt) do { __builtin_amdgcn_s_setprio(1); _Pragma("unroll") for (int m = 0; m < 4; ++m) _Pragma("unroll") for (int n = 0; n < 2; ++n) _Pragma("unroll") for (int k = 0; k < 2; ++k) \
        acc[ai][bj][m][n] = __builtin_amdgcn_mfma_f32_16x16x32_bf16(Bt[n][k], At[m][k], acc[ai][bj][m][n], 0, 0, 0); __builtin_amdgcn_s_setprio(0); } while (0)
#define PG8_WAIT_V(n) asm volatile("s_waitcnt vmcnt(" #n ")" ::: "memory")
#define PG8_WAIT_L(n) asm volatile("s_waitcnt lgkmcnt(" #n ")" ::: "memory")
#define PG8_BAR __builtin_amdgcn_s_barrier()
#define PG8_SCHED __builtin_amdgcn_sched_barrier(0)
    Unit cur, nxt; int ui = 0;
    if (!S.next(0, cur)) return;
    f32x4 acc[2][2][4][2];
#pragma unroll
    for (int a = 0; a < 2; ++a)
#pragma unroll
        for (int b = 0; b < 2; ++b)
#pragma unroll
            for (int m = 0; m < 4; ++m)
#pragma unroll
                for (int n = 0; n < 2; ++n) acc[a][b][m][n] = (f32x4){0.f, 0.f, 0.f, 0.f};
    bf16x8 At[4][2], B0[2][2], B1[2][2];
    const char* cA = (const char*)g.A + (size_t)cur.pm * tstepA; const char* cB = (const char*)g.Bt + (size_t)cur.pn * tstep;
    S.a_ready(cur);
    if constexpr (SP2) {
        PG8_STAGE(PG8_SB(0, 0), cB, voffB); PG8_STAGE(PG8_SB(0, 1), cB + hstep, voffB); PG8_STAGE(PG8_SA(0, 0), cA, voffA); PG8_STAGE(PG8_SA(0, 1), cA + hstepA, voffA);
        if (wr == 1) PG8_BAR;
        PG8_WAIT_V(2); PG8_BAR;
        PG8_STAGE(PG8_SB(1, 0), cB + kstep, voffB); PG8_STAGE(PG8_SA(1, 0), cA + kstep, voffA); PG8_STAGE(PG8_SB(1, 1), cB + hstep + kstep, voffB);
        PG8_WAIT_V(6); PG8_BAR;
    } else {
        PG8_STAGE(PG8_SB(0, 0), cB, voffB); PG8_STAGE(PG8_SA(0, 0), cA, voffA); PG8_STAGE(PG8_SB(0, 1), cB + hstep, voffB); PG8_STAGE(PG8_SA(0, 1), cA + hstepA, voffA);
        if (wr == 1) PG8_BAR;
        PG8_WAIT_V(4); PG8_BAR;
        PG8_STAGE(PG8_SB(1, 0), cB + kstep, voffB); PG8_STAGE(PG8_SA(1, 0), cA + kstep, voffA); PG8_STAGE(PG8_SB(1, 1), cB + hstep + kstep, voffB);
        PG8_WAIT_V(6); PG8_BAR;
    }
    for (;;) {
        const bool has_next = S.next(ui + 1, nxt);
        const char* nA = has_next ? (const char*)g.A + (size_t)nxt.pm * tstepA : cA; const char* nB = has_next ? (const char*)g.Bt + (size_t)nxt.pn * tstep : cB;
        for (int t = 0; t < nt; t += 2) {
            const bool last = (t == nt - 2);
            const char* a1 = cA + (size_t)(t + 1) * kstep;
            const char* a2 = last ? nA : cA + (size_t)(t + 2) * kstep; const char* b2 = last ? nB : cB + (size_t)(t + 2) * kstep;
            const char* a3 = a2 + kstep; const char* b3 = b2 + kstep;
            if (last && has_next) S.a_ready(nxt);
            if constexpr (SP2) {
            PG8_LDB(B0, 0, 0); PG8_LDB(B1, 0, 1); PG8_SCHED; PG8_LDA(At, 0, 0); PG8_STAGE(PG8_SA(1, 1), a1 + hstepA, voffA);
            PG8_WAIT_V(8); PG8_WAIT_L(0); PG8_BAR; PG8_MMA(0, 0, At, B0); PG8_MMA(0, 1, At, B1); PG8_BAR; PG8_SCHED;
            PG8_LDA(At, 0, 1); PG8_STAGE(PG8_SB(0, 0), b2, voffB); PG8_STAGE(PG8_SB(0, 1), b2 + hstep, voffB); PG8_STAGE(PG8_SA(0, 0), a2, voffA);
            PG8_WAIT_V(8); PG8_WAIT_L(0); PG8_BAR; PG8_MMA(1, 0, At, B0); PG8_MMA(1, 1, At, B1); PG8_BAR; PG8_SCHED;
            PG8_LDB(B0, 1, 0); PG8_LDB(B1, 1, 1); PG8_SCHED; PG8_LDA(At, 1, 0); PG8_STAGE(PG8_SA(0, 1), a2 + hstepA, voffA);
            PG8_WAIT_V(8); PG8_WAIT_L(0); PG8_BAR; PG8_MMA(0, 0, At, B0); PG8_MMA(0, 1, At, B1); PG8_BAR; PG8_SCHED;
            PG8_LDA(At, 1, 1); PG8_STAGE(PG8_SB(1, 0), b3, voffB); PG8_STAGE(PG8_SB(1, 1), b3 + hstep, voffB); PG8_STAGE(PG8_SA(1, 0), a3, voffA);
            PG8_WAIT_V(8); PG8_WAIT_L(0); PG8_BAR; PG8_MMA(1, 0, At, B0); PG8_MMA(1, 1, At, B1); PG8_BAR; PG8_SCHED;
            } else {
            PG8_LDB(B0, 0, 0); PG8_SCHED; PG8_LDA(At, 0, 0); PG8_STAGE(PG8_SA(1, 1), a1 + hstepA, voffA);
            PG8_WAIT_L(8); PG8_BAR; PG8_WAIT_L(0); PG8_MMA(0, 0, At, B0); PG8_BAR; PG8_SCHED;
            PG8_LDB(B1, 0, 1); PG8_STAGE(PG8_SB(0, 0), b2, voffB);
            PG8_BAR; PG8_WAIT_L(0); PG8_MMA(0, 1, At, B1); PG8_BAR;
            PG8_LDA(At, 0, 1); PG8_STAGE(PG8_SA(0, 0), a2, voffA);
            PG8_BAR; PG8_WAIT_L(0); PG8_MMA(1, 0, At, B0); PG8_BAR; PG8_SCHED;
            PG8_STAGE(PG8_SB(0, 1), b2 + hstep, voffB);
            PG8_WAIT_V(6); PG8_BAR; PG8_MMA(1, 1, At, B1); PG8_BAR;
            PG8_LDB(B0, 1, 0); PG8_SCHED; PG8_LDA(At, 1, 0); PG8_STAGE(PG8_SA(0, 1), a2 + hstepA, voffA);
            PG8_WAIT_L(8); PG8_BAR; PG8_WAIT_L(0); PG8_MMA(0, 0, At, B0); PG8_BAR; PG8_SCHED;
            PG8_LDB(B1, 1, 1); PG8_STAGE(PG8_SB(1, 0), b3, voffB);
            PG8_BAR; PG8_WAIT_L(0); PG8_MMA(0, 1, At, B1); PG8_BAR;
            PG8_LDA(At, 1, 1); PG8_STAGE(PG8_SA(1, 0), a3, voffA);
            PG8_BAR; PG8_WAIT_L(0); PG8_MMA(1, 0, At, B0); PG8_BAR; PG8_SCHED;
            PG8_STAGE(PG8_SB(1, 1), b3 + hstep, voffB);
            PG8_WAIT_V(6); PG8_BAR; PG8_MMA(1, 1, At, B1); PG8_BAR;
            }
        }
        if constexpr (ALIGN_EPI) { if (wr == 0) PG8_BAR; }
        if constexpr (!Epi::AFTER_DRAIN) { E(acc, cur, wr, wc, fr, fq); S.done(cur); }
        if (!has_next) break;
#pragma unroll
        for (int a = 0; a < 2; ++a)
#pragma unroll
            for (int b = 0; b < 2; ++b)
#pragma unroll
                for (int m = 0; m < 4; ++m)
#pragma unroll
                    for (int n = 0; n < 2; ++n) acc[a][b][m][n] = (f32x4){0.f, 0.f, 0.f, 0.f};
        cur = nxt; cA = nA; cB = nB; ++ui;
        if constexpr (ALIGN_EPI) { if (wr == 1) PG8_BAR; }
    }
    PG8_WAIT_V(0);
    if constexpr (!ALIGN_EPI) { if (wr == 0) PG8_BAR; }
    PG8_BAR;
    if constexpr (Epi::AFTER_DRAIN) { E.fused(acc, cur, wr, wc, fr, fq, lds, wid, lane); S.done(cur); }
#undef PG8_SA
#undef PG8_SB
#undef PG8_STAGE
#undef PG8_LDA
#undef PG8_LDB
#undef PG8_MMA
#undef PG8_WAIT_V
#undef PG8_WAIT_L
#undef PG8_BAR
#undef PG8_SCHED
}
}

#define LAS __attribute__((address_space(3)))
typedef unsigned short bf16_t;
typedef short bf16x8 __attribute__((ext_vector_type(8)));
typedef float f32x4 __attribute__((ext_vector_type(4)));
typedef unsigned u32x4 __attribute__((ext_vector_type(4)));
typedef unsigned u32x2 __attribute__((ext_vector_type(2)));
using pg8::Unit;

constexpr int M = 17408, MP = 16384, DM = 1024;
constexpr int NPRW = 1792, NPGLA = 1792, NGATE = 2048, NIN = 5632;
constexpr int FF = 2816, F2 = 5632;
constexpr float NORM_EPS = 1e-6f;
constexpr int NWAVES = 8, NTHREADS = 512;
constexpr int LDS_BYTES = 131072 + 32768;
constexpr size_t OFF_BAR = 512 * 1024;

constexpr size_t MiB = 1u << 20;
constexpr size_t OFF_ROWSS = 0;
constexpr size_t OFF_WIN = 1 * MiB, OFF_WUP = 12 * MiB, OFF_WDN = 23 * MiB, OFF_WO = 29 * MiB, OFF_WOA = 31 * MiB, OFF_WOB = 32 * MiB;
constexpr size_t OFF_W2T = 33 * MiB, OFF_A2T = OFF_W2T + 65536, OFF_G2T = OFF_A2T + 65536;
constexpr size_t OFF_PRW = 35 * MiB, OFF_PGLA = 95 * MiB, OFF_PGATE = 155 * MiB, OFF_G = 223 * MiB;
constexpr size_t OFF_MERGED = OFF_PRW, OFF_UH = OFF_WIN, OFF_X1B = 222 * MiB, OFF_U = OFF_PRW, OFF_ACT = OFF_PRW, OFF_US = 29 * MiB;
static_assert(OFF_PRW + (size_t)M * NPRW * 2 <= OFF_PGLA && OFF_PGLA + (size_t)M * NPGLA * 2 <= OFF_PGATE && OFF_PGATE + (size_t)M * NGATE * 2 <= OFF_G, "ws map");
static_assert(OFF_G + (size_t)M * 512 * 2 <= 256 * MiB && OFF_U + (size_t)M * F2 * 2 <= OFF_X1B && OFF_X1B + (size_t)M * DM * 2 <= 256 * MiB, "ws map");
static_assert(OFF_UH + (size_t)256 * 4 * F2 * 2 <= OFF_WUP && OFF_ACT + (size_t)M * FF * 2 <= OFF_X1B, "ws map");

constexpr size_t OUT_SHIFT_P = (size_t)M * DM, OUT_WKV_P = OUT_SHIFT_P + 8 * 1792, OUT_GLA_P = OUT_WKV_P + 8 * 8 * 64 * 64, OUT_CONV_P = OUT_GLA_P + 8 * 4 * 64 * 128;
constexpr size_t OUT_SHIFT_S = OUT_CONV_P + 8 * 2 * F2, OUT_WKV_S = OUT_SHIFT_S + 128 * 1792, OUT_GLA_S = OUT_WKV_S + (size_t)128 * 8 * 64 * 64, OUT_CONV_S = OUT_GLA_S + (size_t)128 * 4 * 64 * 128;
constexpr size_t OUTB_H = 0, OUTB_EW = 0, OUTB_AARR = (size_t)M * 512 * 2, OUTB_ORW = (size_t)M * 1024 * 2, OUTB_OGL = OUTB_ORW + (size_t)M * 512 * 2;

struct Args { const float* in[31]; float* out; unsigned char* ws; };
#define IN_XP 0
#define IN_XS 1
#define IN_ST_SHIFT 2
#define IN_ST_WKV 3
#define IN_ST_GLA 4
#define IN_ST_CONV 5
#define IN_NORM_MIX 6
#define IN_W_IN 7
#define IN_MU 8
#define IN_W0 9
#define IN_W2 10
#define IN_A0 11
#define IN_A2 12
#define IN_G2 13
#define IN_KK 14
#define IN_KA 15
#define IN_RK 16
#define IN_LNW 17
#define IN_LNB 18
#define IN_WG2 19
#define IN_BG 20
#define IN_GNW 21
#define IN_WOA 22
#define IN_WOB 23
#define IN_WO 24
#define IN_NORM_FFN 25
#define IN_WUP 26
#define IN_CONVW 27
#define IN_CONVB 28
#define IN_WDN 29
#define IN_NORM_FINAL 30

__device__ __forceinline__ float bf_lo(unsigned w) { return __builtin_bit_cast(float, w << 16); }
__device__ __forceinline__ float bf_hi(unsigned w) { return __builtin_bit_cast(float, w & 0xffff0000u); }
__device__ __forceinline__ float bf2f(bf16_t h) { return __builtin_bit_cast(float, (unsigned)h << 16); }
__device__ __forceinline__ unsigned f2bf(float f) { unsigned u = __builtin_bit_cast(unsigned, f); return (u + 0x7fffu + ((u >> 16) & 1u)) >> 16; }
typedef float f32x2_t __attribute__((ext_vector_type(2)));
typedef __bf16 bf16x2_t __attribute__((ext_vector_type(2)));
__device__ __forceinline__ unsigned pk2(float lo, float hi) { const f32x2_t v = {lo, hi}; const bf16x2_t b = __builtin_convertvector(v, bf16x2_t); return __builtin_bit_cast(unsigned, b); }
__device__ __forceinline__ void unpack8(u32x4 w, float (&o)[8]) { o[0] = bf_lo(w.x); o[1] = bf_hi(w.x); o[2] = bf_lo(w.y); o[3] = bf_hi(w.y); o[4] = bf_lo(w.z); o[5] = bf_hi(w.z); o[6] = bf_lo(w.w); o[7] = bf_hi(w.w); }
__device__ __forceinline__ u32x4 pack8(const float (&v)[8]) { u32x4 w; w.x = pk2(v[0], v[1]); w.y = pk2(v[2], v[3]); w.z = pk2(v[4], v[5]); w.w = pk2(v[6], v[7]); return w; }
__device__ __forceinline__ void ld8bf(const bf16_t* p, float (&o)[8]) { unpack8(*(const u32x4*)p, o); }
__device__ __forceinline__ void ld8f(const float* p, float (&o)[8]) { const f32x4 a = *(const f32x4*)p, b = *(const f32x4*)(p + 4); o[0] = a.x; o[1] = a.y; o[2] = a.z; o[3] = a.w; o[4] = b.x; o[5] = b.y; o[6] = b.z; o[7] = b.w; }
__device__ __forceinline__ float fsigmoid(float x) { return __builtin_amdgcn_rcpf(1.f + __expf(-x)); }
__device__ __forceinline__ float ftanh(float x) { return 1.f - 2.f * __builtin_amdgcn_rcpf(__expf(2.f * x) + 1.f); }
__device__ __forceinline__ float fsoftplus(float x) { return fmaxf(x, 0.f) + __logf(1.f + __expf(-fabsf(x))); }
template <int CTRL> __device__ __forceinline__ float dpp_mov(float x) { return __builtin_bit_cast(float, __builtin_amdgcn_mov_dpp(__builtin_bit_cast(int, x), CTRL, 0xf, 0xf, true)); }
__device__ __forceinline__ float row16_allsum(float x) { x += dpp_mov<0xB1>(x); x += dpp_mov<0x4E>(x); x += dpp_mov<0x124>(x); x += dpp_mov<0x128>(x); return x; }
__device__ __forceinline__ float row8_allsum(float x) { x += dpp_mov<0xB1>(x); x += dpp_mov<0x4E>(x); x += dpp_mov<0x141>(x); return x; }
__device__ __forceinline__ float rdlane(float x, int l) { return __builtin_bit_cast(float, __builtin_amdgcn_readlane(__builtin_bit_cast(int, x), l)); }
__device__ __forceinline__ float wave_allsum(float x) { x = row16_allsum(x); return (rdlane(x, 0) + rdlane(x, 16)) + (rdlane(x, 32) + rdlane(x, 48)); }
#define LDS_WAIT() asm volatile("s_waitcnt lgkmcnt(0)" ::: "memory")
__device__ __forceinline__ const float* xrow_ptr(const Args& A, int r) { return r < MP ? A.in[IN_XP] + (size_t)r * DM : A.in[IN_XS] + (size_t)(r - MP) * DM; }

#define XB_TMO      128
#define XB_XCNT(j)  (256  + 64 * (j))
#define XB_XSUB(j)  (1280 + 64 * (j))
#define XB_XGEN(j)  (2304 + 64 * (j))
#define XB_TOP      3328
#define XB_TOPGEN   3392
#define XCD_BAR_WORDS 3456
#define XB_SPIN_CAP (1u << 18)

__device__ __forceinline__ unsigned xb_ld(unsigned* p)              { return __hip_atomic_load(p, __ATOMIC_RELAXED, __HIP_MEMORY_SCOPE_AGENT); }
__device__ __forceinline__ unsigned xb_add(unsigned* p, unsigned v) { return __hip_atomic_fetch_add(p, v, __ATOMIC_RELAXED, __HIP_MEMORY_SCOPE_AGENT); }
__device__ __forceinline__ unsigned xb_xcc_id() { return (unsigned)__builtin_amdgcn_s_getreg((3 << 11) | 20) & 0xFu; }
#define XB_SPIN(cond, bar) do { unsigned _sp = 0; while (cond) { __builtin_amdgcn_s_sleep(1); \
    if ((++_sp & 255u) == 0u) { if (xb_ld(&(bar)[XB_TMO])) break; if (_sp > XB_SPIN_CAP) { atomicAdd(&(bar)[XB_TMO], 1u); break; } } } } while (0)

struct XcdBarrier {
    unsigned* bar; unsigned x;
    volatile LAS unsigned* st;
};

__device__ __forceinline__ XcdBarrier xcd_barrier_post(unsigned* bar, volatile LAS unsigned* st) {
    XcdBarrier b; b.bar = bar; b.x = xb_xcc_id(); b.st = st;
    if (threadIdx.x == 0) (void)xb_add(&bar[XB_XCNT(b.x)], 1u);
    return b;
}
__device__ __forceinline__ void xcd_barrier_complete(unsigned* bar, unsigned x, unsigned& nloc, unsigned& nx) {
    const unsigned G = gridDim.x * gridDim.y * gridDim.z;
    unsigned sum, cnt, mine, sp = 0u;
    for (;;) {
        sum = 0u; cnt = 0u; mine = 0u;
#pragma unroll
        for (unsigned j = 0; j < 16; ++j) { const unsigned c = xb_ld(&bar[XB_XCNT(j)]); sum += c; cnt += (c > 0u) ? 1u : 0u; mine = (j == x) ? c : mine; }
        if (sum == G) break;
        __builtin_amdgcn_s_sleep(1);
        if ((++sp & 255u) == 0u) { if (xb_ld(&bar[XB_TMO])) break; if (sp > XB_SPIN_CAP) { atomicAdd(&bar[XB_TMO], 1u); break; } }
    }
    nloc = mine > 0u ? mine : 1u; nx = cnt > 0u ? cnt : 1u;
}

__device__ __forceinline__ void xcd_barrier(const XcdBarrier& b) {
    asm volatile("s_waitcnt vmcnt(0)" ::: "memory");
    __syncthreads();
    if (threadIdx.x == 0) {
        unsigned* bar = b.bar;
        __builtin_amdgcn_s_waitcnt(0);
        unsigned nloc = b.st[0], nx = b.st[1];
        if (nloc == 0u) { xcd_barrier_complete(bar, b.x, nloc, nx); b.st[0] = nloc; b.st[1] = nx; }
        const unsigned old = xb_add(&bar[XB_XSUB(b.x)], 1u);
        const unsigned gen = old / nloc;
        if (old + 1u == (gen + 1u) * nloc) {
            __builtin_amdgcn_fence(__ATOMIC_RELEASE, "agent");
            asm volatile("s_waitcnt vmcnt(0)" ::: "memory");
            const unsigned og = xb_add(&bar[XB_TOP], 1u);
            const unsigned tg = og / nx;
            if (og + 1u == (tg + 1u) * nx) xb_add(&bar[XB_TOPGEN], 1u);
            else XB_SPIN(xb_ld(&bar[XB_TOPGEN]) == tg, bar);
            __builtin_amdgcn_fence(__ATOMIC_ACQUIRE, "agent");
            xb_add(&bar[XB_XGEN(b.x)], 1u);
            asm volatile("s_waitcnt vmcnt(0)" ::: "memory");
        } else {
            XB_SPIN(xb_ld(&bar[XB_XGEN(b.x)]) == gen, bar);
            __builtin_amdgcn_fence(__ATOMIC_ACQUIRE, "agent");
            asm volatile("s_waitcnt vmcnt(0)" ::: "memory");
        }
    }
    __syncthreads();
}


struct EpiProj {
    static constexpr bool PERM = true, AFTER_DRAIN = false;
    bf16_t *prw, *pgla, *pgate; float *shift_p, *shift_s;
    __device__ __forceinline__ void operator()(const f32x4 (&acc)[2][2][4][2], const Unit& u, int wr, int wc, int fr, int fq) const {
        asm volatile("" : "+v"(fr), "+v"(fq));
        bf16_t* base; int ld, colt;
        if (u.pn < 7) { base = prw; ld = NPRW; colt = u.pn * 256; } else if (u.pn < 14) { base = pgla; ld = NPGLA; colt = (u.pn - 7) * 256; } else { base = pgate; ld = NGATE; colt = (u.pn - 14) * 256; }
        const int row0 = u.pm * 256 + wr * 64 + fr, col0 = colt + wc * 32 + 8 * fq;
#pragma unroll
        for (int ai = 0; ai < 2; ++ai)
#pragma unroll
            for (int m = 0; m < 4; ++m) {
                const int r = row0 + ai * 128 + m * 16; bf16_t* rowp = base + (size_t)r * ld + col0;
#pragma unroll
                for (int bj = 0; bj < 2; ++bj) { const f32x4 v0 = acc[ai][bj][m][0], v1 = acc[ai][bj][m][1]; u32x4 w; w.x = pk2(v0[0], v0[1]); w.y = pk2(v0[2], v0[3]); w.z = pk2(v1[0], v1[1]); w.w = pk2(v1[2], v1[3]); *(u32x4*)(rowp + bj * 128) = w; }
            }
    }
};
template <bool FIRST> struct EpiGate {
    static constexpr bool PERM = true, AFTER_DRAIN = false;
    bf16_t* merged; const bf16_t* gate;
    __device__ __forceinline__ void operator()(const f32x4 (&acc)[2][2][4][2], const Unit& u, int wr, int wc, int fr, int fq) const {
        asm volatile("" : "+v"(fr), "+v"(fq));
        const int row0 = u.pm * 256 + wr * 64 + fr, col0 = u.pn * 256 + wc * 32 + 8 * fq;
#pragma unroll
        for (int ai = 0; ai < 2; ++ai) {
            u32x4 gr[4][2], pr[4][2];
#pragma unroll
            for (int m = 0; m < 4; ++m)
#pragma unroll
                for (int bj = 0; bj < 2; ++bj) { const size_t r = (size_t)(row0 + ai * 128 + m * 16); const int c = col0 + bj * 128; gr[m][bj] = *(const u32x4*)(gate + r * NGATE + c); if (!FIRST) pr[m][bj] = *(const u32x4*)(merged + r * DM + c); }
#pragma unroll
            for (int m = 0; m < 4; ++m)
#pragma unroll
                for (int bj = 0; bj < 2; ++bj) { const size_t r = (size_t)(row0 + ai * 128 + m * 16); const int c = col0 + bj * 128; float g[8], v[8]; unpack8(gr[m][bj], g);
                    const f32x4 v0 = acc[ai][bj][m][0], v1 = acc[ai][bj][m][1];
#pragma unroll
                    for (int i = 0; i < 4; ++i) { v[i] = v0[i] * fsigmoid(g[i]); v[4 + i] = v1[i] * fsigmoid(g[4 + i]); }
                    if (!FIRST) { float p[8]; unpack8(pr[m][bj], p);
#pragma unroll
                        for (int i = 0; i < 8; ++i) v[i] += p[i]; }
                    *(u32x4*)(merged + r * DM + c) = pack8(v); }
        }
    }
};
struct EpiX1 {
    static constexpr bool PERM = true, AFTER_DRAIN = false;
    const float *xp, *xs; float* x1; bf16_t* x1b; float* rowss;
    __device__ __forceinline__ void operator()(const f32x4 (&acc)[2][2][4][2], const Unit& u, int wr, int wc, int fr, int fq) const {
        asm volatile("" : "+v"(fr), "+v"(fq));
        const int row0 = u.pm * 256 + wr * 64 + fr, col0 = u.pn * 256 + wc * 32 + 8 * fq;
#pragma unroll
        for (int ai = 0; ai < 2; ++ai) {
            f32x4 xa[4][2][2];
#pragma unroll
            for (int m = 0; m < 4; ++m) { const int r = row0 + ai * 128 + m * 16; const float* xr = (r < MP ? xp + (size_t)r * DM : xs + (size_t)(r - MP) * DM);
#pragma unroll
                for (int bj = 0; bj < 2; ++bj) { xa[m][bj][0] = *(const f32x4*)(xr + col0 + bj * 128); xa[m][bj][1] = *(const f32x4*)(xr + col0 + bj * 128 + 4); } }
#pragma unroll
            for (int m = 0; m < 4; ++m) { const int r = row0 + ai * 128 + m * 16; float ssq = 0.f;
#pragma unroll
                for (int bj = 0; bj < 2; ++bj) { const int c = col0 + bj * 128; const f32x4 a = xa[m][bj][0] + acc[ai][bj][m][0], b = xa[m][bj][1] + acc[ai][bj][m][1];
                    ssq += (a[0] * a[0] + a[1] * a[1]) + (a[2] * a[2] + a[3] * a[3]) + (b[0] * b[0] + b[1] * b[1]) + (b[2] * b[2] + b[3] * b[3]);
                    u32x4 w; w.x = pk2(a[0], a[1]); w.y = pk2(a[2], a[3]); w.z = pk2(b[0], b[1]); w.w = pk2(b[2], b[3]); *(u32x4*)(x1b + (size_t)r * DM + c) = w; }
                ssq += __shfl_xor(ssq, 16); ssq += __shfl_xor(ssq, 32);
                if (fq == 0) atomicAdd(rowss + r, ssq); }
        }
    }
};
struct EpiX2 {
    static constexpr bool PERM = true, AFTER_DRAIN = false;
    bf16_t* xb;
    __device__ __forceinline__ void operator()(const f32x4 (&acc)[2][2][4][2], const Unit& u, int wr, int wc, int fr, int fq) const {
        asm volatile("" : "+v"(fr), "+v"(fq));
        const int row0 = u.pm * 256 + wr * 64 + fr, col0 = u.pn * 256 + wc * 32 + 8 * fq;
#pragma unroll
        for (int ai = 0; ai < 2; ++ai) {
            u32x4 xa[4][2];
#pragma unroll
            for (int m = 0; m < 4; ++m)
#pragma unroll
                for (int bj = 0; bj < 2; ++bj) xa[m][bj] = *(const u32x4*)(xb + (size_t)(row0 + ai * 128 + m * 16) * DM + col0 + bj * 128);
#pragma unroll
            for (int m = 0; m < 4; ++m)
#pragma unroll
                for (int bj = 0; bj < 2; ++bj) { float x8[8]; unpack8(xa[m][bj], x8);
#pragma unroll
                    for (int i = 0; i < 4; ++i) { x8[i] += acc[ai][bj][m][0][i]; x8[4 + i] += acc[ai][bj][m][1][i]; }
                    *(u32x4*)(xb + (size_t)(row0 + ai * 128 + m * 16) * DM + col0 + bj * 128) = pack8(x8); }
        }
    }
};
__device__ __forceinline__ float gelu_gate(float g, float v) { const float t = g * (1.f + 0.044715f * g * g) * 1.5957691216057308f; return g * fsigmoid(t) * v; }
struct EpiU {
    static constexpr bool PERM = true, AFTER_DRAIN = false;
    const float* rowss; bf16_t *U, *uh; float *conv_p, *conv_s;
    __device__ __forceinline__ void operator()(const f32x4 (&acc)[2][2][4][2], const Unit& u, int wr, int wc, int fr, int fq) const {
        asm volatile("" : "+v"(fr), "+v"(fq));
        const int row0 = u.pm * 256 + wr * 64 + fr, col0 = u.pn * 256 + wc * 32 + 8 * fq;
#pragma unroll
        for (int ai = 0; ai < 2; ++ai)
#pragma unroll
            for (int m = 0; m < 4; ++m) { const int r = row0 + ai * 128 + m * 16; const float rs = rsqrtf(rowss[r] * (1.f / DM) + NORM_EPS);
#pragma unroll
                for (int bj = 0; bj < 2; ++bj) { const int c = col0 + bj * 128; const f32x4 v0 = acc[ai][bj][m][0] * rs, v1 = acc[ai][bj][m][1] * rs;
                    u32x4 w; w.x = pk2(v0[0], v0[1]); w.y = pk2(v0[2], v0[3]); w.z = pk2(v1[0], v1[1]); w.w = pk2(v1[2], v1[3]);
                    *(u32x4*)(U + (size_t)r * F2 + c) = w;
                    if (m == 3 && fr >= 14 && r < MP) { *(u32x4*)(uh + ((size_t)(r >> 6) * 2 + (fr - 14)) * F2 + c) = w;
                        if ((r & 2047) >= 2046) { float* cp = conv_p + ((size_t)(r >> 11) * 2 + (fr - 14)) * F2 + c; *(f32x4*)cp = v0; *(f32x4*)(cp + 4) = v1; } }
                    if (r >= MP && (fr & 7) >= 6) { float* cp = conv_s + ((size_t)((r - MP) >> 3) * 2 + ((fr & 7) - 6)) * F2 + c; *(f32x4*)cp = v0; *(f32x4*)(cp + 4) = v1; } } }
    }
};

struct EpiAct {
    static constexpr bool PERM = true, AFTER_DRAIN = false;
    const float *rowss, *convw, *convb; bf16_t *act, *uh, *us; float *conv_p, *conv_s; LAS float* ringbase;
    __device__ __forceinline__ void operator()(const f32x4 (&acc)[2][2][4][2], const Unit& u, int wr_, int wc_, int fr_, int fq_) const {
        int wr = wr_, wc = wc_, fr = fr_, fq = fq_;
        asm volatile("" : "+v"(fr), "+v"(fq)); asm volatile("" : "+s"(wr), "+s"(wc));
        const bool sample = u.pm >= 64;
        const int jc0 = u.pn * 128 + wc * 32 + 8 * fq;
        LAS float* ring = ringbase + (wr * 4 + wc) * 512;
#pragma unroll
        for (int ai = 0; ai < 2; ++ai) {
            const int rbase = u.pm * 256 + ai * 128 + wr * 64, grp = rbase >> 6;
#pragma unroll
            for (int m = 0; m < 4; ++m) {
                const int row = rbase + 16 * m + fr;
                const bool wuh = !sample && ((m == 0 && fr < 2) || (m == 3 && fr >= 14)), wus = sample && (fr & 7) < 2, wcs = sample && (fr & 7) >= 6;
                if (wuh || wus || wcs) {
                    const float rsm = rsqrtf(rowss[row] * (1.f / DM) + NORM_EPS);
#pragma unroll
                    for (int bj = 0; bj < 2; ++bj) { const f32x4 v0 = acc[ai][bj][m][0] * rsm, v1 = acc[ai][bj][m][1] * rsm;
                        if (wcs) { float* cp = conv_s + ((size_t)((row - MP) >> 3) * 2 + ((fr & 7) - 6)) * F2 + bj * FF + jc0; *(f32x4*)cp = v0; *(f32x4*)(cp + 4) = v1; }
                        else { u32x4 w; w.x = pk2(v0[0], v0[1]); w.y = pk2(v0[2], v0[3]); w.z = pk2(v1[0], v1[1]); w.w = pk2(v1[2], v1[3]);
                            bf16_t* dst = wuh ? uh + ((size_t)grp * 4 + (m == 0 ? fr : fr - 12)) * F2 : us + ((size_t)((row - MP) >> 3) * 2 + (fr & 7)) * F2;
                            *(u32x4*)(dst + bj * FF + jc0) = w;
                            if (wuh && m == 3 && (grp & 31) == 31) { float* cp = conv_p + ((size_t)(rbase >> 11) * 2 + (fr - 14)) * F2 + bj * FF + jc0; *(f32x4*)cp = v0; *(f32x4*)(cp + 4) = v1; } } }
                }
            }
        }
        asm volatile("" ::: "memory");
        float rsq[2][4];
#pragma unroll
        for (int ai = 0; ai < 2; ++ai)
#pragma unroll
            for (int m = 0; m < 4; ++m) rsq[ai][m] = rsqrtf(rowss[u.pm * 256 + ai * 128 + wr * 64 + 16 * m + fr] * (1.f / DM) + NORM_EPS);
#define EPIACT_STEP(AI, N) do { const int rbase = u.pm * 256 + (AI) * 128 + wr * 64; \
            _Pragma("unroll") for (int m = 0; m < 4; ++m) { const float rsm = rsq[AI][m]; \
                const f32x4 xv = acc[AI][0][m][N] * rsm, xg = acc[AI][1][m][N] * rsm; const int idx = (m & 1) * 16 + fr; \
                asm volatile("" ::: "memory"); *(LAS f32x4*)(ring + idx * 16 + fq * 4) = xv; *(LAS f32x4*)(ring + 4096 + idx * 16 + fq * 4) = xg; asm volatile("" ::: "memory");     \
                const f32x4 p1v = *(const LAS f32x4*)(ring + ((idx + 31) & 31) * 16 + fq * 4), p2v = *(const LAS f32x4*)(ring + ((idx + 30) & 31) * 16 + fq * 4); \
                const f32x4 p1g = *(const LAS f32x4*)(ring + 4096 + ((idx + 31) & 31) * 16 + fq * 4), p2g = *(const LAS f32x4*)(ring + 4096 + ((idx + 30) & 31) * 16 + fq * 4); \
                const f32x4 cv = cbv + w0v * p2v + w1v * p1v + w2v * xv, cg = cbg + w0g * p2g + w1g * p1g + w2g * xg; \
                const bool fix = sample ? ((fr & 7) < 2) : (m == 0 && fr < 2); \
                if (!fix) { u32x2 w; w.x = pk2(gelu_gate(cg[0], cv[0]), gelu_gate(cg[1], cv[1])); w.y = pk2(gelu_gate(cg[2], cv[2]), gelu_gate(cg[3], cv[3])); \
                    *(u32x2*)(act + (size_t)(rbase + 16 * m + fr) * FF + jc0 + 4 * (N)) = w; } } } while (0)
#define EPIACT_N(N) do { const int col4 = jc0 + 4 * (N); \
            const f32x4 w0v = *(const f32x4*)(convw + col4), w1v = *(const f32x4*)(convw + F2 + col4), w2v = *(const f32x4*)(convw + 2 * F2 + col4), cbv = *(const f32x4*)(convb + col4); \
            const f32x4 w0g = *(const f32x4*)(convw + FF + col4), w1g = *(const f32x4*)(convw + F2 + FF + col4), w2g = *(const f32x4*)(convw + 2 * F2 + FF + col4), cbg = *(const f32x4*)(convb + FF + col4); \
            EPIACT_STEP(0, N); EPIACT_STEP(1, N); asm volatile("" ::: "memory"); } while (0)
        EPIACT_N(0); EPIACT_N(1);
#undef EPIACT_N
#undef EPIACT_STEP
    }
};

template <class EF> __device__ __forceinline__ void tail_gemm(LAS unsigned char* lds, const bf16_t* Amat, int lda, const bf16_t* Bt, int K, const pg8::StaticOrder& S, int wave, int lane, const EF& ef) {
    const int l15 = lane & 15, q = lane >> 4, ntail = S.nwg - S.limit, nk = K / 256;
    LAS float* red = (LAS float*)lds;
    for (int item = blockIdx.x; item < ntail * 16; item += gridDim.x) {
        pg8::Unit u; S.unit_of(S.limit + (item >> 4), u);
        const int r0 = u.pm * 256 + (item & 15) * 16, c0 = u.pn * 256;
        const bf16_t* ap = Amat + (size_t)(r0 + l15) * lda + 8 * q + 32 * nk * wave; const bf16_t* bp = Bt + (size_t)(c0 + l15) * K + 8 * q + 32 * nk * wave;
        f32x4 acc[16];
#pragma unroll
        for (int n = 0; n < 16; ++n) acc[n] = (f32x4){0.f, 0.f, 0.f, 0.f};
#pragma unroll 2
        for (int ks = 0; ks < nk; ++ks) {
            const bf16x8 a = *(const bf16x8*)(ap + 32 * ks); bf16x8 b[16];
#pragma unroll
            for (int n = 0; n < 16; ++n) b[n] = *(const bf16x8*)(bp + (size_t)(16 * n) * K + 32 * ks);
#pragma unroll
            for (int n = 0; n < 16; ++n) acc[n] = __builtin_amdgcn_mfma_f32_16x16x32_bf16(a, b[n], acc[n], 0, 0, 0);
        }
        __syncthreads();
#pragma unroll
        for (int n = 0; n < 16; ++n) *(LAS f32x4*)(red + ((wave * 16 + n) * 64 + lane) * 4) = acc[n];
        __syncthreads();
        f32x4 s0 = {0.f, 0.f, 0.f, 0.f}, s1 = s0;
#pragma unroll
        for (int w2 = 0; w2 < 8; ++w2) { s0 += *(const LAS f32x4*)(red + ((w2 * 16 + 2 * wave) * 64 + lane) * 4); s1 += *(const LAS f32x4*)(red + ((w2 * 16 + 2 * wave + 1) * 64 + lane) * 4); }
        ef(r0 + 4 * q, c0 + 32 * wave + l15, s0, s1);
    }
    __syncthreads();
}
struct TfGate { bool first; bf16_t* merged; const bf16_t* gate;
    __device__ __forceinline__ void operator()(int row, int col, f32x4 a0, f32x4 a1) const {
#pragma unroll
        for (int i = 0; i < 4; ++i)
#pragma unroll
            for (int n = 0; n < 2; ++n) { const size_t r = (size_t)(row + i); const int c = col + 16 * n; float v = (n ? a1[i] : a0[i]) * fsigmoid(bf2f(gate[r * NGATE + c]));
                if (!first) v += bf2f(merged[r * DM + c]); merged[r * DM + c] = (bf16_t)f2bf(v); } } };
struct TfX1 { const float *xp, *xs; float* x1; bf16_t* x1b; float* rowss;
    __device__ __forceinline__ void operator()(int row, int col, f32x4 a0, f32x4 a1) const {
#pragma unroll
        for (int i = 0; i < 4; ++i) { const int r = row + i; const float* xr = (r < MP ? xp + (size_t)r * DM : xs + (size_t)(r - MP) * DM);
            const float v0 = xr[col] + a0[i], v1 = xr[col + 16] + a1[i];
            x1b[(size_t)r * DM + col] = (bf16_t)f2bf(v0); x1b[(size_t)r * DM + col + 16] = (bf16_t)f2bf(v1);
            const float ss = row16_allsum(v0 * v0 + v1 * v1); if ((col & 15) == 0) atomicAdd(rowss + r, ss); } } };
struct TfX2 { bf16_t* xb;
    __device__ __forceinline__ void operator()(int row, int col, f32x4 a0, f32x4 a1) const {
#pragma unroll
        for (int i = 0; i < 4; ++i) { const size_t off = (size_t)(row + i) * DM + col; xb[off] = (bf16_t)f2bf(bf2f(xb[off]) + a0[i]); xb[off + 16] = (bf16_t)f2bf(bf2f(xb[off + 16]) + a1[i]); } } };

template <int MODE> __device__ __forceinline__ int map_col(int R) {
    if (MODE == 1) { if (R < 1792) return R; if (R < 3584) return (R - 1792 < 1552) ? R : -1; return R - 240; }
    if (MODE == 2) { return ((R >> 7) & 1) * FF + ((R >> 8) << 7) + (R & 127); }
    return R;
}
template <int MODE> __device__ __forceinline__ void tr_item(const float* __restrict__ W, int K, int Nsrc, int Ndst, bf16_t* WT, const float* kscale, LAS float* scr, int item, int lane) {
    const int nblk = Ndst >> 5, kb = item / nblk, nb = item - kb * nblk, k0 = kb << 6, n0 = nb << 5;
    const int col = map_col<MODE>(n0 + (lane & 31));
    float tv[32];
#pragma unroll
    for (int i = 0; i < 32; ++i) { const int kk = 2 * i + (lane >> 5); tv[i] = (col >= 0) ? W[(size_t)(k0 + kk) * Nsrc + col] : 0.f; }
#pragma unroll
    for (int i = 0; i < 32; ++i) { const int kk = 2 * i + (lane >> 5); float v = tv[i]; if (kscale) v *= kscale[k0 + kk]; scr[kk * 33 + (lane & 31)] = v; }
    LDS_WAIT();
    const int c = lane & 7;
#pragma unroll
    for (int j = 0; j < 4; ++j) { const int n = (lane >> 3) + 8 * j; const LAS float* s = scr + (8 * c) * 33 + n;
        u32x4 o; o.x = pk2(s[0 * 33], s[1 * 33]); o.y = pk2(s[2 * 33], s[3 * 33]); o.z = pk2(s[4 * 33], s[5 * 33]); o.w = pk2(s[6 * 33], s[7 * 33]);
        *(u32x4*)(WT + (size_t)(n0 + n) * K + k0 + 8 * c) = o; }
    LDS_WAIT();
}
__device__ __forceinline__ void p0_prologue(const Args& A, LAS unsigned char* lds, int gw, int NGW, int wave, int lane) {
    LAS float* scr = (LAS float*)(lds + wave * 16384);
    unsigned char* ws = A.ws;
    constexpr int I_IN = 16 * (NIN / 32), I_UP = 16 * (F2 / 32), I_DN = 44 * 32, I_O = 16 * 32, I_OA = 8 * 32, I_W2 = 16, I_G2 = 2 * 16;
    constexpr int NITEMS = I_IN + I_UP + I_DN + I_O + 2 * I_OA + 2 * I_W2 + I_G2;
    for (int it = gw; it < NITEMS; it += NGW) {
        int r = it;
        if (r < I_IN) { tr_item<1>(A.in[IN_W_IN], 1024, 5392, NIN, (bf16_t*)(ws + OFF_WIN), nullptr, scr, r, lane); continue; } r -= I_IN;
        if (r < I_UP) { tr_item<2>(A.in[IN_WUP], 1024, F2, F2, (bf16_t*)(ws + OFF_WUP), A.in[IN_NORM_FFN], scr, r, lane); continue; } r -= I_UP;
        if (r < I_DN) { tr_item<0>(A.in[IN_WDN], FF, 1024, 1024, (bf16_t*)(ws + OFF_WDN), nullptr, scr, r, lane); continue; } r -= I_DN;
        if (r < I_O) { tr_item<0>(A.in[IN_WO], 1024, 1024, 1024, (bf16_t*)(ws + OFF_WO), nullptr, scr, r, lane); continue; } r -= I_O;
        if (r < I_OA) { tr_item<0>(A.in[IN_WOA], 512, 1024, 1024, (bf16_t*)(ws + OFF_WOA), nullptr, scr, r, lane); continue; } r -= I_OA;
        if (r < I_OA) { tr_item<0>(A.in[IN_WOB], 512, 1024, 1024, (bf16_t*)(ws + OFF_WOB), nullptr, scr, r, lane); continue; } r -= I_OA;
        if (r < I_W2) { tr_item<0>(A.in[IN_W2], 64, 512, 512, (bf16_t*)(ws + OFF_W2T), nullptr, scr, r, lane); continue; } r -= I_W2;
        if (r < I_W2) { tr_item<0>(A.in[IN_A2], 64, 512, 512, (bf16_t*)(ws + OFF_A2T), nullptr, scr, r, lane); continue; } r -= I_W2;
        tr_item<0>(A.in[IN_G2], 128, 512, 512, (bf16_t*)(ws + OFF_G2T), nullptr, scr, r, lane);
    }
    bf16_t* H = (bf16_t*)((unsigned char*)A.out + OUTB_H);
    const float* gm = A.in[IN_NORM_MIX];
    for (int m = gw; m < M; m += 2 * NGW) {
        const int m2 = m + NGW; const bool has2 = m2 < M;
        const f32x4* xr = (const f32x4*)xrow_ptr(A, m) + lane; const f32x4* xr2 = (const f32x4*)xrow_ptr(A, has2 ? m2 : m) + lane; f32x4 v[4], w[4]; float s = 0.f, s2 = 0.f;
#pragma unroll
        for (int j = 0; j < 4; ++j) { v[j] = xr[64 * j]; w[j] = xr2[64 * j]; }
#pragma unroll
        for (int j = 0; j < 4; ++j) { s += (v[j].x * v[j].x + v[j].y * v[j].y) + (v[j].z * v[j].z + v[j].w * v[j].w); s2 += (w[j].x * w[j].x + w[j].y * w[j].y) + (w[j].z * w[j].z + w[j].w * w[j].w); }
        const float rstd = rsqrtf(wave_allsum(s) * (1.f / DM) + NORM_EPS), rstd2 = rsqrtf(wave_allsum(s2) * (1.f / DM) + NORM_EPS);
        u32x2* o8 = (u32x2*)(H + (size_t)m * DM) + lane; u32x2* o82 = (u32x2*)(H + (size_t)m2 * DM) + lane;
#pragma unroll
        for (int j = 0; j < 4; ++j) { const f32x4 g = *((const f32x4*)gm + lane + 64 * j); u32x2 p; p.x = pk2(v[j].x * rstd * g.x, v[j].y * rstd * g.y); p.y = pk2(v[j].z * rstd * g.z, v[j].w * rstd * g.w); o8[64 * j] = p;
            if (has2) { u32x2 p2; p2.x = pk2(w[j].x * rstd2 * g.x, w[j].y * rstd2 * g.y); p2.y = pk2(w[j].z * rstd2 * g.z, w[j].w * rstd2 * g.w); o82[64 * j] = p2; } }
    }
    float* rowss = (float*)(ws + OFF_ROWSS);
    for (int i = gw * 64 + lane; i < M; i += NGW * 64) rowss[i] = 0.f;
}

__device__ __forceinline__ void prw_mixed8(const Args& A, const bf16_t* PRW, int r, int col0, float (&xs)[8]) {
    float cur[8], prev[8];
    ld8bf(PRW + (size_t)r * NPRW + col0, cur);
    const bool first = (r < MP) ? ((r & 2047) == 0) : (((r - MP) & 7) == 0);
    if (!first) ld8bf(PRW + (size_t)(r - 1) * NPRW + col0, prev);
    else if (r < MP) {
#pragma unroll
        for (int i = 0; i < 8; ++i) prev[i] = 0.f;
    } else ld8f(A.in[IN_ST_SHIFT] + (size_t)((r - MP) >> 3) * 1792 + col0, prev);
    float mu[8]; ld8f(A.in[IN_MU] + col0, mu);
#pragma unroll
    for (int i = 0; i < 8; ++i) xs[i] = cur[i] + (prev[i] - cur[i]) * mu[i];
}
template <int ACT> __device__ __forceinline__ bf16x8 afrag(const Args& A, const bf16_t* PRW, int r, int col0) {
    float xs[8]; prw_mixed8(A, PRW, r, col0, xs);
#pragma unroll
    for (int i = 0; i < 8; ++i) xs[i] = ACT == 1 ? ftanh(xs[i]) : (ACT == 2 ? fsigmoid(xs[i]) : xs[i]);
    return __builtin_bit_cast(bf16x8, pack8(xs));
}
__device__ __forceinline__ void p2a_lora(const Args& A, LAS unsigned char* lds, int gw, int NGW, int wave, int lane) {
    const bf16_t* PRW = (const bf16_t*)(A.ws + OFF_PRW);
    const bf16_t *W2T = (const bf16_t*)(A.ws + OFF_W2T), *A2T = (const bf16_t*)(A.ws + OFF_A2T), *G2T = (const bf16_t*)(A.ws + OFF_G2T);
    bf16_t *EW = (bf16_t*)((unsigned char*)A.out + OUTB_EW), *AARR = (bf16_t*)((unsigned char*)A.out + OUTB_AARR), *G = (bf16_t*)(A.ws + OFF_G);
    for (int i = gw * 64 + lane; i < 136 * 224; i += NGW * 64) { const int sq = i / 224, c8 = (i - sq * 224) * 8; const int r = sq < 8 ? sq * 2048 + 2047 : MP + (sq - 8) * 8 + 7;
        float v[8]; ld8bf(PRW + (size_t)r * NPRW + c8, v); float* dst = (sq < 8 ? A.out + OUT_SHIFT_P + (size_t)sq * 1792 : A.out + OUT_SHIFT_S + (size_t)(sq - 8) * 1792) + c8;
        *(f32x4*)dst = (f32x4){v[0], v[1], v[2], v[3]}; *(f32x4*)(dst + 4) = (f32x4){v[4], v[5], v[6], v[7]}; }
    const int l15 = lane & 15, kq = lane >> 4;
    LAS bf16_t* acts = (LAS bf16_t*)lds; const int tid = wave * 64 + lane;
    for (int tile = blockIdx.x; tile < M / 16; tile += gridDim.x) {
        const int h = wave, t0 = tile * 16;
        { const int tt = tid >> 5, cg = tid & 31; float xs[8]; prw_mixed8(A, PRW, t0 + tt, 1536 + 8 * cg, xs);
#pragma unroll
          for (int i = 0; i < 8; ++i) xs[i] = cg < 8 ? ftanh(xs[i]) : (cg < 16 ? xs[i] : fsigmoid(xs[i]));
          __syncthreads();
          *(LAS u32x4*)(acts + tt * 264 + 8 * cg) = pack8(xs); }
        __syncthreads();
        bf16x8 aw[2], aa[2], ag[4];
#pragma unroll
        for (int ks = 0; ks < 2; ++ks) { aw[ks] = *(const LAS bf16x8*)(acts + l15 * 264 + ks * 32 + kq * 8); aa[ks] = *(const LAS bf16x8*)(acts + l15 * 264 + 64 + ks * 32 + kq * 8); }
#pragma unroll
        for (int ks = 0; ks < 4; ++ks) ag[ks] = *(const LAS bf16x8*)(acts + l15 * 264 + 128 + ks * 32 + kq * 8);
        f32x4 cwv[4], cav[4], cgg[4];
#pragma unroll
        for (int nt = 0; nt < 4; ++nt) {
            const int c = 64 * h + 16 * nt + l15;
            f32x4 cw = {0.f, 0.f, 0.f, 0.f}, ca = cw, cgv = cw;
#pragma unroll
            for (int ks = 0; ks < 2; ++ks) {
                const bf16x8 bw = *(const bf16x8*)(W2T + (size_t)c * 64 + ks * 32 + kq * 8), ba = *(const bf16x8*)(A2T + (size_t)c * 64 + ks * 32 + kq * 8);
                cw = __builtin_amdgcn_mfma_f32_16x16x32_bf16(bw, aw[ks], cw, 0, 0, 0); ca = __builtin_amdgcn_mfma_f32_16x16x32_bf16(ba, aa[ks], ca, 0, 0, 0); }
#pragma unroll
            for (int ks = 0; ks < 4; ++ks) { const bf16x8 bg = *(const bf16x8*)(G2T + (size_t)c * 128 + ks * 32 + kq * 8); cgv = __builtin_amdgcn_mfma_f32_16x16x32_bf16(bg, ag[ks], cgv, 0, 0, 0); }
            cwv[nt] = cw; cav[nt] = ca; cgg[nt] = cgv;
        }
#pragma unroll
        for (int nt = 0; nt < 4; ++nt) {
            const int c4 = 64 * h + 16 * nt + 4 * kq; const size_t o = (size_t)(t0 + l15) * 512 + c4;
            const f32x4 w0v = *(const f32x4*)(A.in[IN_W0] + c4), a0v = *(const f32x4*)(A.in[IN_A0] + c4);
            float ew[4], av[4];
#pragma unroll
            for (int i = 0; i < 4; ++i) { ew[i] = 0.6065306597f * fsigmoid(w0v[i] + cwv[nt][i]); av[i] = fsigmoid(a0v[i] + cav[nt][i]); }
            u32x2 w; w.x = pk2(ew[0], ew[1]); w.y = pk2(ew[2], ew[3]); *(u32x2*)(EW + o) = w;
            w.x = pk2(av[0], av[1]); w.y = pk2(av[2], av[3]); *(u32x2*)(AARR + o) = w;
            w.x = pk2(cgg[nt][0], cgg[nt][1]); w.y = pk2(cgg[nt][2], cgg[nt][3]); *(u32x2*)(G + o) = w;
        }
    }
}

typedef short bf16x4 __attribute__((ext_vector_type(4)));
#define MFMA32(a, b, c) __builtin_amdgcn_mfma_f32_16x16x32_bf16(a, b, c, 0, 0, 0)
#define MFMA16(a, b, c) __builtin_amdgcn_mfma_f32_16x16x16bf16_1k(a, b, c, 0, 0, 0)
constexpr int SP = 72;
constexpr size_t OFF_RLT = 240 * MiB;
constexpr size_t OFF_GL = 1 * MiB, OFF_GG = 8 * MiB;
static_assert(OFF_RLT + (size_t)448 * 32768 <= 256 * MiB && OFF_GL + (size_t)224 * 32768 <= OFF_GG && OFF_GG + 224 * 256 <= OFF_WUP, "ws map (scan)");
__device__ __forceinline__ bf16x4 bf4(f32x4 v) { u32x2 w; w.x = pk2(v[0], v[1]); w.y = pk2(v[2], v[3]); return __builtin_bit_cast(bf16x4, w); }
__device__ __forceinline__ bf16x8 afr(const LAS bf16_t* X, int l15, int q, int ks) { const LAS bf16_t* p = X + l15 * SP + 32 * ks + 4 * q; const u32x2 lo = *(const LAS u32x2*)p, hi = *(const LAS u32x2*)(p + 16); u32x4 w; w.x = lo.x; w.y = lo.y; w.z = hi.x; w.w = hi.y; return __builtin_bit_cast(bf16x8, w); }
__device__ __forceinline__ bf16x8 hfrag(const f32x4& lo, const f32x4& hi) { u32x4 w; w.x = pk2(lo[0], lo[1]); w.y = pk2(lo[2], lo[3]); w.z = pk2(hi[0], hi[1]); w.w = pk2(hi[2], hi[3]); return __builtin_bit_cast(bf16x8, w); }
__device__ __forceinline__ f32x4 maskc(f32x4 v, int q, int l15, bool rows_lt_col, bool incl) {
#pragma unroll
    for (int i = 0; i < 4; ++i) { const int R = 4 * q + i; const bool keep = rows_lt_col ? (incl ? R <= l15 : R < l15) : (incl ? l15 <= R : l15 < R); v[i] = keep ? v[i] : 0.f; }
    return v;
}
template <bool GLA, int VP> __device__ __forceinline__ void scan_matrix_part(const LAS bf16_t* AT, const LAS bf16_t* RT, const LAS bf16_t* BT, const LAS bf16_t* KT, const LAS bf16_t* VS, const LAS float* GC, bf16_t* OUTP, int l15, int q, int sl, bool use_v, bool write_o, int rowb, int nv, f32x4 (&H)[4]) {
    const bf16x8 hb0 = hfrag(H[0], H[1]), hb1 = hfrag(H[2], H[3]);
    const bf16x8 rt0 = afr(RT, l15, q, 0), rt1 = afr(RT, l15, q, 1), kt0 = afr(KT, l15, q, 0), kt1 = afr(KT, l15, q, 1);
    const f32x4 z4 = {0.f, 0.f, 0.f, 0.f};
    bf16x4 vb = {0, 0, 0, 0};
    if (use_v) { const LAS bf16_t* vp = VS + (4 * q) * VP + 16 * sl + l15; u32x2 w; w.x = (unsigned)vp[0] | ((unsigned)vp[VP] << 16); w.y = (unsigned)vp[2 * VP] | ((unsigned)vp[3 * VP] << 16); vb = __builtin_bit_cast(bf16x4, w); }
    f32x4 O = MFMA32(rt0, hb0, z4); O = MFMA32(rt1, hb1, O);
    f32x4 U = z4;
    if (!GLA) {
        const bf16x8 at0 = afr(AT, l15, q, 0), at1 = afr(AT, l15, q, 1), bt0 = afr(BT, l15, q, 0), bt1 = afr(BT, l15, q, 1);
        f32x4 P = MFMA32(at0, bt0, z4); P = MFMA32(at1, bt1, P); P = maskc(P, q, l15, false, false);
        f32x4 PT = MFMA32(bt0, at0, z4); PT = MFMA32(bt1, at1, PT); PT = maskc(PT, q, l15, true, false);
        f32x4 nrbT = MFMA32(bt0, rt0, z4); nrbT = MFMA32(bt1, rt1, nrbT); nrbT = maskc(nrbT, q, l15, true, true);
        U = MFMA32(at0, hb0, z4); U = MFMA32(at1, hb1, U);
        if (use_v) { f32x4 makT = MFMA32(kt0, at0, z4); makT = MFMA32(kt1, at1, makT); makT = maskc(makT, q, l15, true, false); U = MFMA16(bf4(makT), vb, U); }
#pragma unroll
        for (int it = 0; it < 4; ++it) {
            U = MFMA16(bf4(PT), bf4(U), U);
            if (it < 3) { const f32x4 Pn = MFMA16(bf4(PT), bf4(P), z4), PTn = MFMA16(bf4(P), bf4(PT), z4); P = Pn; PT = PTn; }
        }
        O = MFMA16(bf4(nrbT), bf4(U), O);
    }
    if (use_v) { f32x4 nrkT = MFMA32(kt0, rt0, z4); nrkT = MFMA32(kt1, rt1, nrkT); nrkT = maskc(nrkT, q, l15, true, true); O = MFMA16(bf4(nrkT), vb, O); }
    if (write_o) {
#pragma unroll
        for (int i = 0; i < 4; ++i) if (4 * q + i < nv) OUTP[(size_t)(rowb + 4 * q + i) * 512] = (bf16_t)f2bf(O[i]);
    }
    const bf16x4 ub = bf4(U);
#pragma unroll
    for (int kt = 0; kt < 4; ++kt) {
        const f32x4 g4 = *(const LAS f32x4*)(GC + 16 * kt + 4 * q); const float gk = GC[16 * kt + l15];
        f32x4 acc = H[kt] * g4;
        if (!GLA) { const LAS bf16_t* p = BT + (4 * q) * SP + 16 * kt + l15; u32x2 w; w.x = pk2(bf2f(p[0]) * gk, bf2f(p[SP]) * gk); w.y = pk2(bf2f(p[2 * SP]) * gk, bf2f(p[3 * SP]) * gk); acc = MFMA16(__builtin_bit_cast(bf16x4, w), ub, acc); }
        if (use_v) { const LAS bf16_t* p = KT + (4 * q) * SP + 16 * kt + l15; u32x2 w; w.x = pk2(bf2f(p[0]) * gk, bf2f(p[SP]) * gk); w.y = pk2(bf2f(p[2 * SP]) * gk, bf2f(p[3 * SP]) * gk); acc = MFMA16(__builtin_bit_cast(bf16x4, w), vb, acc); }
        H[kt] = acc;
    }
}
constexpr int GL_RT = 2304, GL_BT = 4608, GL_KT = 6912, GL_VS = 9216, GL_GC = 13568, GL_EG = 13824, GL_BYTES = 26624;
template <bool GLA, int W> __device__ __forceinline__ void scan_block(const Args& A, LAS unsigned char* gl, int lane, int wg, int row0, int nsub, int nvalid, int first_kind, int bsamp, int hh, int sl, bool use_v, bool write_o, f32x4 (&H)[4], float& cumtot) {
    constexpr int TPW = 16 / W, VP = GLA ? 136 : 72;
    const int c = lane, l15 = lane & 15, q = lane >> 4, t0 = wg * TPW;
    const bf16_t* PRW = (const bf16_t*)(A.ws + OFF_PRW); const bf16_t* PGLA = (const bf16_t*)(A.ws + OFF_PGLA);
    const bf16_t *EW = (const bf16_t*)((unsigned char*)A.out + OUTB_EW), *AARR = (const bf16_t*)((unsigned char*)A.out + OUTB_AARR);
    bf16_t* OUTP = GLA ? (bf16_t*)((unsigned char*)A.out + OUTB_OGL) + 128 * hh + 16 * sl + l15 : (bf16_t*)((unsigned char*)A.out + OUTB_ORW) + 64 * hh + 16 * sl + l15;
    LAS bf16_t *AT = (LAS bf16_t*)gl, *RT = (LAS bf16_t*)(gl + GL_RT), *BT = (LAS bf16_t*)(gl + GL_BT), *KT = (LAS bf16_t*)(gl + GL_KT), *VS = (LAS bf16_t*)(gl + GL_VS);
    LAS float *GC = (LAS float*)(gl + GL_GC), *EG = (LAS float*)(gl + GL_EG);
    float mu_r = 0.f, mu_k = 0.f, mu_v = 0.f, kkc = 0.f, kac = 0.f, bgc = 0.f; float wgt[16];
#pragma unroll
    for (int j = 0; j < 16; ++j) wgt[j] = 0.f;
    if (!GLA) { const float* mu = A.in[IN_MU]; mu_r = mu[64 * hh + c]; mu_k = mu[512 + 64 * hh + c]; mu_v = mu[1024 + 64 * hh + c]; kkc = A.in[IN_KK][64 * hh + c]; kac = A.in[IN_KA][64 * hh + c]; }
    else { bgc = A.in[IN_BG][64 * hh + c];
#pragma unroll
        for (int j = 0; j < 16; ++j) wgt[j] = A.in[IN_WG2][j * 256 + 64 * hh + c]; }
    float pr[2] = {0.f, 0.f}, pk[2] = {0.f, 0.f}, pvv[2] = {0.f, 0.f}; bf16_t r0[2][TPW], r1[2][TPW], r2[2][TPW], r3[2][TPW], r4[2][TPW]; unsigned rvv[2][TPW]; u32x4 lg0[2][TPW], lg1[2][TPW];
#pragma unroll
    for (int p = 0; p < 2; ++p)
#pragma unroll
        for (int i = 0; i < TPW; ++i) { r0[p][i] = r1[p][i] = r2[p][i] = r3[p][i] = r4[p][i] = 0; rvv[p][i] = 0u; lg0[p][i] = (u32x4){0u, 0u, 0u, 0u}; lg1[p][i] = lg0[p][i]; }
#define SB_LOAD(SC, P) do { const int nv_ = ((SC) == nsub - 1) ? nvalid : 16; \
        if (!GLA) { if ((SC) == 0 && t0 == 0) { pr[P] = pk[P] = pvv[P] = 0.f; if (first_kind == 0) { const bf16_t* p = PRW + (size_t)(row0 - 1) * NPRW + 64 * hh + c; pr[P] = bf2f(p[0]); pk[P] = bf2f(p[512]); pvv[P] = bf2f(p[1024]); } \
                        else if (first_kind == 2) { const float* st = A.in[IN_ST_SHIFT] + (size_t)bsamp * 1792 + 64 * hh + c; pr[P] = st[0]; pk[P] = st[512]; pvv[P] = st[1024]; } } \
                    else if (t0 < nv_) { const bf16_t* p = PRW + (size_t)(row0 + 16 * (SC) + t0 - 1) * NPRW + 64 * hh + c; pr[P] = bf2f(p[0]); pk[P] = bf2f(p[512]); pvv[P] = bf2f(p[1024]); } } \
        _Pragma("unroll") for (int i = 0; i < TPW; ++i) if (t0 + i < nv_) { const size_t ro = (size_t)(row0 + 16 * (SC) + t0 + i); \
            if (!GLA) { const bf16_t* p = PRW + ro * NPRW + 64 * hh + c; r0[P][i] = p[0]; r1[P][i] = p[512]; r2[P][i] = p[1024]; r3[P][i] = EW[ro * 512 + 64 * hh + c]; r4[P][i] = AARR[ro * 512 + 64 * hh + c]; } \
            else { const bf16_t* p = PGLA + ro * NPGLA; r0[P][i] = p[64 * hh + c]; r1[P][i] = p[256 + 64 * hh + c]; rvv[P][i] = *(const unsigned*)(p + 512 + 128 * hh + 2 * lane); lg0[P][i] = *(const u32x4*)(p + 1024); lg1[P][i] = *(const u32x4*)(p + 1032); } } } while (0)
#define SB_EG(SC, P) do { const int nv_ = ((SC) == nsub - 1) ? nvalid : 16; LAS float* eg_ = EG + (P) * 1024; float tot_ = 0.f; \
        _Pragma("unroll") for (int i = 0; i < TPW; ++i) { float ev = 0.f; if (t0 + i < nv_) { if (!GLA) ev = bf2f(r3[P][i]); else { float lga[16], t8[8]; unpack8(lg0[P][i], t8); _Pragma("unroll") for (int j = 0; j < 8; ++j) lga[j] = t8[j]; \
                unpack8(lg1[P][i], t8); _Pragma("unroll") for (int j = 0; j < 8; ++j) lga[8 + j] = t8[j]; float z = bgc; _Pragma("unroll") for (int j = 0; j < 16; ++j) z += lga[j] * wgt[j]; ev = fsoftplus(-z) * 0.0625f; } } \
            eg_[(t0 + i) * 64 + c] = ev; tot_ += ev; } \
        WT[((P) * 8 + wg) * 64 + c] = tot_; } while (0)
#define SB_ITER(SC, P) do { const int sc = (SC); const int nv = (sc == nsub - 1) ? nvalid : 16; \
        __syncthreads();                                                         \
        { const LAS float* eg = EG + (P) * 1024; float cum = 0.f; \
          _Pragma("unroll") for (int w2 = 0; w2 < W - 1; ++w2) { const float tw = WT[((P) * 8 + w2) * 64 + c]; cum += (w2 < wg) ? tw : 0.f; } \
          _Pragma("unroll") for (int i = 0; i < TPW; ++i) { const int t = t0 + i; \
            if (t < nv) { \
                const float gp = __expf(-cum); cum += eg[t * 64 + c]; const float g = __expf(-cum), e = __expf(cum); \
                if (!GLA) { \
                    const float cr = bf2f(r0[P][i]), ck = bf2f(r1[P][i]), cv = bf2f(r2[P][i]), a = bf2f(r4[P][i]); \
                    const float xr = cr + (pr[P] - cr) * mu_r, xk = ck + (pk[P] - ck) * mu_k, xv = cv + (pvv[P] - cv) * mu_v; pr[P] = cr; pk[P] = ck; pvv[P] = cv; \
                    const float kkv = xk * kkc, ss = wave_allsum(kkv * kkv), kk = kkv * __builtin_amdgcn_rcpf(fmaxf(sqrtf(ss), 1e-12f)); \
                    const unsigned w01 = pk2(-kk * gp, xr * g), w23 = pk2(kk * a * e, xk * (1.f + (a - 1.f) * kac) * e); \
                    AT[t * SP + c] = (bf16_t)(w01 & 0xffffu); RT[t * SP + c] = (bf16_t)(w01 >> 16); BT[t * SP + c] = (bf16_t)(w23 & 0xffffu); KT[t * SP + c] = (bf16_t)(w23 >> 16); \
                    VS[t * VP + c] = (bf16_t)f2bf(xv); \
                } else { \
                    const unsigned w01 = pk2(bf2f(r0[P][i]) * 0.125f * g, bf2f(r1[P][i]) * e); \
                    RT[t * SP + c] = (bf16_t)(w01 & 0xffffu); KT[t * SP + c] = (bf16_t)(w01 >> 16); \
                    *(LAS unsigned*)(VS + t * VP + 2 * lane) = rvv[P][i]; \
                } \
            } else { \
                if (!GLA) { AT[t * SP + c] = 0; BT[t * SP + c] = 0; VS[t * VP + c] = 0; } else *(LAS unsigned*)(VS + t * VP + 2 * lane) = 0u; \
                RT[t * SP + c] = 0; KT[t * SP + c] = 0; \
            } \
          } \
          if (wg == W - 1) { GC[c] = __expf(-cum); cumtot += cum; } \
        } \
        if (sc + 2 < nsub) SB_LOAD(sc + 2, P); \
        __syncthreads();                                                         \
        scan_matrix_part<GLA, VP>(AT, RT, BT, KT, VS, GC, OUTP, l15, q, sl, use_v, write_o, row0 + 16 * sc, nv, H); \
        if (sc + 1 < nsub) SB_EG(sc + 1, 1 - (P)); } while (0)
    LAS float* WT = EG + 2048;
    SB_LOAD(0, 0); if (nsub > 1) SB_LOAD(1, 1); SB_EG(0, 0);
    for (int sc2 = 0; sc2 < nsub; sc2 += 2) { SB_ITER(sc2, 0); if (sc2 + 1 < nsub) SB_ITER(sc2 + 1, 1); }
#undef SB_LOAD
#undef SB_EG
#undef SB_ITER
}
constexpr int GP = 264;
__device__ __forceinline__ void gla_pass1_item(const Args& A, LAS unsigned char* lds, int wave, int lane, int b, int hh, int cc, int ig) {
    const bf16_t* PGLA = (const bf16_t*)(A.ws + OFF_PGLA);
    LAS bf16_t* KHT = (LAS bf16_t*)lds; LAS bf16_t* VT = KHT + 64 * GP; LAS float* WT = (LAS float*)(lds + (64 + 128) * GP * 2);
    const int c = lane, l15 = lane & 15, q = lane >> 4, row0 = b * 2048 + cc * 256 + 32 * wave;
    float wgt[16]; const float bgc = A.in[IN_BG][64 * hh + c];
#pragma unroll
    for (int j = 0; j < 16; ++j) wgt[j] = A.in[IN_WG2][j * 256 + 64 * hh + c];
    float cum[32]; float run = 0.f;
#pragma unroll
    for (int tb = 0; tb < 32; tb += 8) {
        u32x4 g0[8], g1[8];
#pragma unroll
        for (int j = 0; j < 8; ++j) { const bf16_t* p = PGLA + (size_t)(row0 + tb + j) * NPGLA; g0[j] = *(const u32x4*)(p + 1024); g1[j] = *(const u32x4*)(p + 1032); }
#pragma unroll
        for (int j = 0; j < 8; ++j) { float lga[16], t8[8];
            unpack8(g0[j], t8);
#pragma unroll
            for (int i = 0; i < 8; ++i) lga[i] = t8[i];
            unpack8(g1[j], t8);
#pragma unroll
            for (int i = 0; i < 8; ++i) lga[8 + i] = t8[i];
            float z = bgc;
#pragma unroll
            for (int i = 0; i < 16; ++i) z += lga[i] * wgt[i];
            run += fsoftplus(-z) * 0.0625f; cum[tb + j] = run; }
    }
    __syncthreads();
    WT[wave * 64 + c] = run;
    __syncthreads();
    float after = 0.f, tot = 0.f;
#pragma unroll
    for (int w2 = 0; w2 < 8; ++w2) { const float tw = WT[w2 * 64 + c]; tot += tw; after += (w2 > wave) ? tw : 0.f; }
#pragma unroll
    for (int tb = 0; tb < 32; tb += 16) {
        bf16_t rk[16]; unsigned rv[16];
#pragma unroll
        for (int j = 0; j < 16; ++j) { const bf16_t* p = PGLA + (size_t)(row0 + tb + j) * NPGLA; rk[j] = p[256 + 64 * hh + c]; rv[j] = *(const unsigned*)(p + 512 + 128 * hh + 2 * lane); }
#pragma unroll
        for (int j = 0; j < 16; ++j) { const int t = tb + j;
            KHT[c * GP + 32 * wave + t] = (bf16_t)f2bf(bf2f(rk[j]) * __expf(-(after + (run - cum[t]))));
            VT[(2 * lane) * GP + 32 * wave + t] = (bf16_t)(rv[j] & 0xffffu); VT[(2 * lane + 1) * GP + 32 * wave + t] = (bf16_t)(rv[j] >> 16); }
    }
    __syncthreads();
    f32x4 acc[4];
#pragma unroll
    for (int kt = 0; kt < 4; ++kt) acc[kt] = (f32x4){0.f, 0.f, 0.f, 0.f};
#pragma unroll
    for (int ks = 0; ks < 8; ++ks) { const bf16x8 bv = *(const LAS bf16x8*)(VT + (16 * wave + l15) * GP + 32 * ks + 8 * q);
#pragma unroll
        for (int kt = 0; kt < 4; ++kt) { const bf16x8 av = *(const LAS bf16x8*)(KHT + (16 * kt + l15) * GP + 32 * ks + 8 * q); acc[kt] = MFMA32(av, bv, acc[kt]); } }
    float* dst = (float*)(A.ws + OFF_GL) + (size_t)ig * 8192 + 16 * wave + l15;
#pragma unroll
    for (int kt = 0; kt < 4; ++kt)
#pragma unroll
        for (int i = 0; i < 4; ++i) dst[(16 * kt + 4 * q + i) * 128] = acc[kt][i];
    if (wave == 7) ((float*)(A.ws + OFF_GG))[ig * 64 + lane] = __expf(-tot);
}
__device__ __forceinline__ void rwkv_sample_iter(const Args& A, LAS unsigned char* lds, int wave, int lane, int sbi) {
    const int l15 = lane & 15, q = lane >> 4;
    f32x4 H[4]; float cumtot = 0.f;
    const int item = 2 * sbi + (wave >> 2), sl = wave & 3, hh = item & 7, b = item >> 3;
    const float* st = A.in[IN_ST_WKV] + (((size_t)b * 8 + hh) * 64 + 16 * sl + l15) * 64 + 4 * q;
#pragma unroll
    for (int kt = 0; kt < 4; ++kt) H[kt] = *(const f32x4*)(st + 16 * kt);
    scan_block<false, 4>(A, lds + (wave >> 2) * GL_BYTES, lane, wave & 3, MP + b * 8, 1, 8, 2, b, hh, sl, true, true, H, cumtot);
    float* o = A.out + OUT_WKV_S + (((size_t)b * 8 + hh) * 64 + 16 * sl + l15) * 64 + 4 * q;
#pragma unroll
    for (int kt = 0; kt < 4; ++kt) *(f32x4*)(o + 16 * kt) = H[kt];
}
__device__ __forceinline__ void p2x_scan1(const Args& A, LAS unsigned char* lds, int wave, int lane) {
    const int l15 = lane & 15, q = lane >> 4;
    for (int it = blockIdx.x; it < 448; it += gridDim.x) {
        f32x4 H[4]; float cumtot = 0.f;
        if (it < 448) {
            const int seq = it / 7, cc = it - seq * 7, b = seq >> 3, hh = seq & 7; const bool isT = wave >= 4; const int sl = wave & 3;
#pragma unroll
            for (int kt = 0; kt < 4; ++kt)
#pragma unroll
                for (int i = 0; i < 4; ++i) H[kt][i] = (isT && (16 * kt + 4 * q + i == 16 * sl + l15)) ? 1.f : 0.f;
            scan_block<false, 8>(A, lds, lane, wave, b * 2048 + cc * 256, 16, 16, cc == 0 ? 1 : 0, 0, hh, sl, !isT, false, H, cumtot);
            float* dst = (float*)(A.ws + OFF_RLT) + (size_t)it * 8192 + (isT ? 4096 : 0) + 16 * sl + l15;
#pragma unroll
            for (int kt = 0; kt < 4; ++kt)
#pragma unroll
                for (int i = 0; i < 4; ++i) dst[(16 * kt + 4 * q + i) * 64] = H[kt][i];
        }
    }
    if (gridDim.x == 256 && blockIdx.x >= 192) {
        for (int sbi = (int)blockIdx.x - 192; sbi < 512; sbi += 64) rwkv_sample_iter(A, lds, wave, lane, sbi);
    }
    __syncthreads();
}
__device__ __forceinline__ void p2y_scan2(const Args& A, LAS unsigned char* lds, int wave, int lane) {
    const int l15 = lane & 15, q = lane >> 4;
    for (int bi = blockIdx.x; bi < 256 + 256 + 512 + 512; bi += gridDim.x) {
        f32x4 H[4]; float cumtot = 0.f;
#pragma unroll
        for (int kt = 0; kt < 4; ++kt) H[kt] = (f32x4){0.f, 0.f, 0.f, 0.f};
        if (bi < 256) {
            const int item = 2 * bi + (wave >> 2), sl = wave & 3, cc = item & 7, seq = item >> 3, b = seq >> 3, hh = seq & 7;
#pragma unroll 2
            for (int j = 0; j < cc; ++j) {
                const float* Lj = (const float*)(A.ws + OFF_RLT) + (size_t)(seq * 7 + j) * 8192; const float* Tj = Lj + 4096;
                const bf16x8 hb0 = hfrag(H[0], H[1]), hb1 = hfrag(H[2], H[3]);
#pragma unroll
                for (int kt = 0; kt < 4; ++kt) {
                    f32x4 acc;
#pragma unroll
                    for (int i = 0; i < 4; ++i) acc[i] = Lj[(16 * kt + 4 * q + i) * 64 + 16 * sl + l15];
                    const float* tr = Tj + (16 * kt + l15) * 64 + 4 * q;
                    const f32x4 t0 = *(const f32x4*)tr, t1 = *(const f32x4*)(tr + 16), t2 = *(const f32x4*)(tr + 32), t3 = *(const f32x4*)(tr + 48);
                    acc = MFMA32(hfrag(t0, t1), hb0, acc); acc = MFMA32(hfrag(t2, t3), hb1, acc);
                    H[kt] = acc;
                }
            }
            scan_block<false, 4>(A, lds + (wave >> 2) * GL_BYTES, lane, wave & 3, b * 2048 + cc * 256, 16, 16, cc == 0 ? 1 : 0, 0, hh, sl, true, true, H, cumtot);
            if (cc == 7) { float* o = A.out + OUT_WKV_P + (((size_t)b * 8 + hh) * 64 + 16 * sl + l15) * 64 + 4 * q;
#pragma unroll
                for (int kt = 0; kt < 4; ++kt) *(f32x4*)(o + 16 * kt) = H[kt]; }
        } else if (bi < 512) {
            const int item = bi - 256, sl = wave, cc = item & 7, seq = item >> 3, b = seq >> 2, hh = seq & 3;
#pragma unroll 2
            for (int j = 0; j < cc; ++j) {
                const float* Lj = (const float*)(A.ws + OFF_GL) + (size_t)(seq * 7 + j) * 8192; const float* Gj = (const float*)(A.ws + OFF_GG) + (seq * 7 + j) * 64;
#pragma unroll
                for (int kt = 0; kt < 4; ++kt)
#pragma unroll
                    for (int i = 0; i < 4; ++i) H[kt][i] = Gj[16 * kt + 4 * q + i] * H[kt][i] + Lj[(16 * kt + 4 * q + i) * 128 + 16 * sl + l15];
            }
            scan_block<true, 8>(A, lds, lane, wave, b * 2048 + cc * 256, 16, 16, 0, 0, hh, sl, true, true, H, cumtot);
            if (cc == 7) { float* o = A.out + OUT_GLA_P + (((size_t)b * 4 + hh) * 64) * 128 + 16 * sl + l15;
#pragma unroll
                for (int kt = 0; kt < 4; ++kt)
#pragma unroll
                    for (int i = 0; i < 4; ++i) o[(size_t)(16 * kt + 4 * q + i) * 128] = H[kt][i]; }
        } else if (bi < 1024) {
            if (gridDim.x != 256) rwkv_sample_iter(A, lds, wave, lane, bi - 512);
        } else {
            const int item = bi - 1024, sl = wave, hh = item & 3, b = item >> 2;
            const float* st = A.in[IN_ST_GLA] + (((size_t)b * 4 + hh) * 64) * 128 + 16 * sl + l15;
#pragma unroll
            for (int kt = 0; kt < 4; ++kt)
#pragma unroll
                for (int i = 0; i < 4; ++i) H[kt][i] = st[(size_t)(16 * kt + 4 * q + i) * 128];
            scan_block<true, 8>(A, lds, lane, wave, MP + b * 8, 1, 8, 0, b, hh, sl, true, true, H, cumtot);
            float* o = A.out + OUT_GLA_S + (((size_t)b * 4 + hh) * 64) * 128 + 16 * sl + l15;
#pragma unroll
            for (int kt = 0; kt < 4; ++kt)
#pragma unroll
                for (int i = 0; i < 4; ++i) o[(size_t)(16 * kt + 4 * q + i) * 128] = H[kt][i];
        }
    }
}
__device__ __forceinline__ void p2c_mix(const Args& A, int r, int col0, u32x4 rcur, u32x4 rprev, float (&xs)[8]) {
    float cur[8], prev[8]; unpack8(rcur, cur);
    const bool first = (r < MP) ? ((r & 2047) == 0) : (((r - MP) & 7) == 0);
    if (!first) unpack8(rprev, prev);
    else if (r < MP) {
#pragma unroll
        for (int i = 0; i < 8; ++i) prev[i] = 0.f;
    } else ld8f(A.in[IN_ST_SHIFT] + (size_t)((r - MP) >> 3) * 1792 + col0, prev);
    float mu[8]; ld8f(A.in[IN_MU] + col0, mu);
#pragma unroll
    for (int i = 0; i < 8; ++i) xs[i] = cur[i] + (prev[i] - cur[i]) * mu[i];
}
__device__ __forceinline__ void p2c_post(const Args& A, int gw, int NGW, int lane, bool shadow) {
    const bf16_t* PRW = (const bf16_t*)(A.ws + OFF_PRW); const bf16_t* PGLA = (const bf16_t*)(A.ws + OFF_PGLA);
    const bf16_t *AARR = (const bf16_t*)((unsigned char*)A.out + OUTB_AARR), *G = (const bf16_t*)(A.ws + OFF_G);
    bf16_t *ORW = (bf16_t*)((unsigned char*)A.out + OUTB_ORW), *OGL = (bf16_t*)((unsigned char*)A.out + OUTB_OGL);
    const int c0 = 8 * lane;
    for (int rb = gw; rb < M; rb += 2 * NGW) {
        u32x4 raw[2][11];
#pragma unroll
        for (int k = 0; k < 2; ++k) { const int r = (rb + k * NGW < M) ? rb + k * NGW : rb; const int rp = r > 0 ? r - 1 : 0;
            raw[k][0] = *(const u32x4*)(ORW + (size_t)r * 512 + c0); raw[k][1] = *(const u32x4*)(OGL + (size_t)r * 512 + c0);
            raw[k][2] = *(const u32x4*)(PRW + (size_t)r * NPRW + c0); raw[k][3] = *(const u32x4*)(PRW + (size_t)r * NPRW + 512 + c0); raw[k][4] = *(const u32x4*)(PRW + (size_t)r * NPRW + 1024 + c0);
            raw[k][5] = *(const u32x4*)(PRW + (size_t)rp * NPRW + c0); raw[k][6] = *(const u32x4*)(PRW + (size_t)rp * NPRW + 512 + c0); raw[k][7] = *(const u32x4*)(PRW + (size_t)rp * NPRW + 1024 + c0);
            raw[k][8] = *(const u32x4*)(AARR + (size_t)r * 512 + c0); raw[k][9] = *(const u32x4*)(G + (size_t)r * 512 + c0); raw[k][10] = *(const u32x4*)(PGLA + (size_t)r * NPGLA + 1040 + c0); }
#pragma unroll
        for (int k = 0; k < 2; ++k) { const int r = rb + k * NGW; if (r < M) {
            float o[8], d[8], xr[8], xk[8], xv[8], a[8], g[8], p[8], res[8];
            unpack8(raw[k][0], o);
            float s1 = 0.f;
#pragma unroll
            for (int i = 0; i < 8; ++i) s1 += o[i];
            const float mu = row8_allsum(s1) * (1.f / 64.f); float s2 = 0.f;
#pragma unroll
            for (int i = 0; i < 8; ++i) { d[i] = o[i] - mu; s2 += d[i] * d[i]; }
            const float rstd = rsqrtf(row8_allsum(s2) * (1.f / 64.f) + 64e-5f);
            p2c_mix(A, r, c0, raw[k][2], raw[k][5], xr); p2c_mix(A, r, 512 + c0, raw[k][3], raw[k][6], xk); p2c_mix(A, r, 1024 + c0, raw[k][4], raw[k][7], xv);
            unpack8(raw[k][8], a); unpack8(raw[k][9], g);
            float bs = 0.f; ld8f(A.in[IN_KA] + c0, p);
#pragma unroll
            for (int i = 0; i < 8; ++i) d[i] *= rstd, xk[i] = xk[i] * (1.f + (a[i] - 1.f) * p[i]);
            ld8f(A.in[IN_RK] + c0, p);
#pragma unroll
            for (int i = 0; i < 8; ++i) bs += xr[i] * xk[i] * p[i];
            bs = row8_allsum(bs);
            ld8f(A.in[IN_LNW] + c0, p); ld8f(A.in[IN_LNB] + c0, a);
#pragma unroll
            for (int i = 0; i < 8; ++i) res[i] = ((d[i] * p[i] + a[i]) + bs * xv[i]) * g[i];
            if (!shadow) *(u32x4*)(ORW + (size_t)r * 512 + c0) = pack8(res); else *(u32x4*)((bf16_t*)(A.ws + 240 * MiB) + (size_t)(r & 8191) * 512 + c0) = pack8(res);
            unpack8(raw[k][1], o);
            float ms = 0.f;
#pragma unroll
            for (int i = 0; i < 8; ++i) ms += o[i] * o[i];
            const float rs = rsqrtf(row16_allsum(ms) * (1.f / 128.f) + NORM_EPS);
            unpack8(raw[k][10], g); ld8f(A.in[IN_GNW] + (c0 & 127), p);
#pragma unroll
            for (int i = 0; i < 8; ++i) res[i] = o[i] * rs * p[i] * (g[i] * fsigmoid(g[i]));
            if (!shadow) *(u32x4*)(OGL + (size_t)r * 512 + c0) = pack8(res); else *(u32x4*)((bf16_t*)(A.ws + 248 * MiB) + (size_t)(r & 8191) * 512 + c0) = pack8(res);
        } }
    }
}
__device__ __forceinline__ void p6_act(const Args& A, int gtid, int NGT) {
    bf16_t* U = (bf16_t*)(A.ws + OFF_U); const bf16_t* UH = (const bf16_t*)(A.ws + OFF_UH);
    const float *convw = A.in[IN_CONVW], *convb = A.in[IN_CONVB], *cstate = A.in[IN_ST_CONV];
    for (int item = gtid; item < (M / 64) * 352; item += NGT) {
        const int rb = item / 352, jc = (item - rb * 352) * 8, r0 = rb * 64; const bool sample = r0 >= MP;
        float p1v[8], p2v[8], p1g[8], p2g[8], w0v[8], w1v[8], w2v[8], cbv[8], w0g[8], w1g[8], w2g[8], cbg[8];
        ld8f(convw + jc, w0v); ld8f(convw + F2 + jc, w1v); ld8f(convw + 2 * F2 + jc, w2v); ld8f(convb + jc, cbv);
        ld8f(convw + FF + jc, w0g); ld8f(convw + F2 + FF + jc, w1g); ld8f(convw + 2 * F2 + FF + jc, w2g); ld8f(convb + FF + jc, cbg);
#pragma unroll
        for (int i = 0; i < 8; ++i) p1v[i] = p2v[i] = p1g[i] = p2g[i] = 0.f;
        if (!sample && (rb & 31) != 0) { const bf16_t* q = UH + (size_t)(rb - 1) * 2 * F2; ld8bf(q + jc, p2v); ld8bf(q + FF + jc, p2g); ld8bf(q + F2 + jc, p1v); ld8bf(q + F2 + FF + jc, p1g); }
        for (int r8 = 0; r8 < 64; r8 += 8) {
            u32x4 rawv[8], rawg[8];
#pragma unroll
            for (int k = 0; k < 8; ++k) { const bf16_t* row = U + (size_t)(r0 + r8 + k) * F2; rawv[k] = *(const u32x4*)(row + jc); rawg[k] = *(const u32x4*)(row + FF + jc); }
            if (sample) { const float* st = cstate + (size_t)((r0 + r8 - MP) >> 3) * 2 * F2; ld8f(st + jc, p2v); ld8f(st + FF + jc, p2g); ld8f(st + F2 + jc, p1v); ld8f(st + F2 + FF + jc, p1g); }
#pragma unroll
            for (int k = 0; k < 8; ++k) {
                float cv[8], cg[8], res[8]; unpack8(rawv[k], cv); unpack8(rawg[k], cg);
#pragma unroll
                for (int i = 0; i < 8; ++i) { const float v = cbv[i] + w0v[i] * p2v[i] + w1v[i] * p1v[i] + w2v[i] * cv[i], gg = cbg[i] + w0g[i] * p2g[i] + w1g[i] * p1g[i] + w2g[i] * cg[i];
                    res[i] = gelu_gate(gg, v); p2v[i] = p1v[i]; p1v[i] = cv[i]; p2g[i] = p1g[i]; p1g[i] = cg[i]; }
                *(u32x4*)(U + (size_t)(r0 + r8 + k) * F2 + jc) = pack8(res);
            }
        }
    }
}
__device__ __forceinline__ void pfix_act(const Args& A, int gtid, int NGT) {
    const bf16_t* UH = (const bf16_t*)(A.ws + OFF_UH); const bf16_t* US = (const bf16_t*)(A.ws + OFF_US); bf16_t* ACT = (bf16_t*)(A.ws + OFF_ACT);
    const float *convw = A.in[IN_CONVW], *convb = A.in[IN_CONVB], *cstate = A.in[IN_ST_CONV];
    for (int idx = gtid; idx < (256 + 128) * 2 * 352; idx += NGT) {
        const int g = idx / 704, rem = idx - g * 704, rsel = rem / 352, jc = (rem - rsel * 352) * 8;
        float cv[8], cg[8], p1v[8], p1g[8], p2v[8], p2g[8], res[8]; int orow;
#pragma unroll
        for (int i = 0; i < 8; ++i) p1v[i] = p1g[i] = p2v[i] = p2g[i] = 0.f;
        if (g < 256) {
            const bool seq0 = (g & 31) == 0; orow = 64 * g + rsel;
            ld8bf(UH + ((size_t)g * 4 + rsel) * F2 + jc, cv); ld8bf(UH + ((size_t)g * 4 + rsel) * F2 + FF + jc, cg);
            if (rsel == 0) { if (!seq0) { const bf16_t* q = UH + ((size_t)(g - 1) * 4 + 3) * F2; ld8bf(q + jc, p1v); ld8bf(q + FF + jc, p1g); q -= F2; ld8bf(q + jc, p2v); ld8bf(q + FF + jc, p2g); } }
            else { const bf16_t* q = UH + ((size_t)g * 4) * F2; ld8bf(q + jc, p1v); ld8bf(q + FF + jc, p1g);
                if (!seq0) { q = UH + ((size_t)(g - 1) * 4 + 3) * F2; ld8bf(q + jc, p2v); ld8bf(q + FF + jc, p2g); } }
        } else {
            const int sb = g - 256; orow = MP + 8 * sb + rsel; const float* st = cstate + (size_t)sb * 2 * F2;
            ld8bf(US + ((size_t)sb * 2 + rsel) * F2 + jc, cv); ld8bf(US + ((size_t)sb * 2 + rsel) * F2 + FF + jc, cg);
            if (rsel == 0) { ld8f(st + jc, p2v); ld8f(st + FF + jc, p2g); ld8f(st + F2 + jc, p1v); ld8f(st + F2 + FF + jc, p1g); }
            else { ld8f(st + F2 + jc, p2v); ld8f(st + F2 + FF + jc, p2g); ld8bf(US + ((size_t)sb * 2) * F2 + jc, p1v); ld8bf(US + ((size_t)sb * 2) * F2 + FF + jc, p1g); }
        }
#pragma unroll
        for (int i = 0; i < 8; ++i) { const int col = jc + i;
            const float v = convb[col] + convw[col] * p2v[i] + convw[F2 + col] * p1v[i] + convw[2 * F2 + col] * cv[i];
            const float gg = convb[FF + col] + convw[FF + col] * p2g[i] + convw[F2 + FF + col] * p1g[i] + convw[2 * F2 + FF + col] * cg[i];
            res[i] = gelu_gate(gg, v); }
        *(u32x4*)(ACT + (size_t)orow * FF + jc) = pack8(res);
    }
}
__device__ __forceinline__ void p8_final(const Args& A, int gw, int NGW, int lane, float* dst) {
    const float* gf = A.in[IN_NORM_FINAL]; const bf16_t* X2 = (const bf16_t*)(A.ws + OFF_X1B);
    for (int m = gw; m < M; m += 2 * NGW) {
        const int m2 = m + NGW; const bool has2 = m2 < M;
        const u32x2* xr = (const u32x2*)(X2 + (size_t)m * DM) + lane; const u32x2* xr2 = (const u32x2*)(X2 + (size_t)(has2 ? m2 : m) * DM) + lane; u32x2 rv[4], rw[4]; f32x4 v[4], w[4]; float s = 0.f, s2 = 0.f;
#pragma unroll
        for (int j = 0; j < 4; ++j) { rv[j] = xr[64 * j]; rw[j] = xr2[64 * j]; }
#pragma unroll
        for (int j = 0; j < 4; ++j) { v[j] = (f32x4){bf_lo(rv[j].x), bf_hi(rv[j].x), bf_lo(rv[j].y), bf_hi(rv[j].y)}; w[j] = (f32x4){bf_lo(rw[j].x), bf_hi(rw[j].x), bf_lo(rw[j].y), bf_hi(rw[j].y)};
            s += (v[j].x * v[j].x + v[j].y * v[j].y) + (v[j].z * v[j].z + v[j].w * v[j].w); s2 += (w[j].x * w[j].x + w[j].y * w[j].y) + (w[j].z * w[j].z + w[j].w * w[j].w); }
        const float rstd = rsqrtf(wave_allsum(s) * (1.f / DM) + NORM_EPS), rstd2 = rsqrtf(wave_allsum(s2) * (1.f / DM) + NORM_EPS);
#pragma unroll
        for (int j = 0; j < 4; ++j) { const f32x4 g = *((const f32x4*)gf + lane + 64 * j); ((f32x4*)(dst + (size_t)m * DM) + lane)[64 * j] = v[j] * rstd * g; if (has2) ((f32x4*)(dst + (size_t)m2 * DM) + lane)[64 * j] = w[j] * rstd2 * g; }
    }
}

#ifndef PHMASK
#define PHMASK 0xFFFF
#endif
#ifndef PHREP
#define PHREP 0
#endif
#define PH(k) for (int rep_ = 0; rep_ < ((((PHMASK) >> (k)) & 1) ? ((((PHREP) >> (k)) & 1) ? 2 : 1) : 0); ++rep_)
__global__ void __launch_bounds__(NTHREADS, 2) fwd_megakernel(Args A) {
    extern __shared__ __attribute__((aligned(16))) unsigned char lds_raw[];
    LAS unsigned char* lds = (LAS unsigned char*)lds_raw;
    cg::grid_group grid = cg::this_grid();
    const int tid = threadIdx.x, lane = tid & 63, wave = __builtin_amdgcn_readfirstlane(tid >> 6);
    const int G = gridDim.x, gw = blockIdx.x * NWAVES + wave, NGW = G * NWAVES;
    unsigned char* ws = A.ws;
    if (tid < 4) ((LAS unsigned*)(lds + 131072))[tid] = 0u;
    __syncthreads();
    const XcdBarrier xbar = xcd_barrier_post((unsigned*)(ws + OFF_BAR), (volatile LAS unsigned*)(lds + 131072));
#define GSYNC() xcd_barrier(xbar)
    PH(0) p0_prologue(A, lds, gw, NGW, wave, lane);
    if (A.ws == nullptr) grid.sync();
    GSYNC();
    PH(1) { pg8::Gemm g{(const bf16_t*)((unsigned char*)A.out + OUTB_H), (const bf16_t*)(ws + OFF_WIN), M, NIN, 1024, 1024}; pg8::StaticOrder S; S.init(M, NIN, G, (int)blockIdx.x);
      EpiProj E{(bf16_t*)(ws + OFF_PRW), (bf16_t*)(ws + OFF_PGLA), (bf16_t*)(ws + OFF_PGATE), A.out + OUT_SHIFT_P, A.out + OUT_SHIFT_S};
      pg8::gemm_phase<EpiProj, pg8::StaticOrder, true, true>(lds, g, S, E); }
    GSYNC();
    PH(2) p2a_lora(A, lds, gw, NGW, wave, lane);
    PH(2) { for (int ig = (int)gridDim.x - 1 - (int)blockIdx.x; ig < 224; ig += (int)gridDim.x) { const int seq = ig / 7, cc = ig - seq * 7; gla_pass1_item(A, lds, wave, lane, seq >> 2, seq & 3, cc, ig); }
      __syncthreads(); }
    GSYNC();
    PH(3) p2x_scan1(A, lds, wave, lane);
    GSYNC();
    PH(11) p2y_scan2(A, lds, wave, lane);
    GSYNC();
#ifdef SHADOW_P2C
    p2c_post(A, gw, NGW, lane, true);
#endif
    PH(4) p2c_post(A, gw, NGW, lane, false);
    GSYNC();
    PH(5) { pg8::StaticOrder S; S.init(M, 1024, G, (int)blockIdx.x); S.limit = __builtin_amdgcn_readfirstlane((S.nwg / G) * G);
      { pg8::Gemm g{(const bf16_t*)((unsigned char*)A.out + OUTB_ORW), (const bf16_t*)(ws + OFF_WOA), M, 1024, 512, 512};
        EpiGate<true> E{(bf16_t*)(ws + OFF_MERGED), (const bf16_t*)(ws + OFF_PGATE)};
        pg8::gemm_phase<EpiGate<true>, pg8::StaticOrder, false, true>(lds, g, S, E);
        tail_gemm(lds, (const bf16_t*)((unsigned char*)A.out + OUTB_ORW), 512, (const bf16_t*)(ws + OFF_WOA), 512, S, wave, lane, TfGate{true, (bf16_t*)(ws + OFF_MERGED), (const bf16_t*)(ws + OFF_PGATE)}); }
      { pg8::Gemm g{(const bf16_t*)((unsigned char*)A.out + OUTB_OGL), (const bf16_t*)(ws + OFF_WOB), M, 1024, 512, 512};
        EpiGate<false> E{(bf16_t*)(ws + OFF_MERGED), (const bf16_t*)(ws + OFF_PGATE) + 1024};
        pg8::gemm_phase<EpiGate<false>, pg8::StaticOrder, false, true>(lds, g, S, E);
        tail_gemm(lds, (const bf16_t*)((unsigned char*)A.out + OUTB_OGL), 512, (const bf16_t*)(ws + OFF_WOB), 512, S, wave, lane, TfGate{false, (bf16_t*)(ws + OFF_MERGED), (const bf16_t*)(ws + OFF_PGATE) + 1024}); } }
    GSYNC();
    PH(6) { pg8::Gemm g{(const bf16_t*)(ws + OFF_MERGED), (const bf16_t*)(ws + OFF_WO), M, 1024, 1024, 1024}; pg8::StaticOrder S; S.init(M, 1024, G, (int)blockIdx.x); S.limit = __builtin_amdgcn_readfirstlane((S.nwg / G) * G);
#ifdef SHADOW_G3
      float* rss = (rep_ == 0) ? (float*)(ws + OFF_ROWSS + 256 * 1024) : (float*)(ws + OFF_ROWSS);
#else
      float* rss = (float*)(ws + OFF_ROWSS);
#endif
      EpiX1 E{A.in[IN_XP], A.in[IN_XS], A.out, (bf16_t*)(ws + OFF_X1B), rss};
      pg8::gemm_phase<EpiX1, pg8::StaticOrder, false, true>(lds, g, S, E);
      tail_gemm(lds, (const bf16_t*)(ws + OFF_MERGED), 1024, (const bf16_t*)(ws + OFF_WO), 1024, S, wave, lane, TfX1{A.in[IN_XP], A.in[IN_XS], A.out, (bf16_t*)(ws + OFF_X1B), rss}); }
    GSYNC();
    PH(7) { pg8::Gemm g{(const bf16_t*)(ws + OFF_X1B), (const bf16_t*)(ws + OFF_WUP), M, F2, 1024, 1024}; pg8::StaticOrder S; S.init(M, F2, G, (int)blockIdx.x);
      EpiAct E{(const float*)(ws + OFF_ROWSS), A.in[IN_CONVW], A.in[IN_CONVB], (bf16_t*)(ws + OFF_ACT), (bf16_t*)(ws + OFF_UH), (bf16_t*)(ws + OFF_US), A.out + OUT_CONV_P, A.out + OUT_CONV_S, (LAS float*)(lds + 131072)};
      pg8::gemm_phase<EpiAct, pg8::StaticOrder, true, true>(lds, g, S, E); }
    __syncthreads(); if (tid < 4) ((LAS unsigned*)(lds + 131072))[tid] = 0u; __syncthreads();
    GSYNC();
    PH(8) pfix_act(A, blockIdx.x * NTHREADS + tid, G * NTHREADS);
    GSYNC();
    PH(9) { pg8::Gemm g{(const bf16_t*)(ws + OFF_ACT), (const bf16_t*)(ws + OFF_WDN), M, 1024, FF, FF}; pg8::StaticOrder S; S.init(M, 1024, G, (int)blockIdx.x); S.limit = __builtin_amdgcn_readfirstlane((S.nwg / G) * G);
      EpiX2 E{(bf16_t*)(ws + OFF_X1B)};
      pg8::gemm_phase<EpiX2, pg8::StaticOrder, false, true>(lds, g, S, E);
      tail_gemm(lds, (const bf16_t*)(ws + OFF_ACT), FF, (const bf16_t*)(ws + OFF_WDN), FF, S, wave, lane, TfX2{(bf16_t*)(ws + OFF_X1B)}); }
    GSYNC();
#ifdef P8_SHADOW
    p8_final(A, gw, NGW, lane, (float*)(ws + OFF_U));
#endif
    PH(10) p8_final(A, gw, NGW, lane, A.out);
#ifdef EXTRA_SYNCS
    for (int i_ = 0; i_ < EXTRA_SYNCS; ++i_) GSYNC();
#endif
}

extern "C" void kernel_launch(void* const* d_in, const int* in_sizes, int n_in, void* d_out, int out_size, void* d_ws, size_t ws_size, hipStream_t stream) {
    static int grid = 0;
    if (grid == 0) {
        int dev = 0, cus = 0, per_cu = 0;
        if (n_in != 31 || ws_size < 256 * MiB) { fprintf(stderr, "kernel_launch: unexpected n_in %d / ws_size %zu\n", n_in, ws_size); grid = -1; return; }
        (void)hipGetDevice(&dev); (void)hipDeviceGetAttribute(&cus, hipDeviceAttributeMultiprocessorCount, dev);
        if (hipFuncSetAttribute((const void*)fwd_megakernel, hipFuncAttributeMaxDynamicSharedMemorySize, LDS_BYTES) != hipSuccess) { fprintf(stderr, "kernel_launch: hipFuncSetAttribute failed\n"); grid = -1; return; }
        if (hipOccupancyMaxActiveBlocksPerMultiprocessor(&per_cu, (const void*)fwd_megakernel, NTHREADS, LDS_BYTES) != hipSuccess || per_cu < 1) { fprintf(stderr, "kernel_launch: occupancy query failed (%d)\n", per_cu); (void)hipGetLastError(); grid = -1; return; }
        grid = cus * 1;
    }
    if (grid < 0) return;
    Args a{};
    for (int i = 0; i < 31; ++i) a.in[i] = (const float*)d_in[i];
    a.out = (float*)d_out; a.ws = (unsigned char*)d_ws;
    if (hipMemsetAsync((char*)d_ws + OFF_BAR, 0, XCD_BAR_WORDS * 4, stream) != hipSuccess) { fprintf(stderr, "kernel_launch: memset of the barrier words failed\n"); return; }
    void* params[] = {&a};
    hipError_t e = hipLaunchCooperativeKernel((const void*)fwd_megakernel, dim3(grid), dim3(NTHREADS), params, LDS_BYTES, stream);
    if (e != hipSuccess) fprintf(stderr, "kernel_launch: cooperative launch failed: %s (grid %d)\n", hipGetErrorString(e), grid);
}
```
